# Optimizing an MI355X kernel written in HIP

```python
import math
import jax, jax.numpy as jnp
from jax import lax
import numpy as np

D_MODEL = 1024
BATCH = 2
SEQ = 8192
DEPTH = 2

P_DIM = 256
N_BRANCH = 4
W_MIX = D_MODEL // 4
HEAD_DIM = 64
N_HEADS = W_MIX // HEAD_DIM
DIFF_DH = HEAD_DIM // 2
ROPE_THETA = 500000.0
ROPE_DIMS = DIFF_DH // 4
Q_BLOCK = 128
RWKV_LORA_W = 64
RWKV_LORA_A = 64
RWKV_LORA_G = 128
RWKV_GN_EPS = 64e-5
DIFF_LN_EPS = 1e-5
GDN_CONV = 4
GDN_CHUNK = 64
FFN_DENSE = 2816
N_EXPERTS = 8
TOP_K = 2
FFN_EXPERT = 3584
MOE_BLOCK = 256
NORM_EPS = 1e-6
N_DENSE = (DEPTH + 1) // 2
N_MOE = DEPTH // 2

RWKV_COLS = 3 * W_MIX + RWKV_LORA_W + RWKV_LORA_A + RWKV_LORA_G
DIFF_COLS = 3 * W_MIX
FOX_COLS = 3 * W_MIX + N_HEADS
GDN_COLS = 4 * W_MIX + 2 * N_HEADS
GATE_COLS = N_BRANCH * D_MODEL
IN_COLS = RWKV_COLS + DIFF_COLS + FOX_COLS + GDN_COLS + GATE_COLS

kernel_name = "hybrid_rwkv7_diffattn_fox_gdn_moe"


def _split(t, sizes):
    return jnp.split(t, [int(c) for c in np.cumsum(sizes)[:-1]], axis=-1)


def rmsnorm(x, g, eps=NORM_EPS):
    xf = x.astype(jnp.float32)
    y = xf * lax.rsqrt(jnp.mean(xf * xf, axis=-1, keepdims=True) + eps)
    return (y * g.astype(jnp.float32)).astype(x.dtype)


def l2norm(x, eps=1e-6):
    xf = x.astype(jnp.float32)
    return xf * lax.rsqrt(jnp.sum(xf * xf, axis=-1, keepdims=True) + eps)


def causal_mask(i, seq):
    qpos = i * Q_BLOCK + jnp.arange(Q_BLOCK)
    return qpos[:, None] >= jnp.arange(seq)[None, :]


def sweep_query_blocks(block_fn, seq):
    out = lax.map(block_fn, jnp.arange(seq // Q_BLOCK))
    nb, b, qb, h, d = out.shape
    return out.transpose(1, 0, 2, 3, 4).reshape(b, nb * qb, h, d)


def partial_rope(x, pos):
    half = ROPE_DIMS // 2
    inv = ROPE_THETA ** (-jnp.arange(half, dtype=jnp.float32) * 2.0 / ROPE_DIMS)
    ang = pos.astype(jnp.float32)[:, None] * inv[None, :]
    shape = (1, pos.shape[0]) + (1,) * (x.ndim - 3) + (half,)
    cos = jnp.cos(ang).reshape(shape)
    sin = jnp.sin(ang).reshape(shape)
    xf = x.astype(jnp.float32)
    x1, x2, rest = xf[..., :half], xf[..., half:ROPE_DIMS], xf[..., ROPE_DIMS:]
    return jnp.concatenate([x1 * cos - x2 * sin, x2 * cos + x1 * sin, rest], axis=-1).astype(x.dtype)


def causal_conv(u, w):
    seq = u.shape[1]
    k = w.shape[-1]
    up = jnp.pad(u, ((0, 0), (k - 1, 0), (0, 0)))
    return sum(up[:, j:j + seq, :] * w[:, j] for j in range(k))


def rwkv7_scan(r, w, k, v, kk, a):
    b, s, h, n = r.shape

    def step(state, inp):
        r_t, w_t, k_t, v_t, kk_t, a_t = inp
        sa = jnp.einsum('bhvk,bhk->bhv', state, -kk_t)
        state = (state * w_t[:, :, None, :]
                 + sa[..., None] * (kk_t * a_t)[:, :, None, :]
                 + v_t[..., None] * k_t[:, :, None, :])
        return state, jnp.einsum('bhvk,bhk->bhv', state, r_t)

    xs = tuple(t.transpose(1, 0, 2, 3) for t in (r, w, k, v, kk, a))
    _, o = lax.scan(step, jnp.zeros((b, h, n, n), jnp.float32), xs)
    return o.transpose(1, 0, 2, 3)


def rwkv7_branch(u, mu, w0, w2, a0, a2, g2, k_k, k_a, r_k, ln_w, ln_b):
    b, s, _ = u.shape
    u = u.astype(jnp.float32)
    u_prev = jnp.pad(u, ((0, 0), (1, 0), (0, 0)))[:, :s]
    xm = u + (u_prev - u) * mu
    r, k, v, xw, xa, xg = _split(xm, [W_MIX, W_MIX, W_MIX, RWKV_LORA_W, RWKV_LORA_A, RWKV_LORA_G])
    logw = -jax.nn.softplus(-(w0 + jnp.tanh(xw) @ w2)) - 0.5
    decay = jnp.exp(-jnp.exp(logw))
    a = jax.nn.sigmoid(a0 + xa @ a2)
    g = jax.nn.sigmoid(xg) @ g2
    heads = lambda t: t.reshape(b, s, N_HEADS, HEAD_DIM)
    kk = l2norm(heads(k * k_k))
    k = k * (1.0 + (a - 1.0) * k_a)
    r_h, k_h, v_h, w_h, a_h = map(heads, (r, k, v, decay, a))
    o = rwkv7_scan(r_h, w_h, k_h, v_h, kk, a_h)
    mean = jnp.mean(o, axis=-1, keepdims=True)
    var = jnp.mean((o - mean) ** 2, axis=-1, keepdims=True)
    o = ((o - mean) * lax.rsqrt(var + RWKV_GN_EPS)).reshape(b, s, W_MIX) * ln_w + ln_b
    bonus = jnp.sum(r_h * k_h * r_k, axis=-1, keepdims=True) * v_h
    return (o + bonus.reshape(b, s, W_MIX)) * g


def diff_branch(u, pos, lam_p, subln_w, layer_idx):
    b, s, _ = u.shape
    q, k, v = _split(u, [W_MIX, W_MIX, W_MIX])
    q = partial_rope(q.reshape(b, s, N_HEADS, 2, DIFF_DH), pos)
    k = partial_rope(k.reshape(b, s, N_HEADS, 2, DIFF_DH), pos)
    v = v.reshape(b, s, N_HEADS, HEAD_DIM)
    lam_init = 0.8 - 0.6 * math.exp(-0.3 * layer_idx)
    lp = lam_p.astype(jnp.float32)
    lam = jnp.exp(jnp.sum(lp[0] * lp[1])) - jnp.exp(jnp.sum(lp[2] * lp[3])) + lam_init
    scale = DIFF_DH ** -0.5

    def blk(i):
        qs = lax.dynamic_slice_in_dim(q, i * Q_BLOCK, Q_BLOCK, axis=1)
        sc = jnp.einsum('bqhcd,bkhcd->bhcqk', qs, k).astype(jnp.float32) * scale
        sc = jnp.where(causal_mask(i, s)[None, None, None], sc, -jnp.inf)
        pm = jax.nn.softmax(sc, axis=-1)
        pd = pm[:, :, 0] - lam * pm[:, :, 1]
        return jnp.einsum('bhqk,bkhd->bqhd', pd.astype(v.dtype), v)

    o = sweep_query_blocks(blk, s)
    o = rmsnorm(o, subln_w, DIFF_LN_EPS) * (1.0 - lam_init)
    return o.reshape(b, s, W_MIX)


def fox_branch(u, f_bias):
    b, s, _ = u.shape
    q, k, v, fl = _split(u, [W_MIX, W_MIX, W_MIX, N_HEADS])
    q = q.reshape(b, s, N_HEADS, HEAD_DIM)
    k = k.reshape(b, s, N_HEADS, HEAD_DIM)
    v = v.reshape(b, s, N_HEADS, HEAD_DIM)
    logf = jax.nn.log_sigmoid(fl.astype(jnp.float32) + f_bias.astype(jnp.float32))
    c = jnp.cumsum(logf, axis=1).transpose(0, 2, 1)
    scale = HEAD_DIM ** -0.5

    def blk(i):
        qs = lax.dynamic_slice_in_dim(q, i * Q_BLOCK, Q_BLOCK, axis=1)
        cq = lax.dynamic_slice_in_dim(c, i * Q_BLOCK, Q_BLOCK, axis=2)
        sc = jnp.einsum('bqhd,bkhd->bhqk', qs, k).astype(jnp.float32) * scale
        sc = sc + (cq[..., :, None] - c[:, :, None, :])
        sc = jnp.where(causal_mask(i, s)[None, None], sc, -jnp.inf)
        pm = jax.nn.softmax(sc, axis=-1)
        return jnp.einsum('bhqk,bkhd->bqhd', pm.astype(v.dtype), v)

    return sweep_query_blocks(blk, s).reshape(b, s, W_MIX)


def gated_delta_chunked(q, k, v, g, beta):
    b, s, h, dk = q.shape
    dv = v.shape[-1]
    c = GDN_CHUNK
    nc = s // c
    chunks = lambda t: t.reshape(b, nc, c, h, t.shape[-1]).transpose(1, 0, 3, 2, 4)
    q, k, v = chunks(q), chunks(k), chunks(v)
    g = g.reshape(b, nc, c, h).transpose(1, 0, 3, 2)
    beta = beta.reshape(b, nc, c, h).transpose(1, 0, 3, 2)
    gam = jnp.cumsum(g, axis=-1)
    idx = jnp.arange(c)
    incl = idx[:, None] >= idx[None, :]
    strict = idx[:, None] > idx[None, :]
    decay = jnp.exp(jnp.where(incl, gam[..., :, None] - gam[..., None, :], -jnp.inf))
    kk = jnp.einsum('nbhik,nbhjk->nbhij', k, k)
    a_mat = jnp.where(strict, beta[..., :, None] * decay * kk, 0.0) + jnp.eye(c, dtype=jnp.float32)
    rhs = jnp.concatenate([beta[..., None] * v, (beta * jnp.exp(gam))[..., None] * k], axis=-1)
    sol = lax.linalg.triangular_solve(a_mat, rhs, left_side=True, lower=True, unit_diagonal=True)
    u0, wm = sol[..., :dv], sol[..., dv:]
    qk = jnp.einsum('nbhik,nbhjk->nbhij', q, k) * decay

    def step(state, xs):
        qc, kc, u0c, wc, qkc, gc = xs
        uc = u0c - jnp.einsum('bhck,bhkv->bhcv', wc, state)
        o = jnp.exp(gc)[..., None] * jnp.einsum('bhck,bhkv->bhcv', qc, state) + jnp.einsum('bhij,bhjv->bhiv', qkc, uc)
        gl = gc[..., -1:]
        state = jnp.exp(gl)[..., None] * state + jnp.einsum('bhjk,bhjv->bhkv', kc * jnp.exp(gl - gc)[..., None], uc)
        return state, o

    _, o = lax.scan(step, jnp.zeros((b, h, dk, dv), jnp.float32), (q, k, u0, wm, qk, gam))
    return o.transpose(1, 0, 3, 2, 4).reshape(b, s, h, dv)


def gdn_branch(u, conv_w, a_log, dt_bias, norm_w):
    b, s, _ = u.shape
    qkv, b_l, a_l, gate = _split(u, [3 * W_MIX, N_HEADS, N_HEADS, W_MIX])
    qkv = jax.nn.silu(causal_conv(qkv, conv_w))
    q, k, v = _split(qkv, [W_MIX, W_MIX, W_MIX])
    heads = lambda t: t.reshape(b, s, N_HEADS, HEAD_DIM)
    q = l2norm(heads(q)) * (HEAD_DIM ** -0.5)
    k = l2norm(heads(k))
    v = heads(v).astype(jnp.float32)
    beta = jax.nn.sigmoid(b_l.astype(jnp.float32))
    g = -jnp.exp(a_log.astype(jnp.float32)) * jax.nn.softplus(a_l.astype(jnp.float32) + dt_bias)
    o = gated_delta_chunked(q, k, v, g, beta)
    o = rmsnorm(o, norm_w) * jax.nn.silu(heads(gate).astype(jnp.float32))
    return o.reshape(b, s, W_MIX)


def hybrid_mixer(h, pos, layer_idx, w_in, w_bo, w_out,
                 rwkv_mu, rwkv_w0, rwkv_w2, rwkv_a0, rwkv_a2, rwkv_g2, rwkv_kk, rwkv_ka, rwkv_rk,
                 rwkv_ln_w, rwkv_ln_b, diff_lam, diff_subln, fox_fbias,
                 gdn_conv, gdn_a_log, gdn_dt_bias, gdn_norm):
    b, s, _ = h.shape
    u = h @ w_in
    u_a, u_b, u_c, u_d, u_g = _split(u, [RWKV_COLS, DIFF_COLS, FOX_COLS, GDN_COLS, GATE_COLS])
    y_a = rwkv7_branch(u_a, rwkv_mu, rwkv_w0, rwkv_w2, rwkv_a0, rwkv_a2, rwkv_g2,
                       rwkv_kk, rwkv_ka, rwkv_rk, rwkv_ln_w, rwkv_ln_b).astype(h.dtype)
    y_b = diff_branch(u_b, pos, diff_lam, diff_subln, layer_idx).astype(h.dtype)
    y_c = fox_branch(u_c, fox_fbias).astype(h.dtype)
    y_d = gdn_branch(u_d, gdn_conv, gdn_a_log, gdn_dt_bias, gdn_norm).astype(h.dtype)
    ys = jnp.stack([y_a, y_b, y_c, y_d], axis=2)
    proj = jnp.einsum('bsnw,nwd->bsnd', ys, w_bo)
    gates = jax.nn.sigmoid(u_g.reshape(b, s, N_BRANCH, D_MODEL))
    return jnp.sum(gates * proj, axis=2) @ w_out


def swiglu(h, wg, wu, wd):
    return (jax.nn.silu(h @ wg) * (h @ wu)) @ wd


def moe_swiglu(h, router, wg, wu, wd):
    b, s, d = h.shape
    n = b * s
    xf = h.reshape(n, d)
    logits = (xf @ router).astype(jnp.float32)
    top_l, top_i = lax.top_k(logits, TOP_K)
    gate = jax.nn.softmax(top_l, axis=-1)
    na = n * TOP_K
    e = top_i.reshape(na)
    tok = jnp.arange(na) // TOP_K
    order = jnp.argsort(e)
    e_s, tok_s, w_s = e[order], tok[order], gate.reshape(na)[order]
    counts = jnp.zeros((N_EXPERTS,), jnp.int32).at[e].add(1)
    pcounts = (counts + MOE_BLOCK - 1) // MOE_BLOCK * MOE_BLOCK
    offs = jnp.cumsum(counts) - counts
    pends = jnp.cumsum(pcounts)
    poffs = pends - pcounts
    dest = poffs[e_s] + (jnp.arange(na) - offs[e_s])
    nb = (na + MOE_BLOCK - 1) // MOE_BLOCK + N_EXPERTS
    xbuf = jnp.zeros((nb * MOE_BLOCK, d), xf.dtype).at[dest].set(xf[tok_s])
    starts = jnp.arange(nb) * MOE_BLOCK
    blk_e = jnp.minimum(jnp.sum(pends[None, :] <= starts[:, None], axis=1), N_EXPERTS - 1)

    def run(args):
        xb, eb = args
        return (jax.nn.silu(xb @ wg[eb]) * (xb @ wu[eb])) @ wd[eb]

    ybuf = lax.map(run, (xbuf.reshape(nb, MOE_BLOCK, d), blk_e)).reshape(nb * MOE_BLOCK, d)
    y = jax.ops.segment_sum(ybuf[dest] * w_s[:, None].astype(xf.dtype), tok_s, num_segments=n)
    return y.reshape(b, s, d)


def setup_inputs(seed: int = 0) -> dict:
    key = jax.random.key(seed)
    ks = jax.random.split(key, 36)
    nrm = lambda i, shape, sc: sc * jax.random.normal(ks[i], shape, jnp.float32)
    uni = lambda i, shape, lo, hi: jax.random.uniform(ks[i], shape, jnp.float32, lo, hi)
    dt = jnp.exp(uni(24, (DEPTH, N_HEADS), math.log(1e-3), math.log(1e-1)))
    return {
        "x": nrm(0, (BATCH, SEQ, D_MODEL), 1.0),
        "p": nrm(1, (DEPTH, BATCH, SEQ, P_DIM), 1.0),
        "norm_mix": 1.0 + nrm(2, (DEPTH, D_MODEL), 0.02),
        "norm_ffn": 1.0 + nrm(3, (DEPTH, D_MODEL), 0.02),
        "norm_ple": 1.0 + nrm(4, (DEPTH, D_MODEL), 0.02),
        "w_in": nrm(5, (DEPTH, D_MODEL, IN_COLS), D_MODEL ** -0.5),
        "w_bo": nrm(6, (DEPTH, N_BRANCH, W_MIX, D_MODEL), W_MIX ** -0.5),
        "w_out": nrm(7, (DEPTH, D_MODEL, D_MODEL), D_MODEL ** -0.5),
        "rwkv_mu": uni(8, (DEPTH, RWKV_COLS), 0.0, 1.0),
        "rwkv_w0": uni(9, (DEPTH, W_MIX), -4.0, 0.0),
        "rwkv_w2": nrm(10, (DEPTH, RWKV_LORA_W, W_MIX), 0.5 * RWKV_LORA_W ** -0.5),
        "rwkv_a0": nrm(11, (DEPTH, W_MIX), 0.1),
        "rwkv_a2": nrm(12, (DEPTH, RWKV_LORA_A, W_MIX), RWKV_LORA_A ** -0.5),
        "rwkv_g2": nrm(13, (DEPTH, RWKV_LORA_G, W_MIX), RWKV_LORA_G ** -0.5),
        "rwkv_kk": 0.85 + nrm(14, (DEPTH, W_MIX), 0.05),
        "rwkv_ka": 1.0 + nrm(15, (DEPTH, W_MIX), 0.05),
        "rwkv_rk": nrm(16, (DEPTH, N_HEADS, HEAD_DIM), 0.1),
        "rwkv_ln_w": 1.0 + nrm(17, (DEPTH, W_MIX), 0.02),
        "rwkv_ln_b": nrm(18, (DEPTH, W_MIX), 0.02),
        "diff_lam": nrm(19, (DEPTH, 4, DIFF_DH), 0.1),
        "diff_subln": 1.0 + nrm(20, (DEPTH, HEAD_DIM), 0.02),
        "fox_fbias": 3.0 + nrm(21, (DEPTH, N_HEADS), 0.5),
        "gdn_conv": nrm(22, (DEPTH, 3 * W_MIX, GDN_CONV), GDN_CONV ** -0.5),
        "gdn_a_log": jnp.log(uni(23, (DEPTH, N_HEADS), 1.0, 16.0)),
        "gdn_dt_bias": dt + jnp.log(-jnp.expm1(-dt)),
        "gdn_norm": 1.0 + nrm(25, (DEPTH, HEAD_DIM), 0.02),
        "ffn_w_gate": nrm(26, (N_DENSE, D_MODEL, FFN_DENSE), D_MODEL ** -0.5),
        "ffn_w_up": nrm(27, (N_DENSE, D_MODEL, FFN_DENSE), D_MODEL ** -0.5),
        "ffn_w_down": nrm(28, (N_DENSE, FFN_DENSE, D_MODEL), FFN_DENSE ** -0.5),
        "moe_router": nrm(29, (N_MOE, D_MODEL, N_EXPERTS), D_MODEL ** -0.5),
        "moe_w_gate": nrm(30, (N_MOE, N_EXPERTS, D_MODEL, FFN_EXPERT), D_MODEL ** -0.5),
        "moe_w_up": nrm(31, (N_MOE, N_EXPERTS, D_MODEL, FFN_EXPERT), D_MODEL ** -0.5),
        "moe_w_down": nrm(32, (N_MOE, N_EXPERTS, FFN_EXPERT, D_MODEL), FFN_EXPERT ** -0.5),
        "ple_proj": nrm(33, (DEPTH, P_DIM, D_MODEL), P_DIM ** -0.5),
        "ple_gate": nrm(34, (DEPTH, D_MODEL, D_MODEL), D_MODEL ** -0.5),
        "final_norm": 1.0 + nrm(35, (D_MODEL,), 0.02),
    }


def reference(x, p, norm_mix, norm_ffn, norm_ple, w_in, w_bo, w_out,
              rwkv_mu, rwkv_w0, rwkv_w2, rwkv_a0, rwkv_a2, rwkv_g2, rwkv_kk, rwkv_ka, rwkv_rk,
              rwkv_ln_w, rwkv_ln_b, diff_lam, diff_subln, fox_fbias,
              gdn_conv, gdn_a_log, gdn_dt_bias, gdn_norm,
              ffn_w_gate, ffn_w_up, ffn_w_down,
              moe_router, moe_w_gate, moe_w_up, moe_w_down,
              ple_proj, ple_gate, final_norm):
    pos = jnp.arange(x.shape[1])
    for i in range(DEPTH):
        h = rmsnorm(x, norm_mix[i])
        x = x + hybrid_mixer(h, pos, i, w_in[i], w_bo[i], w_out[i],
                             rwkv_mu[i], rwkv_w0[i], rwkv_w2[i], rwkv_a0[i], rwkv_a2[i], rwkv_g2[i],
                             rwkv_kk[i], rwkv_ka[i], rwkv_rk[i], rwkv_ln_w[i], rwkv_ln_b[i],
                             diff_lam[i], diff_subln[i], fox_fbias[i],
                             gdn_conv[i], gdn_a_log[i], gdn_dt_bias[i], gdn_norm[i])
        h = rmsnorm(x, norm_ffn[i])
        j = i // 2
        if i % 2 == 0:
            x = x + swiglu(h, ffn_w_gate[j], ffn_w_up[j], ffn_w_down[j])
        else:
            x = x + moe_swiglu(h, moe_router[j], moe_w_gate[j], moe_w_up[j], moe_w_down[j])
        h = rmsnorm(x, norm_ple[i])
        x = x + jax.nn.sigmoid(h @ ple_gate[i]) * (p[i] @ ple_proj[i])
    return rmsnorm(x, final_norm)
```

```cpp
#include <hip/hip_runtime.h>
#include <hip/hip_cooperative_groups.h>
#include <cstdio>
#include <cstdint>
namespace cg = cooperative_groups;

typedef unsigned short bf16_t;
typedef short bf16x8 __attribute__((ext_vector_type(8)));
typedef short s16x4 __attribute__((ext_vector_type(4)));
typedef float f32x4 __attribute__((ext_vector_type(4)));
typedef float f32x2 __attribute__((ext_vector_type(2)));
typedef float f32x16 __attribute__((ext_vector_type(16)));
typedef unsigned u32x4 __attribute__((ext_vector_type(4)));
typedef unsigned u32x2 __attribute__((ext_vector_type(2)));
typedef __bf16 bf16x2_t __attribute__((ext_vector_type(2)));

#define DI __device__ __forceinline__

constexpr int NTOK = 16384, DM = 1024, SEQ = 8192, NBH = 8;
constexpr int INC = 7692, UC = 3712;
constexpr int OFF_B = 1024, OFF_C = 1792, OFF_D = 2564, OFF_G = 3596;
constexpr int FFD = 2816, FFE = 3584, NEXP = 8;
constexpr int NTHR = 512;

constexpr size_t al256(size_t x) { return (x + 255) & ~(size_t)255; }
constexpr size_t O_WIN = 0;
constexpr size_t SZ_WIN = al256((size_t)INC * DM * 2);
constexpr size_t O_WBO = O_WIN + 2 * SZ_WIN;
constexpr size_t O_WOUT = O_WBO + (size_t)2 * 4 * 1024 * 256 * 2;
constexpr size_t O_PG = O_WOUT + (size_t)2 * 1024 * 1024 * 2;
constexpr size_t O_PP = O_PG + (size_t)2 * 1024 * 1024 * 2;
constexpr size_t O_FGU = O_PP + (size_t)2 * 1024 * 256 * 2;
constexpr size_t O_FD = O_FGU + (size_t)2 * FFD * 1024 * 2;
constexpr size_t O_MGU = O_FD + (size_t)1024 * FFD * 2;
constexpr size_t O_MD = O_MGU + (size_t)NEXP * 2 * FFE * 1024 * 2;
constexpr size_t O_PB = O_MD + (size_t)NEXP * 1024 * FFE * 2;
constexpr size_t O_HB = O_PB + (size_t)2 * NTOK * 256 * 2;
constexpr size_t O_SMALL = O_HB + (size_t)NTOK * DM * 2;
constexpr size_t SM_CTR = 0;
constexpr size_t SM_LIST = 256;
constexpr size_t SM_GW = SM_LIST + (size_t)NEXP * NTOK * 4;
constexpr size_t SM_RK = SM_GW + (size_t)NEXP * NTOK * 4;
constexpr size_t SM_LOGF = SM_RK + (size_t)NTOK * 4 * 4;
constexpr size_t SM_GBETA = SM_LOGF + (size_t)NBH * SEQ * 4;
constexpr size_t SM_GA = SM_GBETA + (size_t)NBH * SEQ * 4;
constexpr size_t SZ_SMALL = al256(SM_GA + (size_t)NBH * SEQ * 4);
constexpr size_t O_R = O_SMALL + SZ_SMALL;
constexpr size_t R_U = 0;
constexpr size_t R_Y = 0;
constexpr size_t R_M = (size_t)NTOK * DM * 2;
constexpr size_t SZ_U = (size_t)NTOK * UC * 2;
constexpr size_t SZ_BH = (size_t)NBH * SEQ * 64 * 2;
constexpr size_t R_RWA = R_U + SZ_U, R_RWB = R_RWA + SZ_BH, R_RWK = R_RWB + SZ_BH, R_RWR = R_RWK + SZ_BH, R_RWV = R_RWR + SZ_BH;
constexpr size_t R_RWW = R_RWV + SZ_BH;
constexpr size_t R_GQ = R_RWW + 2 * SZ_BH, R_GK = R_GQ + SZ_BH, R_GV = R_GK + SZ_BH;
constexpr size_t R_QD = R_GV + SZ_BH, R_KD = R_QD + SZ_BH, R_VD = R_KD + SZ_BH, R_QF = R_VD + SZ_BH, R_KF = R_QF + SZ_BH, R_VF = R_KF + SZ_BH;
constexpr size_t R_AUXG = R_VF + SZ_BH;
constexpr size_t R_AUXGATE = R_AUXG + (size_t)NTOK * 256 * 2;
constexpr size_t R_END_MIX = R_AUXGATE + (size_t)NTOK * 256 * 2;
constexpr size_t R_T = 0;
constexpr size_t R_END_MOE = (size_t)33792 * FFE * 2;
constexpr size_t WS_NEED = O_R + (R_END_MIX > R_END_MOE ? R_END_MIX : R_END_MOE);

struct Params {
  const float* in[36];
  float* x;
  char* ws;
};

DI float bf2f(bf16_t b) { return __uint_as_float(((unsigned)b) << 16); }
DI bf16_t f2bf(float x) { unsigned u = __float_as_uint(x); u += 0x7fffu + ((u >> 16) & 1u); return (bf16_t)(u >> 16); }
DI unsigned pk2(float lo, float hi) { f32x2 v = {lo, hi}; bf16x2_t b = __builtin_convertvector(v, bf16x2_t); return __builtin_bit_cast(unsigned, b); }
DI float sigmoidf_(float x) { return 1.0f / (1.0f + __expf(-x)); }
DI float wave_sum(float v) {
#pragma unroll
  for (int o = 32; o >= 1; o >>= 1) v += __shfl_xor(v, o);
  return v;
}
DI int crow(int r, int hi) { return (r & 3) + 8 * (r >> 2) + 4 * hi; }
DI void gsync() { cg::this_grid().sync(); }
DI int otid() { int t = threadIdx.x; asm volatile("" : "+v"(t)); return t; }
DI int obid() { int t = blockIdx.x; asm volatile("" : "+s"(t)); return t; }
DI Params olaunder(const Params& p) { Params q = p; asm volatile("" : "+s"(q.ws), "+s"(q.x)); return q; }

DI void transpose_job(const float* __restrict__ src, int K, int N, bf16_t* __restrict__ dst, int rmul, int radd, char* lds) {
  float* tl = (float*)lds;
  const int tk = K / 64, tn = (N + 63) / 64, nt = tk * tn, tid = otid();
  for (int t = obid(); t < nt; t += gridDim.x) {
    const int k0 = (t / tn) * 64, n0 = (t % tn) * 64;
    __syncthreads();
    {
      const int kr = tid >> 3, nc = (tid & 7) * 4;
#pragma unroll
      for (int i = 0; i < 2; ++i) {
        const int n = n0 + nc + 32 * i;
        f32x4 v = {0.f, 0.f, 0.f, 0.f};
        if (n < N) v = *(const f32x4*)(src + (size_t)(k0 + kr) * N + n);
        float* d = tl + kr * 65 + nc + 32 * i;
        d[0] = v[0]; d[1] = v[1]; d[2] = v[2]; d[3] = v[3];
      }
    }
    __syncthreads();
    {
      const int nr = tid >> 3, kc = (tid & 7) * 8, n = n0 + nr;
      if (n < N) {
        u32x4 w;
        w[0] = pk2(tl[(kc + 0) * 65 + nr], tl[(kc + 1) * 65 + nr]);
        w[1] = pk2(tl[(kc + 2) * 65 + nr], tl[(kc + 3) * 65 + nr]);
        w[2] = pk2(tl[(kc + 4) * 65 + nr], tl[(kc + 5) * 65 + nr]);
        w[3] = pk2(tl[(kc + 6) * 65 + nr], tl[(kc + 7) * 65 + nr]);
        *(u32x4*)(dst + ((size_t)n * rmul + radd) * K + k0 + kc) = w;
      }
    }
  }
}

DI void phase0(const Params& p, char* lds) {
  char* ws = p.ws;
  const int gtid = obid() * NTHR + otid(), gsz = gridDim.x * NTHR;
  if (obid() == 0 && otid() < 64) ((int*)(ws + O_SMALL + SM_CTR))[otid()] = 0;
  {
    const f32x4* s = (const f32x4*)p.in[0]; f32x4* d = (f32x4*)p.x;
    for (int i = gtid; i < NTOK * DM / 4; i += gsz) d[i] = s[i];
  }
  {
    const f32x4* s = (const f32x4*)p.in[1]; u32x2* d = (u32x2*)(ws + O_PB);
    for (int i = gtid; i < 2 * NTOK * 256 / 4; i += gsz) { f32x4 v = s[i]; u32x2 w; w[0] = pk2(v[0], v[1]); w[1] = pk2(v[2], v[3]); d[i] = w; }
  }
  for (int L = 0; L < 2; ++L) {
    transpose_job(p.in[5] + (size_t)L * DM * INC, 1024, INC, (bf16_t*)(ws + O_WIN + L * SZ_WIN), 1, 0, lds);
    for (int b = 0; b < 4; ++b)
      transpose_job(p.in[6] + (size_t)(L * 4 + b) * 256 * 1024, 256, 1024, (bf16_t*)(ws + O_WBO) + (size_t)(L * 4 + b) * 1024 * 256, 1, 0, lds);
    transpose_job(p.in[7] + (size_t)L * 1024 * 1024, 1024, 1024, (bf16_t*)(ws + O_WOUT) + (size_t)L * 1024 * 1024, 1, 0, lds);
    transpose_job(p.in[34] + (size_t)L * 1024 * 1024, 1024, 1024, (bf16_t*)(ws + O_PG) + (size_t)L * 1024 * 1024, 1, 0, lds);
    transpose_job(p.in[33] + (size_t)L * 256 * 1024, 256, 1024, (bf16_t*)(ws + O_PP) + (size_t)L * 1024 * 256, 1, 0, lds);
  }
  transpose_job(p.in[26], 1024, FFD, (bf16_t*)(ws + O_FGU), 2, 0, lds);
  transpose_job(p.in[27], 1024, FFD, (bf16_t*)(ws + O_FGU), 2, 1, lds);
  transpose_job(p.in[28], FFD, 1024, (bf16_t*)(ws + O_FD), 1, 0, lds);
  for (int e = 0; e < NEXP; ++e) {
    transpose_job(p.in[30] + (size_t)e * 1024 * FFE, 1024, FFE, (bf16_t*)(ws + O_MGU) + (size_t)e * 2 * FFE * 1024, 2, 0, lds);
    transpose_job(p.in[31] + (size_t)e * 1024 * FFE, 1024, FFE, (bf16_t*)(ws + O_MGU) + (size_t)e * 2 * FFE * 1024, 2, 1, lds);
    transpose_job(p.in[32] + (size_t)e * FFE * 1024, FFE, 1024, (bf16_t*)(ws + O_MD) + (size_t)e * 1024 * FFE, 1, 0, lds);
  }
}

template <bool ROUTER>
DI void norm_phase(const Params& p, const float* __restrict__ g, const float* __restrict__ router) {
  const int lane = otid() & 63, wid = otid() >> 6;
  bf16_t* hb = (bf16_t*)(p.ws + O_HB);
  int* cnt = (int*)(p.ws + O_SMALL + SM_CTR) + 32;
  int* list = (int*)(p.ws + O_SMALL + SM_LIST);
  float* gw = (float*)(p.ws + O_SMALL + SM_GW);
  for (int row = obid() * 8 + wid; row < NTOK; row += gridDim.x * 8) {
    const float* xr = p.x + (size_t)row * DM;
    f32x4 v[4]; float ss = 0.f;
#pragma unroll
    for (int j = 0; j < 4; ++j) { v[j] = *(const f32x4*)(xr + j * 256 + lane * 4); ss += v[j][0] * v[j][0] + v[j][1] * v[j][1] + v[j][2] * v[j][2] + v[j][3] * v[j][3]; }
    ss = wave_sum(ss);
    const float rstd = rsqrtf(ss * (1.0f / 1024.0f) + 1e-6f);
    float lg[8];
    if (ROUTER) {
#pragma unroll
      for (int e = 0; e < 8; ++e) lg[e] = 0.f;
    }
#pragma unroll
    for (int j = 0; j < 4; ++j) {
      const f32x4 gg = *(const f32x4*)(g + j * 256 + lane * 4);
      f32x4 h = v[j] * rstd * gg;
      u32x2 w; w[0] = pk2(h[0], h[1]); w[1] = pk2(h[2], h[3]);
      *(u32x2*)(hb + (size_t)row * DM + j * 256 + lane * 4) = w;
      if (ROUTER) {
#pragma unroll
        for (int c = 0; c < 4; ++c) {
          const float* rr = router + (size_t)(j * 256 + lane * 4 + c) * 8;
          const f32x4 r0 = *(const f32x4*)rr, r1 = *(const f32x4*)(rr + 4);
          lg[0] += h[c] * r0[0]; lg[1] += h[c] * r0[1]; lg[2] += h[c] * r0[2]; lg[3] += h[c] * r0[3];
          lg[4] += h[c] * r1[0]; lg[5] += h[c] * r1[1]; lg[6] += h[c] * r1[2]; lg[7] += h[c] * r1[3];
        }
      }
    }
    if (ROUTER) {
#pragma unroll
      for (int e = 0; e < 8; ++e) lg[e] = wave_sum(lg[e]);
      if (lane == 0) {
        int e1 = 0; float l1 = lg[0];
#pragma unroll
        for (int e = 1; e < 8; ++e) if (lg[e] > l1) { l1 = lg[e]; e1 = e; }
        int e2 = -1; float l2 = -INFINITY;
#pragma unroll
        for (int e = 0; e < 8; ++e) if (e != e1 && lg[e] > l2) { l2 = lg[e]; e2 = e; }
        const float w1 = 1.0f / (1.0f + __expf(l2 - l1)), w2 = 1.0f - w1;
        int s1 = atomicAdd(cnt + e1, 1); list[e1 * NTOK + s1] = row; gw[e1 * NTOK + s1] = w1;
        int s2 = atomicAdd(cnt + e2, 1); list[e2 * NTOK + s2] = row; gw[e2 * NTOK + s2] = w2;
      }
    }
  }
}

constexpr int GLD = 72;
template <bool GATHER>
DI void gemm_acc(f32x4 (&acc)[4][2], const bf16_t* __restrict__ A, int lda, const int* __restrict__ rowidx, int nvalid,
                 const bf16_t* __restrict__ Bt, int ldb, int K, char* lds) {
  bf16_t* As = (bf16_t*)lds; bf16_t* Bs = As + 128 * GLD;
  const int tid = otid(), lane = tid & 63, wid = tid >> 6, wr = wid >> 2, wc = wid & 3, fr = lane & 15, fq = lane >> 4;
  const int lr = tid >> 3, lc = (tid & 7) * 8;
  const bf16_t* ap[2]; const bf16_t* bp[2];
#pragma unroll
  for (int i = 0; i < 2; ++i) {
    int r = lr + 64 * i;
    if (GATHER) { int rr = r < nvalid ? r : nvalid - 1; ap[i] = A + (size_t)rowidx[rr] * lda + lc; }
    else ap[i] = A + (size_t)r * lda + lc;
    bp[i] = Bt + (size_t)r * ldb + lc;
  }
  u32x4 ra[2], rb[2];
#pragma unroll
  for (int i = 0; i < 2; ++i) { ra[i] = *(const u32x4*)(ap[i]); rb[i] = *(const u32x4*)(bp[i]); }
  const int nk = K / 64;
  for (int kt = 0; kt < nk; ++kt) {
    __syncthreads();
#pragma unroll
    for (int i = 0; i < 2; ++i) { *(u32x4*)(As + (lr + 64 * i) * GLD + lc) = ra[i]; *(u32x4*)(Bs + (lr + 64 * i) * GLD + lc) = rb[i]; }
    __syncthreads();
    if (kt + 1 < nk) {
#pragma unroll
      for (int i = 0; i < 2; ++i) { ra[i] = *(const u32x4*)(ap[i] + (kt + 1) * 64); rb[i] = *(const u32x4*)(bp[i] + (kt + 1) * 64); }
    }
#pragma unroll
    for (int ks = 0; ks < 2; ++ks) {
      bf16x8 af[4], bfr[2];
#pragma unroll
      for (int mi = 0; mi < 4; ++mi) af[mi] = *(const bf16x8*)(As + (wr * 64 + mi * 16 + fr) * GLD + ks * 32 + fq * 8);
#pragma unroll
      for (int ni = 0; ni < 2; ++ni) bfr[ni] = *(const bf16x8*)(Bs + (wc * 32 + ni * 16 + fr) * GLD + ks * 32 + fq * 8);
#pragma unroll
      for (int mi = 0; mi < 4; ++mi)
#pragma unroll
        for (int ni = 0; ni < 2; ++ni) acc[mi][ni] = __builtin_amdgcn_mfma_f32_16x16x32_bf16(bfr[ni], af[mi], acc[mi][ni], 0, 0, 0);
    }
  }
}
DI void acc_zero(f32x4 (&acc)[4][2]) {
#pragma unroll
  for (int mi = 0; mi < 4; ++mi)
#pragma unroll
    for (int ni = 0; ni < 2; ++ni) acc[mi][ni] = (f32x4){0.f, 0.f, 0.f, 0.f};
}
DI void unit_rc(int unit, int nct, int& rt, int& ct) { const int per = 16 * nct; const int g = unit / per, w = unit % per; rt = g * 16 + (w & 15); ct = w >> 4; }

template <class F>
DI void epi_loop(F f) {
  const int lane_ = otid() & 63, wid_ = otid() >> 6, wr_ = wid_ >> 2, wc_ = wid_ & 3, fr_ = lane_ & 15, fq_ = lane_ >> 4;
#pragma unroll
  for (int mi = 0; mi < 4; ++mi)
#pragma unroll
    for (int ni = 0; ni < 2; ++ni) f(mi, ni, wr_ * 64 + mi * 16 + fr_, wc_ * 32 + ni * 16 + 4 * fq_);
}

DI void phase_u(const Params& p, int L, char* lds) {
  const bf16_t* hb = (const bf16_t*)(p.ws + O_HB);
  const bf16_t* Wt = (const bf16_t*)(p.ws + O_WIN + L * SZ_WIN);
  bf16_t* u = (bf16_t*)(p.ws + O_R + R_U);
  constexpr int NCT = UC / 128;
#pragma unroll 1
  for (int unit = obid(); unit < 128 * NCT; unit += gridDim.x) {
    int rt, ct; unit_rc(unit, NCT, rt, ct);
    f32x4 acc[4][2]; acc_zero(acc);
    gemm_acc<false>(acc, hb + (size_t)rt * 128 * DM, DM, nullptr, 128, Wt + (size_t)ct * 128 * DM, DM, DM, lds);
    epi_loop([&](int mi, int ni, int r, int c) {
      const f32x4 v = acc[mi][ni];
      u32x2 w; w[0] = pk2(v[0], v[1]); w[1] = pk2(v[2], v[3]);
      *(u32x2*)(u + (size_t)(rt * 128 + r) * UC + ct * 128 + c) = w;
    });
  }
}

DI float softplusf_(float z) { return z > 20.f ? z : log1pf(__expf(z)); }
DI float logsigmoidf_(float z) { return z >= 0.f ? -log1pf(__expf(-z)) : z - log1pf(__expf(z)); }

DI void phase_prep(const Params& p, int L, char* lds) {
  float* xw_s = (float*)lds; float* xa_s = xw_s + 8 * 64; float* xg_s = xa_s + 8 * 64;
  char* R = p.ws + O_R;
  const bf16_t* u = (const bf16_t*)(R + R_U);
  bf16_t* rwA = (bf16_t*)(R + R_RWA); bf16_t* rwB = (bf16_t*)(R + R_RWB); bf16_t* rwK = (bf16_t*)(R + R_RWK);
  bf16_t* rwR = (bf16_t*)(R + R_RWR); bf16_t* rwV = (bf16_t*)(R + R_RWV); float* rwW = (float*)(R + R_RWW);
  bf16_t* gq = (bf16_t*)(R + R_GQ); bf16_t* gk = (bf16_t*)(R + R_GK); bf16_t* gv = (bf16_t*)(R + R_GV);
  bf16_t* Qd = (bf16_t*)(R + R_QD); bf16_t* Kd = (bf16_t*)(R + R_KD); bf16_t* Vd = (bf16_t*)(R + R_VD);
  bf16_t* Qf = (bf16_t*)(R + R_QF); bf16_t* Kf = (bf16_t*)(R + R_KF); bf16_t* Vf = (bf16_t*)(R + R_VF);
  bf16_t* auxg = (bf16_t*)(R + R_AUXG); bf16_t* auxgate = (bf16_t*)(R + R_AUXGATE);
  float* rk = (float*)(p.ws + O_SMALL + SM_RK); float* logf_ = (float*)(p.ws + O_SMALL + SM_LOGF);
  float* gbeta = (float*)(p.ws + O_SMALL + SM_GBETA); float* ga = (float*)(p.ws + O_SMALL + SM_GA);
  const float* mu = p.in[8] + L * 1024; const float* w0 = p.in[9] + L * 256; const float* w2 = p.in[10] + L * 64 * 256;
  const float* a0 = p.in[11] + L * 256; const float* a2 = p.in[12] + L * 64 * 256; const float* g2 = p.in[13] + L * 128 * 256;
  const float* kkp = p.in[14] + L * 256; const float* kap = p.in[15] + L * 256; const float* rkp = p.in[16] + L * 256;
  const float* fbias = p.in[21] + L * 4; const float* cw = p.in[22] + L * 768 * 4;
  const float* alog = p.in[23] + L * 4; const float* dtb = p.in[24] + L * 4;
  const int tid = otid(), j = tid & 255, half = tid >> 8, lane = tid & 63, h = j >> 6, dh = j & 63;
  const float QS_D = 0.25503486164919736f, QS_F = 0.18033688011112042f;
  for (int tile = obid(); tile < NTOK / 8; tile += gridDim.x) {
    const int T0 = tile * 8, b = T0 / SEQ, t0 = T0 % SEQ, bh = b * 4 + h;
    float r[4], k[4], v[4];
    __syncthreads();
#pragma unroll
    for (int i = 0; i < 4; ++i) {
      const int tl = half * 4 + i, tok = T0 + tl, t = t0 + tl;
      const bf16_t* ur = u + (size_t)tok * UC;
#pragma unroll
      for (int seg = 0; seg < 4; ++seg) {
        const int c = seg * 256 + j;
        const float ua = bf2f(ur[c]);
        const float up = t > 0 ? bf2f(ur[c - UC]) : 0.f;
        const float xm = ua + (up - ua) * mu[c];
        if (seg == 0) r[i] = xm; else if (seg == 1) k[i] = xm; else if (seg == 2) v[i] = xm;
        else {
          if (j < 64) xw_s[tl * 64 + j] = 1.0f - 2.0f / (1.0f + __expf(2.0f * xm));
          else if (j < 128) xa_s[tl * 64 + (j - 64)] = xm;
          else xg_s[tl * 128 + (j - 128)] = sigmoidf_(xm);
        }
      }
    }
    __syncthreads();
    float lw[4], alr[4], gg[4];
#pragma unroll
    for (int i = 0; i < 4; ++i) { lw[i] = w0[j]; alr[i] = a0[j]; gg[i] = 0.f; }
    for (int q = 0; q < 64; ++q) {
      const float wv = w2[q * 256 + j], av = a2[q * 256 + j];
#pragma unroll
      for (int i = 0; i < 4; ++i) { lw[i] += xw_s[(half * 4 + i) * 64 + q] * wv; alr[i] += xa_s[(half * 4 + i) * 64 + q] * av; }
    }
    for (int q = 0; q < 128; ++q) {
      const float gvv = g2[q * 256 + j];
#pragma unroll
      for (int i = 0; i < 4; ++i) gg[i] += xg_s[(half * 4 + i) * 128 + q] * gvv;
    }
#pragma unroll
    for (int i = 0; i < 4; ++i) {
      const int tl = half * 4 + i, tok = T0 + tl, t = t0 + tl;
      const float dec = __expf(-0.6065306597126334f * sigmoidf_(lw[i]));
      const float a = sigmoidf_(alr[i]);
      const float kkr = k[i] * kkp[j];
      const float ss = wave_sum(kkr * kkr);
      const float kk = kkr * rsqrtf(ss + 1e-6f);
      const float kp = k[i] * (1.0f + (a - 1.0f) * kap[j]);
      const float rks = wave_sum(r[i] * kp * rkp[j]);
      const size_t idx = ((size_t)bh * SEQ + t) * 64 + dh;
      rwA[idx] = f2bf(-kk); rwW[idx] = dec; rwB[idx] = f2bf(kk * a); rwK[idx] = f2bf(kp); rwR[idx] = f2bf(r[i]); rwV[idx] = f2bf(v[i]);
      auxg[(size_t)tok * 256 + j] = f2bf(gg[i]);
      if (lane == 0) rk[tok * 4 + h] = rks;
    }
    {
      float vd[4], vf[4];
#pragma unroll
      for (int i = 0; i < 4; ++i) {
        const int tl = half * 4 + i, tok = T0 + tl, t = t0 + tl;
        const bf16_t* ur = u + (size_t)tok * UC;
        float q = bf2f(ur[OFF_B + j]), kx = bf2f(ur[OFF_B + 256 + j]);
        vd[i] = bf2f(ur[OFF_B + 512 + j]);
        const int d = dh & 31;
        if (d < 8) {
          const int ii = d & 3;
          const double invrev = ii == 0 ? 0.15915494309189535 : ii == 1 ? 0.005985185712713705 : ii == 2 ? 0.00022507907903927653 : 8.464330808241401e-06;
          double rv = (double)t * invrev; rv -= floor(rv);
          const float fr = (float)rv;
          const float sn = __builtin_amdgcn_sinf(fr), cs = __builtin_amdgcn_cosf(fr);
          const int pj = d < 4 ? j + 4 : j - 4;
          const float qp = bf2f(ur[OFF_B + pj]), kpn = bf2f(ur[OFF_B + 256 + pj]);
          if (d < 4) { q = q * cs - qp * sn; kx = kx * cs - kpn * sn; }
          else { q = q * cs + qp * sn; kx = kx * cs + kpn * sn; }
        }
        const size_t idx = ((size_t)bh * SEQ + t) * 64 + dh;
        Qd[idx] = f2bf(q * QS_D); Kd[idx] = f2bf(kx);
        Qf[idx] = f2bf(bf2f(ur[OFF_C + j]) * QS_F); Kf[idx] = ur[OFF_C + 256 + j];
        vf[i] = bf2f(ur[OFF_C + 512 + j]);
        if (j < 4) logf_[(size_t)(b * 4 + j) * SEQ + t] = logsigmoidf_(bf2f(ur[OFF_C + 768 + j]) + fbias[j]);
      }
      const size_t vidx = ((size_t)bh * 64 + dh) * SEQ + t0 + half * 4;
      u32x2 w; w[0] = pk2(vd[0], vd[1]); w[1] = pk2(vd[2], vd[3]); *(u32x2*)(Vd + vidx) = w;
      w[0] = pk2(vf[0], vf[1]); w[1] = pk2(vf[2], vf[3]); *(u32x2*)(Vf + vidx) = w;
    }
#pragma unroll
    for (int i = 0; i < 4; ++i) {
      const int tl = half * 4 + i, tok = T0 + tl, t = t0 + tl;
      const bf16_t* ur = u + (size_t)tok * UC + OFF_D;
      float y[3];
#pragma unroll
      for (int seg = 0; seg < 3; ++seg) {
        const int c = seg * 256 + j;
        const f32x4 wv = *(const f32x4*)(cw + c * 4);
        float acc = wv[3] * bf2f(ur[c]);
        if (t >= 1) acc += wv[2] * bf2f(ur[c - UC]);
        if (t >= 2) acc += wv[1] * bf2f(ur[c - 2 * UC]);
        if (t >= 3) acc += wv[0] * bf2f(ur[c - 3 * UC]);
        y[seg] = acc * sigmoidf_(acc);
      }
      const float sq = wave_sum(y[0] * y[0]), sk = wave_sum(y[1] * y[1]);
      const float qn = y[0] * rsqrtf(sq + 1e-6f) * 0.125f, kn = y[1] * rsqrtf(sk + 1e-6f);
      const size_t idx = ((size_t)bh * SEQ + t) * 64 + dh;
      gq[idx] = f2bf(qn); gk[idx] = f2bf(kn); gv[idx] = f2bf(y[2]);
      const float gate = bf2f(ur[776 + j]);
      auxgate[(size_t)tok * 256 + j] = f2bf(gate * sigmoidf_(gate));
      if (lane == 0) {
        const float beta = sigmoidf_(bf2f(ur[768 + h]));
        const float gl = -__expf(alog[h]) * softplusf_(bf2f(ur[772 + h]) + dtb[h]);
        gbeta[(size_t)bh * SEQ + t] = beta; ga[(size_t)bh * SEQ + t] = __expf(gl);
      }
    }
  }
}

DI float dpp_sum8(float x) {
  x += __int_as_float(__builtin_amdgcn_update_dpp(0, __float_as_int(x), 0xB1, 0xF, 0xF, true));
  x += __int_as_float(__builtin_amdgcn_update_dpp(0, __float_as_int(x), 0x4E, 0xF, 0xF, true));
  x += __int_as_float(__builtin_amdgcn_update_dpp(0, __float_as_int(x), 0x141, 0xF, 0xF, true));
  return x;
}
constexpr int SCH = 16;
template <int WHICH>
DI void scan_block(const Params& p, int L, int bh, char* lds) {
  float* buf = (float*)lds;
  float* obuf = buf + 2 * SCH * 384;
  char* R = p.ws + O_R;
  const int tid = otid(), v = tid >> 3, sub = tid & 7, lane = tid & 63, wid = tid >> 6;
  const int b = bh >> 2, h = bh & 3;
  const size_t base = (size_t)bh * SEQ * 64;
  const unsigned* pA = (const unsigned*)((const bf16_t*)(R + (WHICH == 0 ? R_RWA : R_GK)) + base);
  const unsigned* pB = (const unsigned*)((const bf16_t*)(R + R_RWB) + base);
  const unsigned* pK = (const unsigned*)((const bf16_t*)(R + R_RWK) + base);
  const unsigned* pR = (const unsigned*)((const bf16_t*)(R + (WHICH == 0 ? R_RWR : R_GQ)) + base);
  const unsigned* pV = (const unsigned*)((const bf16_t*)(R + (WHICH == 0 ? R_RWV : R_GV)) + base);
  const f32x2* pW = (const f32x2*)((const float*)(R + R_RWW) + base);
  const float* gbeta = (const float*)(p.ws + O_SMALL + SM_GBETA) + (size_t)bh * SEQ;
  const float* ga = (const float*)(p.ws + O_SMALL + SM_GA) + (size_t)bh * SEQ;
  const float* rk = (const float*)(p.ws + O_SMALL + SM_RK);
  const bf16_t* auxg = (const bf16_t*)(R + (WHICH == 0 ? R_AUXG : R_AUXGATE));
  bf16_t* y = (bf16_t*)(R + R_Y);
  const float pw = WHICH == 0 ? (p.in[17] + L * 256)[h * 64 + lane] : (p.in[25] + L * 64)[lane];
  const float pb = WHICH == 0 ? (p.in[18] + L * 256)[h * 64 + lane] : 0.f;
  float s[8];
#pragma unroll
  for (int i = 0; i < 8; ++i) s[i] = 0.f;
  unsigned ra = 0, rb = 0, rkk = 0, rr = 0, rv = 0; f32x2 rw = {0.f, 0.f}; float rbeta = 0.f, raa = 0.f;
  const int est = tid >> 5;
  const int ek = (tid & 31) * 2;
#define SCAN_LOAD(c)                                                                                         \
  {                                                                                                          \
    const size_t o_ = (size_t)(c) * (SCH * 32) + tid;                                                        \
    ra = pA[o_]; rr = pR[o_]; rv = pV[o_];                                                                   \
    if (WHICH == 0) { rb = pB[o_]; rkk = pK[o_]; rw = pW[o_]; }                                              \
    else { rbeta = gbeta[(c) * SCH + est]; raa = ga[(c) * SCH + est]; }                                      \
  }
#define SCAN_STAGE(c)                                                                                        \
  {                                                                                                          \
    float* d_ = buf + ((c) & 1) * (SCH * 384) + est * 384 + ek;                                              \
    const float a0_ = __uint_as_float(ra << 16), a1_ = __uint_as_float(ra & 0xffff0000u);                   \
    const float r0_ = __uint_as_float(rr << 16), r1_ = __uint_as_float(rr & 0xffff0000u);                   \
    const float v0_ = __uint_as_float(rv << 16), v1_ = __uint_as_float(rv & 0xffff0000u);                   \
    if (WHICH == 0) {                                                                                        \
      d_[0] = a0_; d_[1] = a1_; d_[64] = rw[0]; d_[65] = rw[1];                                              \
      d_[128] = __uint_as_float(rb << 16); d_[129] = __uint_as_float(rb & 0xffff0000u);                      \
      d_[192] = __uint_as_float(rkk << 16); d_[193] = __uint_as_float(rkk & 0xffff0000u);                    \
    } else {                                                                                                 \
      d_[0] = -a0_; d_[1] = -a1_; d_[64] = raa; d_[65] = raa;                                                \
      d_[128] = raa * rbeta * a0_; d_[129] = raa * rbeta * a1_;                                              \
      d_[192] = rbeta * a0_; d_[193] = rbeta * a1_;                                                          \
    }                                                                                                        \
    d_[256] = r0_; d_[257] = r1_; d_[320] = v0_; d_[321] = v1_;                                              \
  }
  SCAN_LOAD(0);
  SCAN_STAGE(0);
  constexpr int NCH = SEQ / SCH;
  for (int c = 0; c < NCH; ++c) {
    __syncthreads();
    if (c + 1 < NCH) SCAN_LOAD(c + 1);
    const float* cb = buf + (c & 1) * (SCH * 384);
#pragma unroll 4
    for (int st = 0; st < SCH; ++st) {
      const float* sp = cb + st * 384 + sub * 8;
      const f32x4 A0 = *(const f32x4*)(sp), A1 = *(const f32x4*)(sp + 4);
      const f32x4 W0 = *(const f32x4*)(sp + 64), W1 = *(const f32x4*)(sp + 68);
      const f32x4 B0 = *(const f32x4*)(sp + 128), B1 = *(const f32x4*)(sp + 132);
      const f32x4 K0 = *(const f32x4*)(sp + 192), K1 = *(const f32x4*)(sp + 196);
      const f32x4 R0 = *(const f32x4*)(sp + 256), R1 = *(const f32x4*)(sp + 260);
      const float vv = cb[st * 384 + 320 + v];
      float d0 = s[0] * A0[0] + s[1] * A0[1], d1 = s[2] * A0[2] + s[3] * A0[3], d2 = s[4] * A1[0] + s[5] * A1[1], d3 = s[6] * A1[2] + s[7] * A1[3];
      const float sa = dpp_sum8((d0 + d1) + (d2 + d3));
      s[0] = s[0] * W0[0] + sa * B0[0] + vv * K0[0]; s[1] = s[1] * W0[1] + sa * B0[1] + vv * K0[1];
      s[2] = s[2] * W0[2] + sa * B0[2] + vv * K0[2]; s[3] = s[3] * W0[3] + sa * B0[3] + vv * K0[3];
      s[4] = s[4] * W1[0] + sa * B1[0] + vv * K1[0]; s[5] = s[5] * W1[1] + sa * B1[1] + vv * K1[1];
      s[6] = s[6] * W1[2] + sa * B1[2] + vv * K1[2]; s[7] = s[7] * W1[3] + sa * B1[3] + vv * K1[3];
      float e0 = s[0] * R0[0] + s[1] * R0[1], e1 = s[2] * R0[2] + s[3] * R0[3], e2 = s[4] * R1[0] + s[5] * R1[1], e3 = s[6] * R1[2] + s[7] * R1[3];
      const float oo = dpp_sum8((e0 + e1) + (e2 + e3));
      if (sub == 0) obuf[st * 64 + v] = oo;
    }
    __syncthreads();
    if (c + 1 < NCH) SCAN_STAGE(c + 1);
#pragma unroll
    for (int q = 0; q < 2; ++q) {
      const int st = wid * 2 + q, t = c * SCH + st, tok = b * SEQ + t;
      const float o = obuf[st * 64 + lane];
      float val;
      if (WHICH == 0) {
        const float mean = wave_sum(o) * (1.0f / 64.0f), dl = o - mean;
        const float var = wave_sum(dl * dl) * (1.0f / 64.0f);
        val = dl * rsqrtf(var + 64e-5f) * pw + pb;
        val += rk[tok * 4 + h] * cb[st * 384 + 320 + lane];
        val *= bf2f(auxg[(size_t)tok * 256 + h * 64 + lane]);
        y[(size_t)tok * DM + h * 64 + lane] = f2bf(val);
      } else {
        const float ms = wave_sum(o * o) * (1.0f / 64.0f);
        val = o * rsqrtf(ms + 1e-6f) * pw * bf2f(auxg[(size_t)tok * 256 + h * 64 + lane]);
        y[(size_t)tok * DM + 768 + h * 64 + lane] = f2bf(val);
      }
    }
  }
#undef SCAN_LOAD
#undef SCAN_STAGE
}

DI bf16x8 packf8(float a0, float a1, float a2, float a3, float a4, float a5, float a6, float a7) {
  u32x4 w; w[0] = pk2(a0, a1); w[1] = pk2(a2, a3); w[2] = pk2(a4, a5); w[3] = pk2(a6, a7);
  return __builtin_bit_cast(bf16x8, w);
}
constexpr int KLD = 72;
template <int TYPE>
DI void attn_unit(const Params& p, int L, int bh, int qt, char* lds) {
  bf16_t* Ks = (bf16_t*)lds;
  bf16_t* Vs = Ks + 64 * KLD;
  float* cs = (float*)(lds + 2 * 64 * KLD * 2);
  float* red = cs + 8192;
  char* R = p.ws + O_R;
  const int tid = otid(), lane = tid & 63, wid = tid >> 6, r32 = lane & 31, hi = lane >> 5;
  const int b = bh >> 2, h = bh & 3;
  const int map = TYPE == 0 ? (wid >> 2) : 0, wq = TYPE == 0 ? (wid & 3) : wid;
  const int QROWS = TYPE == 0 ? 128 : 256;
  const int q0 = qt * QROWS, qw0 = q0 + wq * 32, q = qw0 + r32;
  const bf16_t* Qg = (const bf16_t*)(R + (TYPE == 0 ? R_QD : R_QF)) + (size_t)bh * SEQ * 64;
  const bf16_t* Kg = (const bf16_t*)(R + (TYPE == 0 ? R_KD : R_KF)) + (size_t)bh * SEQ * 64;
  const bf16_t* Vg = (const bf16_t*)(R + (TYPE == 0 ? R_VD : R_VF)) + (size_t)bh * 64 * SEQ;
  const int NT = (q0 + QROWS) / 64;
  __syncthreads();
  const int lrow = tid >> 3, lch = (tid & 7) * 8;
  u32x4 kreg = *(const u32x4*)(Kg + (size_t)lrow * 64 + lch);
  u32x4 vreg = *(const u32x4*)(Vg + (size_t)lrow * SEQ + lch);
  float cq = 0.f;
  if (TYPE == 1) {
    const float* lf = (const float*)(p.ws + O_SMALL + SM_LOGF) + (size_t)bh * SEQ;
    const int n = q0 + 256;
    float loc[16]; float tot = 0.f;
#pragma unroll
    for (int i = 0; i < 16; ++i) { const int e = tid * 16 + i; loc[i] = e < n ? lf[e] : 0.f; tot += loc[i]; }
    float inc = tot;
#pragma unroll
    for (int o = 1; o < 64; o <<= 1) { const float t2 = __shfl_up(inc, o); if (lane >= o) inc += t2; }
    if (lane == 63) red[wid] = inc;
    __syncthreads();
    float pre = inc - tot;
    for (int w = 0; w < wid; ++w) pre += red[w];
#pragma unroll
    for (int i = 0; i < 16; ++i) { pre += loc[i]; const int e = tid * 16 + i; if (e < n) cs[e] = pre * 1.4426950408889634f; }
    __syncthreads();
    cq = cs[q];
  }
  constexpr int NS = TYPE == 0 ? 2 : 4;
  const int sbase = TYPE == 0 ? 2 * map : 0;
  bf16x8 qf[NS];
#pragma unroll
  for (int s = 0; s < NS; ++s) qf[s] = *(const bf16x8*)(Qg + (size_t)q * 64 + 16 * (sbase + s) + 8 * hi);
  float m = -INFINITY, l = 0.f; f32x16 o[2];
#pragma unroll
  for (int r = 0; r < 16; ++r) { o[0][r] = 0.f; o[1][r] = 0.f; }
#pragma unroll 1
  for (int jt = 0; jt < NT; ++jt) {
    const int kv0 = jt * 64;
    __syncthreads();
    *(u32x4*)(Ks + lrow * KLD + lch) = kreg;
    *(u32x4*)(Vs + lrow * KLD + lch) = vreg;
    __syncthreads();
    if (jt + 1 < NT) {
      kreg = *(const u32x4*)(Kg + (size_t)(kv0 + 64 + lrow) * 64 + lch);
      vreg = *(const u32x4*)(Vg + (size_t)lrow * SEQ + kv0 + 64 + lch);
    }
    if (kv0 <= qw0 + 31) {
      const bool needmask = kv0 + 63 > qw0;
      f32x16 p0, p1;
#pragma unroll
      for (int r = 0; r < 16; ++r) { p0[r] = 0.f; p1[r] = 0.f; }
#pragma unroll
      for (int s = 0; s < NS; ++s) {
        const bf16x8 k0 = *(const bf16x8*)(Ks + r32 * KLD + 16 * (sbase + s) + 8 * hi);
        const bf16x8 k1 = *(const bf16x8*)(Ks + (32 + r32) * KLD + 16 * (sbase + s) + 8 * hi);
        p0 = __builtin_amdgcn_mfma_f32_32x32x16_bf16(k0, qf[s], p0, 0, 0, 0);
        p1 = __builtin_amdgcn_mfma_f32_32x32x16_bf16(k1, qf[s], p1, 0, 0, 0);
      }
      if (TYPE == 1) {
#pragma unroll
        for (int r = 0; r < 16; ++r) { p0[r] += cq - cs[kv0 + crow(r, hi)]; p1[r] += cq - cs[kv0 + 32 + crow(r, hi)]; }
      }
      if (needmask) {
#pragma unroll
        for (int r = 0; r < 16; ++r) { if (kv0 + crow(r, hi) > q) p0[r] = -INFINITY; if (kv0 + 32 + crow(r, hi) > q) p1[r] = -INFINITY; }
      }
      float mx = fmaxf(p0[0], p1[0]);
#pragma unroll
      for (int r = 1; r < 16; ++r) mx = fmaxf(mx, fmaxf(p0[r], p1[r]));
      mx = fmaxf(mx, __shfl_xor(mx, 32));
      const float mn = fmaxf(m, mx);
      const float alpha = __builtin_amdgcn_exp2f(m - mn);
      m = mn;
      float rs = 0.f;
#pragma unroll
      for (int r = 0; r < 16; ++r) { p0[r] = __builtin_amdgcn_exp2f(p0[r] - mn); p1[r] = __builtin_amdgcn_exp2f(p1[r] - mn); rs += p0[r] + p1[r]; }
      l = l * alpha + rs;
#pragma unroll
      for (int r = 0; r < 16; ++r) { o[0][r] *= alpha; o[1][r] *= alpha; }
      bf16x8 pf[4];
      pf[0] = packf8(p0[0], p0[1], p0[2], p0[3], p0[4], p0[5], p0[6], p0[7]);
      pf[1] = packf8(p0[8], p0[9], p0[10], p0[11], p0[12], p0[13], p0[14], p0[15]);
      pf[2] = packf8(p1[0], p1[1], p1[2], p1[3], p1[4], p1[5], p1[6], p1[7]);
      pf[3] = packf8(p1[8], p1[9], p1[10], p1[11], p1[12], p1[13], p1[14], p1[15]);
#pragma unroll
      for (int db = 0; db < 2; ++db)
#pragma unroll
        for (int s = 0; s < 4; ++s) {
          const s16x4 lo = *(const s16x4*)(Vs + (32 * db + r32) * KLD + 16 * s + 4 * hi);
          const s16x4 hh = *(const s16x4*)(Vs + (32 * db + r32) * KLD + 16 * s + 8 + 4 * hi);
          const bf16x8 vf = __builtin_shufflevector(lo, hh, 0, 1, 2, 3, 4, 5, 6, 7);
          o[db] = __builtin_amdgcn_mfma_f32_32x32x16_bf16(vf, pf[s], o[db], 0, 0, 0);
        }
    }
  }
  bf16_t* y = (bf16_t*)(R + R_Y);
  const size_t orow = ((size_t)b * SEQ + q) * DM + (TYPE == 0 ? 256 : 512) + h * 64;
  const float lt = l + __shfl_xor(l, 32);
  const float li = 1.0f / lt;
  if (TYPE == 1) {
#pragma unroll
    for (int db = 0; db < 2; ++db)
#pragma unroll
      for (int g = 0; g < 4; ++g) {
        u32x2 w; w[0] = pk2(o[db][4 * g] * li, o[db][4 * g + 1] * li); w[1] = pk2(o[db][4 * g + 2] * li, o[db][4 * g + 3] * li);
        *(u32x2*)(y + orow + 32 * db + 8 * g + 4 * hi) = w;
      }
  } else {
    float* xb = cs;
    if (map == 1) {
#pragma unroll
      for (int db = 0; db < 2; ++db)
#pragma unroll
        for (int r = 0; r < 16; ++r) xb[(wq * 32 + db * 16 + r) * 64 + lane] = o[db][r] * li;
    }
    __syncthreads();
    if (map == 0) {
      const float* lp = p.in[19] + L * 128;
      float s01 = 0.f, s23 = 0.f;
      for (int i = 0; i < 32; ++i) { s01 += lp[i] * lp[32 + i]; s23 += lp[64 + i] * lp[96 + i]; }
      const float lam_init = L == 0 ? 0.2f : 0.35550906759096934f;
      const float lam = __expf(s01) - __expf(s23) + lam_init;
      const float* sub = p.in[20] + L * 64;
      float ss = 0.f;
#pragma unroll
      for (int db = 0; db < 2; ++db)
#pragma unroll
        for (int r = 0; r < 16; ++r) { const float vv = o[db][r] * li - lam * xb[(wq * 32 + db * 16 + r) * 64 + lane]; o[db][r] = vv; ss += vv * vv; }
      ss += __shfl_xor(ss, 32);
      const float sc = rsqrtf(ss * (1.0f / 64.0f) + 1e-5f) * (1.0f - lam_init);
#pragma unroll
      for (int db = 0; db < 2; ++db)
#pragma unroll
        for (int g = 0; g < 4; ++g) {
          const int d = 32 * db + 8 * g + 4 * hi;
          const f32x4 sw = *(const f32x4*)(sub + d);
          u32x2 w; w[0] = pk2(o[db][4 * g] * sc * sw[0], o[db][4 * g + 1] * sc * sw[1]); w[1] = pk2(o[db][4 * g + 2] * sc * sw[2], o[db][4 * g + 3] * sc * sw[3]);
          *(u32x2*)(y + orow + d) = w;
        }
    }
  }
}

DI void phase_mix(const Params& p, int L, char* lds) {
  int* ctr = (int*)(p.ws + O_SMALL + SM_CTR) + L;
  int* s_unit = (int*)(lds + 2 * 64 * KLD * 2 + 8192 * 4 + 64);
  if (obid() < 16) {
    if (obid() < 8) scan_block<0>(p, L, obid() & 7, lds); else scan_block<1>(p, L, obid() & 7, lds);
  }
#pragma unroll 1
  for (;;) {
    __syncthreads();
    if (otid() == 0) *s_unit = atomicAdd(ctr, 1);
    __syncthreads();
    const int u = *s_unit;
    if (u >= 768) break;
    const int level = 31 - u / 24, w = u % 24;
    if (w < 8) attn_unit<1>(p, L, w, level, lds);
    else if (w < 16) attn_unit<0>(p, L, w - 8, 2 * level + 1, lds);
    else attn_unit<0>(p, L, w - 16, 2 * level, lds);
  }
}

DI void phase_merge(const Params& p, int L, char* lds) {
  const bf16_t* hb = (const bf16_t*)(p.ws + O_HB);
  const bf16_t* Wt = (const bf16_t*)(p.ws + O_WIN + L * SZ_WIN);
  const bf16_t* Wbo = (const bf16_t*)(p.ws + O_WBO) + (size_t)L * 4 * 1024 * 256;
  const bf16_t* y = (const bf16_t*)(p.ws + O_R + R_Y);
  bf16_t* M = (bf16_t*)(p.ws + O_R + R_M);
#pragma unroll 1
  for (int unit = obid(); unit < 128 * 8; unit += gridDim.x) {
    int rt, ct; unit_rc(unit, 8, rt, ct);
    f32x4 accM[4][2]; acc_zero(accM);
#pragma unroll 1
    for (int br = 0; br < 4; ++br) {
      u32x2 pp[4][2];
      {
        f32x4 accP[4][2]; acc_zero(accP);
        gemm_acc<false>(accP, y + (size_t)rt * 128 * DM + br * 256, DM, nullptr, 128, Wbo + ((size_t)br * 1024 + ct * 128) * 256, 256, 256, lds);
#pragma unroll
        for (int mi = 0; mi < 4; ++mi)
#pragma unroll
          for (int ni = 0; ni < 2; ++ni) { pp[mi][ni][0] = pk2(accP[mi][ni][0], accP[mi][ni][1]); pp[mi][ni][1] = pk2(accP[mi][ni][2], accP[mi][ni][3]); }
      }
      f32x4 accG[4][2]; acc_zero(accG);
      gemm_acc<false>(accG, hb + (size_t)rt * 128 * DM, DM, nullptr, 128, Wt + ((size_t)OFF_G + br * 1024 + ct * 128) * DM, DM, DM, lds);
#pragma unroll
      for (int mi = 0; mi < 4; ++mi)
#pragma unroll
        for (int ni = 0; ni < 2; ++ni) {
          accM[mi][ni][0] += sigmoidf_(accG[mi][ni][0]) * __uint_as_float(pp[mi][ni][0] << 16);
          accM[mi][ni][1] += sigmoidf_(accG[mi][ni][1]) * __uint_as_float(pp[mi][ni][0] & 0xffff0000u);
          accM[mi][ni][2] += sigmoidf_(accG[mi][ni][2]) * __uint_as_float(pp[mi][ni][1] << 16);
          accM[mi][ni][3] += sigmoidf_(accG[mi][ni][3]) * __uint_as_float(pp[mi][ni][1] & 0xffff0000u);
        }
    }
    epi_loop([&](int mi, int ni, int r, int c) {
      const f32x4 v = accM[mi][ni];
      u32x2 w; w[0] = pk2(v[0], v[1]); w[1] = pk2(v[2], v[3]);
      *(u32x2*)(M + (size_t)(rt * 128 + r) * DM + ct * 128 + c) = w;
    });
  }
}

DI void phase_xadd(const Params& p, const bf16_t* A, int lda, const bf16_t* Bt, int K, char* lds) {
#pragma unroll 1
  for (int unit = obid(); unit < 128 * 8; unit += gridDim.x) {
    int rt, ct; unit_rc(unit, 8, rt, ct);
    f32x4 acc[4][2]; acc_zero(acc);
    gemm_acc<false>(acc, A + (size_t)rt * 128 * lda, lda, nullptr, 128, Bt + (size_t)ct * 128 * K, K, K, lds);
    epi_loop([&](int mi, int ni, int r, int c) {
      float* xp = p.x + (size_t)(rt * 128 + r) * DM + ct * 128 + c;
      f32x4 xv = *(f32x4*)xp; xv += acc[mi][ni]; *(f32x4*)xp = xv;
    });
  }
}

DI void phase_ffn_up(const Params& p, char* lds) {
  const bf16_t* hb = (const bf16_t*)(p.ws + O_HB);
  const bf16_t* Wt = (const bf16_t*)(p.ws + O_FGU);
  bf16_t* T = (bf16_t*)(p.ws + O_R + R_T);
  constexpr int NCT = 2 * FFD / 128;
#pragma unroll 1
  for (int unit = obid(); unit < 128 * NCT; unit += gridDim.x) {
    int rt, ct; unit_rc(unit, NCT, rt, ct);
    f32x4 acc[4][2]; acc_zero(acc);
    gemm_acc<false>(acc, hb + (size_t)rt * 128 * DM, DM, nullptr, 128, Wt + (size_t)ct * 128 * DM, DM, DM, lds);
    epi_loop([&](int mi, int ni, int r, int c) {
      const f32x4 v = acc[mi][ni];
      const float t0 = v[0] * sigmoidf_(v[0]) * v[1], t1 = v[2] * sigmoidf_(v[2]) * v[3];
      *(unsigned*)(T + (size_t)(rt * 128 + r) * FFD + (ct * 128 + c) / 2) = pk2(t0, t1);
    });
  }
}

struct MoeSel { int e, rt, nvalid; };
DI int moe_total_tiles(const Params& p) {
  const int* cnt = (const int*)(p.ws + O_SMALL + SM_CTR) + 32;
  int o = 0;
#pragma unroll
  for (int e = 0; e < 8; ++e) o += (cnt[e] + 127) >> 7;
  return o;
}
DI MoeSel moe_sel(const Params& p, int tile) {
  const int* cnt = (const int*)(p.ws + O_SMALL + SM_CTR) + 32;
  MoeSel r; r.e = 0; r.rt = 0; r.nvalid = 0;
  int o = 0;
#pragma unroll
  for (int e = 0; e < 8; ++e) {
    const int c = cnt[e], n = (c + 127) >> 7;
    if (tile >= o && tile < o + n) { r.e = e; r.rt = tile - o; const int nv = c - (tile - o) * 128; r.nvalid = nv > 128 ? 128 : nv; }
    o += n;
  }
  return r;
}
DI void phase_moe_up(const Params& p, char* lds) {
  const int ntiles = moe_total_tiles(p);
  const bf16_t* hb = (const bf16_t*)(p.ws + O_HB);
  const bf16_t* Wt = (const bf16_t*)(p.ws + O_MGU);
  const int* list = (const int*)(p.ws + O_SMALL + SM_LIST);
  bf16_t* T = (bf16_t*)(p.ws + O_R + R_T);
  constexpr int NCT = 2 * FFE / 128;
  const int nunits = ntiles * NCT;
#pragma unroll 1
  for (int unit = obid(); unit < nunits; unit += gridDim.x) {
    const int tile = unit / NCT, ct = unit % NCT;
    const MoeSel ms = moe_sel(p, tile);
    const int e = ms.e, rt = ms.rt, nvalid = ms.nvalid;
    f32x4 acc[4][2]; acc_zero(acc);
    gemm_acc<true>(acc, hb, DM, list + (size_t)e * NTOK + rt * 128, nvalid, Wt + ((size_t)e * 2 * FFE + ct * 128) * DM, DM, DM, lds);
    epi_loop([&](int mi, int ni, int r, int c) {
      const f32x4 v = acc[mi][ni];
      const float t0 = v[0] * sigmoidf_(v[0]) * v[1], t1 = v[2] * sigmoidf_(v[2]) * v[3];
      *(unsigned*)(T + (size_t)(tile * 128 + r) * FFE + (ct * 128 + c) / 2) = pk2(t0, t1);
    });
  }
}
DI void phase_moe_down(const Params& p, char* lds) {
  const int ntiles = moe_total_tiles(p);
  const bf16_t* Wt = (const bf16_t*)(p.ws + O_MD);
  const int* list = (const int*)(p.ws + O_SMALL + SM_LIST);
  const float* gw = (const float*)(p.ws + O_SMALL + SM_GW);
  const bf16_t* T = (const bf16_t*)(p.ws + O_R + R_T);
  const int nunits = ntiles * 8;
#pragma unroll 1
  for (int unit = obid(); unit < nunits; unit += gridDim.x) {
    const int tile = unit / 8, ct = unit % 8;
    const MoeSel ms = moe_sel(p, tile);
    const int e = ms.e, rt = ms.rt, nvalid = ms.nvalid;
    f32x4 acc[4][2]; acc_zero(acc);
    gemm_acc<false>(acc, T + (size_t)tile * 128 * FFE, FFE, nullptr, 128, Wt + ((size_t)e * 1024 + ct * 128) * FFE, FFE, FFE, lds);
    epi_loop([&](int mi, int ni, int r, int c) {
      if (r < nvalid) {
        const int tok = list[(size_t)e * NTOK + rt * 128 + r];
        const float w = gw[(size_t)e * NTOK + rt * 128 + r];
        float* xp = p.x + (size_t)tok * DM + ct * 128 + c;
        const f32x4 v = acc[mi][ni];
        unsafeAtomicAdd(xp + 0, w * v[0]); unsafeAtomicAdd(xp + 1, w * v[1]); unsafeAtomicAdd(xp + 2, w * v[2]); unsafeAtomicAdd(xp + 3, w * v[3]);
      }
    });
  }
}

DI void phase_ple(const Params& p, int L, char* lds) {
  const bf16_t* hb = (const bf16_t*)(p.ws + O_HB);
  const bf16_t* Pg = (const bf16_t*)(p.ws + O_PG) + (size_t)L * 1024 * 1024;
  const bf16_t* Pp = (const bf16_t*)(p.ws + O_PP) + (size_t)L * 1024 * 256;
  const bf16_t* pb = (const bf16_t*)(p.ws + O_PB) + (size_t)L * NTOK * 256;
#pragma unroll 1
  for (int unit = obid(); unit < 128 * 8; unit += gridDim.x) {
    int rt, ct; unit_rc(unit, 8, rt, ct);
    f32x4 accP[4][2]; acc_zero(accP);
    gemm_acc<false>(accP, pb + (size_t)rt * 128 * 256, 256, nullptr, 128, Pp + (size_t)ct * 128 * 256, 256, 256, lds);
    f32x4 accG[4][2]; acc_zero(accG);
    gemm_acc<false>(accG, hb + (size_t)rt * 128 * DM, DM, nullptr, 128, Pg + (size_t)ct * 128 * DM, DM, DM, lds);
    epi_loop([&](int mi, int ni, int r, int c) {
      float* xp = p.x + (size_t)(rt * 128 + r) * DM + ct * 128 + c;
      f32x4 xv = *(f32x4*)xp;
#pragma unroll
      for (int i = 0; i < 4; ++i) xv[i] += sigmoidf_(accG[mi][ni][i]) * accP[mi][ni][i];
      *(f32x4*)xp = xv;
    });
  }
}

DI void phase_final(const Params& p) {
  const int lane = otid() & 63, wid = otid() >> 6;
  const float* g = p.in[35];
  for (int row = obid() * 8 + wid; row < NTOK; row += gridDim.x * 8) {
    float* xr = p.x + (size_t)row * DM;
    f32x4 v[4]; float ss = 0.f;
#pragma unroll
    for (int j = 0; j < 4; ++j) { v[j] = *(const f32x4*)(xr + j * 256 + lane * 4); ss += v[j][0] * v[j][0] + v[j][1] * v[j][1] + v[j][2] * v[j][2] + v[j][3] * v[j][3]; }
    ss = wave_sum(ss);
    const float rstd = rsqrtf(ss * (1.0f / 1024.0f) + 1e-6f);
#pragma unroll
    for (int j = 0; j < 4; ++j) { const f32x4 gg = *(const f32x4*)(g + j * 256 + lane * 4); *(f32x4*)(xr + j * 256 + lane * 4) = v[j] * rstd * gg; }
  }
}

constexpr int LDS_BYTES = 2 * SCH * 384 * 4 + SCH * 64 * 4;
static_assert(LDS_BYTES >= 2 * 64 * KLD * 2 + 8192 * 4 + 128, "attention LDS");
static_assert(LDS_BYTES >= 2 * 128 * GLD * 2, "gemm LDS");

__global__ void __launch_bounds__(NTHR) fwd_megakernel(Params p) {
  __shared__ __attribute__((aligned(16))) char lds[LDS_BYTES];
  phase0(olaunder(p), lds);
  gsync();
  for (int L = 0; L < 2; ++L) {
    norm_phase<false>(olaunder(p), p.in[2] + L * DM, nullptr);
    gsync();
    phase_u(olaunder(p), L, lds);
    gsync();
    phase_prep(olaunder(p), L, lds);
    gsync();
    phase_mix(olaunder(p), L, lds);
    gsync();
    phase_merge(olaunder(p), L, lds);
    gsync();
    phase_xadd(olaunder(p), (const bf16_t*)(p.ws + O_R + R_M), DM, (const bf16_t*)(p.ws + O_WOUT) + (size_t)L * 1024 * 1024, 1024, lds);
    gsync();
    if (L == 0) {
      norm_phase<false>(olaunder(p), p.in[3] + L * DM, nullptr);
      gsync();
      phase_ffn_up(olaunder(p), lds);
      gsync();
      phase_xadd(olaunder(p), (const bf16_t*)(p.ws + O_R + R_T), FFD, (const bf16_t*)(p.ws + O_FD), FFD, lds);
      gsync();
    } else {
      norm_phase<true>(olaunder(p), p.in[3] + L * DM, p.in[29]);
      gsync();
      phase_moe_up(olaunder(p), lds);
      gsync();
      phase_moe_down(olaunder(p), lds);
      gsync();
    }
    norm_phase<false>(olaunder(p), p.in[4] + L * DM, nullptr);
    gsync();
    phase_ple(olaunder(p), L, lds);
    gsync();
  }
  phase_final(olaunder(p));
}

extern "C" void kernel_launch(void* const* d_in, const int* in_sizes, int n_in, void* d_out, int out_size,
                              void* d_ws, size_t ws_size, hipStream_t stream) {
  static int grid_blocks = 0;
  if (!grid_blocks) {
    int dev = 0, cus = 0, per_cu = 0;
    (void)hipGetDevice(&dev);
    (void)hipDeviceGetAttribute(&cus, hipDeviceAttributeMultiprocessorCount, dev);
    (void)hipOccupancyMaxActiveBlocksPerMultiprocessor(&per_cu, fwd_megakernel, NTHR, 0);
    if (per_cu > 2) per_cu = 2;
    if (per_cu < 1) per_cu = 1;
    grid_blocks = cus * per_cu;
  }
  if (ws_size < WS_NEED) { fprintf(stderr, "workspace too small: %zu < %zu\n", ws_size, (size_t)WS_NEED); return; }
  Params p{};
  for (int i = 0; i < 36; ++i) p.in[i] = (const float*)d_in[i];
  p.x = (float*)d_out;
  p.ws = (char*)d_ws;
  void* args[] = {&p};
  hipError_t e = hipLaunchCooperativeKernel((void*)fwd_megakernel, dim3(grid_blocks), dim3(NTHR), args, 0, stream);
  if (e != hipSuccess) fprintf(stderr, "cooperative launch failed: %s (grid %d)\n", hipGetErrorString(e), grid_blocks);
}
```

```cpp
#include <hip/hip_runtime.h>
#include <hip/hip_cooperative_groups.h>
#include <cstdio>
#include <cstdint>
namespace cg = cooperative_groups;

typedef unsigned short bf16_t;
typedef short bf16x8 __attribute__((ext_vector_type(8)));
typedef short s16x4 __attribute__((ext_vector_type(4)));
typedef float f32x4 __attribute__((ext_vector_type(4)));
typedef float f32x2 __attribute__((ext_vector_type(2)));
typedef float f32x16 __attribute__((ext_vector_type(16)));
typedef unsigned u32x4 __attribute__((ext_vector_type(4)));
typedef unsigned u32x2 __attribute__((ext_vector_type(2)));
typedef __bf16 bf16x2_t __attribute__((ext_vector_type(2)));

#define DI __device__ __forceinline__

constexpr int NTOK = 16384, DM = 1024, SEQ = 8192, NBH = 8;
constexpr int INC = 7692, UC = 3600, UN = 3840;
constexpr int OFF_B = 1024, OFF_C = 1792, OFF_D = 2564, OFF_G = 3596;
constexpr int FFD = 2816, FFE = 3584, NEXP = 8;
constexpr int NTHR = 512;
constexpr int MOE_ROWS = 34816;

constexpr size_t al256(size_t x) { return (x + 255) & ~(size_t)255; }
constexpr size_t O_CTL = 0, CTL_BYTES = 1u << 20;
constexpr int CW_BAR = 4096;
constexpr int CW_QCTR = 16384;
constexpr int CW_MOECNT = 16384 + 256;
constexpr size_t O_MGU = CTL_BYTES;
constexpr size_t O_MD = O_MGU + (size_t)NEXP * 2 * FFE * 1024 * 2;
constexpr size_t O_PG = O_MD + (size_t)NEXP * 1024 * FFE * 2;
constexpr size_t O_PP = O_PG + (size_t)2 * 1024 * 1024 * 2;
constexpr size_t O_PB = O_PP + (size_t)2 * 1024 * 256 * 2;
constexpr size_t O_HB = O_PB + (size_t)NTOK * 256 * 2;
constexpr size_t O_SMALL = O_HB + (size_t)NTOK * DM * 2;
constexpr size_t SM_LIST = 0;
constexpr size_t SM_GW = SM_LIST + (size_t)NEXP * NTOK * 4;
constexpr size_t SM_RK = SM_GW + (size_t)NEXP * NTOK * 4;
constexpr size_t SM_LOGF = SM_RK + (size_t)NTOK * 4 * 4;
constexpr size_t SM_GBETA = SM_LOGF + (size_t)NBH * SEQ * 4;
constexpr size_t SM_GA = SM_GBETA + (size_t)NBH * SEQ * 4;
constexpr size_t SM_TEXP = SM_GA + (size_t)NBH * SEQ * 4;
constexpr size_t SM_ROWTOK = SM_TEXP + 1024;
constexpr size_t SM_ROWGW = SM_ROWTOK + (size_t)MOE_ROWS * 4;
constexpr size_t SZ_SMALL = al256(SM_ROWGW + (size_t)MOE_ROWS * 4);
constexpr size_t O_ERA = O_SMALL + SZ_SMALL;
constexpr size_t SZ_WIN = al256((size_t)INC * DM * 2);
constexpr size_t O_WIN = O_ERA;
constexpr size_t O_WBO = O_WIN + 2 * SZ_WIN;
constexpr size_t O_WOUT = O_WBO + (size_t)2 * 4 * 1024 * 256 * 2;
constexpr size_t O_FGU = O_WOUT + (size_t)2 * 1024 * 1024 * 2;
constexpr size_t O_FD = O_FGU + (size_t)2 * FFD * 1024 * 2;
constexpr size_t O_R = O_FD + (size_t)1024 * FFD * 2;
constexpr size_t SZ_BH = (size_t)NBH * SEQ * 64 * 2;
constexpr size_t R_U = 0;
constexpr size_t R_Y = 0;
constexpr size_t R_PJ = (size_t)NTOK * DM * 2;
constexpr size_t R_M = R_PJ + (size_t)NTOK * 4096 * 2;
constexpr size_t SZ_U = (size_t)NTOK * UC * 2;
constexpr size_t R_RWA = R_U + SZ_U, R_RWB = R_RWA + SZ_BH, R_RWK = R_RWB + SZ_BH, R_RWR = R_RWK + SZ_BH, R_RWV = R_RWR + SZ_BH;
constexpr size_t R_RWW = R_RWV + SZ_BH;
constexpr size_t R_GQ = R_RWW + 2 * SZ_BH, R_GK = R_GQ + SZ_BH, R_GV = R_GK + SZ_BH;
constexpr size_t R_QD = R_GV + SZ_BH, R_KD = R_QD + SZ_BH, R_VD = R_KD + SZ_BH, R_QF = R_VD + SZ_BH, R_KF = R_QF + SZ_BH, R_VF = R_KF + SZ_BH;
constexpr size_t R_AUXG = R_VF + SZ_BH;
constexpr size_t R_AUXGATE = R_AUXG + (size_t)NTOK * 256 * 2;
constexpr size_t R_END_MIX = R_AUXGATE + (size_t)NTOK * 256 * 2;
static_assert(R_M + (size_t)NTOK * DM * 2 <= R_END_MIX, "M inside region R");
constexpr size_t R_T = 0;
constexpr size_t R_PJ2 = 0;
constexpr size_t O_T2 = O_ERA;
constexpr size_t O_XBUF = O_T2 + (size_t)MOE_ROWS * FFE * 2;
constexpr size_t ERA_B_END = O_XBUF + (size_t)MOE_ROWS * DM * 2;
constexpr size_t ERA_A_END = O_R + R_END_MIX;
constexpr size_t WS_NEED = ERA_A_END > ERA_B_END ? ERA_A_END : ERA_B_END;

struct Params {
  const float* in[36];
  float* x;
  char* ws;
};

DI float bf2f(bf16_t b) { return __uint_as_float(((unsigned)b) << 16); }
DI bf16_t f2bf(float x) { unsigned u = __float_as_uint(x); u += 0x7fffu + ((u >> 16) & 1u); return (bf16_t)(u >> 16); }
DI unsigned pk2(float lo, float hi) { f32x2 v = {lo, hi}; bf16x2_t b = __builtin_convertvector(v, bf16x2_t); return __builtin_bit_cast(unsigned, b); }
DI float sigmoidf_(float x) { return 1.0f / (1.0f + __expf(-x)); }
DI float wave_sum(float v) {
#pragma unroll
  for (int o = 32; o >= 1; o >>= 1) v += __shfl_xor(v, o);
  return v;
}
DI int crow(int r, int hi) { return (r & 3) + 8 * (r >> 2) + 4 * hi; }
DI int otid() { int t = threadIdx.x; asm volatile("" : "+v"(t)); return t; }
DI int obid() { int t = blockIdx.x; asm volatile("" : "+s"(t)); return t; }
DI Params olaunder(const Params& p) { Params q = p; asm volatile("" : "+s"(q.ws), "+s"(q.x)); return q; }


#define GAS __attribute__((address_space(1)))
#define LAS __attribute__((address_space(3)))
typedef GAS unsigned gu32;
#define RLX_AGENT __ATOMIC_RELAXED, __HIP_MEMORY_SCOPE_AGENT
namespace pg8 {
#define PG8_LAS __attribute__((address_space(3)))
typedef unsigned short bf16_t;
typedef short bf16x8 __attribute__((ext_vector_type(8)));
typedef float f32x4 __attribute__((ext_vector_type(4)));
typedef unsigned u32x4 __attribute__((ext_vector_type(4)));
constexpr int BM = 256, BK = 64, HALF = 128, HTB = HALF * BK * 2  , STAGE_BYTES = 8 * HTB, NXCD = 8, WGM = 8;

__host__ __device__ __forceinline__ int lds_byte(int r, int c) { const int st = (r >> 4) * 2 + (c >> 5), rr = r & 15, cc = c & 31, ob = rr * 64 + cc * 2; return st * 1024 + (ob ^ (((ob >> 9) & 1) << 5)); }
__host__ __device__ __forceinline__ void stage_rc(int b, int& R, int& C) { const int st = b / 1024, sb = b % 1024, swz = sb ^ (((sb >> 9) & 1) << 5); R = (st >> 1) * 16 + swz / 64; C = (st & 1) * 32 + (swz % 64) / 2; }
__host__ __device__ __forceinline__ int perm32(int rho) { const int n = rho >> 4, i = rho & 15; return 8 * (i >> 2) + 4 * n + (i & 3); }

struct Unit { int pm, pn; };
struct Gemm { const bf16_t* A; const bf16_t* Bt; int M, N, K; const int* texp; size_t bstride;
  __device__ __forceinline__ size_t boff(int pm) const { return texp ? (size_t)texp[pm] * bstride : (size_t)0; } };

struct StaticOrder {
    int nM, nN, nwg, G, c;
    __host__ __device__ void init(int M, int N, int G_, int c_) { nM = M / BM; nN = N / BM; nwg = nM * nN; G = G_; c = c_; }
    __host__ __device__ bool next(int i, Unit& u) const {
        const long L = (long)i * G + c; if (L >= nwg) return false;
        int wgid = (int)L; { const int q = nwg / NXCD, r = nwg % NXCD, xcd = wgid % NXCD, off = wgid / NXCD; wgid = (xcd < r ? xcd * (q + 1) : r * (q + 1) + (xcd - r) * q) + off; }
        const int nig = WGM * nN, gid = wgid / nig, fm = gid * WGM, gsz = (nM - fm) < WGM ? (nM - fm) : WGM;
        u.pm = fm + ((wgid % nig) % gsz); u.pn = (wgid % nig) / gsz; return true;
    }
    __device__ __forceinline__ void a_ready(const Unit&) const {}
    __device__ __forceinline__ void done(const Unit&) const {}
};

template <class F> struct EpiFn {
    static constexpr bool PERM = false, AFTER_DRAIN = false;
    F f;
    __device__ __forceinline__ void operator()(const f32x4 (&acc)[2][2][4][2], const Unit& u, int wr, int wc, int fr, int fq) const {
#pragma unroll
        for (int ai = 0; ai < 2; ++ai)
#pragma unroll
            for (int m = 0; m < 4; ++m)
#pragma unroll
                for (int bj = 0; bj < 2; ++bj)
#pragma unroll
                    for (int n = 0; n < 2; ++n)
                        f(u.pm * BM + ai * HALF + wr * 64 + m * 16 + fr, u.pn * BM + bj * HALF + wc * 32 + n * 16 + 4 * fq, acc[ai][bj][m][n]);
    }
};
template <class Epi, class Sched, bool ALIGN_EPI = false, bool SP2 = false>
__device__ __forceinline__ void gemm_phase(PG8_LAS unsigned char* lds, const Gemm g, const Sched& S, const Epi& E) {
    const int tid = otid(), wid = __builtin_amdgcn_readfirstlane(tid >> 6), lane = tid & 63, wr = wid >> 2, wc = wid & 3, fr = lane & 15, fq = lane >> 4;
    const int K = g.K, nt = K / BK;
    unsigned voffA[2], voffB[2];
#pragma unroll
    for (int i = 0; i < 2; ++i) { int R, C; stage_rc(tid * 16 + i * 8192, R, C); const int Rb = Epi::PERM ? ((R & ~31) + perm32(R & 31)) : R;
        voffA[i] = (unsigned)(R * K + C) * 2u; voffB[i] = (unsigned)(Rb * K + C) * 2u; }
    const size_t kstep = (size_t)(BK * 2);
    const size_t hstep = (size_t)HALF * K * 2;
    const size_t tstep = 2 * hstep;
    const unsigned ldsw = (unsigned)wid * 1024u;
    const int aoff = lds_byte(wr * 64 + fr, fq * 8), boff = lds_byte(wc * 32 + fr, fq * 8);
#define PG8_SA(b, h) (((b) * 2 + (h)) * HTB)
#define PG8_SB(b, h) ((4 + (b) * 2 + (h)) * HTB)
#define PG8_STAGE(bufoff, gbase, voff) do { _Pragma("unroll") for (int _i = 0; _i < 2; ++_i) \
        __builtin_amdgcn_global_load_lds((const unsigned*)((const char*)(gbase) + (voff)[_i]), (PG8_LAS unsigned*)(lds + (bufoff) + ldsw + _i * 8192), 16, 0, 0); } while (0)
#define PG8_LDA(dst, b, h) do { _Pragma("unroll") for (int m = 0; m < 4; ++m) _Pragma("unroll") for (int k = 0; k < 2; ++k) dst[m][k] = *(const PG8_LAS bf16x8*)(lds + PG8_SA(b, h) + aoff + m * 2048 + k * 1024); } while (0)
#define PG8_LDB(dst, b, h) do { _Pragma("unroll") for (int n = 0; n < 2; ++n) _Pragma("unroll") for (int k = 0; k < 2; ++k) dst[n][k] = *(const PG8_LAS bf16x8*)(lds + PG8_SB(b, h) + boff + n * 2048 + k * 1024); } while (0)
#define PG8_MMA(ai, bj, At, Bt) do { __builtin_amdgcn_s_setprio(1); _Pragma("unroll") for (int m = 0; m < 4; ++m) _Pragma("unroll") for (int n = 0; n < 2; ++n) _Pragma("unroll") for (int k = 0; k < 2; ++k) \
        acc[ai][bj][m][n] = __builtin_amdgcn_mfma_f32_16x16x32_bf16(Bt[n][k], At[m][k], acc[ai][bj][m][n], 0, 0, 0); __builtin_amdgcn_s_setprio(0); } while (0)
#define PG8_WAIT_V(n) asm volatile("s_waitcnt vmcnt(" #n ")" ::: "memory")
#define PG8_WAIT_L(n) asm volatile("s_waitcnt lgkmcnt(" #n ")" ::: "memory")
#define PG8_BAR __builtin_amdgcn_s_barrier()
#define PG8_SCHED __builtin_amdgcn_sched_barrier(0)
    Unit cur, nxt; int ui = 0;
    if (!S.next(0, cur)) return;
    f32x4 acc[2][2][4][2];
#pragma unroll
    for (int a = 0; a < 2; ++a)
#pragma unroll
        for (int b = 0; b < 2; ++b)
#pragma unroll
            for (int m = 0; m < 4; ++m)
#pragma unroll
                for (int n = 0; n < 2; ++n) acc[a][b][m][n] = (f32x4){0.f, 0.f, 0.f, 0.f};
    bf16x8 At[4][2], B0[2][2], B1[2][2];
    const char* cA = (const char*)g.A + (size_t)cur.pm * tstep; const char* cB = (const char*)g.Bt + g.boff(cur.pm) + (size_t)cur.pn * tstep;
    S.a_ready(cur);
    if constexpr (SP2) {
        PG8_STAGE(PG8_SB(0, 0), cB, voffB); PG8_STAGE(PG8_SB(0, 1), cB + hstep, voffB); PG8_STAGE(PG8_SA(0, 0), cA, voffA); PG8_STAGE(PG8_SA(0, 1), cA + hstep, voffA);
        if (wr == 1) PG8_BAR;
        PG8_WAIT_V(2); PG8_BAR;
        PG8_STAGE(PG8_SB(1, 0), cB + kstep, voffB); PG8_STAGE(PG8_SA(1, 0), cA + kstep, voffA); PG8_STAGE(PG8_SB(1, 1), cB + hstep + kstep, voffB);
        PG8_WAIT_V(6); PG8_BAR;
    } else {
        PG8_STAGE(PG8_SB(0, 0), cB, voffB); PG8_STAGE(PG8_SA(0, 0), cA, voffA); PG8_STAGE(PG8_SB(0, 1), cB + hstep, voffB); PG8_STAGE(PG8_SA(0, 1), cA + hstep, voffA);
        if (wr == 1) PG8_BAR;
        PG8_WAIT_V(4); PG8_BAR;
        PG8_STAGE(PG8_SB(1, 0), cB + kstep, voffB); PG8_STAGE(PG8_SA(1, 0), cA + kstep, voffA); PG8_STAGE(PG8_SB(1, 1), cB + hstep + kstep, voffB);
        PG8_WAIT_V(6); PG8_BAR;
    }
    for (;;) {
        const bool has_next = S.next(ui + 1, nxt);
        const char* nA = has_next ? (const char*)g.A + (size_t)nxt.pm * tstep : cA; const char* nB = has_next ? (const char*)g.Bt + g.boff(nxt.pm) + (size_t)nxt.pn * tstep : cB;
        for (int t = 0; t < nt; t += 2) {
            const bool last = (t == nt - 2);
            const char* a1 = cA + (size_t)(t + 1) * kstep;
            const char* a2 = last ? nA : cA + (size_t)(t + 2) * kstep; const char* b2 = last ? nB : cB + (size_t)(t + 2) * kstep;
            const char* a3 = a2 + kstep; const char* b3 = b2 + kstep;
            if (last && has_next) S.a_ready(nxt);
            if constexpr (SP2) {
            PG8_LDB(B0, 0, 0); PG8_LDB(B1, 0, 1); PG8_SCHED; PG8_LDA(At, 0, 0); PG8_STAGE(PG8_SA(1, 1), a1 + hstep, voffA);
            PG8_WAIT_V(8); PG8_WAIT_L(0); PG8_BAR; PG8_MMA(0, 0, At, B0); PG8_MMA(0, 1, At, B1); PG8_BAR; PG8_SCHED;
            PG8_LDA(At, 0, 1); PG8_STAGE(PG8_SB(0, 0), b2, voffB); PG8_STAGE(PG8_SB(0, 1), b2 + hstep, voffB); PG8_STAGE(PG8_SA(0, 0), a2, voffA);
            PG8_WAIT_V(8); PG8_WAIT_L(0); PG8_BAR; PG8_MMA(1, 0, At, B0); PG8_MMA(1, 1, At, B1); PG8_BAR; PG8_SCHED;
            PG8_LDB(B0, 1, 0); PG8_LDB(B1, 1, 1); PG8_SCHED; PG8_LDA(At, 1, 0); PG8_STAGE(PG8_SA(0, 1), a2 + hstep, voffA);
            PG8_WAIT_V(8); PG8_WAIT_L(0); PG8_BAR; PG8_MMA(0, 0, At, B0); PG8_MMA(0, 1, At, B1); PG8_BAR; PG8_SCHED;
            PG8_LDA(At, 1, 1); PG8_STAGE(PG8_SB(1, 0), b3, voffB); PG8_STAGE(PG8_SB(1, 1), b3 + hstep, voffB); PG8_STAGE(PG8_SA(1, 0), a3, voffA);
            PG8_WAIT_V(8); PG8_WAIT_L(0); PG8_BAR; PG8_MMA(1, 0, At, B0); PG8_MMA(1, 1, At, B1); PG8_BAR; PG8_SCHED;
            } else {
            PG8_LDB(B0, 0, 0); PG8_SCHED; PG8_LDA(At, 0, 0); PG8_STAGE(PG8_SA(1, 1), a1 + hstep, voffA);
            PG8_WAIT_L(8); PG8_BAR; PG8_WAIT_L(0); PG8_MMA(0, 0, At, B0); PG8_BAR; PG8_SCHED;
            PG8_LDB(B1, 0, 1); PG8_STAGE(PG8_SB(0, 0), b2, voffB);
            PG8_BAR; PG8_WAIT_L(0); PG8_MMA(0, 1, At, B1); PG8_BAR;
            PG8_LDA(At, 0, 1); PG8_STAGE(PG8_SA(0, 0), a2, voffA);
            PG8_BAR; PG8_WAIT_L(0); PG8_MMA(1, 0, At, B0); PG8_BAR; PG8_SCHED;
            PG8_STAGE(PG8_SB(0, 1), b2 + hstep, voffB);
            PG8_WAIT_V(6); PG8_BAR; PG8_MMA(1, 1, At, B1); PG8_BAR;
            PG8_LDB(B0, 1, 0); PG8_SCHED; PG8_LDA(At, 1, 0); PG8_STAGE(PG8_SA(0, 1), a2 + hstep, voffA);
            PG8_WAIT_L(8); PG8_BAR; PG8_WAIT_L(0); PG8_MMA(0, 0, At, B0); PG8_BAR; PG8_SCHED;
            PG8_LDB(B1, 1, 1); PG8_STAGE(PG8_SB(1, 0), b3, voffB);
            PG8_BAR; PG8_WAIT_L(0); PG8_MMA(0, 1, At, B1); PG8_BAR;
            PG8_LDA(At, 1, 1); PG8_STAGE(PG8_SA(1, 0), a3, voffA);
            PG8_BAR; PG8_WAIT_L(0); PG8_MMA(1, 0, At, B0); PG8_BAR; PG8_SCHED;
            PG8_STAGE(PG8_SB(1, 1), b3 + hstep, voffB);
            PG8_WAIT_V(6); PG8_BAR; PG8_MMA(1, 1, At, B1); PG8_BAR;
            }
        }
        if constexpr (ALIGN_EPI) { if (wr == 0) PG8_BAR; }
        if constexpr (!Epi::AFTER_DRAIN) { E(acc, cur, wr, wc, fr, fq); S.done(cur); }
        if (!has_next) break;
#pragma unroll
        for (int a = 0; a < 2; ++a)
#pragma unroll
            for (int b = 0; b < 2; ++b)
#pragma unroll
                for (int m = 0; m < 4; ++m)
#pragma unroll
                    for (int n = 0; n < 2; ++n) acc[a][b][m][n] = (f32x4){0.f, 0.f, 0.f, 0.f};
        cur = nxt; cA = nA; cB = nB; ++ui;
        if constexpr (ALIGN_EPI) { if (wr == 1) PG8_BAR; }
    }
    PG8_WAIT_V(0);
    if constexpr (!ALIGN_EPI) { if (wr == 0) PG8_BAR; }
    PG8_BAR;
    if constexpr (Epi::AFTER_DRAIN) { E.fused(acc, cur, wr, wc, fr, fq, lds, wid, lane); S.done(cur); }
#undef PG8_SA
#undef PG8_SB
#undef PG8_STAGE
#undef PG8_LDA
#undef PG8_LDB
#undef PG8_MMA
#undef PG8_WAIT_V
#undef PG8_WAIT_L
#undef PG8_BAR
#undef PG8_SCHED
}
}

#define XB_TMO      128
#define XB_XCNT(j)  (256  + 64 * (j))
#define XB_XSUB(j)  (1280 + 64 * (j))
#define XB_XGEN(j)  (2304 + 64 * (j))
#define XB_TOP      3328
#define XB_TOPGEN   3392
#define XCD_BAR_WORDS 3456
#define XB_SPIN_CAP (1u << 18)

__device__ __forceinline__ unsigned xb_ld(unsigned* p)              { return __hip_atomic_load(p, __ATOMIC_RELAXED, __HIP_MEMORY_SCOPE_AGENT); }
__device__ __forceinline__ unsigned xb_add(unsigned* p, unsigned v) { return __hip_atomic_fetch_add(p, v, __ATOMIC_RELAXED, __HIP_MEMORY_SCOPE_AGENT); }
__device__ __forceinline__ unsigned xb_xcc_id() { return (unsigned)__builtin_amdgcn_s_getreg((3 << 11) | 20) & 0xFu; }
#define XB_SPIN(cond, bar) do { unsigned _sp = 0; while (cond) { __builtin_amdgcn_s_sleep(1); \
    if ((++_sp & 255u) == 0u) { if (xb_ld(&(bar)[XB_TMO])) break; if (_sp > XB_SPIN_CAP) { atomicAdd(&(bar)[XB_TMO], 1u); break; } } } } while (0)

struct XcdBarrier {
    unsigned* bar; unsigned x;
    volatile LAS unsigned* st;
};

__device__ __forceinline__ XcdBarrier xcd_barrier_post(unsigned* bar, volatile LAS unsigned* st) {
    XcdBarrier b; b.bar = bar; b.x = xb_xcc_id(); b.st = st;
    if (threadIdx.x == 0) (void)xb_add(&bar[XB_XCNT(b.x)], 1u);
    return b;
}
__device__ __forceinline__ void xcd_barrier_complete(unsigned* bar, unsigned x, unsigned& nloc, unsigned& nx) {
    const unsigned G = gridDim.x * gridDim.y * gridDim.z;
    unsigned sum, cnt, mine, sp = 0u;
    for (;;) {
        sum = 0u; cnt = 0u; mine = 0u;
#pragma unroll
        for (unsigned j = 0; j < 16; ++j) { const unsigned c = xb_ld(&bar[XB_XCNT(j)]); sum += c; cnt += (c > 0u) ? 1u : 0u; mine = (j == x) ? c : mine; }
        if (sum == G) break;
        __builtin_amdgcn_s_sleep(1);
        if ((++sp & 255u) == 0u) { if (xb_ld(&bar[XB_TMO])) break; if (sp > XB_SPIN_CAP) { atomicAdd(&bar[XB_TMO], 1u); break; } }
    }
    nloc = mine > 0u ? mine : 1u; nx = cnt > 0u ? cnt : 1u;
}

__device__ __forceinline__ void xcd_barrier(const XcdBarrier& b) {
    asm volatile("s_waitcnt vmcnt(0)" ::: "memory");
    __syncthreads();
    if (threadIdx.x == 0) {
        unsigned* bar = b.bar; unsigned bx_ = b.x;
        asm volatile("" : "+s"(bar), "+s"(bx_));
        __builtin_amdgcn_s_waitcnt(0);
        unsigned nloc = b.st[0], nx = b.st[1];
        if (nloc == 0u) { xcd_barrier_complete(bar, bx_, nloc, nx); b.st[0] = nloc; b.st[1] = nx; }
        const unsigned old = xb_add(&bar[XB_XSUB(bx_)], 1u);
        const unsigned gen = old / nloc;
        if (old + 1u == (gen + 1u) * nloc) {
            __builtin_amdgcn_fence(__ATOMIC_RELEASE, "agent");
            asm volatile("s_waitcnt vmcnt(0)" ::: "memory");
            const unsigned og = xb_add(&bar[XB_TOP], 1u);
            const unsigned tg = og / nx;
            if (og + 1u == (tg + 1u) * nx) xb_add(&bar[XB_TOPGEN], 1u);
            else XB_SPIN(xb_ld(&bar[XB_TOPGEN]) == tg, bar);
            __builtin_amdgcn_fence(__ATOMIC_ACQUIRE, "agent");
            xb_add(&bar[XB_XGEN(bx_)], 1u);
            asm volatile("s_waitcnt vmcnt(0)" ::: "memory");
        } else {
            XB_SPIN(xb_ld(&bar[XB_XGEN(bx_)]) == gen, bar);
            __builtin_amdgcn_fence(__ATOMIC_ACQUIRE, "agent");
            asm volatile("s_waitcnt vmcnt(0)" ::: "memory");
        }
    }
    __syncthreads();
}

DI void transpose_job(const float* __restrict__ src, int K, int N, bf16_t* __restrict__ dst, int rmul, int radd, char* lds) {
  float* tl = (float*)lds;
  const int tk = K / 64, tn = (N + 63) / 64, nt = tk * tn, tid = otid();
  for (int t = obid(); t < nt; t += gridDim.x) {
    const int k0 = (t / tn) * 64, n0 = (t % tn) * 64;
    __syncthreads();
    {
      const int kr = tid >> 3, nc = (tid & 7) * 4;
#pragma unroll
      for (int i = 0; i < 2; ++i) {
        const int n = n0 + nc + 32 * i;
        f32x4 v = {0.f, 0.f, 0.f, 0.f};
        if (n < N) v = *(const f32x4*)(src + (size_t)(k0 + kr) * N + n);
        float* d = tl + kr * 65 + nc + 32 * i;
        d[0] = v[0]; d[1] = v[1]; d[2] = v[2]; d[3] = v[3];
      }
    }
    __syncthreads();
    {
      const int nr = tid >> 3, kc = (tid & 7) * 8, n = n0 + nr;
      if (n < N) {
        u32x4 w;
        w[0] = pk2(tl[(kc + 0) * 65 + nr], tl[(kc + 1) * 65 + nr]);
        w[1] = pk2(tl[(kc + 2) * 65 + nr], tl[(kc + 3) * 65 + nr]);
        w[2] = pk2(tl[(kc + 4) * 65 + nr], tl[(kc + 5) * 65 + nr]);
        w[3] = pk2(tl[(kc + 6) * 65 + nr], tl[(kc + 7) * 65 + nr]);
        *(u32x4*)(dst + ((size_t)n * rmul + radd) * K + k0 + kc) = w;
      }
    }
  }
}


DI void phase0(const Params& p, char* lds) {
  char* ws = p.ws;
  const int gtid = obid() * NTHR + otid(), gsz = gridDim.x * NTHR;
  {
    const f32x4* s = (const f32x4*)p.in[0]; f32x4* d = (f32x4*)p.x;
    for (int i = gtid; i < NTOK * DM / 4; i += gsz) d[i] = s[i];
  }
  for (int L = 0; L < 2; ++L) {
    transpose_job(p.in[5] + (size_t)L * DM * INC, 1024, INC, (bf16_t*)(ws + O_WIN + L * SZ_WIN), 1, 0, lds);
    for (int b = 0; b < 4; ++b)
      transpose_job(p.in[6] + (size_t)(L * 4 + b) * 256 * 1024, 256, 1024, (bf16_t*)(ws + O_WBO) + (size_t)(L * 4 + b) * 1024 * 256, 1, 0, lds);
    transpose_job(p.in[7] + (size_t)L * 1024 * 1024, 1024, 1024, (bf16_t*)(ws + O_WOUT) + (size_t)L * 1024 * 1024, 1, 0, lds);
    transpose_job(p.in[34] + (size_t)L * 1024 * 1024, 1024, 1024, (bf16_t*)(ws + O_PG) + (size_t)L * 1024 * 1024, 1, 0, lds);
    transpose_job(p.in[33] + (size_t)L * 256 * 1024, 256, 1024, (bf16_t*)(ws + O_PP) + (size_t)L * 1024 * 256, 1, 0, lds);
  }
  transpose_job(p.in[26], 1024, FFD, (bf16_t*)(ws + O_FGU), 2, 0, lds);
  transpose_job(p.in[27], 1024, FFD, (bf16_t*)(ws + O_FGU), 2, 1, lds);
  transpose_job(p.in[28], FFD, 1024, (bf16_t*)(ws + O_FD), 1, 0, lds);
  for (int e = 0; e < NEXP; ++e) {
    transpose_job(p.in[30] + (size_t)e * 1024 * FFE, 1024, FFE, (bf16_t*)(ws + O_MGU) + (size_t)e * 2 * FFE * 1024, 2, 0, lds);
    transpose_job(p.in[31] + (size_t)e * 1024 * FFE, 1024, FFE, (bf16_t*)(ws + O_MGU) + (size_t)e * 2 * FFE * 1024, 2, 1, lds);
    transpose_job(p.in[32] + (size_t)e * FFE * 1024, FFE, 1024, (bf16_t*)(ws + O_MD) + (size_t)e * 1024 * FFE, 1, 0, lds);
  }
}
DI void convert_p(const Params& p, int L) {
  const int gtid = obid() * NTHR + otid(), gsz = gridDim.x * NTHR;
  const f32x4* s = (const f32x4*)(p.in[1] + (size_t)L * NTOK * 256); u32x2* d = (u32x2*)(p.ws + O_PB);
  for (int i = gtid; i < NTOK * 256 / 4; i += gsz) { f32x4 v = s[i]; u32x2 w; w[0] = pk2(v[0], v[1]); w[1] = pk2(v[2], v[3]); d[i] = w; }
}
template <bool ROUTER>
DI void norm_phase(const Params& p, const float* __restrict__ g, const float* __restrict__ router) {
  const int lane = otid() & 63, wid = otid() >> 6;
  bf16_t* hb = (bf16_t*)(p.ws + O_HB);
  int* cnt = (int*)(p.ws + O_CTL) + CW_MOECNT;
  int* list = (int*)(p.ws + O_SMALL + SM_LIST);
  float* gw = (float*)(p.ws + O_SMALL + SM_GW);
  for (int row = obid() * 8 + wid; row < NTOK; row += gridDim.x * 8) {
    const float* xr = p.x + (size_t)row * DM;
    f32x4 v[4]; float ss = 0.f;
#pragma unroll
    for (int j = 0; j < 4; ++j) { v[j] = *(const f32x4*)(xr + j * 256 + lane * 4); ss += v[j][0] * v[j][0] + v[j][1] * v[j][1] + v[j][2] * v[j][2] + v[j][3] * v[j][3]; }
    ss = wave_sum(ss);
    const float rstd = rsqrtf(ss * (1.0f / 1024.0f) + 1e-6f);
    float lg[8];
    if (ROUTER) {
#pragma unroll
      for (int e = 0; e < 8; ++e) lg[e] = 0.f;
    }
#pragma unroll
    for (int j = 0; j < 4; ++j) {
      const f32x4 gg = *(const f32x4*)(g + j * 256 + lane * 4);
      f32x4 h = v[j] * rstd * gg;
      u32x2 w; w[0] = pk2(h[0], h[1]); w[1] = pk2(h[2], h[3]);
      *(u32x2*)(hb + (size_t)row * DM + j * 256 + lane * 4) = w;
      if (ROUTER) {
#pragma unroll
        for (int c = 0; c < 4; ++c) {
          const float* rr = router + (size_t)(j * 256 + lane * 4 + c) * 8;
          const f32x4 r0 = *(const f32x4*)rr, r1 = *(const f32x4*)(rr + 4);
          lg[0] += h[c] * r0[0]; lg[1] += h[c] * r0[1]; lg[2] += h[c] * r0[2]; lg[3] += h[c] * r0[3];
          lg[4] += h[c] * r1[0]; lg[5] += h[c] * r1[1]; lg[6] += h[c] * r1[2]; lg[7] += h[c] * r1[3];
        }
      }
    }
    if (ROUTER) {
#pragma unroll
      for (int e = 0; e < 8; ++e) lg[e] = wave_sum(lg[e]);
      if (lane == 0) {
        int e1 = 0; float l1 = lg[0];
#pragma unroll
        for (int e = 1; e < 8; ++e) if (lg[e] > l1) { l1 = lg[e]; e1 = e; }
        int e2 = -1; float l2 = -INFINITY;
#pragma unroll
        for (int e = 0; e < 8; ++e) if (e != e1 && lg[e] > l2) { l2 = lg[e]; e2 = e; }
        const float w1 = 1.0f / (1.0f + __expf(l2 - l1)), w2 = 1.0f - w1;
        int s1 = atomicAdd(cnt + e1, 1); list[e1 * NTOK + s1] = row; gw[e1 * NTOK + s1] = w1;
        int s2 = atomicAdd(cnt + e2, 1); list[e2 * NTOK + s2] = row; gw[e2 * NTOK + s2] = w2;
      }
    }
  }
}

DI float softplusf_(float z) { return z > 20.f ? z : __logf(1.0f + __expf(z)); }
DI float logsigmoidf_(float z) { return z >= 0.f ? -__logf(1.0f + __expf(-z)) : z - __logf(1.0f + __expf(z)); }

DI void phase_prep(const Params& p, int L, char* lds) {
  float* xw_s = (float*)lds; float* xa_s = xw_s + 8 * 64; float* xg_s = xa_s + 8 * 64;
  char* R = p.ws + O_R;
  const bf16_t* u = (const bf16_t*)(R + R_U);
  bf16_t* rwA = (bf16_t*)(R + R_RWA); bf16_t* rwB = (bf16_t*)(R + R_RWB); bf16_t* rwK = (bf16_t*)(R + R_RWK);
  bf16_t* rwR = (bf16_t*)(R + R_RWR); bf16_t* rwV = (bf16_t*)(R + R_RWV); float* rwW = (float*)(R + R_RWW);
  bf16_t* gq = (bf16_t*)(R + R_GQ); bf16_t* gk = (bf16_t*)(R + R_GK); bf16_t* gv = (bf16_t*)(R + R_GV);
  bf16_t* Qd = (bf16_t*)(R + R_QD); bf16_t* Kd = (bf16_t*)(R + R_KD); bf16_t* Vd = (bf16_t*)(R + R_VD);
  bf16_t* Qf = (bf16_t*)(R + R_QF); bf16_t* Kf = (bf16_t*)(R + R_KF); bf16_t* Vf = (bf16_t*)(R + R_VF);
  bf16_t* auxg = (bf16_t*)(R + R_AUXG); bf16_t* auxgate = (bf16_t*)(R + R_AUXGATE);
  float* rk = (float*)(p.ws + O_SMALL + SM_RK); float* logf_ = (float*)(p.ws + O_SMALL + SM_LOGF);
  float* gbeta = (float*)(p.ws + O_SMALL + SM_GBETA); float* ga = (float*)(p.ws + O_SMALL + SM_GA);
  const float* mu = p.in[8] + L * 1024; const float* w0 = p.in[9] + L * 256; const float* w2 = p.in[10] + L * 64 * 256;
  const float* a0 = p.in[11] + L * 256; const float* a2 = p.in[12] + L * 64 * 256; const float* g2 = p.in[13] + L * 128 * 256;
  const float* kkp = p.in[14] + L * 256; const float* kap = p.in[15] + L * 256; const float* rkp = p.in[16] + L * 256;
  const float* fbias = p.in[21] + L * 4; const float* cw = p.in[22] + L * 768 * 4;
  const float* alog = p.in[23] + L * 4; const float* dtb = p.in[24] + L * 4;
  const int tid = otid(), j = tid & 255, half = tid >> 8, lane = tid & 63, h = j >> 6, dh = j & 63;
  const float QS_D = 0.25503486164919736f, QS_F = 0.18033688011112042f;
  for (int tile = obid(); tile < NTOK / 8; tile += gridDim.x) {
    const int T0 = tile * 8, b = T0 / SEQ, t0 = T0 % SEQ, bh = b * 4 + h;
    float r[4], k[4], v[4];
    __syncthreads();
#pragma unroll
    for (int i = 0; i < 4; ++i) {
      const int tl = half * 4 + i, tok = T0 + tl, t = t0 + tl;
      const bf16_t* ur = u + (size_t)tok * UC;
#pragma unroll
      for (int seg = 0; seg < 4; ++seg) {
        const int c = seg * 256 + j;
        const float ua = bf2f(ur[c]);
        const float up = t > 0 ? bf2f(ur[c - UC]) : 0.f;
        const float xm = ua + (up - ua) * mu[c];
        if (seg == 0) r[i] = xm; else if (seg == 1) k[i] = xm; else if (seg == 2) v[i] = xm;
        else {
          if (j < 64) xw_s[tl * 64 + j] = 1.0f - 2.0f / (1.0f + __expf(2.0f * xm));
          else if (j < 128) xa_s[tl * 64 + (j - 64)] = xm;
          else xg_s[tl * 128 + (j - 128)] = sigmoidf_(xm);
        }
      }
    }
    __syncthreads();
    float lw[4], alr[4], gg[4];
#pragma unroll
    for (int i = 0; i < 4; ++i) { lw[i] = w0[j]; alr[i] = a0[j]; gg[i] = 0.f; }
    for (int q = 0; q < 64; ++q) {
      const float wv = w2[q * 256 + j], av = a2[q * 256 + j];
#pragma unroll
      for (int i = 0; i < 4; ++i) { lw[i] += xw_s[(half * 4 + i) * 64 + q] * wv; alr[i] += xa_s[(half * 4 + i) * 64 + q] * av; }
    }
    for (int q = 0; q < 128; ++q) {
      const float gvv = g2[q * 256 + j];
#pragma unroll
      for (int i = 0; i < 4; ++i) gg[i] += xg_s[(half * 4 + i) * 128 + q] * gvv;
    }
#pragma unroll
    for (int i = 0; i < 4; ++i) {
      const int tl = half * 4 + i, tok = T0 + tl, t = t0 + tl;
      const float dec = __expf(-0.6065306597126334f * sigmoidf_(lw[i]));
      const float a = sigmoidf_(alr[i]);
      const float kkr = k[i] * kkp[j];
      const float ss = wave_sum(kkr * kkr);
      const float kk = kkr * rsqrtf(ss + 1e-6f);
      const float kp = k[i] * (1.0f + (a - 1.0f) * kap[j]);
      const float rks = wave_sum(r[i] * kp * rkp[j]);
      const size_t idx = ((size_t)bh * SEQ + t) * 64 + dh;
      rwA[idx] = f2bf(-kk); rwW[idx] = dec; rwB[idx] = f2bf(kk * a); rwK[idx] = f2bf(kp); rwR[idx] = f2bf(r[i]); rwV[idx] = f2bf(v[i]);
      auxg[(size_t)tok * 256 + j] = f2bf(gg[i]);
      if (lane == 0) rk[tok * 4 + h] = rks;
    }
    {
      float vd[4], vf[4];
#pragma unroll
      for (int i = 0; i < 4; ++i) {
        const int tl = half * 4 + i, tok = T0 + tl, t = t0 + tl;
        const bf16_t* ur = u + (size_t)tok * UC;
        float q = bf2f(ur[OFF_B + j]), kx = bf2f(ur[OFF_B + 256 + j]);
        vd[i] = bf2f(ur[OFF_B + 512 + j]);
        const int d = dh & 31;
        if (d < 8) {
          const int ii = d & 3;
          const float invrev = ii == 0 ? 0.15915494309189535f : ii == 1 ? 0.005985185712713705f : ii == 2 ? 0.00022507907903927653f : 8.464330808241401e-06f;
          const float rvf = (float)t * invrev;
          const float fr = rvf - floorf(rvf);
          const float sn = __builtin_amdgcn_sinf(fr), cs = __builtin_amdgcn_cosf(fr);
          const int pj = d < 4 ? j + 4 : j - 4;
          const float qp = bf2f(ur[OFF_B + pj]), kpn = bf2f(ur[OFF_B + 256 + pj]);
          if (d < 4) { q = q * cs - qp * sn; kx = kx * cs - kpn * sn; }
          else { q = q * cs + qp * sn; kx = kx * cs + kpn * sn; }
        }
        const size_t idx = ((size_t)bh * SEQ + t) * 64 + dh;
        Qd[idx] = f2bf(q * QS_D); Kd[idx] = f2bf(kx);
        Qf[idx] = f2bf(bf2f(ur[OFF_C + j]) * QS_F); Kf[idx] = ur[OFF_C + 256 + j];
        vf[i] = bf2f(ur[OFF_C + 512 + j]);
        if (j < 4) logf_[(size_t)(b * 4 + j) * SEQ + t] = logsigmoidf_(bf2f(ur[OFF_C + 768 + j]) + fbias[j]);
      }
      const size_t vidx = ((size_t)bh * 64 + dh) * SEQ + t0 + half * 4;
      u32x2 w; w[0] = pk2(vd[0], vd[1]); w[1] = pk2(vd[2], vd[3]); *(u32x2*)(Vd + vidx) = w;
      w[0] = pk2(vf[0], vf[1]); w[1] = pk2(vf[2], vf[3]); *(u32x2*)(Vf + vidx) = w;
    }
#pragma unroll
    for (int i = 0; i < 4; ++i) {
      const int tl = half * 4 + i, tok = T0 + tl, t = t0 + tl;
      const bf16_t* ur = u + (size_t)tok * UC + OFF_D;
      float y[3];
#pragma unroll
      for (int seg = 0; seg < 3; ++seg) {
        const int c = seg * 256 + j;
        const f32x4 wv = *(const f32x4*)(cw + c * 4);
        float acc = wv[3] * bf2f(ur[c]);
        if (t >= 1) acc += wv[2] * bf2f(ur[c - UC]);
        if (t >= 2) acc += wv[1] * bf2f(ur[c - 2 * UC]);
        if (t >= 3) acc += wv[0] * bf2f(ur[c - 3 * UC]);
        y[seg] = acc * sigmoidf_(acc);
      }
      const float sq = wave_sum(y[0] * y[0]), sk = wave_sum(y[1] * y[1]);
      const float qn = y[0] * rsqrtf(sq + 1e-6f) * 0.125f, kn = y[1] * rsqrtf(sk + 1e-6f);
      const size_t idx = ((size_t)bh * SEQ + t) * 64 + dh;
      gq[idx] = f2bf(qn); gk[idx] = f2bf(kn); gv[idx] = f2bf(y[2]);
      const float gate = bf2f(ur[776 + j]);
      auxgate[(size_t)tok * 256 + j] = f2bf(gate * sigmoidf_(gate));
      if (lane == 0) {
        const float beta = sigmoidf_(bf2f(ur[768 + h]));
        const float gl = -__expf(alog[h]) * softplusf_(bf2f(ur[772 + h]) + dtb[h]);
        gbeta[(size_t)bh * SEQ + t] = beta; ga[(size_t)bh * SEQ + t] = __expf(gl);
      }
    }
  }
}

DI float dpp_sum8(float x) {
  x += __int_as_float(__builtin_amdgcn_update_dpp(0, __float_as_int(x), 0xB1, 0xF, 0xF, true));
  x += __int_as_float(__builtin_amdgcn_update_dpp(0, __float_as_int(x), 0x4E, 0xF, 0xF, true));
  x += __int_as_float(__builtin_amdgcn_update_dpp(0, __float_as_int(x), 0x141, 0xF, 0xF, true));
  return x;
}
constexpr int SCH = 16;
template <int WHICH>
DI void scan_block(const Params& p, int L, int bh, char* lds) {
  float* buf = (float*)lds;
  float* obuf = buf + 2 * SCH * 384;
  char* R = p.ws + O_R;
  const int tid = otid(), v = tid >> 3, sub = tid & 7, lane = tid & 63, wid = tid >> 6;
  const int b = bh >> 2, h = bh & 3;
  const size_t base = (size_t)bh * SEQ * 64;
  const unsigned* pA = (const unsigned*)((const bf16_t*)(R + (WHICH == 0 ? R_RWA : R_GK)) + base);
  const unsigned* pB = (const unsigned*)((const bf16_t*)(R + R_RWB) + base);
  const unsigned* pK = (const unsigned*)((const bf16_t*)(R + R_RWK) + base);
  const unsigned* pR = (const unsigned*)((const bf16_t*)(R + (WHICH == 0 ? R_RWR : R_GQ)) + base);
  const unsigned* pV = (const unsigned*)((const bf16_t*)(R + (WHICH == 0 ? R_RWV : R_GV)) + base);
  const f32x2* pW = (const f32x2*)((const float*)(R + R_RWW) + base);
  const float* gbeta = (const float*)(p.ws + O_SMALL + SM_GBETA) + (size_t)bh * SEQ;
  const float* ga = (const float*)(p.ws + O_SMALL + SM_GA) + (size_t)bh * SEQ;
  const float* rk = (const float*)(p.ws + O_SMALL + SM_RK);
  const bf16_t* auxg = (const bf16_t*)(R + (WHICH == 0 ? R_AUXG : R_AUXGATE));
  bf16_t* y = (bf16_t*)(R + R_Y);
  const float pw = WHICH == 0 ? (p.in[17] + L * 256)[h * 64 + lane] : (p.in[25] + L * 64)[lane];
  const float pb = WHICH == 0 ? (p.in[18] + L * 256)[h * 64 + lane] : 0.f;
  float s[8];
#pragma unroll
  for (int i = 0; i < 8; ++i) s[i] = 0.f;
  unsigned ra = 0, rb = 0, rkk = 0, rr = 0, rv = 0; f32x2 rw = {0.f, 0.f}; float rbeta = 0.f, raa = 0.f;
  const int est = tid >> 5;
  const int ek = (tid & 31) * 2;
#define SCAN_LOAD(c)                                                                                         \
  {                                                                                                          \
    const size_t o_ = (size_t)(c) * (SCH * 32) + tid;                                                        \
    ra = pA[o_]; rr = pR[o_]; rv = pV[o_];                                                                   \
    if (WHICH == 0) { rb = pB[o_]; rkk = pK[o_]; rw = pW[o_]; }                                              \
    else { rbeta = gbeta[(c) * SCH + est]; raa = ga[(c) * SCH + est]; }                                      \
  }
#define SCAN_STAGE(c)                                                                                        \
  {                                                                                                          \
    float* d_ = buf + ((c) & 1) * (SCH * 384) + est * 384 + ek;                                              \
    const float a0_ = __uint_as_float(ra << 16), a1_ = __uint_as_float(ra & 0xffff0000u);                   \
    const float r0_ = __uint_as_float(rr << 16), r1_ = __uint_as_float(rr & 0xffff0000u);                   \
    const float v0_ = __uint_as_float(rv << 16), v1_ = __uint_as_float(rv & 0xffff0000u);                   \
    if (WHICH == 0) {                                                                                        \
      d_[0] = a0_; d_[1] = a1_; d_[64] = rw[0]; d_[65] = rw[1];                                              \
      d_[128] = __uint_as_float(rb << 16); d_[129] = __uint_as_float(rb & 0xffff0000u);                      \
      d_[192] = __uint_as_float(rkk << 16); d_[193] = __uint_as_float(rkk & 0xffff0000u);                    \
    } else {                                                                                                 \
      d_[0] = -a0_; d_[1] = -a1_; d_[64] = raa; d_[65] = raa;                                                \
      d_[128] = raa * rbeta * a0_; d_[129] = raa * rbeta * a1_;                                              \
      d_[192] = rbeta * a0_; d_[193] = rbeta * a1_;                                                          \
    }                                                                                                        \
    d_[256] = r0_; d_[257] = r1_; d_[320] = v0_; d_[321] = v1_;                                              \
  }
  SCAN_LOAD(0);
  SCAN_STAGE(0);
  constexpr int NCH = SEQ / SCH;
  for (int c = 0; c < NCH; ++c) {
    __syncthreads();
    if (c + 1 < NCH) SCAN_LOAD(c + 1);
    const float* cb = buf + (c & 1) * (SCH * 384);
#pragma unroll 4
    for (int st = 0; st < SCH; ++st) {
      const float* sp = cb + st * 384 + sub * 8;
      const f32x4 A0 = *(const f32x4*)(sp), A1 = *(const f32x4*)(sp + 4);
      const f32x4 W0 = *(const f32x4*)(sp + 64), W1 = *(const f32x4*)(sp + 68);
      const f32x4 B0 = *(const f32x4*)(sp + 128), B1 = *(const f32x4*)(sp + 132);
      const f32x4 K0 = *(const f32x4*)(sp + 192), K1 = *(const f32x4*)(sp + 196);
      const f32x4 R0 = *(const f32x4*)(sp + 256), R1 = *(const f32x4*)(sp + 260);
      const float vv = cb[st * 384 + 320 + v];
      float d0 = s[0] * A0[0] + s[1] * A0[1], d1 = s[2] * A0[2] + s[3] * A0[3], d2 = s[4] * A1[0] + s[5] * A1[1], d3 = s[6] * A1[2] + s[7] * A1[3];
      const float sa = dpp_sum8((d0 + d1) + (d2 + d3));
      s[0] = s[0] * W0[0] + sa * B0[0] + vv * K0[0]; s[1] = s[1] * W0[1] + sa * B0[1] + vv * K0[1];
      s[2] = s[2] * W0[2] + sa * B0[2] + vv * K0[2]; s[3] = s[3] * W0[3] + sa * B0[3] + vv * K0[3];
      s[4] = s[4] * W1[0] + sa * B1[0] + vv * K1[0]; s[5] = s[5] * W1[1] + sa * B1[1] + vv * K1[1];
      s[6] = s[6] * W1[2] + sa * B1[2] + vv * K1[2]; s[7] = s[7] * W1[3] + sa * B1[3] + vv * K1[3];
      float e0 = s[0] * R0[0] + s[1] * R0[1], e1 = s[2] * R0[2] + s[3] * R0[3], e2 = s[4] * R1[0] + s[5] * R1[1], e3 = s[6] * R1[2] + s[7] * R1[3];
      const float oo = dpp_sum8((e0 + e1) + (e2 + e3));
      if (sub == 0) obuf[st * 64 + v] = oo;
    }
    __syncthreads();
    if (c + 1 < NCH) SCAN_STAGE(c + 1);
#pragma unroll
    for (int q = 0; q < 2; ++q) {
      const int st = wid * 2 + q, t = c * SCH + st, tok = b * SEQ + t;
      const float o = obuf[st * 64 + lane];
      float val;
      if (WHICH == 0) {
        const float mean = wave_sum(o) * (1.0f / 64.0f), dl = o - mean;
        const float var = wave_sum(dl * dl) * (1.0f / 64.0f);
        val = dl * rsqrtf(var + 64e-5f) * pw + pb;
        val += rk[tok * 4 + h] * cb[st * 384 + 320 + lane];
        val *= bf2f(auxg[(size_t)tok * 256 + h * 64 + lane]);
        y[((size_t)0 * NTOK + tok) * 256 + h * 64 + lane] = f2bf(val);
      } else {
        const float ms = wave_sum(o * o) * (1.0f / 64.0f);
        val = o * rsqrtf(ms + 1e-6f) * pw * bf2f(auxg[(size_t)tok * 256 + h * 64 + lane]);
        y[((size_t)3 * NTOK + tok) * 256 + h * 64 + lane] = f2bf(val);
      }
    }
  }
#undef SCAN_LOAD
#undef SCAN_STAGE
}

DI bf16x8 packf8(float a0, float a1, float a2, float a3, float a4, float a5, float a6, float a7) {
  u32x4 w; w[0] = pk2(a0, a1); w[1] = pk2(a2, a3); w[2] = pk2(a4, a5); w[3] = pk2(a6, a7);
  return __builtin_bit_cast(bf16x8, w);
}
constexpr int KLD = 72;
template <int TYPE>
DI void attn_unit(const Params& p, int L, int bh, int qt, char* lds) {
  bf16_t* Ks = (bf16_t*)lds;
  bf16_t* Vs = Ks + 64 * KLD;
  float* cs = (float*)(lds + 2 * 64 * KLD * 2);
  float* red = cs + 8192;
  char* R = p.ws + O_R;
  const int tid = otid(), lane = tid & 63, wid = tid >> 6, r32 = lane & 31, hi = lane >> 5;
  const int b = bh >> 2, h = bh & 3;
  const int map = TYPE == 0 ? (wid >> 2) : 0, wq = TYPE == 0 ? (wid & 3) : wid;
  const int QROWS = TYPE == 0 ? 128 : 256;
  const int q0 = qt * QROWS, qw0 = q0 + wq * 32, q = qw0 + r32;
  const bf16_t* Qg = (const bf16_t*)(R + (TYPE == 0 ? R_QD : R_QF)) + (size_t)bh * SEQ * 64;
  const bf16_t* Kg = (const bf16_t*)(R + (TYPE == 0 ? R_KD : R_KF)) + (size_t)bh * SEQ * 64;
  const bf16_t* Vg = (const bf16_t*)(R + (TYPE == 0 ? R_VD : R_VF)) + (size_t)bh * 64 * SEQ;
  const int NT = (q0 + QROWS) / 64;
  __syncthreads();
  const int lrow = tid >> 3, lch = (tid & 7) * 8;
  u32x4 kreg = *(const u32x4*)(Kg + (size_t)lrow * 64 + lch);
  u32x4 vreg = *(const u32x4*)(Vg + (size_t)lrow * SEQ + lch);
  float cq = 0.f;
  if (TYPE == 1) {
    const float* lf = (const float*)(p.ws + O_SMALL + SM_LOGF) + (size_t)bh * SEQ;
    const int n = q0 + 256;
    float loc[16]; float tot = 0.f;
#pragma unroll
    for (int i = 0; i < 16; ++i) { const int e = tid * 16 + i; loc[i] = e < n ? lf[e] : 0.f; tot += loc[i]; }
    float inc = tot;
#pragma unroll
    for (int o = 1; o < 64; o <<= 1) { const float t2 = __shfl_up(inc, o); if (lane >= o) inc += t2; }
    if (lane == 63) red[wid] = inc;
    __syncthreads();
    float pre = inc - tot;
    for (int w = 0; w < wid; ++w) pre += red[w];
#pragma unroll
    for (int i = 0; i < 16; ++i) { pre += loc[i]; const int e = tid * 16 + i; if (e < n) cs[e] = pre * 1.4426950408889634f; }
    __syncthreads();
    cq = cs[q];
  }
  constexpr int NS = TYPE == 0 ? 2 : 4;
  const int sbase = TYPE == 0 ? 2 * map : 0;
  bf16x8 qf[NS];
#pragma unroll
  for (int s = 0; s < NS; ++s) qf[s] = *(const bf16x8*)(Qg + (size_t)q * 64 + 16 * (sbase + s) + 8 * hi);
  float m = -INFINITY, l = 0.f; f32x16 o[2];
#pragma unroll
  for (int r = 0; r < 16; ++r) { o[0][r] = 0.f; o[1][r] = 0.f; }
#pragma unroll 1
  for (int jt = 0; jt < NT; ++jt) {
    const int kv0 = jt * 64;
    __syncthreads();
    *(u32x4*)(Ks + lrow * KLD + lch) = kreg;
    *(u32x4*)(Vs + lrow * KLD + lch) = vreg;
    __syncthreads();
    if (jt + 1 < NT) {
      kreg = *(const u32x4*)(Kg + (size_t)(kv0 + 64 + lrow) * 64 + lch);
      vreg = *(const u32x4*)(Vg + (size_t)lrow * SEQ + kv0 + 64 + lch);
    }
    if (kv0 <= qw0 + 31) {
      const bool needmask = kv0 + 63 > qw0;
      f32x16 p0, p1;
#pragma unroll
      for (int r = 0; r < 16; ++r) { p0[r] = 0.f; p1[r] = 0.f; }
#pragma unroll
      for (int s = 0; s < NS; ++s) {
        const bf16x8 k0 = *(const bf16x8*)(Ks + r32 * KLD + 16 * (sbase + s) + 8 * hi);
        const bf16x8 k1 = *(const bf16x8*)(Ks + (32 + r32) * KLD + 16 * (sbase + s) + 8 * hi);
        p0 = __builtin_amdgcn_mfma_f32_32x32x16_bf16(k0, qf[s], p0, 0, 0, 0);
        p1 = __builtin_amdgcn_mfma_f32_32x32x16_bf16(k1, qf[s], p1, 0, 0, 0);
      }
      if (TYPE == 1) {
#pragma unroll
        for (int r = 0; r < 16; ++r) { p0[r] += cq - cs[kv0 + crow(r, hi)]; p1[r] += cq - cs[kv0 + 32 + crow(r, hi)]; }
      }
      if (needmask) {
#pragma unroll
        for (int r = 0; r < 16; ++r) { if (kv0 + crow(r, hi) > q) p0[r] = -INFINITY; if (kv0 + 32 + crow(r, hi) > q) p1[r] = -INFINITY; }
      }
      float mx = fmaxf(p0[0], p1[0]);
#pragma unroll
      for (int r = 1; r < 16; ++r) mx = fmaxf(mx, fmaxf(p0[r], p1[r]));
      mx = fmaxf(mx, __shfl_xor(mx, 32));
      const float mn = fmaxf(m, mx);
      const float alpha = __builtin_amdgcn_exp2f(m - mn);
      m = mn;
      float rs = 0.f;
#pragma unroll
      for (int r = 0; r < 16; ++r) { p0[r] = __builtin_amdgcn_exp2f(p0[r] - mn); p1[r] = __builtin_amdgcn_exp2f(p1[r] - mn); rs += p0[r] + p1[r]; }
      l = l * alpha + rs;
#pragma unroll
      for (int r = 0; r < 16; ++r) { o[0][r] *= alpha; o[1][r] *= alpha; }
      bf16x8 pf[4];
      pf[0] = packf8(p0[0], p0[1], p0[2], p0[3], p0[4], p0[5], p0[6], p0[7]);
      pf[1] = packf8(p0[8], p0[9], p0[10], p0[11], p0[12], p0[13], p0[14], p0[15]);
      pf[2] = packf8(p1[0], p1[1], p1[2], p1[3], p1[4], p1[5], p1[6], p1[7]);
      pf[3] = packf8(p1[8], p1[9], p1[10], p1[11], p1[12], p1[13], p1[14], p1[15]);
#pragma unroll
      for (int db = 0; db < 2; ++db)
#pragma unroll
        for (int s = 0; s < 4; ++s) {
          const s16x4 lo = *(const s16x4*)(Vs + (32 * db + r32) * KLD + 16 * s + 4 * hi);
          const s16x4 hh = *(const s16x4*)(Vs + (32 * db + r32) * KLD + 16 * s + 8 + 4 * hi);
          const bf16x8 vf = __builtin_shufflevector(lo, hh, 0, 1, 2, 3, 4, 5, 6, 7);
          o[db] = __builtin_amdgcn_mfma_f32_32x32x16_bf16(vf, pf[s], o[db], 0, 0, 0);
        }
    }
  }
  bf16_t* y = (bf16_t*)(R + R_Y);
  const size_t orow = ((size_t)(TYPE == 0 ? 1 : 2) * NTOK + (size_t)b * SEQ + q) * 256 + h * 64;
  const float lt = l + __shfl_xor(l, 32);
  const float li = 1.0f / lt;
  if (TYPE == 1) {
#pragma unroll
    for (int db = 0; db < 2; ++db)
#pragma unroll
      for (int g = 0; g < 4; ++g) {
        u32x2 w; w[0] = pk2(o[db][4 * g] * li, o[db][4 * g + 1] * li); w[1] = pk2(o[db][4 * g + 2] * li, o[db][4 * g + 3] * li);
        *(u32x2*)(y + orow + 32 * db + 8 * g + 4 * hi) = w;
      }
  } else {
    float* xb = cs;
    if (map == 1) {
#pragma unroll
      for (int db = 0; db < 2; ++db)
#pragma unroll
        for (int r = 0; r < 16; ++r) xb[(wq * 32 + db * 16 + r) * 64 + lane] = o[db][r] * li;
    }
    __syncthreads();
    if (map == 0) {
      const float* lp = p.in[19] + L * 128;
      float s01 = 0.f, s23 = 0.f;
      for (int i = 0; i < 32; ++i) { s01 += lp[i] * lp[32 + i]; s23 += lp[64 + i] * lp[96 + i]; }
      const float lam_init = L == 0 ? 0.2f : 0.35550906759096934f;
      const float lam = __expf(s01) - __expf(s23) + lam_init;
      const float* sub = p.in[20] + L * 64;
      float ss = 0.f;
#pragma unroll
      for (int db = 0; db < 2; ++db)
#pragma unroll
        for (int r = 0; r < 16; ++r) { const float vv = o[db][r] * li - lam * xb[(wq * 32 + db * 16 + r) * 64 + lane]; o[db][r] = vv; ss += vv * vv; }
      ss += __shfl_xor(ss, 32);
      const float sc = rsqrtf(ss * (1.0f / 64.0f) + 1e-5f) * (1.0f - lam_init);
#pragma unroll
      for (int db = 0; db < 2; ++db)
#pragma unroll
        for (int g = 0; g < 4; ++g) {
          const int d = 32 * db + 8 * g + 4 * hi;
          const f32x4 sw = *(const f32x4*)(sub + d);
          u32x2 w; w[0] = pk2(o[db][4 * g] * sc * sw[0], o[db][4 * g + 1] * sc * sw[1]); w[1] = pk2(o[db][4 * g + 2] * sc * sw[2], o[db][4 * g + 3] * sc * sw[3]);
          *(u32x2*)(y + orow + d) = w;
        }
    }
  }
}

DI void phase_mix(const Params& p, int L, char* lds) {
  int* ctr = (int*)(p.ws + O_CTL) + CW_QCTR + L * 64;
  int* s_unit = (int*)(lds + 2 * 64 * KLD * 2 + 8192 * 4 + 64);
  if (obid() < 16) {
    if (obid() < 8) scan_block<0>(p, L, obid() & 7, lds); else scan_block<1>(p, L, obid() & 7, lds);
  }
#pragma unroll 1
  for (;;) {
    __syncthreads();
    if (otid() == 0) *s_unit = atomicAdd(ctr, 1);
    __syncthreads();
    const int u = *s_unit;
    if (u >= 768) break;
    const int level = 31 - u / 24, w = u % 24;
    if (w < 8) attn_unit<1>(p, L, w, level, lds);
    else if (w < 16) attn_unit<0>(p, L, w - 8, 2 * level + 1, lds);
    else attn_unit<0>(p, L, w - 16, 2 * level, lds);
  }
}


template <class F>
DI void run_gemm(PG8_LAS unsigned char* lds, const bf16_t* A, const bf16_t* Bt, int M, int N, int K, const int* texp, size_t bstride, F f) {
  pg8::Gemm g{A, Bt, M, N, K, texp, bstride};
  pg8::StaticOrder S; S.init(M, N, (int)gridDim.x, obid());
  pg8::EpiFn<F> E{f};
  pg8::gemm_phase<pg8::EpiFn<F>, pg8::StaticOrder, true, true>(lds, g, S, E);
}
DI void st_bf16x4(bf16_t* dst, const f32x4& v) { u32x2 w; w[0] = pk2(v[0], v[1]); w[1] = pk2(v[2], v[3]); *(u32x2*)dst = w; }
DI f32x4 ld_bf16x4(const bf16_t* src) { const u32x2 w = *(const u32x2*)src; return (f32x4){__uint_as_float(w[0] << 16), __uint_as_float(w[0] & 0xffff0000u), __uint_as_float(w[1] << 16), __uint_as_float(w[1] & 0xffff0000u)}; }

DI void phase_u(const Params& p, int L, PG8_LAS unsigned char* lds) {
  bf16_t* u = (bf16_t*)(p.ws + O_R + R_U);
  run_gemm(lds, (const bf16_t*)(p.ws + O_HB), (const bf16_t*)(p.ws + O_WIN + L * SZ_WIN), NTOK, UN, DM, nullptr, 0,
           [=](int row, int col, const f32x4& v) { if (col < UC) st_bf16x4(u + (size_t)row * UC + col, v); });
}
DI void phase_proj(const Params& p, int L, PG8_LAS unsigned char* lds) {
  bf16_t* PJ = (bf16_t*)(p.ws + O_R + R_PJ);
#pragma unroll 1
  for (int br = 0; br < 4; ++br) {
    const bf16_t* yb = (const bf16_t*)(p.ws + O_R + R_Y) + (size_t)br * NTOK * 256;
    const bf16_t* W = (const bf16_t*)(p.ws + O_WBO) + (size_t)(L * 4 + br) * 1024 * 256;
    bf16_t* dst = PJ + br * 1024;
    run_gemm(lds, yb, W, NTOK, 1024, 256, nullptr, 0, [=](int row, int col, const f32x4& v) { st_bf16x4(dst + (size_t)row * 4096 + col, v); });
  }
}
DI void phase_gate(const Params& p, int L, PG8_LAS unsigned char* lds) {
  bf16_t* PJ = (bf16_t*)(p.ws + O_R + R_PJ);
  run_gemm(lds, (const bf16_t*)(p.ws + O_HB), (const bf16_t*)(p.ws + O_WIN + L * SZ_WIN) + (size_t)OFF_G * DM, NTOK, 4096, DM, nullptr, 0,
           [=](int row, int col, const f32x4& v) {
             bf16_t* q = PJ + (size_t)row * 4096 + col;
             const f32x4 pj = ld_bf16x4(q);
             f32x4 o; o[0] = sigmoidf_(v[0]) * pj[0]; o[1] = sigmoidf_(v[1]) * pj[1]; o[2] = sigmoidf_(v[2]) * pj[2]; o[3] = sigmoidf_(v[3]) * pj[3];
             st_bf16x4(q, o);
           });
}
DI void phase_bsum(const Params& p) {
  const u32x4* GP = (const u32x4*)(p.ws + O_R + R_PJ); u32x4* M = (u32x4*)(p.ws + O_R + R_M);
  const int gtid = obid() * NTHR + otid(), gsz = gridDim.x * NTHR;
  for (int i = gtid; i < NTOK * 128; i += gsz) {
    const int tok = i >> 7, c8 = i & 127;
    float a[8];
#pragma unroll
    for (int k = 0; k < 8; ++k) a[k] = 0.f;
#pragma unroll
    for (int b = 0; b < 4; ++b) {
      const u32x4 w = GP[(size_t)tok * 512 + b * 128 + c8];
#pragma unroll
      for (int k = 0; k < 4; ++k) { a[2 * k] += __uint_as_float(w[k] << 16); a[2 * k + 1] += __uint_as_float(w[k] & 0xffff0000u); }
    }
    u32x4 o; o[0] = pk2(a[0], a[1]); o[1] = pk2(a[2], a[3]); o[2] = pk2(a[4], a[5]); o[3] = pk2(a[6], a[7]);
    M[i] = o;
  }
}
DI void phase_xadd(const Params& p, const bf16_t* A, const bf16_t* Bt, int K, PG8_LAS unsigned char* lds) {
  float* x = p.x;
  run_gemm(lds, A, Bt, NTOK, DM, K, nullptr, 0, [=](int row, int col, const f32x4& v) { float* xp = x + (size_t)row * DM + col; f32x4 xv = *(f32x4*)xp; xv += v; *(f32x4*)xp = xv; });
}
DI void phase_ffn_up(const Params& p, PG8_LAS unsigned char* lds) {
  bf16_t* T = (bf16_t*)(p.ws + O_R + R_T);
  run_gemm(lds, (const bf16_t*)(p.ws + O_HB), (const bf16_t*)(p.ws + O_FGU), NTOK, 2 * FFD, DM, nullptr, 0,
           [=](int row, int col, const f32x4& v) {
             const float t0 = v[0] * sigmoidf_(v[0]) * v[1], t1 = v[2] * sigmoidf_(v[2]) * v[3];
             *(unsigned*)(T + (size_t)row * FFD + (col >> 1)) = pk2(t0, t1);
           });
}
DI void phase_moe_gather(const Params& p) {
  const int* cnt = (const int*)(p.ws + O_CTL) + CW_MOECNT;
  const int* list = (const int*)(p.ws + O_SMALL + SM_LIST);
  const float* gw = (const float*)(p.ws + O_SMALL + SM_GW);
  int* texp = (int*)(p.ws + O_SMALL + SM_TEXP);
  int* rowtok = (int*)(p.ws + O_SMALL + SM_ROWTOK);
  float* rowgw = (float*)(p.ws + O_SMALL + SM_ROWGW);
  const bf16_t* hb = (const bf16_t*)(p.ws + O_HB);
  bf16_t* xbuf = (bf16_t*)(p.ws + O_XBUF);
  const int lane = otid() & 63, wid = otid() >> 6;
  int c[8];
#pragma unroll
  for (int e = 0; e < 8; ++e) c[e] = cnt[e];
  int total = 0;
#pragma unroll
  for (int e = 0; e < 8; ++e) total += (c[e] + 255) & ~255;
  for (int row = obid() * 8 + wid; row < total; row += gridDim.x * 8) {
    int e = 0, s = 0, o = 0;
#pragma unroll
    for (int i = 0; i < 8; ++i) { const int pc = (c[i] + 255) & ~255; if (row >= o && row < o + pc) { e = i; s = row - o; } o += pc; }
    int ce = 0;
#pragma unroll
    for (int i = 0; i < 8; ++i) if (i == e) ce = c[i];
    const bool valid = s < ce;
    const int tok = valid ? list[(size_t)e * NTOK + s] : -1;
    u32x4 v0 = {0u, 0u, 0u, 0u}, v1 = {0u, 0u, 0u, 0u};
    if (valid) { const u32x4* src = (const u32x4*)(hb + (size_t)tok * DM); v0 = src[lane]; v1 = src[64 + lane]; }
    u32x4* dst = (u32x4*)(xbuf + (size_t)row * DM); dst[lane] = v0; dst[64 + lane] = v1;
    if (lane == 0) { rowtok[row] = tok; rowgw[row] = valid ? gw[(size_t)e * NTOK + s] : 0.f; if ((row & 255) == 0) texp[row >> 8] = e; }
  }
}
DI int moe_rows(const Params& p) {
  const int* cnt = (const int*)(p.ws + O_CTL) + CW_MOECNT;
  int total = 0;
#pragma unroll
  for (int e = 0; e < 8; ++e) total += (cnt[e] + 255) & ~255;
  return total;
}
DI void phase_moe_up(const Params& p, PG8_LAS unsigned char* lds) {
  const int Mp = moe_rows(p);
  bf16_t* T = (bf16_t*)(p.ws + O_T2);
  run_gemm(lds, (const bf16_t*)(p.ws + O_XBUF), (const bf16_t*)(p.ws + O_MGU), Mp, 2 * FFE, DM, (const int*)(p.ws + O_SMALL + SM_TEXP), (size_t)2 * FFE * DM * 2,
           [=](int row, int col, const f32x4& v) {
             const float t0 = v[0] * sigmoidf_(v[0]) * v[1], t1 = v[2] * sigmoidf_(v[2]) * v[3];
             *(unsigned*)(T + (size_t)row * FFE + (col >> 1)) = pk2(t0, t1);
           });
}
DI void phase_moe_down(const Params& p, PG8_LAS unsigned char* lds) {
  const int Mp = moe_rows(p);
  const int* rowtok = (const int*)(p.ws + O_SMALL + SM_ROWTOK);
  const float* rowgw = (const float*)(p.ws + O_SMALL + SM_ROWGW);
  float* x = p.x;
  run_gemm(lds, (const bf16_t*)(p.ws + O_T2), (const bf16_t*)(p.ws + O_MD), Mp, DM, FFE, (const int*)(p.ws + O_SMALL + SM_TEXP), (size_t)DM * FFE * 2,
           [=](int row, int col, const f32x4& v) {
             const int tok = rowtok[row];
             if (tok >= 0) {
               const float w = rowgw[row];
               float* xp = x + (size_t)tok * DM + col;
               unsafeAtomicAdd(xp + 0, w * v[0]); unsafeAtomicAdd(xp + 1, w * v[1]); unsafeAtomicAdd(xp + 2, w * v[2]); unsafeAtomicAdd(xp + 3, w * v[3]);
             }
           });
}
DI void phase_ple_proj(const Params& p, int L, PG8_LAS unsigned char* lds) {
  bf16_t* PJ2 = (bf16_t*)(p.ws + O_R + R_PJ2);
  run_gemm(lds, (const bf16_t*)(p.ws + O_PB), (const bf16_t*)(p.ws + O_PP) + (size_t)L * 1024 * 256, NTOK, DM, 256, nullptr, 0,
           [=](int row, int col, const f32x4& v) { st_bf16x4(PJ2 + (size_t)row * DM + col, v); });
}
DI void phase_ple_gate(const Params& p, int L, PG8_LAS unsigned char* lds) {
  const bf16_t* PJ2 = (const bf16_t*)(p.ws + O_R + R_PJ2);
  float* x = p.x;
  run_gemm(lds, (const bf16_t*)(p.ws + O_HB), (const bf16_t*)(p.ws + O_PG) + (size_t)L * 1024 * 1024, NTOK, DM, DM, nullptr, 0,
           [=](int row, int col, const f32x4& v) {
             const f32x4 pj = ld_bf16x4(PJ2 + (size_t)row * DM + col);
             float* xp = x + (size_t)row * DM + col; f32x4 xv = *(f32x4*)xp;
             xv[0] += sigmoidf_(v[0]) * pj[0]; xv[1] += sigmoidf_(v[1]) * pj[1]; xv[2] += sigmoidf_(v[2]) * pj[2]; xv[3] += sigmoidf_(v[3]) * pj[3];
             *(f32x4*)xp = xv;
           });
}
DI void phase_final(const Params& p) {
  const int lane = otid() & 63, wid = otid() >> 6;
  const float* g = p.in[35];
  for (int row = obid() * 8 + wid; row < NTOK; row += gridDim.x * 8) {
    float* xr = p.x + (size_t)row * DM;
    f32x4 v[4]; float ss = 0.f;
#pragma unroll
    for (int j = 0; j < 4; ++j) { v[j] = *(const f32x4*)(xr + j * 256 + lane * 4); ss += v[j][0] * v[j][0] + v[j][1] * v[j][1] + v[j][2] * v[j][2] + v[j][3] * v[j][3]; }
    ss = wave_sum(ss);
    const float rstd = rsqrtf(ss * (1.0f / 1024.0f) + 1e-6f);
#pragma unroll
    for (int j = 0; j < 4; ++j) { const f32x4 gg = *(const f32x4*)(g + j * 256 + lane * 4); *(f32x4*)(xr + j * 256 + lane * 4) = v[j] * rstd * gg; }
  }
}


constexpr int RING_BYTES = 131072, LDSCTL_OFF = RING_BYTES, MISC_OFF = LDSCTL_OFF + 320, LDS_BYTES = 147456;
static_assert(2 * SCH * 384 * 4 + SCH * 64 * 4 <= RING_BYTES, "scan LDS");

__global__ void __launch_bounds__(NTHR) fwd_megakernel(Params p) {
  extern __shared__ __attribute__((aligned(16))) unsigned char lds_raw[];
  LAS unsigned char* ldsp = (LAS unsigned char*)lds_raw;
  char* lds = (char*)lds_raw;
  for (int u = threadIdx.x; u < (LDS_BYTES - LDSCTL_OFF) / 4; u += NTHR) ((LAS unsigned*)(ldsp + LDSCTL_OFF))[u] = 0u;
  __syncthreads();
  XcdBarrier bar = xcd_barrier_post((unsigned*)(p.ws + O_CTL) + CW_BAR, (volatile LAS unsigned*)(ldsp + MISC_OFF) + 8);
#define GBAR() xcd_barrier(bar)
  phase0(olaunder(p), lds);
  cg::this_grid().sync();
  GBAR();
#pragma unroll 1
  for (int L = 0; L < 2; ++L) {
    norm_phase<false>(olaunder(p), p.in[2] + L * DM, nullptr);
    GBAR();
    phase_u(olaunder(p), L, ldsp);
    GBAR();
    phase_prep(olaunder(p), L, lds);
    GBAR();
    phase_mix(olaunder(p), L, lds);
    GBAR();
    phase_proj(olaunder(p), L, ldsp);
    GBAR();
    phase_gate(olaunder(p), L, ldsp);
    GBAR();
    phase_bsum(olaunder(p));
    GBAR();
    phase_xadd(olaunder(p), (const bf16_t*)(p.ws + O_R + R_M), (const bf16_t*)(p.ws + O_WOUT) + (size_t)L * 1024 * 1024, DM, ldsp);
    GBAR();
    if (L == 0) {
      norm_phase<false>(olaunder(p), p.in[3] + L * DM, nullptr);
      GBAR();
      phase_ffn_up(olaunder(p), ldsp);
      GBAR();
      phase_xadd(olaunder(p), (const bf16_t*)(p.ws + O_R + R_T), (const bf16_t*)(p.ws + O_FD), FFD, ldsp);
      GBAR();
    } else {
      norm_phase<true>(olaunder(p), p.in[3] + L * DM, p.in[29]);
      GBAR();
      phase_moe_gather(olaunder(p));
      GBAR();
      phase_moe_up(olaunder(p), ldsp);
      GBAR();
      phase_moe_down(olaunder(p), ldsp);
      GBAR();
    }
    norm_phase<false>(olaunder(p), p.in[4] + L * DM, nullptr);
    convert_p(olaunder(p), L);
    GBAR();
    phase_ple_proj(olaunder(p), L, ldsp);
    GBAR();
    phase_ple_gate(olaunder(p), L, ldsp);
    GBAR();
  }
  phase_final(olaunder(p));
}

extern "C" void kernel_launch(void* const* d_in, const int* in_sizes, int n_in, void* d_out, int out_size,
                              void* d_ws, size_t ws_size, hipStream_t stream) {
  static int grid_blocks = 0;
  if (grid_blocks == 0) {
    int dev = 0, cus = 0, per_cu = 0;
    (void)hipGetDevice(&dev);
    (void)hipDeviceGetAttribute(&cus, hipDeviceAttributeMultiprocessorCount, dev);
    if (hipFuncSetAttribute((const void*)fwd_megakernel, hipFuncAttributeMaxDynamicSharedMemorySize, LDS_BYTES) != hipSuccess) { fprintf(stderr, "hipFuncSetAttribute failed\n"); grid_blocks = -1; return; }
    (void)hipOccupancyMaxActiveBlocksPerMultiprocessor(&per_cu, (const void*)fwd_megakernel, NTHR, LDS_BYTES);
    if (per_cu < 1) { fprintf(stderr, "occupancy query says %d blocks per CU\n", per_cu); grid_blocks = -1; return; }
    grid_blocks = cus;
  }
  if (grid_blocks < 0) return;
  if (ws_size < WS_NEED) { fprintf(stderr, "workspace too small: %zu < %zu\n", ws_size, (size_t)WS_NEED); return; }
  (void)hipMemsetAsync((char*)d_ws + O_CTL, 0, CTL_BYTES, stream);
  Params p{};
  for (int i = 0; i < 36; ++i) p.in[i] = (const float*)d_in[i];
  p.x = (float*)d_out;
  p.ws = (char*)d_ws;
  void* args[] = {&p};
  hipError_t e = hipLaunchCooperativeKernel((void*)fwd_megakernel, dim3(grid_blocks), dim3(NTHR), args, LDS_BYTES, stream);
  if (e != hipSuccess) fprintf(stderr, "cooperative launch failed: %s (grid %d)\n", hipGetErrorString(e), grid_blocks);
}
```

```cpp
#include <hip/hip_runtime.h>
#include <hip/hip_cooperative_groups.h>
#include <cstdio>
#include <cstdint>
namespace cg = cooperative_groups;

typedef unsigned short bf16_t;
typedef short bf16x8 __attribute__((ext_vector_type(8)));
typedef short s16x4 __attribute__((ext_vector_type(4)));
typedef float f32x4 __attribute__((ext_vector_type(4)));
typedef float f32x2 __attribute__((ext_vector_type(2)));
typedef float f32x16 __attribute__((ext_vector_type(16)));
typedef unsigned u32x4 __attribute__((ext_vector_type(4)));
typedef unsigned u32x2 __attribute__((ext_vector_type(2)));
typedef __bf16 bf16x2_t __attribute__((ext_vector_type(2)));

#define DI __device__ __forceinline__

#ifndef PROBE
#define PROBE 0
#endif
constexpr int NTOK = 16384, DM = 1024, SEQ = 8192, NBH = 8;
constexpr int INC = 7692, UC = 3600, UN = 3840;
constexpr int OFF_B = 1024, OFF_C = 1792, OFF_D = 2564, OFF_G = 3596;
constexpr int FFD = 2816, FFE = 3584, NEXP = 8;
constexpr int NTHR = 512;
constexpr int MOE_ROWS = 34816;

constexpr size_t al256(size_t x) { return (x + 255) & ~(size_t)255; }
constexpr size_t O_CTL = 0, CTL_BYTES = 1u << 20;
constexpr int CW_BAR = 4096;
constexpr int CW_QCTR = 16384;
constexpr int CW_MOECNT = 16384 + 256;
constexpr size_t O_MGU = CTL_BYTES;
constexpr size_t O_MD = O_MGU + (size_t)NEXP * 2 * FFE * 1024 * 2;
constexpr size_t O_PG = O_MD + (size_t)NEXP * 1024 * FFE * 2;
constexpr size_t O_PP = O_PG + (size_t)2 * 1024 * 1024 * 2;
constexpr size_t O_PB = O_PP + (size_t)2 * 1024 * 256 * 2;
constexpr size_t O_HB = O_PB + (size_t)NTOK * 256 * 2;
constexpr size_t O_SMALL = O_HB + (size_t)NTOK * DM * 2;
constexpr size_t SM_LIST = 0;
constexpr size_t SM_GW = SM_LIST + (size_t)NEXP * NTOK * 4;
constexpr size_t SM_RK = SM_GW + (size_t)NEXP * NTOK * 4;
constexpr size_t SM_LOGF = SM_RK + (size_t)NTOK * 4 * 4;
constexpr size_t SM_GBETA = SM_LOGF + (size_t)NBH * SEQ * 4;
constexpr size_t SM_GA = SM_GBETA + (size_t)NBH * SEQ * 4;
constexpr size_t SM_TEXP = SM_GA + (size_t)NBH * SEQ * 4;
constexpr size_t SM_ROWTOK = SM_TEXP + 1024;
constexpr size_t SM_ROWGW = SM_ROWTOK + (size_t)MOE_ROWS * 4;
constexpr size_t SM_TOKSLOT = SM_ROWGW + (size_t)MOE_ROWS * 4;
constexpr size_t SM_SLOTROW = SM_TOKSLOT + (size_t)NTOK * 2 * 4;
constexpr size_t SZ_SMALL = al256(SM_SLOTROW + (size_t)NEXP * NTOK * 4);
constexpr size_t O_ERA = O_SMALL + SZ_SMALL;
constexpr size_t SZ_WIN = al256((size_t)INC * DM * 2);
constexpr size_t O_WIN = O_ERA;
constexpr size_t O_WBO = O_WIN + 2 * SZ_WIN;
constexpr size_t O_WOUT = O_WBO + (size_t)2 * 4 * 1024 * 256 * 2;
constexpr size_t O_FGU = O_WOUT + (size_t)2 * 1024 * 1024 * 2;
constexpr size_t O_FD = O_FGU + (size_t)2 * FFD * 1024 * 2;
constexpr size_t O_R = O_FD + (size_t)1024 * FFD * 2;
constexpr size_t SZ_BH = (size_t)NBH * SEQ * 64 * 2;
constexpr size_t R_U = 0;
constexpr size_t R_Y = 0;
constexpr size_t R_PJ = (size_t)NTOK * DM * 2;
constexpr size_t R_M = R_PJ + (size_t)NTOK * 4096 * 2;
constexpr size_t SZ_U = (size_t)NTOK * UC * 2;
constexpr size_t R_OSCAN = (size_t)NTOK * DM * 2;
static_assert(R_OSCAN + (size_t)2 * NBH * SEQ * 64 * 4 <= SZ_U, "scan outputs inside dead u");
constexpr size_t R_RWA = R_U + SZ_U, R_RWB = R_RWA + SZ_BH, R_RWK = R_RWB + SZ_BH, R_RWR = R_RWK + SZ_BH, R_RWV = R_RWR + SZ_BH;
constexpr size_t R_RWW = R_RWV + SZ_BH;
constexpr size_t R_GQ = R_RWW + 2 * SZ_BH, R_GK = R_GQ + SZ_BH, R_GV = R_GK + SZ_BH;
constexpr size_t R_QD = R_GV + SZ_BH, R_KD = R_QD + SZ_BH, R_VD = R_KD + SZ_BH, R_QF = R_VD + SZ_BH, R_KF = R_QF + SZ_BH, R_VF = R_KF + SZ_BH;
constexpr size_t R_AUXG = R_VF + SZ_BH;
constexpr size_t R_AUXGATE = R_AUXG + (size_t)NTOK * 256 * 2;
constexpr size_t R_END_MIX = R_AUXGATE + (size_t)NTOK * 256 * 2;
static_assert(R_M + (size_t)NTOK * DM * 2 <= R_END_MIX, "M inside region R");
constexpr size_t R_T = 0;
constexpr size_t R_PJ2 = 0;
constexpr size_t O_T2 = O_ERA;
constexpr size_t O_XBUF = O_T2 + (size_t)MOE_ROWS * FFE * 2;
constexpr size_t ERA_B_END = O_XBUF + (size_t)MOE_ROWS * DM * 2;
constexpr size_t ERA_A_END = O_R + R_END_MIX;
constexpr size_t WS_NEED = ERA_A_END > ERA_B_END ? ERA_A_END : ERA_B_END;

struct Params {
  const float* in[36];
  float* x;
  char* ws;
};

DI float bf2f(bf16_t b) { return __uint_as_float(((unsigned)b) << 16); }
DI bf16_t f2bf(float x) { unsigned u = __float_as_uint(x); u += 0x7fffu + ((u >> 16) & 1u); return (bf16_t)(u >> 16); }
DI unsigned pk2(float lo, float hi) { f32x2 v = {lo, hi}; bf16x2_t b = __builtin_convertvector(v, bf16x2_t); return __builtin_bit_cast(unsigned, b); }
DI float sigmoidf_(float x) { return 1.0f / (1.0f + __expf(-x)); }
DI float wave_sum(float v) {
#pragma unroll
  for (int o = 32; o >= 1; o >>= 1) v += __shfl_xor(v, o);
  return v;
}
DI int crow(int r, int hi) { return (r & 3) + 8 * (r >> 2) + 4 * hi; }
DI int otid() { int t = threadIdx.x; asm volatile("" : "+v"(t)); return t; }
DI int obid() { int t = blockIdx.x; asm volatile("" : "+s"(t)); return t; }
DI Params olaunder(const Params& p) { Params q = p; size_t o0 = 0, o1 = 0; asm volatile("" : "+s"(o0), "+s"(o1)); q.ws = p.ws + o0; q.x = p.x + o1; return q; }


#define GAS __attribute__((address_space(1)))
#define LAS __attribute__((address_space(3)))
typedef GAS unsigned gu32;
#define RLX_AGENT __ATOMIC_RELAXED, __HIP_MEMORY_SCOPE_AGENT
namespace pg8 {
#define PG8_LAS __attribute__((address_space(3)))
typedef unsigned short bf16_t;
typedef short bf16x8 __attribute__((ext_vector_type(8)));
typedef float f32x4 __attribute__((ext_vector_type(4)));
typedef unsigned u32x4 __attribute__((ext_vector_type(4)));
constexpr int BM = 256, BK = 64, HALF = 128, HTB = HALF * BK * 2  , STAGE_BYTES = 8 * HTB, NXCD = 8, WGM = 8;

__host__ __device__ __forceinline__ int lds_byte(int r, int c) { const int st = (r >> 4) * 2 + (c >> 5), rr = r & 15, cc = c & 31, ob = rr * 64 + cc * 2; return st * 1024 + (ob ^ (((ob >> 9) & 1) << 5)); }
__host__ __device__ __forceinline__ void stage_rc(int b, int& R, int& C) { const int st = b / 1024, sb = b % 1024, swz = sb ^ (((sb >> 9) & 1) << 5); R = (st >> 1) * 16 + swz / 64; C = (st & 1) * 32 + (swz % 64) / 2; }
__host__ __device__ __forceinline__ int perm32(int rho) { const int n = rho >> 4, i = rho & 15; return 8 * (i >> 2) + 4 * n + (i & 3); }

struct Unit { int pm, pn; };
struct Gemm { const bf16_t* A; const bf16_t* Bt; int M, N, K; const int* texp; size_t bstride;
  __device__ __forceinline__ size_t boff(int pm) const { return texp ? (size_t)texp[pm] * bstride : (size_t)0; } };

struct StaticOrder {
    int nM, nN, nwg, G, c;
    __host__ __device__ void init(int M, int N, int G_, int c_) { nM = M / BM; nN = N / BM; nwg = nM * nN; G = G_; c = c_; }
    __host__ __device__ bool next(int i, Unit& u) const {
        const long L = (long)i * G + c; if (L >= nwg) return false;
        int wgid = (int)L; { const int q = nwg / NXCD, r = nwg % NXCD, xcd = wgid % NXCD, off = wgid / NXCD; wgid = (xcd < r ? xcd * (q + 1) : r * (q + 1) + (xcd - r) * q) + off; }
        const int nig = WGM * nN, gid = wgid / nig, fm = gid * WGM, gsz = (nM - fm) < WGM ? (nM - fm) : WGM;
        u.pm = fm + ((wgid % nig) % gsz); u.pn = (wgid % nig) / gsz; return true;
    }
    __device__ __forceinline__ void a_ready(const Unit&) const {}
    __device__ __forceinline__ void done(const Unit&) const {}
};

template <class F> struct EpiFn {
    static constexpr bool PERM = false, AFTER_DRAIN = false;
    F f;
    __device__ __forceinline__ void operator()(const f32x4 (&acc)[2][2][4][2], const Unit& u, int wr, int wc, int fr, int fq) const {
#pragma unroll
        for (int ai = 0; ai < 2; ++ai)
#pragma unroll
            for (int m = 0; m < 4; ++m)
#pragma unroll
                for (int bj = 0; bj < 2; ++bj)
#pragma unroll
                    for (int n = 0; n < 2; ++n)
                        f(u.pm * BM + ai * HALF + wr * 64 + m * 16 + fr, u.pn * BM + bj * HALF + wc * 32 + n * 16 + 4 * fq, acc[ai][bj][m][n]);
    }
};
template <class Epi, class Sched, bool ALIGN_EPI = false, bool SP2 = false>
__device__ __forceinline__ void gemm_phase(PG8_LAS unsigned char* lds, const Gemm g, const Sched& S, const Epi& E) {
    const int tid = otid(), wid = __builtin_amdgcn_readfirstlane(tid >> 6), lane = tid & 63, wr = wid >> 2, wc = wid & 3, fr = lane & 15, fq = lane >> 4;
    const int K = g.K, nt = K / BK;
    unsigned voffA[2], voffB[2];
#pragma unroll
    for (int i = 0; i < 2; ++i) { int R, C; stage_rc(tid * 16 + i * 8192, R, C); const int Rb = Epi::PERM ? ((R & ~31) + perm32(R & 31)) : R;
        voffA[i] = (unsigned)(R * K + C) * 2u; voffB[i] = (unsigned)(Rb * K + C) * 2u; }
    const size_t kstep = (size_t)(BK * 2);
    const size_t hstep = (size_t)HALF * K * 2;
    const size_t tstep = 2 * hstep;
    const unsigned ldsw = (unsigned)wid * 1024u;
    const int aoff = lds_byte(wr * 64 + fr, fq * 8), boff = lds_byte(wc * 32 + fr, fq * 8);
#define PG8_SA(b, h) (((b) * 2 + (h)) * HTB)
#define PG8_SB(b, h) ((4 + (b) * 2 + (h)) * HTB)
#define PG8_STAGE(bufoff, gbase, voff) do { _Pragma("unroll") for (int _i = 0; _i < 2; ++_i) \
        __builtin_amdgcn_global_load_lds((const unsigned*)((const char*)(gbase) + (voff)[_i]), (PG8_LAS unsigned*)(lds + (bufoff) + ldsw + _i * 8192), 16, 0, 0); } while (0)
#define PG8_LDA(dst, b, h) do { _Pragma("unroll") for (int m = 0; m < 4; ++m) _Pragma("unroll") for (int k = 0; k < 2; ++k) dst[m][k] = *(const PG8_LAS bf16x8*)(lds + PG8_SA(b, h) + aoff + m * 2048 + k * 1024); } while (0)
#define PG8_LDB(dst, b, h) do { _Pragma("unroll") for (int n = 0; n < 2; ++n) _Pragma("unroll") for (int k = 0; k < 2; ++k) dst[n][k] = *(const PG8_LAS bf16x8*)(lds + PG8_SB(b, h) + boff + n * 2048 + k * 1024); } while (0)
#define PG8_MMA(ai, bj, At, Bt) do { __builtin_amdgcn_s_setprio(1); _Pragma("unroll") for (int m = 0; m < 4; ++m) _Pragma("unroll") for (int n = 0; n < 2; ++n) _Pragma("unroll") for (int k = 0; k < 2; ++k) \
        acc[ai][bj][m][n] = __builtin_amdgcn_mfma_f32_16x16x32_bf16(Bt[n][k], At[m][k], acc[ai][bj][m][n], 0, 0, 0); __builtin_amdgcn_s_setprio(0); } while (0)
#define PG8_WAIT_V(n) asm volatile("s_waitcnt vmcnt(" #n ")" ::: "memory")
#define PG8_WAIT_L(n) asm volatile("s_waitcnt lgkmcnt(" #n ")" ::: "memory")
#define PG8_BAR __builtin_amdgcn_s_barrier()
#define PG8_SCHED __builtin_amdgcn_sched_barrier(0)
    Unit cur, nxt; int ui = 0;
    if (!S.next(0, cur)) return;
    f32x4 acc[2][2][4][2];
#pragma unroll
    for (int a = 0; a < 2; ++a)
#pragma unroll
        for (int b = 0; b < 2; ++b)
#pragma unroll
            for (int m = 0; m < 4; ++m)
#pragma unroll
                for (int n = 0; n < 2; ++n) acc[a][b][m][n] = (f32x4){0.f, 0.f, 0.f, 0.f};
    bf16x8 At[4][2], B0[2][2], B1[2][2];
    const char* cA = (const char*)g.A + (size_t)cur.pm * tstep; const char* cB = (const char*)g.Bt + g.boff(cur.pm) + (size_t)cur.pn * tstep;
    S.a_ready(cur);
    if constexpr (SP2) {
        PG8_STAGE(PG8_SB(0, 0), cB, voffB); PG8_STAGE(PG8_SB(0, 1), cB + hstep, voffB); PG8_STAGE(PG8_SA(0, 0), cA, voffA); PG8_STAGE(PG8_SA(0, 1), cA + hstep, voffA);
        if (wr == 1) PG8_BAR;
        PG8_WAIT_V(2); PG8_BAR;
        PG8_STAGE(PG8_SB(1, 0), cB + kstep, voffB); PG8_STAGE(PG8_SA(1, 0), cA + kstep, voffA); PG8_STAGE(PG8_SB(1, 1), cB + hstep + kstep, voffB);
        PG8_WAIT_V(6); PG8_BAR;
    } else {
        PG8_STAGE(PG8_SB(0, 0), cB, voffB); PG8_STAGE(PG8_SA(0, 0), cA, voffA); PG8_STAGE(PG8_SB(0, 1), cB + hstep, voffB); PG8_STAGE(PG8_SA(0, 1), cA + hstep, voffA);
        if (wr == 1) PG8_BAR;
        PG8_WAIT_V(4); PG8_BAR;
        PG8_STAGE(PG8_SB(1, 0), cB + kstep, voffB); PG8_STAGE(PG8_SA(1, 0), cA + kstep, voffA); PG8_STAGE(PG8_SB(1, 1), cB + hstep + kstep, voffB);
        PG8_WAIT_V(6); PG8_BAR;
    }
    for (;;) {
        const bool has_next = S.next(ui + 1, nxt);
        const char* nA = has_next ? (const char*)g.A + (size_t)nxt.pm * tstep : cA; const char* nB = has_next ? (const char*)g.Bt + g.boff(nxt.pm) + (size_t)nxt.pn * tstep : cB;
        for (int t = 0; t < nt; t += 2) {
            const bool last = (t == nt - 2);
            const char* a1 = cA + (size_t)(t + 1) * kstep;
            const char* a2 = last ? nA : cA + (size_t)(t + 2) * kstep; const char* b2 = last ? nB : cB + (size_t)(t + 2) * kstep;
            const char* a3 = a2 + kstep; const char* b3 = b2 + kstep;
            if (last && has_next) S.a_ready(nxt);
            if constexpr (SP2) {
            PG8_LDB(B0, 0, 0); PG8_LDB(B1, 0, 1); PG8_SCHED; PG8_LDA(At, 0, 0); PG8_STAGE(PG8_SA(1, 1), a1 + hstep, voffA);
            PG8_WAIT_V(8); PG8_WAIT_L(0); PG8_BAR; PG8_MMA(0, 0, At, B0); PG8_MMA(0, 1, At, B1); PG8_BAR; PG8_SCHED;
            PG8_LDA(At, 0, 1); PG8_STAGE(PG8_SB(0, 0), b2, voffB); PG8_STAGE(PG8_SB(0, 1), b2 + hstep, voffB); PG8_STAGE(PG8_SA(0, 0), a2, voffA);
            PG8_WAIT_V(8); PG8_WAIT_L(0); PG8_BAR; PG8_MMA(1, 0, At, B0); PG8_MMA(1, 1, At, B1); PG8_BAR; PG8_SCHED;
            PG8_LDB(B0, 1, 0); PG8_LDB(B1, 1, 1); PG8_SCHED; PG8_LDA(At, 1, 0); PG8_STAGE(PG8_SA(0, 1), a2 + hstep, voffA);
            PG8_WAIT_V(8); PG8_WAIT_L(0); PG8_BAR; PG8_MMA(0, 0, At, B0); PG8_MMA(0, 1, At, B1); PG8_BAR; PG8_SCHED;
            PG8_LDA(At, 1, 1); PG8_STAGE(PG8_SB(1, 0), b3, voffB); PG8_STAGE(PG8_SB(1, 1), b3 + hstep, voffB); PG8_STAGE(PG8_SA(1, 0), a3, voffA);
            PG8_WAIT_V(8); PG8_WAIT_L(0); PG8_BAR; PG8_MMA(1, 0, At, B0); PG8_MMA(1, 1, At, B1); PG8_BAR; PG8_SCHED;
            } else {
            PG8_LDB(B0, 0, 0); PG8_SCHED; PG8_LDA(At, 0, 0); PG8_STAGE(PG8_SA(1, 1), a1 + hstep, voffA);
            PG8_WAIT_L(8); PG8_BAR; PG8_WAIT_L(0); PG8_MMA(0, 0, At, B0); PG8_BAR; PG8_SCHED;
            PG8_LDB(B1, 0, 1); PG8_STAGE(PG8_SB(0, 0), b2, voffB);
            PG8_BAR; PG8_WAIT_L(0); PG8_MMA(0, 1, At, B1); PG8_BAR;
            PG8_LDA(At, 0, 1); PG8_STAGE(PG8_SA(0, 0), a2, voffA);
            PG8_BAR; PG8_WAIT_L(0); PG8_MMA(1, 0, At, B0); PG8_BAR; PG8_SCHED;
            PG8_STAGE(PG8_SB(0, 1), b2 + hstep, voffB);
            PG8_WAIT_V(6); PG8_BAR; PG8_MMA(1, 1, At, B1); PG8_BAR;
            PG8_LDB(B0, 1, 0); PG8_SCHED; PG8_LDA(At, 1, 0); PG8_STAGE(PG8_SA(0, 1), a2 + hstep, voffA);
            PG8_WAIT_L(8); PG8_BAR; PG8_WAIT_L(0); PG8_MMA(0, 0, At, B0); PG8_BAR; PG8_SCHED;
            PG8_LDB(B1, 1, 1); PG8_STAGE(PG8_SB(1, 0), b3, voffB);
            PG8_BAR; PG8_WAIT_L(0); PG8_MMA(0, 1, At, B1); PG8_BAR;
            PG8_LDA(At, 1, 1); PG8_STAGE(PG8_SA(1, 0), a3, voffA);
            PG8_BAR; PG8_WAIT_L(0); PG8_MMA(1, 0, At, B0); PG8_BAR; PG8_SCHED;
            PG8_STAGE(PG8_SB(1, 1), b3 + hstep, voffB);
            PG8_WAIT_V(6); PG8_BAR; PG8_MMA(1, 1, At, B1); PG8_BAR;
            }
        }
        if constexpr (ALIGN_EPI) { if (wr == 0) PG8_BAR; }
        if constexpr (!Epi::AFTER_DRAIN) { E(acc, cur, wr, wc, fr, fq); S.done(cur); }
        if (!has_next) break;
#pragma unroll
        for (int a = 0; a < 2; ++a)
#pragma unroll
            for (int b = 0; b < 2; ++b)
#pragma unroll
                for (int m = 0; m < 4; ++m)
#pragma unroll
                    for (int n = 0; n < 2; ++n) acc[a][b][m][n] = (f32x4){0.f, 0.f, 0.f, 0.f};
        cur = nxt; cA = nA; cB = nB; ++ui;
        if constexpr (ALIGN_EPI) { if (wr == 1) PG8_BAR; }
    }
    PG8_WAIT_V(0);
    if constexpr (!ALIGN_EPI) { if (wr == 0) PG8_BAR; }
    PG8_BAR;
    if constexpr (Epi::AFTER_DRAIN) { E.fused(acc, cur, wr, wc, fr, fq, lds, wid, lane); S.done(cur); }
#undef PG8_SA
#undef PG8_SB
#undef PG8_STAGE
#undef PG8_LDA
#undef PG8_LDB
#undef PG8_MMA
#undef PG8_WAIT_V
#undef PG8_WAIT_L
#undef PG8_BAR
#undef PG8_SCHED
}
}

#define XB_TMO      128
#define XB_XCNT(j)  (256  + 64 * (j))
#define XB_XSUB(j)  (1280 + 64 * (j))
#define XB_XGEN(j)  (2304 + 64 * (j))
#define XB_TOP      3328
#define XB_TOPGEN   3392
#define XCD_BAR_WORDS 3456
#define XB_SPIN_CAP (1u << 18)

__device__ __forceinline__ unsigned xb_ld(unsigned* p)              { return __hip_atomic_load(p, __ATOMIC_RELAXED, __HIP_MEMORY_SCOPE_AGENT); }
__device__ __forceinline__ unsigned xb_add(unsigned* p, unsigned v) { return __hip_atomic_fetch_add(p, v, __ATOMIC_RELAXED, __HIP_MEMORY_SCOPE_AGENT); }
__device__ __forceinline__ unsigned xb_xcc_id() { return (unsigned)__builtin_amdgcn_s_getreg((3 << 11) | 20) & 0xFu; }
#define XB_SPIN(cond, bar) do { unsigned _sp = 0; while (cond) { __builtin_amdgcn_s_sleep(1); \
    if ((++_sp & 255u) == 0u) { if (xb_ld(&(bar)[XB_TMO])) break; if (_sp > XB_SPIN_CAP) { atomicAdd(&(bar)[XB_TMO], 1u); break; } } } } while (0)

struct XcdBarrier {
    unsigned* bar; unsigned x;
    volatile LAS unsigned* st;
};

__device__ __forceinline__ XcdBarrier xcd_barrier_post(unsigned* bar, volatile LAS unsigned* st) {
    XcdBarrier b; b.bar = bar; b.x = xb_xcc_id(); b.st = st;
    if (threadIdx.x == 0) (void)xb_add(&bar[XB_XCNT(b.x)], 1u);
    return b;
}
__device__ __forceinline__ void xcd_barrier_complete(unsigned* bar, unsigned x, unsigned& nloc, unsigned& nx) {
    const unsigned G = gridDim.x * gridDim.y * gridDim.z;
    unsigned sum, cnt, mine, sp = 0u;
    for (;;) {
        sum = 0u; cnt = 0u; mine = 0u;
#pragma unroll
        for (unsigned j = 0; j < 16; ++j) { const unsigned c = xb_ld(&bar[XB_XCNT(j)]); sum += c; cnt += (c > 0u) ? 1u : 0u; mine = (j == x) ? c : mine; }
        if (sum == G) break;
        __builtin_amdgcn_s_sleep(1);
        if ((++sp & 255u) == 0u) { if (xb_ld(&bar[XB_TMO])) break; if (sp > XB_SPIN_CAP) { atomicAdd(&bar[XB_TMO], 1u); break; } }
    }
    nloc = mine > 0u ? mine : 1u; nx = cnt > 0u ? cnt : 1u;
}

__device__ __forceinline__ void xcd_barrier(const XcdBarrier& b) {
    asm volatile("s_waitcnt vmcnt(0)" ::: "memory");
    __syncthreads();
    if (threadIdx.x == 0) {
        unsigned* bar = b.bar; unsigned bx_ = b.x;
        asm volatile("" : "+s"(bar), "+s"(bx_));
        __builtin_amdgcn_s_waitcnt(0);
        unsigned nloc = b.st[0], nx = b.st[1];
        if (nloc == 0u) { xcd_barrier_complete(bar, bx_, nloc, nx); b.st[0] = nloc; b.st[1] = nx; }
        const unsigned old = xb_add(&bar[XB_XSUB(bx_)], 1u);
        const unsigned gen = old / nloc;
        if (old + 1u == (gen + 1u) * nloc) {
            __builtin_amdgcn_fence(__ATOMIC_RELEASE, "agent");
            asm volatile("s_waitcnt vmcnt(0)" ::: "memory");
            const unsigned og = xb_add(&bar[XB_TOP], 1u);
            const unsigned tg = og / nx;
            if (og + 1u == (tg + 1u) * nx) xb_add(&bar[XB_TOPGEN], 1u);
            else XB_SPIN(xb_ld(&bar[XB_TOPGEN]) == tg, bar);
            __builtin_amdgcn_fence(__ATOMIC_ACQUIRE, "agent");
            xb_add(&bar[XB_XGEN(bx_)], 1u);
            asm volatile("s_waitcnt vmcnt(0)" ::: "memory");
        } else {
            XB_SPIN(xb_ld(&bar[XB_XGEN(bx_)]) == gen, bar);
            __builtin_amdgcn_fence(__ATOMIC_ACQUIRE, "agent");
            asm volatile("s_waitcnt vmcnt(0)" ::: "memory");
        }
    }
    __syncthreads();
}

DI void transpose_job(const float* __restrict__ src, int K, int N, bf16_t* __restrict__ dst, int rmul, int radd, char* lds) {
  float* tl = (float*)lds;
  const int tk = K / 64, tn = (N + 63) / 64, nt = tk * tn, tid = otid();
  for (int t = obid(); t < nt; t += gridDim.x) {
    const int k0 = (t / tn) * 64, n0 = (t % tn) * 64;
    __syncthreads();
    {
      const int kr = tid >> 3, nc = (tid & 7) * 4;
#pragma unroll
      for (int i = 0; i < 2; ++i) {
        const int n = n0 + nc + 32 * i;
        f32x4 v = {0.f, 0.f, 0.f, 0.f};
        if (n < N) v = *(const f32x4*)(src + (size_t)(k0 + kr) * N + n);
        float* d = tl + kr * 65 + nc + 32 * i;
        d[0] = v[0]; d[1] = v[1]; d[2] = v[2]; d[3] = v[3];
      }
    }
    __syncthreads();
    {
      const int nr = tid >> 3, kc = (tid & 7) * 8, n = n0 + nr;
      if (n < N) {
        u32x4 w;
        w[0] = pk2(tl[(kc + 0) * 65 + nr], tl[(kc + 1) * 65 + nr]);
        w[1] = pk2(tl[(kc + 2) * 65 + nr], tl[(kc + 3) * 65 + nr]);
        w[2] = pk2(tl[(kc + 4) * 65 + nr], tl[(kc + 5) * 65 + nr]);
        w[3] = pk2(tl[(kc + 6) * 65 + nr], tl[(kc + 7) * 65 + nr]);
        *(u32x4*)(dst + ((size_t)n * rmul + radd) * K + k0 + kc) = w;
      }
    }
  }
}


DI void phase0(const Params& p, char* lds) {
  char* ws = p.ws;
  const int gtid = obid() * NTHR + otid(), gsz = gridDim.x * NTHR;
  {
    const f32x4* s = (const f32x4*)p.in[0]; f32x4* d = (f32x4*)p.x;
    for (int i = gtid; i < NTOK * DM / 4; i += gsz) d[i] = s[i];
  }
  for (int L = 0; L < 2; ++L) {
    transpose_job(p.in[5] + (size_t)L * DM * INC, 1024, INC, (bf16_t*)(ws + O_WIN + L * SZ_WIN), 1, 0, lds);
    for (int b = 0; b < 4; ++b)
      transpose_job(p.in[6] + (size_t)(L * 4 + b) * 256 * 1024, 256, 1024, (bf16_t*)(ws + O_WBO) + (size_t)(L * 4 + b) * 1024 * 256, 1, 0, lds);
    transpose_job(p.in[7] + (size_t)L * 1024 * 1024, 1024, 1024, (bf16_t*)(ws + O_WOUT) + (size_t)L * 1024 * 1024, 1, 0, lds);
    transpose_job(p.in[34] + (size_t)L * 1024 * 1024, 1024, 1024, (bf16_t*)(ws + O_PG) + (size_t)L * 1024 * 1024, 1, 0, lds);
    transpose_job(p.in[33] + (size_t)L * 256 * 1024, 256, 1024, (bf16_t*)(ws + O_PP) + (size_t)L * 1024 * 256, 1, 0, lds);
  }
  transpose_job(p.in[26], 1024, FFD, (bf16_t*)(ws + O_FGU), 2, 0, lds);
  transpose_job(p.in[27], 1024, FFD, (bf16_t*)(ws + O_FGU), 2, 1, lds);
  transpose_job(p.in[28], FFD, 1024, (bf16_t*)(ws + O_FD), 1, 0, lds);
  for (int e = 0; e < NEXP; ++e) {
    transpose_job(p.in[30] + (size_t)e * 1024 * FFE, 1024, FFE, (bf16_t*)(ws + O_MGU) + (size_t)e * 2 * FFE * 1024, 2, 0, lds);
    transpose_job(p.in[31] + (size_t)e * 1024 * FFE, 1024, FFE, (bf16_t*)(ws + O_MGU) + (size_t)e * 2 * FFE * 1024, 2, 1, lds);
    transpose_job(p.in[32] + (size_t)e * FFE * 1024, FFE, 1024, (bf16_t*)(ws + O_MD) + (size_t)e * 1024 * FFE, 1, 0, lds);
  }
}
DI void convert_p(const Params& p, int L) {
  const int gtid = obid() * NTHR + otid(), gsz = gridDim.x * NTHR;
  const f32x4* s = (const f32x4*)(p.in[1] + (size_t)L * NTOK * 256); u32x2* d = (u32x2*)(p.ws + O_PB);
  for (int i = gtid; i < NTOK * 256 / 4; i += gsz) { f32x4 v = s[i]; u32x2 w; w[0] = pk2(v[0], v[1]); w[1] = pk2(v[2], v[3]); d[i] = w; }
}
template <bool ROUTER, bool ADDMOE = false>
DI void norm_phase(const Params& p, const float* __restrict__ g, const float* __restrict__ router) {
  const int lane = otid() & 63, wid = otid() >> 6;
  bf16_t* hb = (bf16_t*)(p.ws + O_HB);
  int* cnt = (int*)(p.ws + O_CTL) + CW_MOECNT;
  int* list = (int*)(p.ws + O_SMALL + SM_LIST);
  float* gw = (float*)(p.ws + O_SMALL + SM_GW);
  int* tokslot = (int*)(p.ws + O_SMALL + SM_TOKSLOT);
  const int* slotrow = (const int*)(p.ws + O_SMALL + SM_SLOTROW);
  const bf16_t* Y2 = (const bf16_t*)(p.ws + O_XBUF);
  for (int row = obid() * 8 + wid; row < NTOK; row += gridDim.x * 8) {
    float* xr = p.x + (size_t)row * DM;
    f32x4 v[4]; float ss = 0.f;
#pragma unroll
    for (int j = 0; j < 4; ++j) v[j] = *(const f32x4*)(xr + j * 256 + lane * 4);
    if (ADDMOE) {
      const int r1 = slotrow[tokslot[row * 2]], r2 = slotrow[tokslot[row * 2 + 1]];
#pragma unroll
      for (int j = 0; j < 4; ++j) {
        const u32x2 a = *(const u32x2*)(Y2 + (size_t)r1 * DM + j * 256 + lane * 4), b = *(const u32x2*)(Y2 + (size_t)r2 * DM + j * 256 + lane * 4);
        v[j][0] += __uint_as_float(a[0] << 16) + __uint_as_float(b[0] << 16); v[j][1] += __uint_as_float(a[0] & 0xffff0000u) + __uint_as_float(b[0] & 0xffff0000u);
        v[j][2] += __uint_as_float(a[1] << 16) + __uint_as_float(b[1] << 16); v[j][3] += __uint_as_float(a[1] & 0xffff0000u) + __uint_as_float(b[1] & 0xffff0000u);
        *(f32x4*)(xr + j * 256 + lane * 4) = v[j];
      }
    }
#pragma unroll
    for (int j = 0; j < 4; ++j) ss += v[j][0] * v[j][0] + v[j][1] * v[j][1] + v[j][2] * v[j][2] + v[j][3] * v[j][3];
    ss = wave_sum(ss);
    const float rstd = rsqrtf(ss * (1.0f / 1024.0f) + 1e-6f);
    float lg[8];
    if (ROUTER) {
#pragma unroll
      for (int e = 0; e < 8; ++e) lg[e] = 0.f;
    }
#pragma unroll
    for (int j = 0; j < 4; ++j) {
      const f32x4 gg = *(const f32x4*)(g + j * 256 + lane * 4);
      f32x4 h = v[j] * rstd * gg;
      u32x2 w; w[0] = pk2(h[0], h[1]); w[1] = pk2(h[2], h[3]);
      *(u32x2*)(hb + (size_t)row * DM + j * 256 + lane * 4) = w;
      if (ROUTER) {
#pragma unroll
        for (int c = 0; c < 4; ++c) {
          const float* rr = router + (size_t)(j * 256 + lane * 4 + c) * 8;
          const f32x4 r0 = *(const f32x4*)rr, r1 = *(const f32x4*)(rr + 4);
          lg[0] += h[c] * r0[0]; lg[1] += h[c] * r0[1]; lg[2] += h[c] * r0[2]; lg[3] += h[c] * r0[3];
          lg[4] += h[c] * r1[0]; lg[5] += h[c] * r1[1]; lg[6] += h[c] * r1[2]; lg[7] += h[c] * r1[3];
        }
      }
    }
    if (ROUTER) {
#pragma unroll
      for (int e = 0; e < 8; ++e) lg[e] = wave_sum(lg[e]);
      if (lane == 0) {
        int e1 = 0; float l1 = lg[0];
#pragma unroll
        for (int e = 1; e < 8; ++e) if (lg[e] > l1) { l1 = lg[e]; e1 = e; }
        int e2 = -1; float l2 = -INFINITY;
#pragma unroll
        for (int e = 0; e < 8; ++e) if (e != e1 && lg[e] > l2) { l2 = lg[e]; e2 = e; }
        const float w1 = 1.0f / (1.0f + __expf(l2 - l1)), w2 = 1.0f - w1;
        int s1 = atomicAdd(cnt + e1, 1); list[e1 * NTOK + s1] = row; gw[e1 * NTOK + s1] = w1;
        int s2 = atomicAdd(cnt + e2, 1); list[e2 * NTOK + s2] = row; gw[e2 * NTOK + s2] = w2;
        tokslot[row * 2] = e1 * NTOK + s1; tokslot[row * 2 + 1] = e2 * NTOK + s2;
      }
    }
  }
}

DI float softplusf_(float z) { return z > 20.f ? z : __logf(1.0f + __expf(z)); }
DI float logsigmoidf_(float z) { return z >= 0.f ? -__logf(1.0f + __expf(-z)) : z - __logf(1.0f + __expf(z)); }

DI void phase_prep(const Params& p, int L, char* lds) {
  float* xw_s = (float*)lds; float* xa_s = xw_s + 8 * 64; float* xg_s = xa_s + 8 * 64;
  char* R = p.ws + O_R;
  const bf16_t* u = (const bf16_t*)(R + R_U);
  bf16_t* rwA = (bf16_t*)(R + R_RWA); bf16_t* rwB = (bf16_t*)(R + R_RWB); bf16_t* rwK = (bf16_t*)(R + R_RWK);
  bf16_t* rwR = (bf16_t*)(R + R_RWR); bf16_t* rwV = (bf16_t*)(R + R_RWV); float* rwW = (float*)(R + R_RWW);
  bf16_t* gq = (bf16_t*)(R + R_GQ); bf16_t* gk = (bf16_t*)(R + R_GK); bf16_t* gv = (bf16_t*)(R + R_GV);
  bf16_t* Qd = (bf16_t*)(R + R_QD); bf16_t* Kd = (bf16_t*)(R + R_KD); bf16_t* Vd = (bf16_t*)(R + R_VD);
  bf16_t* Qf = (bf16_t*)(R + R_QF); bf16_t* Kf = (bf16_t*)(R + R_KF); bf16_t* Vf = (bf16_t*)(R + R_VF);
  bf16_t* auxg = (bf16_t*)(R + R_AUXG); bf16_t* auxgate = (bf16_t*)(R + R_AUXGATE);
  float* rk = (float*)(p.ws + O_SMALL + SM_RK); float* logf_ = (float*)(p.ws + O_SMALL + SM_LOGF);
  float* gbeta = (float*)(p.ws + O_SMALL + SM_GBETA); float* ga = (float*)(p.ws + O_SMALL + SM_GA);
  const float* mu = p.in[8] + L * 1024; const float* w0 = p.in[9] + L * 256; const float* w2 = p.in[10] + L * 64 * 256;
  const float* a0 = p.in[11] + L * 256; const float* a2 = p.in[12] + L * 64 * 256; const float* g2 = p.in[13] + L * 128 * 256;
  const float* kkp = p.in[14] + L * 256; const float* kap = p.in[15] + L * 256; const float* rkp = p.in[16] + L * 256;
  const float* fbias = p.in[21] + L * 4; const float* cw = p.in[22] + L * 768 * 4;
  const float* alog = p.in[23] + L * 4; const float* dtb = p.in[24] + L * 4;
  const int tid = otid(), j = tid & 255, half = tid >> 8, lane = tid & 63, h = j >> 6, dh = j & 63;
  const float QS_D = 0.25503486164919736f, QS_F = 0.18033688011112042f;
  for (int tile = obid(); tile < NTOK / 8; tile += gridDim.x) {
    const int T0 = tile * 8, b = T0 / SEQ, t0 = T0 % SEQ, bh = b * 4 + h;
    float r[4], k[4], v[4];
    __syncthreads();
#pragma unroll
    for (int i = 0; i < 4; ++i) {
      const int tl = half * 4 + i, tok = T0 + tl, t = t0 + tl;
      const bf16_t* ur = u + (size_t)tok * UC;
#pragma unroll
      for (int seg = 0; seg < 4; ++seg) {
        const int c = seg * 256 + j;
        const float ua = bf2f(ur[c]);
        const float up = t > 0 ? bf2f(ur[c - UC]) : 0.f;
        const float xm = ua + (up - ua) * mu[c];
        if (seg == 0) r[i] = xm; else if (seg == 1) k[i] = xm; else if (seg == 2) v[i] = xm;
        else {
          if (j < 64) xw_s[tl * 64 + j] = 1.0f - 2.0f / (1.0f + __expf(2.0f * xm));
          else if (j < 128) xa_s[tl * 64 + (j - 64)] = xm;
          else xg_s[tl * 128 + (j - 128)] = sigmoidf_(xm);
        }
      }
    }
    __syncthreads();
    float lw[4], alr[4], gg[4];
#pragma unroll
    for (int i = 0; i < 4; ++i) { lw[i] = w0[j]; alr[i] = a0[j]; gg[i] = 0.f; }
    for (int q = 0; q < 64; ++q) {
      const float wv = w2[q * 256 + j], av = a2[q * 256 + j];
#pragma unroll
      for (int i = 0; i < 4; ++i) { lw[i] += xw_s[(half * 4 + i) * 64 + q] * wv; alr[i] += xa_s[(half * 4 + i) * 64 + q] * av; }
    }
    for (int q = 0; q < 128; ++q) {
      const float gvv = g2[q * 256 + j];
#pragma unroll
      for (int i = 0; i < 4; ++i) gg[i] += xg_s[(half * 4 + i) * 128 + q] * gvv;
    }
#pragma unroll
    for (int i = 0; i < 4; ++i) {
      const int tl = half * 4 + i, tok = T0 + tl, t = t0 + tl;
      const float dec = __expf(-0.6065306597126334f * sigmoidf_(lw[i]));
      const float a = sigmoidf_(alr[i]);
      const float kkr = k[i] * kkp[j];
      const float ss = wave_sum(kkr * kkr);
      const float kk = kkr * rsqrtf(ss + 1e-6f);
      const float kp = k[i] * (1.0f + (a - 1.0f) * kap[j]);
      const float rks = wave_sum(r[i] * kp * rkp[j]);
      const size_t idx = ((size_t)bh * SEQ + t) * 64 + dh;
      rwA[idx] = f2bf(-kk); rwW[idx] = dec; rwB[idx] = f2bf(kk * a); rwK[idx] = f2bf(kp); rwR[idx] = f2bf(r[i]); rwV[idx] = f2bf(v[i]);
      auxg[(size_t)tok * 256 + j] = f2bf(gg[i]);
      if (lane == 0) rk[tok * 4 + h] = rks;
    }
    {
      float vd[4], vf[4];
#pragma unroll
      for (int i = 0; i < 4; ++i) {
        const int tl = half * 4 + i, tok = T0 + tl, t = t0 + tl;
        const bf16_t* ur = u + (size_t)tok * UC;
        float q = bf2f(ur[OFF_B + j]), kx = bf2f(ur[OFF_B + 256 + j]);
        vd[i] = bf2f(ur[OFF_B + 512 + j]);
        const int d = dh & 31;
        if (d < 8) {
          const int ii = d & 3;
          const float invrev = ii == 0 ? 0.15915494309189535f : ii == 1 ? 0.005985185712713705f : ii == 2 ? 0.00022507907903927653f : 8.464330808241401e-06f;
          const float rvf = (float)t * invrev;
          const float fr = rvf - floorf(rvf);
          const float sn = __builtin_amdgcn_sinf(fr), cs = __builtin_amdgcn_cosf(fr);
          const int pj = d < 4 ? j + 4 : j - 4;
          const float qp = bf2f(ur[OFF_B + pj]), kpn = bf2f(ur[OFF_B + 256 + pj]);
          if (d < 4) { q = q * cs - qp * sn; kx = kx * cs - kpn * sn; }
          else { q = q * cs + qp * sn; kx = kx * cs + kpn * sn; }
        }
        const size_t idx = ((size_t)bh * SEQ + t) * 64 + dh;
        Qd[idx] = f2bf(q * QS_D); Kd[idx] = f2bf(kx);
        Qf[idx] = f2bf(bf2f(ur[OFF_C + j]) * QS_F); Kf[idx] = ur[OFF_C + 256 + j];
        vf[i] = bf2f(ur[OFF_C + 512 + j]);
        if (j < 4) logf_[(size_t)(b * 4 + j) * SEQ + t] = logsigmoidf_(bf2f(ur[OFF_C + 768 + j]) + fbias[j]);
      }
      const size_t vidx = ((size_t)bh * 64 + dh) * SEQ + t0 + half * 4;
      u32x2 w; w[0] = pk2(vd[0], vd[1]); w[1] = pk2(vd[2], vd[3]); *(u32x2*)(Vd + vidx) = w;
      w[0] = pk2(vf[0], vf[1]); w[1] = pk2(vf[2], vf[3]); *(u32x2*)(Vf + vidx) = w;
    }
#pragma unroll
    for (int i = 0; i < 4; ++i) {
      const int tl = half * 4 + i, tok = T0 + tl, t = t0 + tl;
      const bf16_t* ur = u + (size_t)tok * UC + OFF_D;
      float y[3];
#pragma unroll
      for (int seg = 0; seg < 3; ++seg) {
        const int c = seg * 256 + j;
        const f32x4 wv = *(const f32x4*)(cw + c * 4);
        float acc = wv[3] * bf2f(ur[c]);
        if (t >= 1) acc += wv[2] * bf2f(ur[c - UC]);
        if (t >= 2) acc += wv[1] * bf2f(ur[c - 2 * UC]);
        if (t >= 3) acc += wv[0] * bf2f(ur[c - 3 * UC]);
        y[seg] = acc * sigmoidf_(acc);
      }
      const float sq = wave_sum(y[0] * y[0]), sk = wave_sum(y[1] * y[1]);
      const float qn = y[0] * rsqrtf(sq + 1e-6f) * 0.125f, kn = y[1] * rsqrtf(sk + 1e-6f);
      const size_t idx = ((size_t)bh * SEQ + t) * 64 + dh;
      gq[idx] = f2bf(qn); gk[idx] = f2bf(kn); gv[idx] = f2bf(y[2]);
      const float gate = bf2f(ur[776 + j]);
      auxgate[(size_t)tok * 256 + j] = f2bf(gate * sigmoidf_(gate));
      if (lane == 0) {
        const float beta = sigmoidf_(bf2f(ur[768 + h]));
        const float gl = -__expf(alog[h]) * softplusf_(bf2f(ur[772 + h]) + dtb[h]);
        gbeta[(size_t)bh * SEQ + t] = beta; ga[(size_t)bh * SEQ + t] = __expf(gl);
      }
    }
  }
}

DI float dpp_sum16(float x) {
  x += __int_as_float(__builtin_amdgcn_update_dpp(0, __float_as_int(x), 0xB1, 0xF, 0xF, true));
  x += __int_as_float(__builtin_amdgcn_update_dpp(0, __float_as_int(x), 0x4E, 0xF, 0xF, true));
  x += __int_as_float(__builtin_amdgcn_update_dpp(0, __float_as_int(x), 0x141, 0xF, 0xF, true));
  x += __int_as_float(__builtin_amdgcn_update_dpp(0, __float_as_int(x), 0x140, 0xF, 0xF, true));
  return x;
}
constexpr int SCH = 16;
constexpr int RS = 448;
DI float sum32(float x) {
  x = dpp_sum16(x);
  auto rr = __builtin_amdgcn_permlane16_swap(__float_as_uint(x), __float_as_uint(x), false, false);
  return __uint_as_float(rr[0]) + __uint_as_float(rr[1]);
}
struct StepIn { f32x4 q0, q1, q2; float V; };
DI void ld_step(StepIn& s, const float* sp, const float* vp) {
  s.q0 = *(const f32x4*)(sp); s.q1 = *(const f32x4*)(sp + 4); s.q2 = *(const f32x4*)(sp + 8); s.V = *vp;
}
template <int WHICH>
DI void scan_block(const Params& p, int L, int bh, int quarter, char* lds) {
  float* buf = (float*)lds;
  float* pbuf = buf + 2 * SCH * RS;
  char* R = p.ws + O_R;
  const int tid = otid();
  const size_t base = (size_t)bh * SEQ * 64;
  float* oout = (float*)(R + R_OSCAN) + (size_t)WHICH * NBH * SEQ * 64 + base;
  constexpr int NCH = SEQ / SCH;
  const int r = tid >> 5, sub = tid & 31, v = quarter * 16 + r;
  const int sst = (tid >> 4) & (SCH - 1), sk = (tid & 15) * 4;
  const bool stager = tid < SCH * 16;
  const u32x2* pA = (const u32x2*)((const bf16_t*)(R + (WHICH == 0 ? R_RWA : R_GK)) + base);
  const u32x2* pB = (const u32x2*)((const bf16_t*)(R + R_RWB) + base);
  const u32x2* pK = (const u32x2*)((const bf16_t*)(R + R_RWK) + base);
  const u32x2* pR = (const u32x2*)((const bf16_t*)(R + (WHICH == 0 ? R_RWR : R_GQ)) + base);
  const u32x2* pV = (const u32x2*)((const bf16_t*)(R + (WHICH == 0 ? R_RWV : R_GV)) + base);
  const f32x4* pW = (const f32x4*)((const float*)(R + R_RWW) + base);
  const float* gbeta = (const float*)(p.ws + O_SMALL + SM_GBETA) + (size_t)bh * SEQ;
  const float* ga = (const float*)(p.ws + O_SMALL + SM_GA) + (size_t)bh * SEQ;
  const u32x2 z2 = {0u, 0u};
  u32x2 ra = z2, ran = z2, rb = z2, rkk = z2, rr = z2, rv = z2; f32x4 rw = {0.f, 0.f, 0.f, 0.f};
  float rbeta = 0.f, raa = 0.f;
#define SCAN_LOAD(c)                                                                           \
  if (stager) {                                                                                \
    const int t_ = (c) * SCH + sst;                                                            \
    const size_t o_ = (size_t)t_ * 16 + (tid & 15);                                            \
    ra = pA[o_]; rr = pR[o_]; rv = pV[o_];                                                     \
    ran = t_ + 1 < SEQ ? pA[o_ + 16] : z2;                                                     \
    if (WHICH == 0) { rb = pB[o_]; rkk = pK[o_]; rw = pW[o_]; }                                \
    else { rbeta = gbeta[t_]; raa = ga[t_]; }                                                  \
  }
#define UNPK4(src) ((f32x4){__uint_as_float(src[0] << 16), __uint_as_float(src[0] & 0xffff0000u), __uint_as_float(src[1] << 16), __uint_as_float(src[1] & 0xffff0000u)})
#define DOT4(a, b) ((a[0] * b[0] + a[1] * b[1]) + (a[2] * b[2] + a[3] * b[3]))
#define SCAN_STAGE(c)                                                                          \
  if (stager) {                                                                                \
    float* rec_ = buf + ((c) & 1) * (SCH * RS) + sst * RS;                                     \
    f32x4 fAn, fW, fB, fK;                                                                     \
    if (WHICH == 0) { fAn = UNPK4(ran); fW = rw; fB = UNPK4(rb); fK = UNPK4(rkk); }            \
    else { const f32x4 k0_ = UNPK4(ra), kn_ = UNPK4(ran); fAn = -kn_; fW = (f32x4){raa, raa, raa, raa}; fB = k0_ * (raa * rbeta); fK = k0_ * rbeta; } \
    const float c1_ = dpp_sum16(DOT4(fB, fAn)), c2_ = dpp_sum16(DOT4(fK, fAn));               \
    const f32x4 fR = UNPK4(rr), fWA = fW * fAn;                                                \
    float* d_ = rec_ + (tid & 15) * 24;                                                        \
    *(f32x4*)(d_) = (f32x4){fWA[0], fWA[1], fW[0], fW[1]}; *(f32x4*)(d_ + 4) = (f32x4){fB[0], fB[1], fK[0], fK[1]}; *(f32x4*)(d_ + 8) = (f32x4){fR[0], fR[1], c1_, c2_};       \
    *(f32x4*)(d_ + 12) = (f32x4){fWA[2], fWA[3], fW[2], fW[3]}; *(f32x4*)(d_ + 16) = (f32x4){fB[2], fB[3], fK[2], fK[3]}; *(f32x4*)(d_ + 20) = (f32x4){fR[2], fR[3], c1_, c2_}; \
    *(f32x4*)(rec_ + 384 + sk) = UNPK4(rv);                                                    \
  }
#define SCAN_FLUSH(c)                                                                          \
  {                                                                                            \
    const float* pb_ = pbuf + ((c) & 1) * (SCH * 512);                                         \
    _Pragma("unroll") for (int ps_ = 0; ps_ < 4; ++ps_) {                                      \
      const int o_ = ps_ * 64 + (tid >> 3);                                                    \
      const f32x4 q_ = *(const f32x4*)(pb_ + o_ * 32 + (tid & 7) * 4);                         \
      float sm_ = (q_[0] + q_[1]) + (q_[2] + q_[3]);                                           \
      sm_ += __int_as_float(__builtin_amdgcn_update_dpp(0, __float_as_int(sm_), 0xB1, 0xF, 0xF, true));   \
      sm_ += __int_as_float(__builtin_amdgcn_update_dpp(0, __float_as_int(sm_), 0x4E, 0xF, 0xF, true));   \
      sm_ += __int_as_float(__builtin_amdgcn_update_dpp(0, __float_as_int(sm_), 0x141, 0xF, 0xF, true));  \
      if ((tid & 7) == 0) oout[((size_t)(c) * SCH + (o_ >> 4)) * 64 + quarter * 16 + (o_ & 15)] = sm_;   \
    }                                                                                          \
  }
  SCAN_LOAD(0);
  __syncthreads();
  SCAN_STAGE(0);
  f32x2 S1 = {0.f, 0.f}; float pre = 0.f, X = 0.f;
#pragma unroll 1
  for (int c = 0; c < NCH; ++c) {
    __syncthreads();
    if (c >= 1) SCAN_FLUSH(c - 1);
    if (c + 1 < NCH) SCAN_LOAD(c + 1);
    const float* cb = buf + (c & 1) * (SCH * RS);
    float* pb = pbuf + (c & 1) * (SCH * 512) + r * 32 + sub;
    StepIn cur, nxt;
    ld_step(cur, cb + sub * 12, cb + 384 + v);
#pragma unroll 4
    for (int st = 0; st < SCH; ++st) {
      const int sn = st + 1 < SCH ? st + 1 : st;
      ld_step(nxt, cb + sn * RS + sub * 12, cb + sn * RS + 384 + v);
      const float sa = X + pre;
      const float Xn = sum32(S1[0] * cur.q0[0] + S1[1] * cur.q0[1]);
      const float s0 = S1[0] * cur.q0[2] + (cur.q1[0] * sa + cur.q1[2] * cur.V);
      const float s1 = S1[1] * cur.q0[3] + (cur.q1[1] * sa + cur.q1[3] * cur.V);
      pre = sa * cur.q2[2] + cur.V * cur.q2[3];
      pb[st * 512] = s0 * cur.q2[0] + s1 * cur.q2[1];
      S1[0] = s0; S1[1] = s1; X = Xn;
      cur = nxt;
    }
    if (c + 1 < NCH) SCAN_STAGE(c + 1);
  }
  __syncthreads();
  SCAN_FLUSH(NCH - 1);
#undef SCAN_LOAD
#undef SCAN_STAGE
#undef SCAN_FLUSH
#undef UNPK4
#undef DOT4
}
DI void phase_scanpost(const Params& p, int L) {
  char* R = p.ws + O_R;
  const int lane = otid() & 63, wid = otid() >> 6;
  const float* osc = (const float*)(R + R_OSCAN);
  const float* rk = (const float*)(p.ws + O_SMALL + SM_RK);
  const bf16_t* rwV = (const bf16_t*)(R + R_RWV);
  const bf16_t* auxg = (const bf16_t*)(R + R_AUXG); const bf16_t* auxgate = (const bf16_t*)(R + R_AUXGATE);
  bf16_t* y = (bf16_t*)(R + R_Y);
  const float* lnw = p.in[17] + L * 256; const float* lnb = p.in[18] + L * 256; const float* gnw = p.in[25] + L * 64;
  for (int item = obid() * 8 + wid; item < 2 * NBH * SEQ; item += gridDim.x * 8) {
    const int which = item >= NBH * SEQ, rem = item - which * NBH * SEQ, bh = rem / SEQ, t = rem % SEQ, b = bh >> 2, h = bh & 3, tok = b * SEQ + t;
    const float o = osc[(size_t)item * 64 + lane];
    if (which == 0) {
      const float mean = wave_sum(o) * (1.0f / 64.0f), dl = o - mean;
      const float var = wave_sum(dl * dl) * (1.0f / 64.0f);
      float val = dl * rsqrtf(var + 64e-5f) * lnw[h * 64 + lane] + lnb[h * 64 + lane];
      val += rk[tok * 4 + h] * bf2f(rwV[((size_t)bh * SEQ + t) * 64 + lane]);
      val *= bf2f(auxg[(size_t)tok * 256 + h * 64 + lane]);
      y[((size_t)0 * NTOK + tok) * 256 + h * 64 + lane] = f2bf(val);
    } else {
      const float ms = wave_sum(o * o) * (1.0f / 64.0f);
      const float val = o * rsqrtf(ms + 1e-6f) * gnw[lane] * bf2f(auxgate[(size_t)tok * 256 + h * 64 + lane]);
      y[((size_t)3 * NTOK + tok) * 256 + h * 64 + lane] = f2bf(val);
    }
  }
}

DI bf16x8 packf8(float a0, float a1, float a2, float a3, float a4, float a5, float a6, float a7) {
  u32x4 w; w[0] = pk2(a0, a1); w[1] = pk2(a2, a3); w[2] = pk2(a4, a5); w[3] = pk2(a6, a7);
  return __builtin_bit_cast(bf16x8, w);
}
constexpr int KLD = 72;
template <int TYPE>
DI void attn_unit(const Params& p, int L, int bh, int qt, char* lds) {
  bf16_t* Ks = (bf16_t*)lds;
  bf16_t* Vs = Ks + 64 * KLD;
  float* cs = (float*)(lds + 2 * 64 * KLD * 2);
  float* red = cs + 8192;
  char* R = p.ws + O_R;
  const int tid = otid(), lane = tid & 63, wid = tid >> 6, r32 = lane & 31, hi = lane >> 5;
  const int b = bh >> 2, h = bh & 3;
  const int map = TYPE == 0 ? (wid >> 2) : 0, wq = TYPE == 0 ? (wid & 3) : wid;
  const int QROWS = TYPE == 0 ? 128 : 256;
  const int q0 = qt * QROWS, qw0 = q0 + wq * 32, q = qw0 + r32;
  const bf16_t* Qg = (const bf16_t*)(R + (TYPE == 0 ? R_QD : R_QF)) + (size_t)bh * SEQ * 64;
  const bf16_t* Kg = (const bf16_t*)(R + (TYPE == 0 ? R_KD : R_KF)) + (size_t)bh * SEQ * 64;
  const bf16_t* Vg = (const bf16_t*)(R + (TYPE == 0 ? R_VD : R_VF)) + (size_t)bh * 64 * SEQ;
  const int NT = (q0 + QROWS) / 64;
  __syncthreads();
  const int lrow = tid >> 3, lch = (tid & 7) * 8;
  u32x4 kreg = *(const u32x4*)(Kg + (size_t)lrow * 64 + lch);
  u32x4 vreg = *(const u32x4*)(Vg + (size_t)lrow * SEQ + lch);
  float cq = 0.f;
  if (TYPE == 1) {
    const float* lf = (const float*)(p.ws + O_SMALL + SM_LOGF) + (size_t)bh * SEQ;
    const int n = q0 + 256;
    float loc[16]; float tot = 0.f;
#pragma unroll
    for (int i = 0; i < 16; ++i) { const int e = tid * 16 + i; loc[i] = e < n ? lf[e] : 0.f; tot += loc[i]; }
    float inc = tot;
#pragma unroll
    for (int o = 1; o < 64; o <<= 1) { const float t2 = __shfl_up(inc, o); if (lane >= o) inc += t2; }
    if (lane == 63) red[wid] = inc;
    __syncthreads();
    float pre = inc - tot;
    for (int w = 0; w < wid; ++w) pre += red[w];
#pragma unroll
    for (int i = 0; i < 16; ++i) { pre += loc[i]; const int e = tid * 16 + i; if (e < n) cs[e] = pre * 1.4426950408889634f; }
    __syncthreads();
    cq = cs[q];
  }
  constexpr int NS = TYPE == 0 ? 2 : 4;
  const int sbase = TYPE == 0 ? 2 * map : 0;
  bf16x8 qf[NS];
#pragma unroll
  for (int s = 0; s < NS; ++s) qf[s] = *(const bf16x8*)(Qg + (size_t)q * 64 + 16 * (sbase + s) + 8 * hi);
  float m = -INFINITY, l = 0.f; f32x16 o[2];
#pragma unroll
  for (int r = 0; r < 16; ++r) { o[0][r] = 0.f; o[1][r] = 0.f; }
#pragma unroll 1
  for (int jt = 0; jt < NT; ++jt) {
    const int kv0 = jt * 64;
    __syncthreads();
    *(u32x4*)(Ks + lrow * KLD + lch) = kreg;
    *(u32x4*)(Vs + lrow * KLD + lch) = vreg;
    __syncthreads();
    if (jt + 1 < NT) {
      kreg = *(const u32x4*)(Kg + (size_t)(kv0 + 64 + lrow) * 64 + lch);
      vreg = *(const u32x4*)(Vg + (size_t)lrow * SEQ + kv0 + 64 + lch);
    }
    if (kv0 <= qw0 + 31) {
      const bool needmask = kv0 + 63 > qw0;
      f32x16 p0, p1;
#pragma unroll
      for (int r = 0; r < 16; ++r) { p0[r] = 0.f; p1[r] = 0.f; }
#pragma unroll
      for (int s = 0; s < NS; ++s) {
        const bf16x8 k0 = *(const bf16x8*)(Ks + r32 * KLD + 16 * (sbase + s) + 8 * hi);
        const bf16x8 k1 = *(const bf16x8*)(Ks + (32 + r32) * KLD + 16 * (sbase + s) + 8 * hi);
        p0 = __builtin_amdgcn_mfma_f32_32x32x16_bf16(k0, qf[s], p0, 0, 0, 0);
        p1 = __builtin_amdgcn_mfma_f32_32x32x16_bf16(k1, qf[s], p1, 0, 0, 0);
      }
      if (TYPE == 1) {
#pragma unroll
        for (int r = 0; r < 16; ++r) { p0[r] += cq - cs[kv0 + crow(r, hi)]; p1[r] += cq - cs[kv0 + 32 + crow(r, hi)]; }
      }
      if (needmask) {
#pragma unroll
        for (int r = 0; r < 16; ++r) { if (kv0 + crow(r, hi) > q) p0[r] = -INFINITY; if (kv0 + 32 + crow(r, hi) > q) p1[r] = -INFINITY; }
      }
      float mx = fmaxf(p0[0], p1[0]);
#pragma unroll
      for (int r = 1; r < 16; ++r) mx = fmaxf(mx, fmaxf(p0[r], p1[r]));
      mx = fmaxf(mx, __shfl_xor(mx, 32));
      const float mn = fmaxf(m, mx);
      const float alpha = __builtin_amdgcn_exp2f(m - mn);
      m = mn;
      float rs = 0.f;
#pragma unroll
      for (int r = 0; r < 16; ++r) { p0[r] = __builtin_amdgcn_exp2f(p0[r] - mn); p1[r] = __builtin_amdgcn_exp2f(p1[r] - mn); rs += p0[r] + p1[r]; }
      l = l * alpha + rs;
#pragma unroll
      for (int r = 0; r < 16; ++r) { o[0][r] *= alpha; o[1][r] *= alpha; }
      bf16x8 pf[4];
      pf[0] = packf8(p0[0], p0[1], p0[2], p0[3], p0[4], p0[5], p0[6], p0[7]);
      pf[1] = packf8(p0[8], p0[9], p0[10], p0[11], p0[12], p0[13], p0[14], p0[15]);
      pf[2] = packf8(p1[0], p1[1], p1[2], p1[3], p1[4], p1[5], p1[6], p1[7]);
      pf[3] = packf8(p1[8], p1[9], p1[10], p1[11], p1[12], p1[13], p1[14], p1[15]);
#pragma unroll
      for (int db = 0; db < 2; ++db)
#pragma unroll
        for (int s = 0; s < 4; ++s) {
          const s16x4 lo = *(const s16x4*)(Vs + (32 * db + r32) * KLD + 16 * s + 4 * hi);
          const s16x4 hh = *(const s16x4*)(Vs + (32 * db + r32) * KLD + 16 * s + 8 + 4 * hi);
          const bf16x8 vf = __builtin_shufflevector(lo, hh, 0, 1, 2, 3, 4, 5, 6, 7);
          o[db] = __builtin_amdgcn_mfma_f32_32x32x16_bf16(vf, pf[s], o[db], 0, 0, 0);
        }
    }
  }
  bf16_t* y = (bf16_t*)(R + R_Y);
  const size_t orow = ((size_t)(TYPE == 0 ? 1 : 2) * NTOK + (size_t)b * SEQ + q) * 256 + h * 64;
  const float lt = l + __shfl_xor(l, 32);
  const float li = 1.0f / lt;
  if (TYPE == 1) {
#pragma unroll
    for (int db = 0; db < 2; ++db)
#pragma unroll
      for (int g = 0; g < 4; ++g) {
        u32x2 w; w[0] = pk2(o[db][4 * g] * li, o[db][4 * g + 1] * li); w[1] = pk2(o[db][4 * g + 2] * li, o[db][4 * g + 3] * li);
        *(u32x2*)(y + orow + 32 * db + 8 * g + 4 * hi) = w;
      }
  } else {
    float* xb = cs;
    if (map == 1) {
#pragma unroll
      for (int db = 0; db < 2; ++db)
#pragma unroll
        for (int r = 0; r < 16; ++r) xb[(wq * 32 + db * 16 + r) * 64 + lane] = o[db][r] * li;
    }
    __syncthreads();
    if (map == 0) {
      const float* lp = p.in[19] + L * 128;
      float s01 = 0.f, s23 = 0.f;
      for (int i = 0; i < 32; ++i) { s01 += lp[i] * lp[32 + i]; s23 += lp[64 + i] * lp[96 + i]; }
      const float lam_init = L == 0 ? 0.2f : 0.35550906759096934f;
      const float lam = __expf(s01) - __expf(s23) + lam_init;
      const float* sub = p.in[20] + L * 64;
      float ss = 0.f;
#pragma unroll
      for (int db = 0; db < 2; ++db)
#pragma unroll
        for (int r = 0; r < 16; ++r) { const float vv = o[db][r] * li - lam * xb[(wq * 32 + db * 16 + r) * 64 + lane]; o[db][r] = vv; ss += vv * vv; }
      ss += __shfl_xor(ss, 32);
      const float sc = rsqrtf(ss * (1.0f / 64.0f) + 1e-5f) * (1.0f - lam_init);
#pragma unroll
      for (int db = 0; db < 2; ++db)
#pragma unroll
        for (int g = 0; g < 4; ++g) {
          const int d = 32 * db + 8 * g + 4 * hi;
          const f32x4 sw = *(const f32x4*)(sub + d);
          u32x2 w; w[0] = pk2(o[db][4 * g] * sc * sw[0], o[db][4 * g + 1] * sc * sw[1]); w[1] = pk2(o[db][4 * g + 2] * sc * sw[2], o[db][4 * g + 3] * sc * sw[3]);
          *(u32x2*)(y + orow + d) = w;
        }
    }
  }
}

DI void phase_mix(const Params& p, int L, char* lds, int qslot) {
  int* ctr = (int*)(p.ws + O_CTL) + CW_QCTR + qslot * 64;
  int* s_unit = (int*)(lds + 2 * 64 * KLD * 2 + 8192 * 4 + 64);
  {
    const int bid = obid();
    if (bid < 64) {
      if (bid < 32) scan_block<0>(p, L, (bid >> 2) & 7, bid & 3, lds); else scan_block<1>(p, L, (bid >> 2) & 7, bid & 3, lds);
#if PROBE == 4
      if (L == 0) { __syncthreads(); if (bid < 32) scan_block<0>(p, L, (bid >> 2) & 7, bid & 3, lds); else scan_block<1>(p, L, (bid >> 2) & 7, bid & 3, lds); }
#endif
    }
  }
#pragma unroll 1
  for (;;) {
    __syncthreads();
    if (otid() == 0) *s_unit = atomicAdd(ctr, 1);
    __syncthreads();
    const int u = *s_unit;
    if (u >= 768) break;
    const int level = 31 - u / 24, w = u % 24;
    if (w < 8) attn_unit<1>(p, L, w, level, lds);
    else if (w < 16) attn_unit<0>(p, L, w - 8, 2 * level + 1, lds);
    else attn_unit<0>(p, L, w - 16, 2 * level, lds);
  }
}
DI void phase_mix_attn_only(const Params& p, int L, char* lds, int qslot) {
  int* ctr = (int*)(p.ws + O_CTL) + CW_QCTR + qslot * 64;
  int* s_unit = (int*)(lds + 2 * 64 * KLD * 2 + 8192 * 4 + 64);
#pragma unroll 1
  for (;;) {
    __syncthreads();
    if (otid() == 0) *s_unit = atomicAdd(ctr, 1);
    __syncthreads();
    const int u = *s_unit;
    if (u >= 768) break;
    const int level = 31 - u / 24, w = u % 24;
    if (w < 8) attn_unit<1>(p, L, w, level, lds);
    else if (w < 16) attn_unit<0>(p, L, w - 8, 2 * level + 1, lds);
    else attn_unit<0>(p, L, w - 16, 2 * level, lds);
  }
}


template <class F>
DI void run_gemm(PG8_LAS unsigned char* lds, const bf16_t* A, const bf16_t* Bt, int M, int N, int K, const int* texp, size_t bstride, F f) {
  pg8::Gemm g{A, Bt, M, N, K, texp, bstride};
  pg8::StaticOrder S; S.init(M, N, (int)gridDim.x, obid());
  pg8::EpiFn<F> E{f};
  pg8::gemm_phase<pg8::EpiFn<F>, pg8::StaticOrder, true, true>(lds, g, S, E);
}
DI void st_bf16x4(bf16_t* dst, const f32x4& v) { u32x2 w; w[0] = pk2(v[0], v[1]); w[1] = pk2(v[2], v[3]); *(u32x2*)dst = w; }
DI f32x4 ld_bf16x4(const bf16_t* src) { const u32x2 w = *(const u32x2*)src; return (f32x4){__uint_as_float(w[0] << 16), __uint_as_float(w[0] & 0xffff0000u), __uint_as_float(w[1] << 16), __uint_as_float(w[1] & 0xffff0000u)}; }

DI void phase_u(const Params& p, int L, PG8_LAS unsigned char* lds) {
  bf16_t* u = (bf16_t*)(p.ws + O_R + R_U);
  run_gemm(lds, (const bf16_t*)(p.ws + O_HB), (const bf16_t*)(p.ws + O_WIN + L * SZ_WIN), NTOK, UN, DM, nullptr, 0,
           [=](int row, int col, const f32x4& v) { if (col < UC) st_bf16x4(u + (size_t)row * UC + col, v); });
}
DI void phase_proj(const Params& p, int L, PG8_LAS unsigned char* lds) {
  bf16_t* PJ = (bf16_t*)(p.ws + O_R + R_PJ);
#pragma unroll 1
  for (int br = 0; br < 4; ++br) {
    const bf16_t* yb = (const bf16_t*)(p.ws + O_R + R_Y) + (size_t)br * NTOK * 256;
    const bf16_t* W = (const bf16_t*)(p.ws + O_WBO) + (size_t)(L * 4 + br) * 1024 * 256;
    bf16_t* dst = PJ + br * 1024;
    run_gemm(lds, yb, W, NTOK, 1024, 256, nullptr, 0, [=](int row, int col, const f32x4& v) { st_bf16x4(dst + (size_t)row * 4096 + col, v); });
  }
}
DI void phase_gate(const Params& p, int L, PG8_LAS unsigned char* lds) {
  bf16_t* PJ = (bf16_t*)(p.ws + O_R + R_PJ);
  run_gemm(lds, (const bf16_t*)(p.ws + O_HB), (const bf16_t*)(p.ws + O_WIN + L * SZ_WIN) + (size_t)OFF_G * DM, NTOK, 4096, DM, nullptr, 0,
           [=](int row, int col, const f32x4& v) {
             bf16_t* q = PJ + (size_t)row * 4096 + col;
             const f32x4 pj = ld_bf16x4(q);
             f32x4 o; o[0] = sigmoidf_(v[0]) * pj[0]; o[1] = sigmoidf_(v[1]) * pj[1]; o[2] = sigmoidf_(v[2]) * pj[2]; o[3] = sigmoidf_(v[3]) * pj[3];
             st_bf16x4(q, o);
           });
}
DI void phase_bsum(const Params& p) {
  const u32x4* GP = (const u32x4*)(p.ws + O_R + R_PJ); u32x4* M = (u32x4*)(p.ws + O_R + R_M);
  const int gtid = obid() * NTHR + otid(), gsz = gridDim.x * NTHR;
  for (int i = gtid; i < NTOK * 128; i += gsz) {
    const int tok = i >> 7, c8 = i & 127;
    float a[8];
#pragma unroll
    for (int k = 0; k < 8; ++k) a[k] = 0.f;
#pragma unroll
    for (int b = 0; b < 4; ++b) {
      const u32x4 w = GP[(size_t)tok * 512 + b * 128 + c8];
#pragma unroll
      for (int k = 0; k < 4; ++k) { a[2 * k] += __uint_as_float(w[k] << 16); a[2 * k + 1] += __uint_as_float(w[k] & 0xffff0000u); }
    }
    u32x4 o; o[0] = pk2(a[0], a[1]); o[1] = pk2(a[2], a[3]); o[2] = pk2(a[4], a[5]); o[3] = pk2(a[6], a[7]);
    M[i] = o;
  }
}
DI void phase_xadd(const Params& p, const bf16_t* A, const bf16_t* Bt, int K, PG8_LAS unsigned char* lds) {
  float* x = p.x;
  run_gemm(lds, A, Bt, NTOK, DM, K, nullptr, 0, [=](int row, int col, const f32x4& v) { float* xp = x + (size_t)row * DM + col; f32x4 xv = *(f32x4*)xp; xv += v; *(f32x4*)xp = xv; });
}
DI void phase_ffn_up(const Params& p, PG8_LAS unsigned char* lds) {
  bf16_t* T = (bf16_t*)(p.ws + O_R + R_T);
  run_gemm(lds, (const bf16_t*)(p.ws + O_HB), (const bf16_t*)(p.ws + O_FGU), NTOK, 2 * FFD, DM, nullptr, 0,
           [=](int row, int col, const f32x4& v) {
             const float t0 = v[0] * sigmoidf_(v[0]) * v[1], t1 = v[2] * sigmoidf_(v[2]) * v[3];
             *(unsigned*)(T + (size_t)row * FFD + (col >> 1)) = pk2(t0, t1);
           });
}
DI void phase_moe_gather(const Params& p) {
  const int* cnt = (const int*)(p.ws + O_CTL) + CW_MOECNT;
  const int* list = (const int*)(p.ws + O_SMALL + SM_LIST);
  const float* gw = (const float*)(p.ws + O_SMALL + SM_GW);
  int* texp = (int*)(p.ws + O_SMALL + SM_TEXP);
  int* rowtok = (int*)(p.ws + O_SMALL + SM_ROWTOK);
  float* rowgw = (float*)(p.ws + O_SMALL + SM_ROWGW);
  int* slotrow = (int*)(p.ws + O_SMALL + SM_SLOTROW);
  const bf16_t* hb = (const bf16_t*)(p.ws + O_HB);
  bf16_t* xbuf = (bf16_t*)(p.ws + O_XBUF);
  const int lane = otid() & 63, wid = otid() >> 6;
  int c[8];
#pragma unroll
  for (int e = 0; e < 8; ++e) c[e] = cnt[e];
  int total = 0;
#pragma unroll
  for (int e = 0; e < 8; ++e) total += (c[e] + 255) & ~255;
  for (int row = obid() * 8 + wid; row < total; row += gridDim.x * 8) {
    int e = 0, s = 0, o = 0;
#pragma unroll
    for (int i = 0; i < 8; ++i) { const int pc = (c[i] + 255) & ~255; if (row >= o && row < o + pc) { e = i; s = row - o; } o += pc; }
    int ce = 0;
#pragma unroll
    for (int i = 0; i < 8; ++i) if (i == e) ce = c[i];
    const bool valid = s < ce;
    const int tok = valid ? list[(size_t)e * NTOK + s] : -1;
    u32x4 v0 = {0u, 0u, 0u, 0u}, v1 = {0u, 0u, 0u, 0u};
    if (valid) { const u32x4* src = (const u32x4*)(hb + (size_t)tok * DM); v0 = src[lane]; v1 = src[64 + lane]; }
    u32x4* dst = (u32x4*)(xbuf + (size_t)row * DM); dst[lane] = v0; dst[64 + lane] = v1;
    if (lane == 0) { rowtok[row] = tok; rowgw[row] = valid ? gw[(size_t)e * NTOK + s] : 0.f; if ((row & 255) == 0) texp[row >> 8] = e; if (valid) slotrow[(size_t)e * NTOK + s] = row; }
  }
}
DI int moe_rows(const Params& p) {
  const int* cnt = (const int*)(p.ws + O_CTL) + CW_MOECNT;
  int total = 0;
#pragma unroll
  for (int e = 0; e < 8; ++e) total += (cnt[e] + 255) & ~255;
  return total;
}
DI void phase_moe_up(const Params& p, PG8_LAS unsigned char* lds) {
  const int Mp = moe_rows(p);
  bf16_t* T = (bf16_t*)(p.ws + O_T2);
  run_gemm(lds, (const bf16_t*)(p.ws + O_XBUF), (const bf16_t*)(p.ws + O_MGU), Mp, 2 * FFE, DM, (const int*)(p.ws + O_SMALL + SM_TEXP), (size_t)2 * FFE * DM * 2,
           [=](int row, int col, const f32x4& v) {
             const float t0 = v[0] * sigmoidf_(v[0]) * v[1], t1 = v[2] * sigmoidf_(v[2]) * v[3];
             *(unsigned*)(T + (size_t)row * FFE + (col >> 1)) = pk2(t0, t1);
           });
}
DI void phase_moe_down(const Params& p, PG8_LAS unsigned char* lds) {
  const int Mp = moe_rows(p);
  const float* rowgw = (const float*)(p.ws + O_SMALL + SM_ROWGW);
  bf16_t* Y2 = (bf16_t*)(p.ws + O_XBUF);
  run_gemm(lds, (const bf16_t*)(p.ws + O_T2), (const bf16_t*)(p.ws + O_MD), Mp, DM, FFE, (const int*)(p.ws + O_SMALL + SM_TEXP), (size_t)DM * FFE * 2,
           [=](int row, int col, const f32x4& v) { const float w = rowgw[row]; st_bf16x4(Y2 + (size_t)row * DM + col, v * w); });
}
DI void phase_ple_proj(const Params& p, int L, PG8_LAS unsigned char* lds) {
  bf16_t* PJ2 = (bf16_t*)(p.ws + O_R + R_PJ2);
  run_gemm(lds, (const bf16_t*)(p.ws + O_PB), (const bf16_t*)(p.ws + O_PP) + (size_t)L * 1024 * 256, NTOK, DM, 256, nullptr, 0,
           [=](int row, int col, const f32x4& v) { st_bf16x4(PJ2 + (size_t)row * DM + col, v); });
}
DI void phase_ple_gate(const Params& p, int L, PG8_LAS unsigned char* lds) {
  const bf16_t* PJ2 = (const bf16_t*)(p.ws + O_R + R_PJ2);
  float* x = p.x;
  run_gemm(lds, (const bf16_t*)(p.ws + O_HB), (const bf16_t*)(p.ws + O_PG) + (size_t)L * 1024 * 1024, NTOK, DM, DM, nullptr, 0,
           [=](int row, int col, const f32x4& v) {
             const f32x4 pj = ld_bf16x4(PJ2 + (size_t)row * DM + col);
             float* xp = x + (size_t)row * DM + col; f32x4 xv = *(f32x4*)xp;
             xv[0] += sigmoidf_(v[0]) * pj[0]; xv[1] += sigmoidf_(v[1]) * pj[1]; xv[2] += sigmoidf_(v[2]) * pj[2]; xv[3] += sigmoidf_(v[3]) * pj[3];
             *(f32x4*)xp = xv;
           });
}
DI void phase_final(const Params& p) {
  const int lane = otid() & 63, wid = otid() >> 6;
  const float* g = p.in[35];
  for (int row = obid() * 8 + wid; row < NTOK; row += gridDim.x * 8) {
    float* xr = p.x + (size_t)row * DM;
    f32x4 v[4]; float ss = 0.f;
#pragma unroll
    for (int j = 0; j < 4; ++j) { v[j] = *(const f32x4*)(xr + j * 256 + lane * 4); ss += v[j][0] * v[j][0] + v[j][1] * v[j][1] + v[j][2] * v[j][2] + v[j][3] * v[j][3]; }
    ss = wave_sum(ss);
    const float rstd = rsqrtf(ss * (1.0f / 1024.0f) + 1e-6f);
#pragma unroll
    for (int j = 0; j < 4; ++j) { const f32x4 gg = *(const f32x4*)(g + j * 256 + lane * 4); *(f32x4*)(xr + j * 256 + lane * 4) = v[j] * rstd * gg; }
  }
}


constexpr int RING_BYTES = 131072, LDSCTL_OFF = RING_BYTES, MISC_OFF = LDSCTL_OFF + 320, LDS_BYTES = 147456;
static_assert(2 * SCH * RS * 4 + 2 * SCH * 512 * 4 <= RING_BYTES, "scan LDS");

__global__ void __launch_bounds__(NTHR) __attribute__((target("no-packed-fp32-ops"))) fwd_megakernel(Params p) {
  extern __shared__ __attribute__((aligned(16))) unsigned char lds_raw[];
  LAS unsigned char* ldsp = (LAS unsigned char*)lds_raw;
  char* lds = (char*)lds_raw;
  for (int u = threadIdx.x; u < (LDS_BYTES - LDSCTL_OFF) / 4; u += NTHR) ((LAS unsigned*)(ldsp + LDSCTL_OFF))[u] = 0u;
  __syncthreads();
  XcdBarrier bar = xcd_barrier_post((unsigned*)(p.ws + O_CTL) + CW_BAR, (volatile LAS unsigned*)(ldsp + MISC_OFF) + 8);
#define GBAR() xcd_barrier(bar)
  phase0(olaunder(p), lds);
#if PROBE == 3
  GBAR(); phase0(olaunder(p), lds);
#endif
  cg::this_grid().sync();
  GBAR();
#pragma unroll 1
  for (int L = 0; L < 2; ++L) {
    norm_phase<false>(olaunder(p), p.in[2] + L * DM, nullptr);
    GBAR();
    phase_u(olaunder(p), L, ldsp);
    GBAR();
    phase_prep(olaunder(p), L, lds);
    GBAR();
#if PROBE == 2
    if (L == 0) { phase_prep(olaunder(p), L, lds); GBAR(); }
#endif
    phase_mix(olaunder(p), L, lds, L);
    GBAR();
#if PROBE == 1
    if (L == 0) { phase_mix(olaunder(p), L, lds, 2); GBAR(); }
#endif
#if PROBE == 5
    if (L == 0) { phase_mix_attn_only(olaunder(p), L, lds, 2); GBAR(); }
#endif
    phase_scanpost(olaunder(p), L);
    GBAR();
    phase_proj(olaunder(p), L, ldsp);
    GBAR();
    phase_gate(olaunder(p), L, ldsp);
    GBAR();
    phase_bsum(olaunder(p));
    GBAR();
    phase_xadd(olaunder(p), (const bf16_t*)(p.ws + O_R + R_M), (const bf16_t*)(p.ws + O_WOUT) + (size_t)L * 1024 * 1024, DM, ldsp);
    GBAR();
    if (L == 0) {
      norm_phase<false>(olaunder(p), p.in[3] + L * DM, nullptr);
      GBAR();
      phase_ffn_up(olaunder(p), ldsp);
      GBAR();
      phase_xadd(olaunder(p), (const bf16_t*)(p.ws + O_R + R_T), (const bf16_t*)(p.ws + O_FD), FFD, ldsp);
      GBAR();
    } else {
      norm_phase<true>(olaunder(p), p.in[3] + L * DM, p.in[29]);
      GBAR();
      phase_moe_gather(olaunder(p));
      GBAR();
      phase_moe_up(olaunder(p), ldsp);
      GBAR();
      phase_moe_down(olaunder(p), ldsp);
      GBAR();
    }
    if (L == 0) norm_phase<false>(olaunder(p), p.in[4] + L * DM, nullptr);
    else norm_phase<false, true>(olaunder(p), p.in[4] + L * DM, nullptr);
    convert_p(olaunder(p), L);
    GBAR();
    phase_ple_proj(olaunder(p), L, ldsp);
    GBAR();
    phase_ple_gate(olaunder(p), L, ldsp);
    GBAR();
  }
  phase_final(olaunder(p));
}

extern "C" void kernel_launch(void* const* d_in, const int* in_sizes, int n_in, void* d_out, int out_size,
                              void* d_ws, size_t ws_size, hipStream_t stream) {
  static int grid_blocks = 0;
  if (grid_blocks == 0) {
    int dev = 0, cus = 0, per_cu = 0;
    (void)hipGetDevice(&dev);
    (void)hipDeviceGetAttribute(&cus, hipDeviceAttributeMultiprocessorCount, dev);
    if (hipFuncSetAttribute((const void*)fwd_megakernel, hipFuncAttributeMaxDynamicSharedMemorySize, LDS_BYTES) != hipSuccess) { fprintf(stderr, "hipFuncSetAttribute failed\n"); grid_blocks = -1; return; }
    (void)hipOccupancyMaxActiveBlocksPerMultiprocessor(&per_cu, (const void*)fwd_megakernel, NTHR, LDS_BYTES);
    if (per_cu < 1) { fprintf(stderr, "occupancy query says %d blocks per CU\n", per_cu); grid_blocks = -1; return; }
    grid_blocks = cus;
  }
  if (grid_blocks < 0) return;
  if (ws_size < WS_NEED) { fprintf(stderr, "workspace too small: %zu < %zu\n", ws_size, (size_t)WS_NEED); return; }
  (void)hipMemsetAsync((char*)d_ws + O_CTL, 0, CTL_BYTES, stream);
  Params p{};
  for (int i = 0; i < 36; ++i) p.in[i] = (const float*)d_in[i];
  p.x = (float*)d_out;
  p.ws = (char*)d_ws;
  void* args[] = {&p};
  hipError_t e = hipLaunchCooperativeKernel((void*)fwd_megakernel, dim3(grid_blocks), dim3(NTHR), args, LDS_BYTES, stream);
  if (e != hipSuccess) fprintf(stderr, "cooperative launch failed: %s (grid %d)\n", hipGetErrorString(e), grid_blocks);
}
```

```cpp
#include <hip/hip_runtime.h>
#include <hip/hip_cooperative_groups.h>
#include <cstdio>
#include <cstdint>
namespace cg = cooperative_groups;

typedef unsigned short bf16_t;
typedef short bf16x8 __attribute__((ext_vector_type(8)));
typedef short s16x4 __attribute__((ext_vector_type(4)));
typedef float f32x4 __attribute__((ext_vector_type(4)));
typedef float f32x2 __attribute__((ext_vector_type(2)));
typedef float f32x16 __attribute__((ext_vector_type(16)));
typedef unsigned u32x4 __attribute__((ext_vector_type(4)));
typedef unsigned u32x2 __attribute__((ext_vector_type(2)));
typedef __bf16 bf16x2_t __attribute__((ext_vector_type(2)));

#define DI __device__ __forceinline__

#ifndef PROBE
#define PROBE 0
#endif
constexpr int NTOK = 16384, DM = 1024, SEQ = 8192, NBH = 8;
constexpr int INC = 7692, UC = 3600, UN = 3840;
constexpr int OFF_B = 1024, OFF_C = 1792, OFF_D = 2564, OFF_G = 3596;
constexpr int FFD = 2816, FFE = 3584, NEXP = 8;
constexpr int NTHR = 512;
constexpr int MOE_ROWS = 34816;

constexpr size_t al256(size_t x) { return (x + 255) & ~(size_t)255; }
constexpr size_t O_CTL = 0, CTL_BYTES = 1u << 20;
constexpr int CW_BAR = 4096;
constexpr int CW_QCTR = 16384;
constexpr int CW_MOECNT = 16384 + 256;
constexpr size_t O_MGU = CTL_BYTES;
constexpr size_t O_MD = O_MGU + (size_t)NEXP * 2 * FFE * 1024 * 2;
constexpr size_t O_PG = O_MD + (size_t)NEXP * 1024 * FFE * 2;
constexpr size_t O_PP = O_PG + (size_t)2 * 1024 * 1024 * 2;
constexpr size_t O_PB = O_PP + (size_t)2 * 1024 * 256 * 2;
constexpr size_t O_LORA = O_PB + (size_t)NTOK * 256 * 2;
constexpr size_t SZ_LORA = (size_t)256 * 256 * 2;
constexpr size_t O_HB = O_LORA + 2 * SZ_LORA;
constexpr size_t O_SMALL = O_HB + (size_t)NTOK * DM * 2;
constexpr size_t SM_LIST = 0;
constexpr size_t SM_GW = SM_LIST + (size_t)NEXP * NTOK * 4;
constexpr size_t SM_RK = SM_GW + (size_t)NEXP * NTOK * 4;
constexpr size_t SM_LOGF = SM_RK + (size_t)NTOK * 4 * 4;
constexpr size_t SM_GBETA = SM_LOGF + (size_t)NBH * SEQ * 4;
constexpr size_t SM_GA = SM_GBETA + (size_t)NBH * SEQ * 4;
constexpr size_t SM_TEXP = SM_GA + (size_t)NBH * SEQ * 4;
constexpr size_t SM_ROWTOK = SM_TEXP + 1024;
constexpr size_t SM_ROWGW = SM_ROWTOK + (size_t)MOE_ROWS * 4;
constexpr size_t SM_TOKSLOT = SM_ROWGW + (size_t)MOE_ROWS * 4;
constexpr size_t SM_SLOTROW = SM_TOKSLOT + (size_t)NTOK * 2 * 4;
constexpr size_t SZ_SMALL = al256(SM_SLOTROW + (size_t)NEXP * NTOK * 4);
constexpr size_t O_ERA = O_SMALL + SZ_SMALL;
constexpr size_t SZ_WIN = al256((size_t)INC * DM * 2);
constexpr size_t O_WIN = O_ERA;
constexpr size_t O_WBO = O_WIN + 2 * SZ_WIN;
constexpr size_t O_WOUT = O_WBO + (size_t)2 * 4 * 1024 * 256 * 2;
constexpr size_t O_FGU = O_WOUT + (size_t)2 * 1024 * 1024 * 2;
constexpr size_t O_FD = O_FGU + (size_t)2 * FFD * 1024 * 2;
constexpr size_t O_R = O_FD + (size_t)1024 * FFD * 2;
constexpr size_t SZ_BH = (size_t)NBH * SEQ * 64 * 2;
constexpr size_t R_U = 0;
constexpr size_t R_Y = 0;
constexpr size_t R_PJ = (size_t)NTOK * DM * 2;
constexpr size_t R_M = R_PJ + (size_t)NTOK * 4096 * 2;
constexpr size_t SZ_U = (size_t)NTOK * UC * 2;
constexpr size_t R_OSCAN = (size_t)NTOK * DM * 2;
static_assert(R_OSCAN + (size_t)2 * NBH * SEQ * 64 * 4 <= SZ_U, "scan outputs inside dead u");
constexpr size_t R_RWA = R_U + SZ_U, R_RWB = R_RWA + SZ_BH, R_RWK = R_RWB + SZ_BH, R_RWR = R_RWK + SZ_BH, R_RWV = R_RWR + SZ_BH;
constexpr size_t R_RWW = R_RWV + SZ_BH;
constexpr size_t R_GQ = R_RWW + 2 * SZ_BH, R_GK = R_GQ + SZ_BH, R_GV = R_GK + SZ_BH;
constexpr size_t R_QD = R_GV + SZ_BH, R_KD = R_QD + SZ_BH, R_VD = R_KD + SZ_BH, R_QF = R_VD + SZ_BH, R_KF = R_QF + SZ_BH, R_VF = R_KF + SZ_BH;
constexpr size_t R_AUXG = R_VF + SZ_BH;
constexpr size_t R_AUXGATE = R_AUXG + (size_t)NTOK * 256 * 2;
constexpr size_t R_END_MIX = R_AUXGATE + (size_t)NTOK * 256 * 2;
static_assert(R_M + (size_t)NTOK * DM * 2 <= R_END_MIX, "M inside region R");
constexpr size_t R_T = 0;
constexpr size_t R_PJ2 = 0;
constexpr size_t O_T2 = O_ERA;
constexpr size_t O_XBUF = O_T2 + (size_t)MOE_ROWS * FFE * 2;
constexpr size_t ERA_B_END = O_XBUF + (size_t)MOE_ROWS * DM * 2;
constexpr size_t ERA_A_END = O_R + R_END_MIX;
constexpr size_t WS_NEED = ERA_A_END > ERA_B_END ? ERA_A_END : ERA_B_END;

struct Params {
  const float* in[36];
  float* x;
  char* ws;
};

DI float bf2f(bf16_t b) { return __uint_as_float(((unsigned)b) << 16); }
DI bf16_t f2bf(float x) { unsigned u = __float_as_uint(x); u += 0x7fffu + ((u >> 16) & 1u); return (bf16_t)(u >> 16); }
DI unsigned pk2(float lo, float hi) { f32x2 v = {lo, hi}; bf16x2_t b = __builtin_convertvector(v, bf16x2_t); return __builtin_bit_cast(unsigned, b); }
DI float sigmoidf_(float x) { return 1.0f / (1.0f + __expf(-x)); }
DI float wave_sum(float v) {
#pragma unroll
  for (int o = 32; o >= 1; o >>= 1) v += __shfl_xor(v, o);
  return v;
}
DI int crow(int r, int hi) { return (r & 3) + 8 * (r >> 2) + 4 * hi; }
DI int otid() { int t = threadIdx.x; asm volatile("" : "+v"(t)); return t; }
DI int obid() { int t = blockIdx.x; asm volatile("" : "+s"(t)); return t; }
DI Params olaunder(const Params& p) { Params q = p; size_t o0 = 0, o1 = 0; asm volatile("" : "+s"(o0), "+s"(o1)); q.ws = p.ws + o0; q.x = p.x + o1; return q; }


#define GAS __attribute__((address_space(1)))
#define LAS __attribute__((address_space(3)))
typedef GAS unsigned gu32;
#define RLX_AGENT __ATOMIC_RELAXED, __HIP_MEMORY_SCOPE_AGENT
namespace pg8 {
#define PG8_LAS __attribute__((address_space(3)))
typedef unsigned short bf16_t;
typedef short bf16x8 __attribute__((ext_vector_type(8)));
typedef float f32x4 __attribute__((ext_vector_type(4)));
typedef unsigned u32x4 __attribute__((ext_vector_type(4)));
constexpr int BM = 256, BK = 64, HALF = 128, HTB = HALF * BK * 2  , STAGE_BYTES = 8 * HTB, NXCD = 8, WGM = 8;

__host__ __device__ __forceinline__ int lds_byte(int r, int c) { const int st = (r >> 4) * 2 + (c >> 5), rr = r & 15, cc = c & 31, ob = rr * 64 + cc * 2; return st * 1024 + (ob ^ (((ob >> 9) & 1) << 5)); }
__host__ __device__ __forceinline__ void stage_rc(int b, int& R, int& C) { const int st = b / 1024, sb = b % 1024, swz = sb ^ (((sb >> 9) & 1) << 5); R = (st >> 1) * 16 + swz / 64; C = (st & 1) * 32 + (swz % 64) / 2; }
__host__ __device__ __forceinline__ int perm32(int rho) { const int n = rho >> 4, i = rho & 15; return 8 * (i >> 2) + 4 * n + (i & 3); }

struct Unit { int pm, pn; };
struct Gemm { const bf16_t* A; const bf16_t* Bt; int M, N, K; const int* texp; size_t bstride;
  __device__ __forceinline__ size_t boff(int pm) const { return texp ? (size_t)texp[pm] * bstride : (size_t)0; } };

struct StaticOrder {
    int nM, nN, nwg, G, c;
    __host__ __device__ void init(int M, int N, int G_, int c_) { nM = M / BM; nN = N / BM; nwg = nM * nN; G = G_; c = c_; }
    __host__ __device__ bool next(int i, Unit& u) const {
        const long L = (long)i * G + c; if (L >= nwg) return false;
        int wgid = (int)L; { const int q = nwg / NXCD, r = nwg % NXCD, xcd = wgid % NXCD, off = wgid / NXCD; wgid = (xcd < r ? xcd * (q + 1) : r * (q + 1) + (xcd - r) * q) + off; }
        const int nig = WGM * nN, gid = wgid / nig, fm = gid * WGM, gsz = (nM - fm) < WGM ? (nM - fm) : WGM;
        u.pm = fm + ((wgid % nig) % gsz); u.pn = (wgid % nig) / gsz; return true;
    }
    __device__ __forceinline__ void a_ready(const Unit&) const {}
    __device__ __forceinline__ void done(const Unit&) const {}
};

template <class F> struct EpiFn {
    static constexpr bool PERM = false, AFTER_DRAIN = false;
    F f;
    __device__ __forceinline__ void operator()(const f32x4 (&acc)[2][2][4][2], const Unit& u, int wr, int wc, int fr, int fq) const {
#pragma unroll
        for (int ai = 0; ai < 2; ++ai)
#pragma unroll
            for (int m = 0; m < 4; ++m)
#pragma unroll
                for (int bj = 0; bj < 2; ++bj)
#pragma unroll
                    for (int n = 0; n < 2; ++n)
                        f(u.pm * BM + ai * HALF + wr * 64 + m * 16 + fr, u.pn * BM + bj * HALF + wc * 32 + n * 16 + 4 * fq, acc[ai][bj][m][n]);
    }
};
template <class Epi, class Sched, bool ALIGN_EPI = false, bool SP2 = false>
__device__ __forceinline__ void gemm_phase(PG8_LAS unsigned char* lds, const Gemm g, const Sched& S, const Epi& E) {
    const int tid = otid(), wid = __builtin_amdgcn_readfirstlane(tid >> 6), lane = tid & 63, wr = wid >> 2, wc = wid & 3, fr = lane & 15, fq = lane >> 4;
    const int K = g.K, nt = K / BK;
    unsigned voffA[2], voffB[2];
#pragma unroll
    for (int i = 0; i < 2; ++i) { int R, C; stage_rc(tid * 16 + i * 8192, R, C); const int Rb = Epi::PERM ? ((R & ~31) + perm32(R & 31)) : R;
        voffA[i] = (unsigned)(R * K + C) * 2u; voffB[i] = (unsigned)(Rb * K + C) * 2u; }
    const size_t kstep = (size_t)(BK * 2);
    const size_t hstep = (size_t)HALF * K * 2;
    const size_t tstep = 2 * hstep;
    const unsigned ldsw = (unsigned)wid * 1024u;
    const int aoff = lds_byte(wr * 64 + fr, fq * 8), boff = lds_byte(wc * 32 + fr, fq * 8);
#define PG8_SA(b, h) (((b) * 2 + (h)) * HTB)
#define PG8_SB(b, h) ((4 + (b) * 2 + (h)) * HTB)
#define PG8_STAGE(bufoff, gbase, voff) do { _Pragma("unroll") for (int _i = 0; _i < 2; ++_i) \
        __builtin_amdgcn_global_load_lds((const unsigned*)((const char*)(gbase) + (voff)[_i]), (PG8_LAS unsigned*)(lds + (bufoff) + ldsw + _i * 8192), 16, 0, 0); } while (0)
#define PG8_LDA(dst, b, h) do { _Pragma("unroll") for (int m = 0; m < 4; ++m) _Pragma("unroll") for (int k = 0; k < 2; ++k) dst[m][k] = *(const PG8_LAS bf16x8*)(lds + PG8_SA(b, h) + aoff + m * 2048 + k * 1024); } while (0)
#define PG8_LDB(dst, b, h) do { _Pragma("unroll") for (int n = 0; n < 2; ++n) _Pragma("unroll") for (int k = 0; k < 2; ++k) dst[n][k] = *(const PG8_LAS bf16x8*)(lds + PG8_SB(b, h) + boff + n * 2048 + k * 1024); } while (0)
#define PG8_MMA(ai, bj, At, Bt) do { __builtin_amdgcn_s_setprio(1); _Pragma("unroll") for (int m = 0; m < 4; ++m) _Pragma("unroll") for (int n = 0; n < 2; ++n) _Pragma("unroll") for (int k = 0; k < 2; ++k) \
        acc[ai][bj][m][n] = __builtin_amdgcn_mfma_f32_16x16x32_bf16(Bt[n][k], At[m][k], acc[ai][bj][m][n], 0, 0, 0); __builtin_amdgcn_s_setprio(0); } while (0)
#define PG8_WAIT_V(n) asm volatile("s_waitcnt vmcnt(" #n ")" ::: "memory")
#define PG8_WAIT_L(n) asm volatile("s_waitcnt lgkmcnt(" #n ")" ::: "memory")
#define PG8_BAR __builtin_amdgcn_s_barrier()
#define PG8_SCHED __builtin_amdgcn_sched_barrier(0)
    Unit cur, nxt; int ui = 0;
    if (!S.next(0, cur)) return;
    f32x4 acc[2][2][4][2];
#pragma unroll
    for (int a = 0; a < 2; ++a)
#pragma unroll
        for (int b = 0; b < 2; ++b)
#pragma unroll
            for (int m = 0; m < 4; ++m)
#pragma unroll
                for (int n = 0; n < 2; ++n) acc[a][b][m][n] = (f32x4){0.f, 0.f, 0.f, 0.f};
    bf16x8 At[4][2], B0[2][2], B1[2][2];
    const char* cA = (const char*)g.A + (size_t)cur.pm * tstep; const char* cB = (const char*)g.Bt + g.boff(cur.pm) + (size_t)cur.pn * tstep;
    S.a_ready(cur);
    if constexpr (SP2) {
        PG8_STAGE(PG8_SB(0, 0), cB, voffB); PG8_STAGE(PG8_SB(0, 1), cB + hstep, voffB); PG8_STAGE(PG8_SA(0, 0), cA, voffA); PG8_STAGE(PG8_SA(0, 1), cA + hstep, voffA);
        if (wr == 1) PG8_BAR;
        PG8_WAIT_V(2); PG8_BAR;
        PG8_STAGE(PG8_SB(1, 0), cB + kstep, voffB); PG8_STAGE(PG8_SA(1, 0), cA + kstep, voffA); PG8_STAGE(PG8_SB(1, 1), cB + hstep + kstep, voffB);
        PG8_WAIT_V(6); PG8_BAR;
    } else {
        PG8_STAGE(PG8_SB(0, 0), cB, voffB); PG8_STAGE(PG8_SA(0, 0), cA, voffA); PG8_STAGE(PG8_SB(0, 1), cB + hstep, voffB); PG8_STAGE(PG8_SA(0, 1), cA + hstep, voffA);
        if (wr == 1) PG8_BAR;
        PG8_WAIT_V(4); PG8_BAR;
        PG8_STAGE(PG8_SB(1, 0), cB + kstep, voffB); PG8_STAGE(PG8_SA(1, 0), cA + kstep, voffA); PG8_STAGE(PG8_SB(1, 1), cB + hstep + kstep, voffB);
        PG8_WAIT_V(6); PG8_BAR;
    }
    for (;;) {
        const bool has_next = S.next(ui + 1, nxt);
        const char* nA = has_next ? (const char*)g.A + (size_t)nxt.pm * tstep : cA; const char* nB = has_next ? (const char*)g.Bt + g.boff(nxt.pm) + (size_t)nxt.pn * tstep : cB;
        for (int t = 0; t < nt; t += 2) {
            const bool last = (t == nt - 2);
            const char* a1 = cA + (size_t)(t + 1) * kstep;
            const char* a2 = last ? nA : cA + (size_t)(t + 2) * kstep; const char* b2 = last ? nB : cB + (size_t)(t + 2) * kstep;
            const char* a3 = a2 + kstep; const char* b3 = b2 + kstep;
            if (last && has_next) S.a_ready(nxt);
            if constexpr (SP2) {
            PG8_LDB(B0, 0, 0); PG8_LDB(B1, 0, 1); PG8_SCHED; PG8_LDA(At, 0, 0); PG8_STAGE(PG8_SA(1, 1), a1 + hstep, voffA);
            PG8_WAIT_V(8); PG8_WAIT_L(0); PG8_BAR; PG8_MMA(0, 0, At, B0); PG8_MMA(0, 1, At, B1); PG8_BAR; PG8_SCHED;
            PG8_LDA(At, 0, 1); PG8_STAGE(PG8_SB(0, 0), b2, voffB); PG8_STAGE(PG8_SB(0, 1), b2 + hstep, voffB); PG8_STAGE(PG8_SA(0, 0), a2, voffA);
            PG8_WAIT_V(8); PG8_WAIT_L(0); PG8_BAR; PG8_MMA(1, 0, At, B0); PG8_MMA(1, 1, At, B1); PG8_BAR; PG8_SCHED;
            PG8_LDB(B0, 1, 0); PG8_LDB(B1, 1, 1); PG8_SCHED; PG8_LDA(At, 1, 0); PG8_STAGE(PG8_SA(0, 1), a2 + hstep, voffA);
            PG8_WAIT_V(8); PG8_WAIT_L(0); PG8_BAR; PG8_MMA(0, 0, At, B0); PG8_MMA(0, 1, At, B1); PG8_BAR; PG8_SCHED;
            PG8_LDA(At, 1, 1); PG8_STAGE(PG8_SB(1, 0), b3, voffB); PG8_STAGE(PG8_SB(1, 1), b3 + hstep, voffB); PG8_STAGE(PG8_SA(1, 0), a3, voffA);
            PG8_WAIT_V(8); PG8_WAIT_L(0); PG8_BAR; PG8_MMA(1, 0, At, B0); PG8_MMA(1, 1, At, B1); PG8_BAR; PG8_SCHED;
            } else {
            PG8_LDB(B0, 0, 0); PG8_SCHED; PG8_LDA(At, 0, 0); PG8_STAGE(PG8_SA(1, 1), a1 + hstep, voffA);
            PG8_WAIT_L(8); PG8_BAR; PG8_WAIT_L(0); PG8_MMA(0, 0, At, B0); PG8_BAR; PG8_SCHED;
            PG8_LDB(B1, 0, 1); PG8_STAGE(PG8_SB(0, 0), b2, voffB);
            PG8_BAR; PG8_WAIT_L(0); PG8_MMA(0, 1, At, B1); PG8_BAR;
            PG8_LDA(At, 0, 1); PG8_STAGE(PG8_SA(0, 0), a2, voffA);
            PG8_BAR; PG8_WAIT_L(0); PG8_MMA(1, 0, At, B0); PG8_BAR; PG8_SCHED;
            PG8_STAGE(PG8_SB(0, 1), b2 + hstep, voffB);
            PG8_WAIT_V(6); PG8_BAR; PG8_MMA(1, 1, At, B1); PG8_BAR;
            PG8_LDB(B0, 1, 0); PG8_SCHED; PG8_LDA(At, 1, 0); PG8_STAGE(PG8_SA(0, 1), a2 + hstep, voffA);
            PG8_WAIT_L(8); PG8_BAR; PG8_WAIT_L(0); PG8_MMA(0, 0, At, B0); PG8_BAR; PG8_SCHED;
            PG8_LDB(B1, 1, 1); PG8_STAGE(PG8_SB(1, 0), b3, voffB);
            PG8_BAR; PG8_WAIT_L(0); PG8_MMA(0, 1, At, B1); PG8_BAR;
            PG8_LDA(At, 1, 1); PG8_STAGE(PG8_SA(1, 0), a3, voffA);
            PG8_BAR; PG8_WAIT_L(0); PG8_MMA(1, 0, At, B0); PG8_BAR; PG8_SCHED;
            PG8_STAGE(PG8_SB(1, 1), b3 + hstep, voffB);
            PG8_WAIT_V(6); PG8_BAR; PG8_MMA(1, 1, At, B1); PG8_BAR;
            }
        }
        if constexpr (ALIGN_EPI) { if (wr == 0) PG8_BAR; }
        if constexpr (!Epi::AFTER_DRAIN) { E(acc, cur, wr, wc, fr, fq); S.done(cur); }
        if (!has_next) break;
#pragma unroll
        for (int a = 0; a < 2; ++a)
#pragma unroll
            for (int b = 0; b < 2; ++b)
#pragma unroll
                for (int m = 0; m < 4; ++m)
#pragma unroll
                    for (int n = 0; n < 2; ++n) acc[a][b][m][n] = (f32x4){0.f, 0.f, 0.f, 0.f};
        cur = nxt; cA = nA; cB = nB; ++ui;
        if constexpr (ALIGN_EPI) { if (wr == 1) PG8_BAR; }
    }
    PG8_WAIT_V(0);
    if constexpr (!ALIGN_EPI) { if (wr == 0) PG8_BAR; }
    PG8_BAR;
    if constexpr (Epi::AFTER_DRAIN) { E.fused(acc, cur, wr, wc, fr, fq, lds, wid, lane); S.done(cur); }
#undef PG8_SA
#undef PG8_SB
#undef PG8_STAGE
#undef PG8_LDA
#undef PG8_LDB
#undef PG8_MMA
#undef PG8_WAIT_V
#undef PG8_WAIT_L
#undef PG8_BAR
#undef PG8_SCHED
}
}

#define XB_TMO      128
#define XB_XCNT(j)  (256  + 64 * (j))
#define XB_XSUB(j)  (1280 + 64 * (j))
#define XB_XGEN(j)  (2304 + 64 * (j))
#define XB_TOP      3328
#define XB_TOPGEN   3392
#define XCD_BAR_WORDS 3456
#define XB_SPIN_CAP (1u << 18)

__device__ __forceinline__ unsigned xb_ld(unsigned* p)              { return __hip_atomic_load(p, __ATOMIC_RELAXED, __HIP_MEMORY_SCOPE_AGENT); }
__device__ __forceinline__ unsigned xb_add(unsigned* p, unsigned v) { return __hip_atomic_fetch_add(p, v, __ATOMIC_RELAXED, __HIP_MEMORY_SCOPE_AGENT); }
__device__ __forceinline__ unsigned xb_xcc_id() { return (unsigned)__builtin_amdgcn_s_getreg((3 << 11) | 20) & 0xFu; }
#define XB_SPIN(cond, bar) do { unsigned _sp = 0; while (cond) { __builtin_amdgcn_s_sleep(1); \
    if ((++_sp & 255u) == 0u) { if (xb_ld(&(bar)[XB_TMO])) break; if (_sp > XB_SPIN_CAP) { atomicAdd(&(bar)[XB_TMO], 1u); break; } } } } while (0)

struct XcdBarrier {
    unsigned* bar; unsigned x;
    volatile LAS unsigned* st;
};

__device__ __forceinline__ XcdBarrier xcd_barrier_post(unsigned* bar, volatile LAS unsigned* st) {
    XcdBarrier b; b.bar = bar; b.x = xb_xcc_id(); b.st = st;
    if (threadIdx.x == 0) (void)xb_add(&bar[XB_XCNT(b.x)], 1u);
    return b;
}
__device__ __forceinline__ void xcd_barrier_complete(unsigned* bar, unsigned x, unsigned& nloc, unsigned& nx) {
    const unsigned G = gridDim.x * gridDim.y * gridDim.z;
    unsigned sum, cnt, mine, sp = 0u;
    for (;;) {
        sum = 0u; cnt = 0u; mine = 0u;
#pragma unroll
        for (unsigned j = 0; j < 16; ++j) { const unsigned c = xb_ld(&bar[XB_XCNT(j)]); sum += c; cnt += (c > 0u) ? 1u : 0u; mine = (j == x) ? c : mine; }
        if (sum == G) break;
        __builtin_amdgcn_s_sleep(1);
        if ((++sp & 255u) == 0u) { if (xb_ld(&bar[XB_TMO])) break; if (sp > XB_SPIN_CAP) { atomicAdd(&bar[XB_TMO], 1u); break; } }
    }
    nloc = mine > 0u ? mine : 1u; nx = cnt > 0u ? cnt : 1u;
}

__device__ __forceinline__ void xcd_barrier(const XcdBarrier& b) {
    asm volatile("s_waitcnt vmcnt(0)" ::: "memory");
    __syncthreads();
    if (threadIdx.x == 0) {
        unsigned* bar = b.bar; unsigned bx_ = b.x;
        asm volatile("" : "+s"(bar), "+s"(bx_));
        __builtin_amdgcn_s_waitcnt(0);
        unsigned nloc = b.st[0], nx = b.st[1];
        if (nloc == 0u) { xcd_barrier_complete(bar, bx_, nloc, nx); b.st[0] = nloc; b.st[1] = nx; }
        const unsigned old = xb_add(&bar[XB_XSUB(bx_)], 1u);
        const unsigned gen = old / nloc;
        if (old + 1u == (gen + 1u) * nloc) {
            __builtin_amdgcn_fence(__ATOMIC_RELEASE, "agent");
            asm volatile("s_waitcnt vmcnt(0)" ::: "memory");
            const unsigned og = xb_add(&bar[XB_TOP], 1u);
            const unsigned tg = og / nx;
            if (og + 1u == (tg + 1u) * nx) xb_add(&bar[XB_TOPGEN], 1u);
            else XB_SPIN(xb_ld(&bar[XB_TOPGEN]) == tg, bar);
            __builtin_amdgcn_fence(__ATOMIC_ACQUIRE, "agent");
            xb_add(&bar[XB_XGEN(bx_)], 1u);
            asm volatile("s_waitcnt vmcnt(0)" ::: "memory");
        } else {
            XB_SPIN(xb_ld(&bar[XB_XGEN(bx_)]) == gen, bar);
            __builtin_amdgcn_fence(__ATOMIC_ACQUIRE, "agent");
            asm volatile("s_waitcnt vmcnt(0)" ::: "memory");
        }
    }
    __syncthreads();
}

DI void transpose_job(const float* __restrict__ src, int K, int N, bf16_t* __restrict__ dst, int rmul, int radd, char* lds) {
  float* tl = (float*)lds;
  const int tk = K / 64, tn = (N + 63) / 64, nt = tk * tn, tid = otid();
  for (int t = obid(); t < nt; t += gridDim.x) {
    const int k0 = (t / tn) * 64, n0 = (t % tn) * 64;
    __syncthreads();
    {
      const int kr = tid >> 3, nc = (tid & 7) * 4;
#pragma unroll
      for (int i = 0; i < 2; ++i) {
        const int n = n0 + nc + 32 * i;
        f32x4 v = {0.f, 0.f, 0.f, 0.f};
        if (n < N) v = *(const f32x4*)(src + (size_t)(k0 + kr) * N + n);
        float* d = tl + kr * 65 + nc + 32 * i;
        d[0] = v[0]; d[1] = v[1]; d[2] = v[2]; d[3] = v[3];
      }
    }
    __syncthreads();
    {
      const int nr = tid >> 3, kc = (tid & 7) * 8, n = n0 + nr;
      if (n < N) {
        u32x4 w;
        w[0] = pk2(tl[(kc + 0) * 65 + nr], tl[(kc + 1) * 65 + nr]);
        w[1] = pk2(tl[(kc + 2) * 65 + nr], tl[(kc + 3) * 65 + nr]);
        w[2] = pk2(tl[(kc + 4) * 65 + nr], tl[(kc + 5) * 65 + nr]);
        w[3] = pk2(tl[(kc + 6) * 65 + nr], tl[(kc + 7) * 65 + nr]);
        *(u32x4*)(dst + ((size_t)n * rmul + radd) * K + k0 + kc) = w;
      }
    }
  }
}


DI void phase0(const Params& p, char* lds) {
  char* ws = p.ws;
  const int gtid = obid() * NTHR + otid(), gsz = gridDim.x * NTHR;
  {
    const f32x4* s = (const f32x4*)p.in[0]; f32x4* d = (f32x4*)p.x;
    for (int i = gtid; i < NTOK * DM / 4; i += gsz) d[i] = s[i];
  }
  for (int L = 0; L < 2; ++L) {
    transpose_job(p.in[5] + (size_t)L * DM * INC, 1024, INC, (bf16_t*)(ws + O_WIN + L * SZ_WIN), 1, 0, lds);
    for (int b = 0; b < 4; ++b)
      transpose_job(p.in[6] + (size_t)(L * 4 + b) * 256 * 1024, 256, 1024, (bf16_t*)(ws + O_WBO) + (size_t)(L * 4 + b) * 1024 * 256, 1, 0, lds);
    transpose_job(p.in[7] + (size_t)L * 1024 * 1024, 1024, 1024, (bf16_t*)(ws + O_WOUT) + (size_t)L * 1024 * 1024, 1, 0, lds);
    transpose_job(p.in[34] + (size_t)L * 1024 * 1024, 1024, 1024, (bf16_t*)(ws + O_PG) + (size_t)L * 1024 * 1024, 1, 0, lds);
    transpose_job(p.in[33] + (size_t)L * 256 * 1024, 256, 1024, (bf16_t*)(ws + O_PP) + (size_t)L * 1024 * 256, 1, 0, lds);
    transpose_job(p.in[10] + (size_t)L * 64 * 256, 64, 256, (bf16_t*)(ws + O_LORA + L * SZ_LORA), 1, 0, lds);
    transpose_job(p.in[12] + (size_t)L * 64 * 256, 64, 256, (bf16_t*)(ws + O_LORA + L * SZ_LORA) + 256 * 64, 1, 0, lds);
    transpose_job(p.in[13] + (size_t)L * 128 * 256, 128, 256, (bf16_t*)(ws + O_LORA + L * SZ_LORA) + 2 * 256 * 64, 1, 0, lds);
  }
  transpose_job(p.in[26], 1024, FFD, (bf16_t*)(ws + O_FGU), 2, 0, lds);
  transpose_job(p.in[27], 1024, FFD, (bf16_t*)(ws + O_FGU), 2, 1, lds);
  transpose_job(p.in[28], FFD, 1024, (bf16_t*)(ws + O_FD), 1, 0, lds);
  for (int e = 0; e < NEXP; ++e) {
    transpose_job(p.in[30] + (size_t)e * 1024 * FFE, 1024, FFE, (bf16_t*)(ws + O_MGU) + (size_t)e * 2 * FFE * 1024, 2, 0, lds);
    transpose_job(p.in[31] + (size_t)e * 1024 * FFE, 1024, FFE, (bf16_t*)(ws + O_MGU) + (size_t)e * 2 * FFE * 1024, 2, 1, lds);
    transpose_job(p.in[32] + (size_t)e * FFE * 1024, FFE, 1024, (bf16_t*)(ws + O_MD) + (size_t)e * 1024 * FFE, 1, 0, lds);
  }
}
DI void convert_p(const Params& p, int L) {
  const int gtid = obid() * NTHR + otid(), gsz = gridDim.x * NTHR;
  const f32x4* s = (const f32x4*)(p.in[1] + (size_t)L * NTOK * 256); u32x2* d = (u32x2*)(p.ws + O_PB);
  for (int i = gtid; i < NTOK * 256 / 4; i += gsz) { f32x4 v = s[i]; u32x2 w; w[0] = pk2(v[0], v[1]); w[1] = pk2(v[2], v[3]); d[i] = w; }
}
template <bool ROUTER, bool ADDMOE = false>
DI void norm_phase(const Params& p, const float* __restrict__ g, const float* __restrict__ router) {
  const int lane = otid() & 63, wid = otid() >> 6;
  bf16_t* hb = (bf16_t*)(p.ws + O_HB);
  int* cnt = (int*)(p.ws + O_CTL) + CW_MOECNT;
  int* list = (int*)(p.ws + O_SMALL + SM_LIST);
  float* gw = (float*)(p.ws + O_SMALL + SM_GW);
  int* tokslot = (int*)(p.ws + O_SMALL + SM_TOKSLOT);
  const int* slotrow = (const int*)(p.ws + O_SMALL + SM_SLOTROW);
  const bf16_t* Y2 = (const bf16_t*)(p.ws + O_XBUF);
  for (int row = obid() * 8 + wid; row < NTOK; row += gridDim.x * 8) {
    float* xr = p.x + (size_t)row * DM;
    f32x4 v[4]; float ss = 0.f;
#pragma unroll
    for (int j = 0; j < 4; ++j) v[j] = *(const f32x4*)(xr + j * 256 + lane * 4);
    if (ADDMOE) {
      const int r1 = slotrow[tokslot[row * 2]], r2 = slotrow[tokslot[row * 2 + 1]];
#pragma unroll
      for (int j = 0; j < 4; ++j) {
        const u32x2 a = *(const u32x2*)(Y2 + (size_t)r1 * DM + j * 256 + lane * 4), b = *(const u32x2*)(Y2 + (size_t)r2 * DM + j * 256 + lane * 4);
        v[j][0] += __uint_as_float(a[0] << 16) + __uint_as_float(b[0] << 16); v[j][1] += __uint_as_float(a[0] & 0xffff0000u) + __uint_as_float(b[0] & 0xffff0000u);
        v[j][2] += __uint_as_float(a[1] << 16) + __uint_as_float(b[1] << 16); v[j][3] += __uint_as_float(a[1] & 0xffff0000u) + __uint_as_float(b[1] & 0xffff0000u);
        *(f32x4*)(xr + j * 256 + lane * 4) = v[j];
      }
    }
#pragma unroll
    for (int j = 0; j < 4; ++j) ss += v[j][0] * v[j][0] + v[j][1] * v[j][1] + v[j][2] * v[j][2] + v[j][3] * v[j][3];
    ss = wave_sum(ss);
    const float rstd = rsqrtf(ss * (1.0f / 1024.0f) + 1e-6f);
    float lg[8];
    if (ROUTER) {
#pragma unroll
      for (int e = 0; e < 8; ++e) lg[e] = 0.f;
    }
#pragma unroll
    for (int j = 0; j < 4; ++j) {
      const f32x4 gg = *(const f32x4*)(g + j * 256 + lane * 4);
      f32x4 h = v[j] * rstd * gg;
      u32x2 w; w[0] = pk2(h[0], h[1]); w[1] = pk2(h[2], h[3]);
      *(u32x2*)(hb + (size_t)row * DM + j * 256 + lane * 4) = w;
      if (ROUTER) {
#pragma unroll
        for (int c = 0; c < 4; ++c) {
          const float* rr = router + (size_t)(j * 256 + lane * 4 + c) * 8;
          const f32x4 r0 = *(const f32x4*)rr, r1 = *(const f32x4*)(rr + 4);
          lg[0] += h[c] * r0[0]; lg[1] += h[c] * r0[1]; lg[2] += h[c] * r0[2]; lg[3] += h[c] * r0[3];
          lg[4] += h[c] * r1[0]; lg[5] += h[c] * r1[1]; lg[6] += h[c] * r1[2]; lg[7] += h[c] * r1[3];
        }
      }
    }
    if (ROUTER) {
#pragma unroll
      for (int e = 0; e < 8; ++e) lg[e] = wave_sum(lg[e]);
      if (lane == 0) {
        int e1 = 0; float l1 = lg[0];
#pragma unroll
        for (int e = 1; e < 8; ++e) if (lg[e] > l1) { l1 = lg[e]; e1 = e; }
        int e2 = -1; float l2 = -INFINITY;
#pragma unroll
        for (int e = 0; e < 8; ++e) if (e != e1 && lg[e] > l2) { l2 = lg[e]; e2 = e; }
        const float w1 = 1.0f / (1.0f + __expf(l2 - l1)), w2 = 1.0f - w1;
        int s1 = atomicAdd(cnt + e1, 1); list[e1 * NTOK + s1] = row; gw[e1 * NTOK + s1] = w1;
        int s2 = atomicAdd(cnt + e2, 1); list[e2 * NTOK + s2] = row; gw[e2 * NTOK + s2] = w2;
        tokslot[row * 2] = e1 * NTOK + s1; tokslot[row * 2 + 1] = e2 * NTOK + s2;
      }
    }
  }
}

DI float softplusf_(float z) { return z > 20.f ? z : __logf(1.0f + __expf(z)); }
DI float logsigmoidf_(float z) { return z >= 0.f ? -__logf(1.0f + __expf(-z)) : z - __logf(1.0f + __expf(z)); }

template <int PARTS = 7>
DI void phase_prep(const Params& p, int L, char* lds) {
  float* xw_s = (float*)lds; float* xa_s = xw_s + 8 * 64; float* xg_s = xa_s + 8 * 64;
  char* R = p.ws + O_R;
  const bf16_t* u = (const bf16_t*)(R + R_U);
  bf16_t* rwA = (bf16_t*)(R + R_RWA); bf16_t* rwB = (bf16_t*)(R + R_RWB); bf16_t* rwK = (bf16_t*)(R + R_RWK);
  bf16_t* rwR = (bf16_t*)(R + R_RWR); bf16_t* rwV = (bf16_t*)(R + R_RWV); float* rwW = (float*)(R + R_RWW);
  bf16_t* gq = (bf16_t*)(R + R_GQ); bf16_t* gk = (bf16_t*)(R + R_GK); bf16_t* gv = (bf16_t*)(R + R_GV);
  bf16_t* Qd = (bf16_t*)(R + R_QD); bf16_t* Kd = (bf16_t*)(R + R_KD); bf16_t* Vd = (bf16_t*)(R + R_VD);
  bf16_t* Qf = (bf16_t*)(R + R_QF); bf16_t* Kf = (bf16_t*)(R + R_KF); bf16_t* Vf = (bf16_t*)(R + R_VF);
  bf16_t* auxg = (bf16_t*)(R + R_AUXG); bf16_t* auxgate = (bf16_t*)(R + R_AUXGATE);
  float* rk = (float*)(p.ws + O_SMALL + SM_RK); float* logf_ = (float*)(p.ws + O_SMALL + SM_LOGF);
  float* gbeta = (float*)(p.ws + O_SMALL + SM_GBETA); float* ga = (float*)(p.ws + O_SMALL + SM_GA);
  const float* mu = p.in[8] + L * 1024; const float* w0 = p.in[9] + L * 256; const float* w2 = p.in[10] + L * 64 * 256;
  const float* a0 = p.in[11] + L * 256; const float* a2 = p.in[12] + L * 64 * 256; const float* g2 = p.in[13] + L * 128 * 256;
  const float* kkp = p.in[14] + L * 256; const float* kap = p.in[15] + L * 256; const float* rkp = p.in[16] + L * 256;
  const float* fbias = p.in[21] + L * 4; const float* cw = p.in[22] + L * 768 * 4;
  const float* alog = p.in[23] + L * 4; const float* dtb = p.in[24] + L * 4;
  const int tid = otid(), j = tid & 255, half = tid >> 8, lane = tid & 63, h = j >> 6, dh = j & 63;
  const float QS_D = 0.25503486164919736f, QS_F = 0.18033688011112042f;
  for (int tile = obid(); tile < NTOK / 8; tile += gridDim.x) {
    const int T0 = tile * 8, b = T0 / SEQ, t0 = T0 % SEQ, bh = b * 4 + h;
    if (PARTS & 1) {
    float r[4], k[4], v[4];
    __syncthreads();
#pragma unroll
    for (int i = 0; i < 4; ++i) {
      const int tl = half * 4 + i, tok = T0 + tl, t = t0 + tl;
      const bf16_t* ur = u + (size_t)tok * UC;
#pragma unroll
      for (int seg = 0; seg < 4; ++seg) {
        const int c = seg * 256 + j;
        const float ua = bf2f(ur[c]);
        const float up = t > 0 ? bf2f(ur[c - UC]) : 0.f;
        const float xm = ua + (up - ua) * mu[c];
        if (seg == 0) r[i] = xm; else if (seg == 1) k[i] = xm; else if (seg == 2) v[i] = xm;
        else {
          if (j < 64) xw_s[tl * 64 + j] = 1.0f - 2.0f / (1.0f + __expf(2.0f * xm));
          else if (j < 128) xa_s[tl * 64 + (j - 64)] = xm;
          else xg_s[tl * 128 + (j - 128)] = sigmoidf_(xm);
        }
      }
    }
    __syncthreads();
    float lw[4], alr[4], gg[4];
#pragma unroll
    for (int i = 0; i < 4; ++i) { lw[i] = w0[j]; alr[i] = a0[j]; gg[i] = 0.f; }
    for (int q = 0; q < 64; ++q) {
      const float wv = w2[q * 256 + j], av = a2[q * 256 + j];
#pragma unroll
      for (int i = 0; i < 4; ++i) { lw[i] += xw_s[(half * 4 + i) * 64 + q] * wv; alr[i] += xa_s[(half * 4 + i) * 64 + q] * av; }
    }
    for (int q = 0; q < 128; ++q) {
      const float gvv = g2[q * 256 + j];
#pragma unroll
      for (int i = 0; i < 4; ++i) gg[i] += xg_s[(half * 4 + i) * 128 + q] * gvv;
    }
#pragma unroll
    for (int i = 0; i < 4; ++i) {
      const int tl = half * 4 + i, tok = T0 + tl, t = t0 + tl;
      const float dec = __expf(-0.6065306597126334f * sigmoidf_(lw[i]));
      const float a = sigmoidf_(alr[i]);
      const float kkr = k[i] * kkp[j];
      const float ss = wave_sum(kkr * kkr);
      const float kk = kkr * rsqrtf(ss + 1e-6f);
      const float kp = k[i] * (1.0f + (a - 1.0f) * kap[j]);
      const float rks = wave_sum(r[i] * kp * rkp[j]);
      const size_t idx = ((size_t)bh * SEQ + t) * 64 + dh;
      rwA[idx] = f2bf(-kk); rwW[idx] = dec; rwB[idx] = f2bf(kk * a); rwK[idx] = f2bf(kp); rwR[idx] = f2bf(r[i]); rwV[idx] = f2bf(v[i]);
      auxg[(size_t)tok * 256 + j] = f2bf(gg[i]);
      if (lane == 0) rk[tok * 4 + h] = rks;
    }
    }
    if (PARTS & 2)
    {
      float vd[4], vf[4];
#pragma unroll
      for (int i = 0; i < 4; ++i) {
        const int tl = half * 4 + i, tok = T0 + tl, t = t0 + tl;
        const bf16_t* ur = u + (size_t)tok * UC;
        float q = bf2f(ur[OFF_B + j]), kx = bf2f(ur[OFF_B + 256 + j]);
        vd[i] = bf2f(ur[OFF_B + 512 + j]);
        const int d = dh & 31;
        if (d < 8) {
          const int ii = d & 3;
          const float invrev = ii == 0 ? 0.15915494309189535f : ii == 1 ? 0.005985185712713705f : ii == 2 ? 0.00022507907903927653f : 8.464330808241401e-06f;
          const float rvf = (float)t * invrev;
          const float fr = rvf - floorf(rvf);
          const float sn = __builtin_amdgcn_sinf(fr), cs = __builtin_amdgcn_cosf(fr);
          const int pj = d < 4 ? j + 4 : j - 4;
          const float qp = bf2f(ur[OFF_B + pj]), kpn = bf2f(ur[OFF_B + 256 + pj]);
          if (d < 4) { q = q * cs - qp * sn; kx = kx * cs - kpn * sn; }
          else { q = q * cs + qp * sn; kx = kx * cs + kpn * sn; }
        }
        const size_t idx = ((size_t)bh * SEQ + t) * 64 + dh;
        Qd[idx] = f2bf(q * QS_D); Kd[idx] = f2bf(kx);
        Qf[idx] = f2bf(bf2f(ur[OFF_C + j]) * QS_F); Kf[idx] = ur[OFF_C + 256 + j];
        vf[i] = bf2f(ur[OFF_C + 512 + j]);
        if (j < 4) logf_[(size_t)(b * 4 + j) * SEQ + t] = logsigmoidf_(bf2f(ur[OFF_C + 768 + j]) + fbias[j]);
      }
      const size_t vidx = ((size_t)bh * 64 + dh) * SEQ + t0 + half * 4;
      u32x2 w; w[0] = pk2(vd[0], vd[1]); w[1] = pk2(vd[2], vd[3]); *(u32x2*)(Vd + vidx) = w;
      w[0] = pk2(vf[0], vf[1]); w[1] = pk2(vf[2], vf[3]); *(u32x2*)(Vf + vidx) = w;
    }
    if (PARTS & 4) {
#pragma unroll
    for (int i = 0; i < 4; ++i) {
      const int tl = half * 4 + i, tok = T0 + tl, t = t0 + tl;
      const bf16_t* ur = u + (size_t)tok * UC + OFF_D;
      float y[3];
#pragma unroll
      for (int seg = 0; seg < 3; ++seg) {
        const int c = seg * 256 + j;
        const f32x4 wv = *(const f32x4*)(cw + c * 4);
        float acc = wv[3] * bf2f(ur[c]);
        if (t >= 1) acc += wv[2] * bf2f(ur[c - UC]);
        if (t >= 2) acc += wv[1] * bf2f(ur[c - 2 * UC]);
        if (t >= 3) acc += wv[0] * bf2f(ur[c - 3 * UC]);
        y[seg] = acc * sigmoidf_(acc);
      }
      const float sq = wave_sum(y[0] * y[0]), sk = wave_sum(y[1] * y[1]);
      const float qn = y[0] * rsqrtf(sq + 1e-6f) * 0.125f, kn = y[1] * rsqrtf(sk + 1e-6f);
      const size_t idx = ((size_t)bh * SEQ + t) * 64 + dh;
      gq[idx] = f2bf(qn); gk[idx] = f2bf(kn); gv[idx] = f2bf(y[2]);
      const float gate = bf2f(ur[776 + j]);
      auxgate[(size_t)tok * 256 + j] = f2bf(gate * sigmoidf_(gate));
      if (lane == 0) {
        const float beta = sigmoidf_(bf2f(ur[768 + h]));
        const float gl = -__expf(alog[h]) * softplusf_(bf2f(ur[772 + h]) + dtb[h]);
        gbeta[(size_t)bh * SEQ + t] = beta; ga[(size_t)bh * SEQ + t] = __expf(gl);
      }
    }
    }
  }
}


DI float sum8(float x) {
  x += __int_as_float(__builtin_amdgcn_update_dpp(0, __float_as_int(x), 0xB1, 0xF, 0xF, true));
  x += __int_as_float(__builtin_amdgcn_update_dpp(0, __float_as_int(x), 0x4E, 0xF, 0xF, true));
  x += __int_as_float(__builtin_amdgcn_update_dpp(0, __float_as_int(x), 0x141, 0xF, 0xF, true));
  return x;
}
DI void unpk8(float (&f)[8], const u32x4& w) {
#pragma unroll
  for (int i = 0; i < 4; ++i) { f[2 * i] = __uint_as_float(w[i] << 16); f[2 * i + 1] = __uint_as_float(w[i] & 0xffff0000u); }
}
DI u32x4 pk8(const float (&f)[8]) { u32x4 w; w[0] = pk2(f[0], f[1]); w[1] = pk2(f[2], f[3]); w[2] = pk2(f[4], f[5]); w[3] = pk2(f[6], f[7]); return w; }
DI void ld8f(float (&f)[8], const float* p) { const f32x4 a = *(const f32x4*)p, b = *(const f32x4*)(p + 4); f[0] = a[0]; f[1] = a[1]; f[2] = a[2]; f[3] = a[3]; f[4] = b[0]; f[5] = b[1]; f[6] = b[2]; f[7] = b[3]; }
DI void phase_prep2(const Params& p, int L, char* lds) {
  constexpr int XLD = 264;
  bf16_t* XS = (bf16_t*)lds;
  float* LR = (float*)(lds + 16 * XLD * 2);
  bf16_t* VT = (bf16_t*)(lds + 16 * XLD * 2 + 3 * 16 * 256 * 4);
  char* R = p.ws + O_R;
  const bf16_t* u = (const bf16_t*)(R + R_U);
  bf16_t* rwA = (bf16_t*)(R + R_RWA); bf16_t* rwB = (bf16_t*)(R + R_RWB); bf16_t* rwK = (bf16_t*)(R + R_RWK);
  bf16_t* rwR = (bf16_t*)(R + R_RWR); bf16_t* rwV = (bf16_t*)(R + R_RWV); float* rwW = (float*)(R + R_RWW);
  bf16_t* gq = (bf16_t*)(R + R_GQ); bf16_t* gk = (bf16_t*)(R + R_GK); bf16_t* gv = (bf16_t*)(R + R_GV);
  bf16_t* Qd = (bf16_t*)(R + R_QD); bf16_t* Kd = (bf16_t*)(R + R_KD); bf16_t* Vd = (bf16_t*)(R + R_VD);
  bf16_t* Qf = (bf16_t*)(R + R_QF); bf16_t* Kf = (bf16_t*)(R + R_KF); bf16_t* Vf = (bf16_t*)(R + R_VF);
  bf16_t* auxg = (bf16_t*)(R + R_AUXG); bf16_t* auxgate = (bf16_t*)(R + R_AUXGATE);
  float* rk = (float*)(p.ws + O_SMALL + SM_RK); float* logf_ = (float*)(p.ws + O_SMALL + SM_LOGF);
  float* gbeta = (float*)(p.ws + O_SMALL + SM_GBETA); float* ga = (float*)(p.ws + O_SMALL + SM_GA);
  const float* mu = p.in[8] + L * 1024; const float* w0 = p.in[9] + L * 256; const float* a0 = p.in[11] + L * 256;
  const float* kkp = p.in[14] + L * 256; const float* kap = p.in[15] + L * 256; const float* rkp = p.in[16] + L * 256;
  const float* fbias = p.in[21] + L * 4; const float* cw = p.in[22] + L * 768 * 4;
  const float* alog = p.in[23] + L * 4; const float* dtb = p.in[24] + L * 4;
  const bf16_t* WL = (const bf16_t*)(p.ws + O_LORA + L * SZ_LORA);
  const float QS_D = 0.25503486164919736f, QS_F = 0.18033688011112042f;
#pragma unroll 1
  for (int tile = obid(); tile < NTOK / 16; tile += gridDim.x) {
    const int tid = otid(), tk = tid >> 5, cg = tid & 31, c0 = cg * 8, h = cg >> 3, d0 = (cg & 7) * 8, lane = tid & 63, wid = tid >> 6;
    const int fr = lane & 15, fq = lane >> 4;
    const int T0 = tile * 16, b = T0 / SEQ, t0 = T0 % SEQ, tok = T0 + tk, t = t0 + tk, bh = b * 4 + h;
    const bf16_t* ur = u + (size_t)tok * UC;
    const size_t idx = ((size_t)bh * SEQ + t) * 64 + d0;
    float r[8], k[8], v[8];
    __syncthreads();
    {
#pragma unroll
      for (int seg = 0; seg < 4; ++seg) {
        asm volatile("" ::: "memory");
        float ua[8], up[8], mm[8], xm[8];
        unpk8(ua, *(const u32x4*)(ur + seg * 256 + c0));
        if (t > 0) unpk8(up, *(const u32x4*)(ur - UC + seg * 256 + c0));
        else {
#pragma unroll
          for (int i = 0; i < 8; ++i) up[i] = 0.f;
        }
        ld8f(mm, mu + seg * 256 + c0);
#pragma unroll
        for (int i = 0; i < 8; ++i) xm[i] = ua[i] + (up[i] - ua[i]) * mm[i];
        if (seg == 0) {
#pragma unroll
          for (int i = 0; i < 8; ++i) r[i] = xm[i];
        } else if (seg == 1) {
#pragma unroll
          for (int i = 0; i < 8; ++i) k[i] = xm[i];
        } else if (seg == 2) {
#pragma unroll
          for (int i = 0; i < 8; ++i) v[i] = xm[i];
        } else {
          if (cg < 8) {
#pragma unroll
            for (int i = 0; i < 8; ++i) xm[i] = 1.0f - 2.0f / (1.0f + __expf(2.0f * xm[i]));
          } else if (cg >= 16) {
#pragma unroll
            for (int i = 0; i < 8; ++i) xm[i] = sigmoidf_(xm[i]);
          }
          *(u32x4*)(XS + tk * XLD + c0) = pk8(xm);
        }
      }
    }
    __syncthreads();
    {
#pragma unroll
      for (int nt2 = 0; nt2 < 2; ++nt2) {
        const int nt = wid * 2 + nt2;
        f32x4 aw = {0.f, 0.f, 0.f, 0.f}, aa = aw, ag = aw;
#pragma unroll
        for (int ks = 0; ks < 2; ++ks) {
          const bf16x8 xw = *(const bf16x8*)(XS + fr * XLD + 32 * ks + 8 * fq);
          const bf16x8 xa = *(const bf16x8*)(XS + fr * XLD + 64 + 32 * ks + 8 * fq);
          const bf16x8 ww = *(const bf16x8*)(WL + (size_t)(16 * nt + fr) * 64 + 32 * ks + 8 * fq);
          const bf16x8 wa = *(const bf16x8*)(WL + 256 * 64 + (size_t)(16 * nt + fr) * 64 + 32 * ks + 8 * fq);
          aw = __builtin_amdgcn_mfma_f32_16x16x32_bf16(ww, xw, aw, 0, 0, 0);
          aa = __builtin_amdgcn_mfma_f32_16x16x32_bf16(wa, xa, aa, 0, 0, 0);
        }
#pragma unroll
        for (int ks = 0; ks < 4; ++ks) {
          const bf16x8 xg = *(const bf16x8*)(XS + fr * XLD + 128 + 32 * ks + 8 * fq);
          const bf16x8 wg = *(const bf16x8*)(WL + 2 * 256 * 64 + (size_t)(16 * nt + fr) * 128 + 32 * ks + 8 * fq);
          ag = __builtin_amdgcn_mfma_f32_16x16x32_bf16(wg, xg, ag, 0, 0, 0);
        }
        *(f32x4*)(LR + (0 * 16 + fr) * 256 + 16 * nt + 4 * fq) = aw;
        *(f32x4*)(LR + (1 * 16 + fr) * 256 + 16 * nt + 4 * fq) = aa;
        *(f32x4*)(LR + (2 * 16 + fr) * 256 + 16 * nt + 4 * fq) = ag;
      }
    }
    __syncthreads();
    {
      float lw[8], al[8], gg[8], t8[8], kkv[8], kpv[8], o8[8];
      ld8f(lw, LR + (0 * 16 + tk) * 256 + c0); ld8f(al, LR + (1 * 16 + tk) * 256 + c0); ld8f(gg, LR + (2 * 16 + tk) * 256 + c0);
      ld8f(t8, w0 + c0);
#pragma unroll
      for (int i = 0; i < 8; ++i) lw[i] = __expf(-0.6065306597126334f * sigmoidf_(lw[i] + t8[i]));
      ld8f(t8, a0 + c0);
#pragma unroll
      for (int i = 0; i < 8; ++i) al[i] = sigmoidf_(al[i] + t8[i]);
      ld8f(t8, kkp + c0);
      float ss = 0.f;
#pragma unroll
      for (int i = 0; i < 8; ++i) { kkv[i] = k[i] * t8[i]; ss += kkv[i] * kkv[i]; }
      ss = sum8(ss);
      const float rn = rsqrtf(ss + 1e-6f);
      ld8f(t8, kap + c0);
#pragma unroll
      for (int i = 0; i < 8; ++i) { kkv[i] *= rn; kpv[i] = k[i] * (1.0f + (al[i] - 1.0f) * t8[i]); }
      ld8f(t8, rkp + c0);
      float rks = 0.f;
#pragma unroll
      for (int i = 0; i < 8; ++i) rks += r[i] * kpv[i] * t8[i];
      rks = sum8(rks);
#pragma unroll
      for (int i = 0; i < 8; ++i) o8[i] = -kkv[i];
      *(u32x4*)(rwA + idx) = pk8(o8);
      *(f32x4*)(rwW + idx) = (f32x4){lw[0], lw[1], lw[2], lw[3]}; *(f32x4*)(rwW + idx + 4) = (f32x4){lw[4], lw[5], lw[6], lw[7]};
#pragma unroll
      for (int i = 0; i < 8; ++i) o8[i] = kkv[i] * al[i];
      *(u32x4*)(rwB + idx) = pk8(o8);
      *(u32x4*)(rwK + idx) = pk8(kpv);
      *(u32x4*)(rwR + idx) = pk8(r);
      *(u32x4*)(rwV + idx) = pk8(v);
      *(u32x4*)(auxg + (size_t)tok * 256 + c0) = pk8(gg);
      if ((cg & 7) == 0) rk[tok * 4 + h] = rks;
    }
    asm volatile("" ::: "memory");
    {
      float q[8], kx[8];
      unpk8(q, *(const u32x4*)(ur + OFF_B + c0)); unpk8(kx, *(const u32x4*)(ur + OFF_B + 256 + c0));
      const u32x4 vdw = *(const u32x4*)(ur + OFF_B + 512 + c0);
      if ((cg & 3) == 0) {
#pragma unroll
        for (int i = 0; i < 4; ++i) {
          const float invrev = i == 0 ? 0.15915494309189535f : i == 1 ? 0.005985185712713705f : i == 2 ? 0.00022507907903927653f : 8.464330808241401e-06f;
          const float rvf = (float)t * invrev, fr_ = rvf - floorf(rvf);
          const float sn = __builtin_amdgcn_sinf(fr_), cs = __builtin_amdgcn_cosf(fr_);
          const float q1 = q[i], q2 = q[i + 4], k1 = kx[i], k2 = kx[i + 4];
          q[i] = q1 * cs - q2 * sn; q[i + 4] = q2 * cs + q1 * sn;
          kx[i] = k1 * cs - k2 * sn; kx[i + 4] = k2 * cs + k1 * sn;
        }
      }
#pragma unroll
      for (int i = 0; i < 8; ++i) q[i] *= QS_D;
      *(u32x4*)(Qd + idx) = pk8(q); *(u32x4*)(Kd + idx) = pk8(kx);
      asm volatile("" ::: "memory");
      float fqv[8];
      unpk8(fqv, *(const u32x4*)(ur + OFF_C + c0));
#pragma unroll
      for (int i = 0; i < 8; ++i) fqv[i] *= QS_F;
      *(u32x4*)(Qf + idx) = pk8(fqv);
      *(u32x4*)(Kf + idx) = *(const u32x4*)(ur + OFF_C + 256 + c0);
      const u32x4 vfw = *(const u32x4*)(ur + OFF_C + 512 + c0);
      *(u32x4*)(VT + (0 * 16 + tk) * 256 + c0) = vdw;
      *(u32x4*)(VT + (1 * 16 + tk) * 256 + c0) = vfw;
      if (cg == 0) {
        const u32x2 fl = *(const u32x2*)(ur + OFF_C + 768);
        const float f0 = __uint_as_float(fl[0] << 16), f1 = __uint_as_float(fl[0] & 0xffff0000u), f2 = __uint_as_float(fl[1] << 16), f3 = __uint_as_float(fl[1] & 0xffff0000u);
        logf_[(size_t)(b * 4 + 0) * SEQ + t] = logsigmoidf_(f0 + fbias[0]); logf_[(size_t)(b * 4 + 1) * SEQ + t] = logsigmoidf_(f1 + fbias[1]);
        logf_[(size_t)(b * 4 + 2) * SEQ + t] = logsigmoidf_(f2 + fbias[2]); logf_[(size_t)(b * 4 + 3) * SEQ + t] = logsigmoidf_(f3 + fbias[3]);
      }
    }
    asm volatile("" ::: "memory");
    {
      float y[3][8];
#pragma unroll
      for (int seg = 0; seg < 3; ++seg) {
        asm volatile("" ::: "memory");
#pragma unroll
        for (int i = 0; i < 8; ++i) y[seg][i] = 0.f;
#pragma unroll
        for (int jj = 0; jj < 4; ++jj) {
          if (t - 3 + jj >= 0) {
            const bf16_t* up_ = ur + (jj - 3) * UC + OFF_D + seg * 256 + c0;
            const u32x2 lo = *(const u32x2*)up_, hi = *(const u32x2*)(up_ + 4);
            const u32x4 w4 = {lo[0], lo[1], hi[0], hi[1]};
            float uu[8]; unpk8(uu, w4);
#pragma unroll
            for (int i = 0; i < 8; ++i) y[seg][i] += cw[(seg * 256 + c0 + i) * 4 + jj] * uu[i];
          }
        }
#pragma unroll
        for (int i = 0; i < 8; ++i) y[seg][i] = y[seg][i] * sigmoidf_(y[seg][i]);
      }
      float sq = 0.f, sk = 0.f;
#pragma unroll
      for (int i = 0; i < 8; ++i) { sq += y[0][i] * y[0][i]; sk += y[1][i] * y[1][i]; }
      sq = sum8(sq); sk = sum8(sk);
      const float rq = rsqrtf(sq + 1e-6f) * 0.125f, rkn = rsqrtf(sk + 1e-6f);
#pragma unroll
      for (int i = 0; i < 8; ++i) { y[0][i] *= rq; y[1][i] *= rkn; }
      *(u32x4*)(gq + idx) = pk8(y[0]); *(u32x4*)(gk + idx) = pk8(y[1]); *(u32x4*)(gv + idx) = pk8(y[2]);
      asm volatile("" ::: "memory");
      {
        const bf16_t* gp = ur + OFF_D + 776 + c0;
        const u32x2 lo = *(const u32x2*)gp, hi = *(const u32x2*)(gp + 4);
        const u32x4 w4 = {lo[0], lo[1], hi[0], hi[1]};
        float g8[8]; unpk8(g8, w4);
#pragma unroll
        for (int i = 0; i < 8; ++i) g8[i] = g8[i] * sigmoidf_(g8[i]);
        *(u32x4*)(auxgate + (size_t)tok * 256 + c0) = pk8(g8);
      }
      if ((cg & 7) == 0) {
        const float beta = sigmoidf_(bf2f(ur[OFF_D + 768 + h]));
        const float gl = -__expf(alog[h]) * softplusf_(bf2f(ur[OFF_D + 772 + h]) + dtb[h]);
        gbeta[(size_t)bh * SEQ + t] = beta; ga[(size_t)bh * SEQ + t] = __expf(gl);
      }
    }
    __syncthreads();
    {
      const int ch = tid & 255, hf = tid >> 8;
#pragma unroll
      for (int m = 0; m < 2; ++m) {
        const bf16_t* vs = VT + (m * 16 + hf * 8) * 256 + ch;
        u32x4 w;
        w[0] = (unsigned)vs[0] | ((unsigned)vs[256] << 16); w[1] = (unsigned)vs[512] | ((unsigned)vs[768] << 16);
        w[2] = (unsigned)vs[1024] | ((unsigned)vs[1280] << 16); w[3] = (unsigned)vs[1536] | ((unsigned)vs[1792] << 16);
        bf16_t* dst = (m == 0 ? Vd : Vf) + ((size_t)(b * 4 + (ch >> 6)) * 64 + (ch & 63)) * SEQ + t0 + hf * 8;
        *(u32x4*)dst = w;
      }
    }
  }
}

DI float dpp_sum16(float x) {
  x += __int_as_float(__builtin_amdgcn_update_dpp(0, __float_as_int(x), 0xB1, 0xF, 0xF, true));
  x += __int_as_float(__builtin_amdgcn_update_dpp(0, __float_as_int(x), 0x4E, 0xF, 0xF, true));
  x += __int_as_float(__builtin_amdgcn_update_dpp(0, __float_as_int(x), 0x141, 0xF, 0xF, true));
  x += __int_as_float(__builtin_amdgcn_update_dpp(0, __float_as_int(x), 0x140, 0xF, 0xF, true));
  return x;
}
constexpr int SCH = 16;
constexpr int RS = 448;
DI float sum32(float x) {
  x = dpp_sum16(x);
  auto rr = __builtin_amdgcn_permlane16_swap(__float_as_uint(x), __float_as_uint(x), false, false);
  return __uint_as_float(rr[0]) + __uint_as_float(rr[1]);
}
struct StepIn { f32x4 q0, q1, q2; float V; };
DI void ld_step(StepIn& s, const float* sp, const float* vp) {
  s.q0 = *(const f32x4*)(sp); s.q1 = *(const f32x4*)(sp + 4); s.q2 = *(const f32x4*)(sp + 8); s.V = *vp;
}
template <int WHICH>
DI void scan_block(const Params& p, int L, int bh, int quarter, char* lds) {
  float* buf = (float*)lds;
  float* pbuf = buf + 2 * SCH * RS;
  char* R = p.ws + O_R;
  const int tid = otid();
  const size_t base = (size_t)bh * SEQ * 64;
  float* oout = (float*)(R + R_OSCAN) + (size_t)WHICH * NBH * SEQ * 64 + base;
  constexpr int NCH = SEQ / SCH;
  const int r = tid >> 5, sub = tid & 31, v = quarter * 16 + r;
  const int sst = (tid >> 4) & (SCH - 1), sk = (tid & 15) * 4;
  const bool stager = tid < SCH * 16;
  const u32x2* pA = (const u32x2*)((const bf16_t*)(R + (WHICH == 0 ? R_RWA : R_GK)) + base);
  const u32x2* pB = (const u32x2*)((const bf16_t*)(R + R_RWB) + base);
  const u32x2* pK = (const u32x2*)((const bf16_t*)(R + R_RWK) + base);
  const u32x2* pR = (const u32x2*)((const bf16_t*)(R + (WHICH == 0 ? R_RWR : R_GQ)) + base);
  const u32x2* pV = (const u32x2*)((const bf16_t*)(R + (WHICH == 0 ? R_RWV : R_GV)) + base);
  const f32x4* pW = (const f32x4*)((const float*)(R + R_RWW) + base);
  const float* gbeta = (const float*)(p.ws + O_SMALL + SM_GBETA) + (size_t)bh * SEQ;
  const float* ga = (const float*)(p.ws + O_SMALL + SM_GA) + (size_t)bh * SEQ;
  const u32x2 z2 = {0u, 0u};
  u32x2 ra = z2, ran = z2, rb = z2, rkk = z2, rr = z2, rv = z2; f32x4 rw = {0.f, 0.f, 0.f, 0.f};
  float rbeta = 0.f, raa = 0.f;
#define SCAN_LOAD(c)                                                                           \
  if (stager) {                                                                                \
    const int t_ = (c) * SCH + sst;                                                            \
    const size_t o_ = (size_t)t_ * 16 + (tid & 15);                                            \
    ra = pA[o_]; rr = pR[o_]; rv = pV[o_];                                                     \
    ran = t_ + 1 < SEQ ? pA[o_ + 16] : z2;                                                     \
    if (WHICH == 0) { rb = pB[o_]; rkk = pK[o_]; rw = pW[o_]; }                                \
    else { rbeta = gbeta[t_]; raa = ga[t_]; }                                                  \
  }
#define UNPK4(src) ((f32x4){__uint_as_float(src[0] << 16), __uint_as_float(src[0] & 0xffff0000u), __uint_as_float(src[1] << 16), __uint_as_float(src[1] & 0xffff0000u)})
#define DOT4(a, b) ((a[0] * b[0] + a[1] * b[1]) + (a[2] * b[2] + a[3] * b[3]))
#define SCAN_STAGE(c)                                                                          \
  if (stager) {                                                                                \
    float* rec_ = buf + ((c) & 1) * (SCH * RS) + sst * RS;                                     \
    f32x4 fAn, fW, fB, fK;                                                                     \
    if (WHICH == 0) { fAn = UNPK4(ran); fW = rw; fB = UNPK4(rb); fK = UNPK4(rkk); }            \
    else { const f32x4 k0_ = UNPK4(ra), kn_ = UNPK4(ran); fAn = -kn_; fW = (f32x4){raa, raa, raa, raa}; fB = k0_ * (raa * rbeta); fK = k0_ * rbeta; } \
    const float c1_ = dpp_sum16(DOT4(fB, fAn)), c2_ = dpp_sum16(DOT4(fK, fAn));               \
    const f32x4 fR = UNPK4(rr), fWA = fW * fAn;                                                \
    float* d_ = rec_ + (tid & 15) * 24;                                                        \
    *(f32x4*)(d_) = (f32x4){fWA[0], fWA[1], fW[0], fW[1]}; *(f32x4*)(d_ + 4) = (f32x4){fB[0], fB[1], fK[0], fK[1]}; *(f32x4*)(d_ + 8) = (f32x4){fR[0], fR[1], c1_, c2_};       \
    *(f32x4*)(d_ + 12) = (f32x4){fWA[2], fWA[3], fW[2], fW[3]}; *(f32x4*)(d_ + 16) = (f32x4){fB[2], fB[3], fK[2], fK[3]}; *(f32x4*)(d_ + 20) = (f32x4){fR[2], fR[3], c1_, c2_}; \
    *(f32x4*)(rec_ + 384 + sk) = UNPK4(rv);                                                    \
  }
#define SCAN_FLUSH(c)                                                                          \
  {                                                                                            \
    const float* pb_ = pbuf + ((c) & 1) * (SCH * 512);                                         \
    _Pragma("unroll") for (int ps_ = 0; ps_ < 4; ++ps_) {                                      \
      const int o_ = ps_ * 64 + (tid >> 3);                                                    \
      const f32x4 q_ = *(const f32x4*)(pb_ + o_ * 32 + (tid & 7) * 4);                         \
      float sm_ = (q_[0] + q_[1]) + (q_[2] + q_[3]);                                           \
      sm_ += __int_as_float(__builtin_amdgcn_update_dpp(0, __float_as_int(sm_), 0xB1, 0xF, 0xF, true));   \
      sm_ += __int_as_float(__builtin_amdgcn_update_dpp(0, __float_as_int(sm_), 0x4E, 0xF, 0xF, true));   \
      sm_ += __int_as_float(__builtin_amdgcn_update_dpp(0, __float_as_int(sm_), 0x141, 0xF, 0xF, true));  \
      if ((tid & 7) == 0) oout[((size_t)(c) * SCH + (o_ >> 4)) * 64 + quarter * 16 + (o_ & 15)] = sm_;   \
    }                                                                                          \
  }
  SCAN_LOAD(0);
  __syncthreads();
  SCAN_STAGE(0);
  f32x2 S1 = {0.f, 0.f}; float pre = 0.f, X = 0.f;
#pragma unroll 1
  for (int c = 0; c < NCH; ++c) {
    __syncthreads();
    if (c >= 1) SCAN_FLUSH(c - 1);
    if (c + 1 < NCH) SCAN_LOAD(c + 1);
    const float* cb = buf + (c & 1) * (SCH * RS);
    float* pb = pbuf + (c & 1) * (SCH * 512) + r * 32 + sub;
    StepIn cur, nxt;
    ld_step(cur, cb + sub * 12, cb + 384 + v);
#pragma unroll 4
    for (int st = 0; st < SCH; ++st) {
      const int sn = st + 1 < SCH ? st + 1 : st;
      ld_step(nxt, cb + sn * RS + sub * 12, cb + sn * RS + 384 + v);
      const float sa = X + pre;
      const float Xn = sum32(S1[0] * cur.q0[0] + S1[1] * cur.q0[1]);
      const float s0 = S1[0] * cur.q0[2] + (cur.q1[0] * sa + cur.q1[2] * cur.V);
      const float s1 = S1[1] * cur.q0[3] + (cur.q1[1] * sa + cur.q1[3] * cur.V);
      pre = sa * cur.q2[2] + cur.V * cur.q2[3];
      pb[st * 512] = s0 * cur.q2[0] + s1 * cur.q2[1];
      S1[0] = s0; S1[1] = s1; X = Xn;
      cur = nxt;
    }
    if (c + 1 < NCH) SCAN_STAGE(c + 1);
  }
  __syncthreads();
  SCAN_FLUSH(NCH - 1);
#undef SCAN_LOAD
#undef SCAN_STAGE
#undef SCAN_FLUSH
#undef UNPK4
#undef DOT4
}
DI void phase_scanpost(const Params& p, int L) {
  char* R = p.ws + O_R;
  const int lane = otid() & 63, wid = otid() >> 6;
  const float* osc = (const float*)(R + R_OSCAN);
  const float* rk = (const float*)(p.ws + O_SMALL + SM_RK);
  const bf16_t* rwV = (const bf16_t*)(R + R_RWV);
  const bf16_t* auxg = (const bf16_t*)(R + R_AUXG); const bf16_t* auxgate = (const bf16_t*)(R + R_AUXGATE);
  bf16_t* y = (bf16_t*)(R + R_Y);
  const float* lnw = p.in[17] + L * 256; const float* lnb = p.in[18] + L * 256; const float* gnw = p.in[25] + L * 64;
  for (int item = obid() * 8 + wid; item < 2 * NBH * SEQ; item += gridDim.x * 8) {
    const int which = item >= NBH * SEQ, rem = item - which * NBH * SEQ, bh = rem / SEQ, t = rem % SEQ, b = bh >> 2, h = bh & 3, tok = b * SEQ + t;
    const float o = osc[(size_t)item * 64 + lane];
    if (which == 0) {
      const float mean = wave_sum(o) * (1.0f / 64.0f), dl = o - mean;
      const float var = wave_sum(dl * dl) * (1.0f / 64.0f);
      float val = dl * rsqrtf(var + 64e-5f) * lnw[h * 64 + lane] + lnb[h * 64 + lane];
      val += rk[tok * 4 + h] * bf2f(rwV[((size_t)bh * SEQ + t) * 64 + lane]);
      val *= bf2f(auxg[(size_t)tok * 256 + h * 64 + lane]);
      y[((size_t)0 * NTOK + tok) * 256 + h * 64 + lane] = f2bf(val);
    } else {
      const float ms = wave_sum(o * o) * (1.0f / 64.0f);
      const float val = o * rsqrtf(ms + 1e-6f) * gnw[lane] * bf2f(auxgate[(size_t)tok * 256 + h * 64 + lane]);
      y[((size_t)3 * NTOK + tok) * 256 + h * 64 + lane] = f2bf(val);
    }
  }
}

DI bf16x8 packf8(float a0, float a1, float a2, float a3, float a4, float a5, float a6, float a7) {
  u32x4 w; w[0] = pk2(a0, a1); w[1] = pk2(a2, a3); w[2] = pk2(a4, a5); w[3] = pk2(a6, a7);
  return __builtin_bit_cast(bf16x8, w);
}
constexpr int KLD = 72;
template <int TYPE>
DI void attn_unit(const Params& p, int L, int bh, int qt, char* lds) {
  bf16_t* Ks = (bf16_t*)lds;
  bf16_t* Vs = Ks + 64 * KLD;
  float* cs = (float*)(lds + 2 * 64 * KLD * 2);
  float* red = cs + 8192;
  char* R = p.ws + O_R;
  const int tid = otid(), lane = tid & 63, wid = tid >> 6, r32 = lane & 31, hi = lane >> 5;
  const int b = bh >> 2, h = bh & 3;
  const int map = TYPE == 0 ? (wid >> 2) : 0, wq = TYPE == 0 ? (wid & 3) : wid;
  const int QROWS = TYPE == 0 ? 128 : 256;
  const int q0 = qt * QROWS, qw0 = q0 + wq * 32, q = qw0 + r32;
  const bf16_t* Qg = (const bf16_t*)(R + (TYPE == 0 ? R_QD : R_QF)) + (size_t)bh * SEQ * 64;
  const bf16_t* Kg = (const bf16_t*)(R + (TYPE == 0 ? R_KD : R_KF)) + (size_t)bh * SEQ * 64;
  const bf16_t* Vg = (const bf16_t*)(R + (TYPE == 0 ? R_VD : R_VF)) + (size_t)bh * 64 * SEQ;
  const int NT = (q0 + QROWS) / 64;
  __syncthreads();
  const int lrow = tid >> 3, lch = (tid & 7) * 8;
  u32x4 kreg = *(const u32x4*)(Kg + (size_t)lrow * 64 + lch);
  u32x4 vreg = *(const u32x4*)(Vg + (size_t)lrow * SEQ + lch);
  float cq = 0.f;
  if (TYPE == 1) {
    const float* lf = (const float*)(p.ws + O_SMALL + SM_LOGF) + (size_t)bh * SEQ;
    const int n = q0 + 256;
    float loc[16]; float tot = 0.f;
#pragma unroll
    for (int i = 0; i < 16; ++i) { const int e = tid * 16 + i; loc[i] = e < n ? lf[e] : 0.f; tot += loc[i]; }
    float inc = tot;
#pragma unroll
    for (int o = 1; o < 64; o <<= 1) { const float t2 = __shfl_up(inc, o); if (lane >= o) inc += t2; }
    if (lane == 63) red[wid] = inc;
    __syncthreads();
    float pre = inc - tot;
    for (int w = 0; w < wid; ++w) pre += red[w];
#pragma unroll
    for (int i = 0; i < 16; ++i) { pre += loc[i]; const int e = tid * 16 + i; if (e < n) cs[e] = pre * 1.4426950408889634f; }
    __syncthreads();
    cq = cs[q];
  }
  constexpr int NS = TYPE == 0 ? 2 : 4;
  const int sbase = TYPE == 0 ? 2 * map : 0;
  bf16x8 qf[NS];
#pragma unroll
  for (int s = 0; s < NS; ++s) qf[s] = *(const bf16x8*)(Qg + (size_t)q * 64 + 16 * (sbase + s) + 8 * hi);
  float m = -INFINITY, l = 0.f; f32x16 o[2];
#pragma unroll
  for (int r = 0; r < 16; ++r) { o[0][r] = 0.f; o[1][r] = 0.f; }
#pragma unroll 1
  for (int jt = 0; jt < NT; ++jt) {
    const int kv0 = jt * 64;
    __syncthreads();
    *(u32x4*)(Ks + lrow * KLD + lch) = kreg;
    *(u32x4*)(Vs + lrow * KLD + lch) = vreg;
    __syncthreads();
    if (jt + 1 < NT) {
      kreg = *(const u32x4*)(Kg + (size_t)(kv0 + 64 + lrow) * 64 + lch);
      vreg = *(const u32x4*)(Vg + (size_t)lrow * SEQ + kv0 + 64 + lch);
    }
    if (kv0 <= qw0 + 31) {
      const bool needmask = kv0 + 63 > qw0;
      f32x16 p0, p1;
#pragma unroll
      for (int r = 0; r < 16; ++r) { p0[r] = 0.f; p1[r] = 0.f; }
#pragma unroll
      for (int s = 0; s < NS; ++s) {
        const bf16x8 k0 = *(const bf16x8*)(Ks + r32 * KLD + 16 * (sbase + s) + 8 * hi);
        const bf16x8 k1 = *(const bf16x8*)(Ks + (32 + r32) * KLD + 16 * (sbase + s) + 8 * hi);
        p0 = __builtin_amdgcn_mfma_f32_32x32x16_bf16(k0, qf[s], p0, 0, 0, 0);
        p1 = __builtin_amdgcn_mfma_f32_32x32x16_bf16(k1, qf[s], p1, 0, 0, 0);
      }
      if (TYPE == 1) {
#pragma unroll
        for (int r = 0; r < 16; ++r) { p0[r] += cq - cs[kv0 + crow(r, hi)]; p1[r] += cq - cs[kv0 + 32 + crow(r, hi)]; }
      }
      if (needmask) {
#pragma unroll
        for (int r = 0; r < 16; ++r) { if (kv0 + crow(r, hi) > q) p0[r] = -INFINITY; if (kv0 + 32 + crow(r, hi) > q) p1[r] = -INFINITY; }
      }
      float mx = fmaxf(p0[0], p1[0]);
#pragma unroll
      for (int r = 1; r < 16; ++r) mx = fmaxf(mx, fmaxf(p0[r], p1[r]));
      mx = fmaxf(mx, __shfl_xor(mx, 32));
      const float mn = fmaxf(m, mx);
      const float alpha = __builtin_amdgcn_exp2f(m - mn);
      m = mn;
      float rs = 0.f;
#pragma unroll
      for (int r = 0; r < 16; ++r) { p0[r] = __builtin_amdgcn_exp2f(p0[r] - mn); p1[r] = __builtin_amdgcn_exp2f(p1[r] - mn); rs += p0[r] + p1[r]; }
      l = l * alpha + rs;
#pragma unroll
      for (int r = 0; r < 16; ++r) { o[0][r] *= alpha; o[1][r] *= alpha; }
      bf16x8 pf[4];
      pf[0] = packf8(p0[0], p0[1], p0[2], p0[3], p0[4], p0[5], p0[6], p0[7]);
      pf[1] = packf8(p0[8], p0[9], p0[10], p0[11], p0[12], p0[13], p0[14], p0[15]);
      pf[2] = packf8(p1[0], p1[1], p1[2], p1[3], p1[4], p1[5], p1[6], p1[7]);
      pf[3] = packf8(p1[8], p1[9], p1[10], p1[11], p1[12], p1[13], p1[14], p1[15]);
#pragma unroll
      for (int db = 0; db < 2; ++db)
#pragma unroll
        for (int s = 0; s < 4; ++s) {
          const s16x4 lo = *(const s16x4*)(Vs + (32 * db + r32) * KLD + 16 * s + 4 * hi);
          const s16x4 hh = *(const s16x4*)(Vs + (32 * db + r32) * KLD + 16 * s + 8 + 4 * hi);
          const bf16x8 vf = __builtin_shufflevector(lo, hh, 0, 1, 2, 3, 4, 5, 6, 7);
          o[db] = __builtin_amdgcn_mfma_f32_32x32x16_bf16(vf, pf[s], o[db], 0, 0, 0);
        }
    }
  }
  bf16_t* y = (bf16_t*)(R + R_Y);
  const size_t orow = ((size_t)(TYPE == 0 ? 1 : 2) * NTOK + (size_t)b * SEQ + q) * 256 + h * 64;
  const float lt = l + __shfl_xor(l, 32);
  const float li = 1.0f / lt;
  if (TYPE == 1) {
#pragma unroll
    for (int db = 0; db < 2; ++db)
#pragma unroll
      for (int g = 0; g < 4; ++g) {
        u32x2 w; w[0] = pk2(o[db][4 * g] * li, o[db][4 * g + 1] * li); w[1] = pk2(o[db][4 * g + 2] * li, o[db][4 * g + 3] * li);
        *(u32x2*)(y + orow + 32 * db + 8 * g + 4 * hi) = w;
      }
  } else {
    float* xb = cs;
    if (map == 1) {
#pragma unroll
      for (int db = 0; db < 2; ++db)
#pragma unroll
        for (int r = 0; r < 16; ++r) xb[(wq * 32 + db * 16 + r) * 64 + lane] = o[db][r] * li;
    }
    __syncthreads();
    if (map == 0) {
      const float* lp = p.in[19] + L * 128;
      float s01 = 0.f, s23 = 0.f;
      for (int i = 0; i < 32; ++i) { s01 += lp[i] * lp[32 + i]; s23 += lp[64 + i] * lp[96 + i]; }
      const float lam_init = L == 0 ? 0.2f : 0.35550906759096934f;
      const float lam = __expf(s01) - __expf(s23) + lam_init;
      const float* sub = p.in[20] + L * 64;
      float ss = 0.f;
#pragma unroll
      for (int db = 0; db < 2; ++db)
#pragma unroll
        for (int r = 0; r < 16; ++r) { const float vv = o[db][r] * li - lam * xb[(wq * 32 + db * 16 + r) * 64 + lane]; o[db][r] = vv; ss += vv * vv; }
      ss += __shfl_xor(ss, 32);
      const float sc = rsqrtf(ss * (1.0f / 64.0f) + 1e-5f) * (1.0f - lam_init);
#pragma unroll
      for (int db = 0; db < 2; ++db)
#pragma unroll
        for (int g = 0; g < 4; ++g) {
          const int d = 32 * db + 8 * g + 4 * hi;
          const f32x4 sw = *(const f32x4*)(sub + d);
          u32x2 w; w[0] = pk2(o[db][4 * g] * sc * sw[0], o[db][4 * g + 1] * sc * sw[1]); w[1] = pk2(o[db][4 * g + 2] * sc * sw[2], o[db][4 * g + 3] * sc * sw[3]);
          *(u32x2*)(y + orow + d) = w;
        }
    }
  }
}

DI void phase_mix(const Params& p, int L, char* lds, int qslot) {
  int* ctr = (int*)(p.ws + O_CTL) + CW_QCTR + qslot * 64;
  int* s_unit = (int*)(lds + 2 * 64 * KLD * 2 + 8192 * 4 + 64);
  {
    const int bid = obid();
    if (bid < 64) {
      if (bid < 32) scan_block<0>(p, L, (bid >> 2) & 7, bid & 3, lds); else scan_block<1>(p, L, (bid >> 2) & 7, bid & 3, lds);
#if PROBE == 4
      if (L == 0) { __syncthreads(); if (bid < 32) scan_block<0>(p, L, (bid >> 2) & 7, bid & 3, lds); else scan_block<1>(p, L, (bid >> 2) & 7, bid & 3, lds); }
#endif
    }
  }
#pragma unroll 1
  for (;;) {
    __syncthreads();
    if (otid() == 0) *s_unit = atomicAdd(ctr, 1);
    __syncthreads();
    const int u = *s_unit;
    if (u >= 768) break;
    const int level = 31 - u / 24, w = u % 24;
    if (w < 8) attn_unit<1>(p, L, w, level, lds);
    else if (w < 16) attn_unit<0>(p, L, w - 8, 2 * level + 1, lds);
    else attn_unit<0>(p, L, w - 16, 2 * level, lds);
  }
}
DI void phase_mix_attn_only(const Params& p, int L, char* lds, int qslot) {
  int* ctr = (int*)(p.ws + O_CTL) + CW_QCTR + qslot * 64;
  int* s_unit = (int*)(lds + 2 * 64 * KLD * 2 + 8192 * 4 + 64);
#pragma unroll 1
  for (;;) {
    __syncthreads();
    if (otid() == 0) *s_unit = atomicAdd(ctr, 1);
    __syncthreads();
    const int u = *s_unit;
    if (u >= 768) break;
    const int level = 31 - u / 24, w = u % 24;
    if (w < 8) attn_unit<1>(p, L, w, level, lds);
    else if (w < 16) attn_unit<0>(p, L, w - 8, 2 * level + 1, lds);
    else attn_unit<0>(p, L, w - 16, 2 * level, lds);
  }
}


template <class F>
DI void run_gemm(PG8_LAS unsigned char* lds, const bf16_t* A, const bf16_t* Bt, int M, int N, int K, const int* texp, size_t bstride, F f) {
  pg8::Gemm g{A, Bt, M, N, K, texp, bstride};
  pg8::StaticOrder S; S.init(M, N, (int)gridDim.x, obid());
  pg8::EpiFn<F> E{f};
  pg8::gemm_phase<pg8::EpiFn<F>, pg8::StaticOrder, true, true>(lds, g, S, E);
}
DI void st_bf16x4(bf16_t* dst, const f32x4& v) { u32x2 w; w[0] = pk2(v[0], v[1]); w[1] = pk2(v[2], v[3]); *(u32x2*)dst = w; }
DI f32x4 ld_bf16x4(const bf16_t* src) { const u32x2 w = *(const u32x2*)src; return (f32x4){__uint_as_float(w[0] << 16), __uint_as_float(w[0] & 0xffff0000u), __uint_as_float(w[1] << 16), __uint_as_float(w[1] & 0xffff0000u)}; }

DI void phase_u(const Params& p, int L, PG8_LAS unsigned char* lds) {
  bf16_t* u = (bf16_t*)(p.ws + O_R + R_U);
  run_gemm(lds, (const bf16_t*)(p.ws + O_HB), (const bf16_t*)(p.ws + O_WIN + L * SZ_WIN), NTOK, UN, DM, nullptr, 0,
           [=](int row, int col, const f32x4& v) { if (col < UC) st_bf16x4(u + (size_t)row * UC + col, v); });
}
DI void phase_proj(const Params& p, int L, PG8_LAS unsigned char* lds) {
  bf16_t* PJ = (bf16_t*)(p.ws + O_R + R_PJ);
#pragma unroll 1
  for (int br = 0; br < 4; ++br) {
    const bf16_t* yb = (const bf16_t*)(p.ws + O_R + R_Y) + (size_t)br * NTOK * 256;
    const bf16_t* W = (const bf16_t*)(p.ws + O_WBO) + (size_t)(L * 4 + br) * 1024 * 256;
    bf16_t* dst = PJ + br * 1024;
    run_gemm(lds, yb, W, NTOK, 1024, 256, nullptr, 0, [=](int row, int col, const f32x4& v) { st_bf16x4(dst + (size_t)row * 4096 + col, v); });
  }
}
DI void phase_gate(const Params& p, int L, PG8_LAS unsigned char* lds) {
  bf16_t* PJ = (bf16_t*)(p.ws + O_R + R_PJ);
  run_gemm(lds, (const bf16_t*)(p.ws + O_HB), (const bf16_t*)(p.ws + O_WIN + L * SZ_WIN) + (size_t)OFF_G * DM, NTOK, 4096, DM, nullptr, 0,
           [=](int row, int col, const f32x4& v) {
             bf16_t* q = PJ + (size_t)row * 4096 + col;
             const f32x4 pj = ld_bf16x4(q);
             f32x4 o; o[0] = sigmoidf_(v[0]) * pj[0]; o[1] = sigmoidf_(v[1]) * pj[1]; o[2] = sigmoidf_(v[2]) * pj[2]; o[3] = sigmoidf_(v[3]) * pj[3];
             st_bf16x4(q, o);
           });
}
DI void phase_bsum(const Params& p) {
  const u32x4* GP = (const u32x4*)(p.ws + O_R + R_PJ); u32x4* M = (u32x4*)(p.ws + O_R + R_M);
  const int gtid = obid() * NTHR + otid(), gsz = gridDim.x * NTHR;
  for (int i = gtid; i < NTOK * 128; i += gsz) {
    const int tok = i >> 7, c8 = i & 127;
    float a[8];
#pragma unroll
    for (int k = 0; k < 8; ++k) a[k] = 0.f;
#pragma unroll
    for (int b = 0; b < 4; ++b) {
      const u32x4 w = GP[(size_t)tok * 512 + b * 128 + c8];
#pragma unroll
      for (int k = 0; k < 4; ++k) { a[2 * k] += __uint_as_float(w[k] << 16); a[2 * k + 1] += __uint_as_float(w[k] & 0xffff0000u); }
    }
    u32x4 o; o[0] = pk2(a[0], a[1]); o[1] = pk2(a[2], a[3]); o[2] = pk2(a[4], a[5]); o[3] = pk2(a[6], a[7]);
    M[i] = o;
  }
}
DI void phase_xadd(const Params& p, const bf16_t* A, const bf16_t* Bt, int K, PG8_LAS unsigned char* lds) {
  float* x = p.x;
  run_gemm(lds, A, Bt, NTOK, DM, K, nullptr, 0, [=](int row, int col, const f32x4& v) { float* xp = x + (size_t)row * DM + col; f32x4 xv = *(f32x4*)xp; xv += v; *(f32x4*)xp = xv; });
}
DI void phase_ffn_up(const Params& p, PG8_LAS unsigned char* lds) {
  bf16_t* T = (bf16_t*)(p.ws + O_R + R_T);
  run_gemm(lds, (const bf16_t*)(p.ws + O_HB), (const bf16_t*)(p.ws + O_FGU), NTOK, 2 * FFD, DM, nullptr, 0,
           [=](int row, int col, const f32x4& v) {
             const float t0 = v[0] * sigmoidf_(v[0]) * v[1], t1 = v[2] * sigmoidf_(v[2]) * v[3];
             *(unsigned*)(T + (size_t)row * FFD + (col >> 1)) = pk2(t0, t1);
           });
}
DI void phase_moe_gather(const Params& p) {
  const int* cnt = (const int*)(p.ws + O_CTL) + CW_MOECNT;
  const int* list = (const int*)(p.ws + O_SMALL + SM_LIST);
  const float* gw = (const float*)(p.ws + O_SMALL + SM_GW);
  int* texp = (int*)(p.ws + O_SMALL + SM_TEXP);
  int* rowtok = (int*)(p.ws + O_SMALL + SM_ROWTOK);
  float* rowgw = (float*)(p.ws + O_SMALL + SM_ROWGW);
  int* slotrow = (int*)(p.ws + O_SMALL + SM_SLOTROW);
  const bf16_t* hb = (const bf16_t*)(p.ws + O_HB);
  bf16_t* xbuf = (bf16_t*)(p.ws + O_XBUF);
  const int lane = otid() & 63, wid = otid() >> 6;
  int c[8];
#pragma unroll
  for (int e = 0; e < 8; ++e) c[e] = cnt[e];
  int total = 0;
#pragma unroll
  for (int e = 0; e < 8; ++e) total += (c[e] + 255) & ~255;
  for (int row = obid() * 8 + wid; row < total; row += gridDim.x * 8) {
    int e = 0, s = 0, o = 0;
#pragma unroll
    for (int i = 0; i < 8; ++i) { const int pc = (c[i] + 255) & ~255; if (row >= o && row < o + pc) { e = i; s = row - o; } o += pc; }
    int ce = 0;
#pragma unroll
    for (int i = 0; i < 8; ++i) if (i == e) ce = c[i];
    const bool valid = s < ce;
    const int tok = valid ? list[(size_t)e * NTOK + s] : -1;
    u32x4 v0 = {0u, 0u, 0u, 0u}, v1 = {0u, 0u, 0u, 0u};
    if (valid) { const u32x4* src = (const u32x4*)(hb + (size_t)tok * DM); v0 = src[lane]; v1 = src[64 + lane]; }
    u32x4* dst = (u32x4*)(xbuf + (size_t)row * DM); dst[lane] = v0; dst[64 + lane] = v1;
    if (lane == 0) { rowtok[row] = tok; rowgw[row] = valid ? gw[(size_t)e * NTOK + s] : 0.f; if ((row & 255) == 0) texp[row >> 8] = e; if (valid) slotrow[(size_t)e * NTOK + s] = row; }
  }
}
DI int moe_rows(const Params& p) {
  const int* cnt = (const int*)(p.ws + O_CTL) + CW_MOECNT;
  int total = 0;
#pragma unroll
  for (int e = 0; e < 8; ++e) total += (cnt[e] + 255) & ~255;
  return total;
}
DI void phase_moe_up(const Params& p, PG8_LAS unsigned char* lds) {
  const int Mp = moe_rows(p);
  bf16_t* T = (bf16_t*)(p.ws + O_T2);
  run_gemm(lds, (const bf16_t*)(p.ws + O_XBUF), (const bf16_t*)(p.ws + O_MGU), Mp, 2 * FFE, DM, (const int*)(p.ws + O_SMALL + SM_TEXP), (size_t)2 * FFE * DM * 2,
           [=](int row, int col, const f32x4& v) {
             const float t0 = v[0] * sigmoidf_(v[0]) * v[1], t1 = v[2] * sigmoidf_(v[2]) * v[3];
             *(unsigned*)(T + (size_t)row * FFE + (col >> 1)) = pk2(t0, t1);
           });
}
DI void phase_moe_down(const Params& p, PG8_LAS unsigned char* lds) {
  const int Mp = moe_rows(p);
  const float* rowgw = (const float*)(p.ws + O_SMALL + SM_ROWGW);
  bf16_t* Y2 = (bf16_t*)(p.ws + O_XBUF);
  run_gemm(lds, (const bf16_t*)(p.ws + O_T2), (const bf16_t*)(p.ws + O_MD), Mp, DM, FFE, (const int*)(p.ws + O_SMALL + SM_TEXP), (size_t)DM * FFE * 2,
           [=](int row, int col, const f32x4& v) { const float w = rowgw[row]; st_bf16x4(Y2 + (size_t)row * DM + col, v * w); });
}
DI void phase_ple_proj(const Params& p, int L, PG8_LAS unsigned char* lds) {
  bf16_t* PJ2 = (bf16_t*)(p.ws + O_R + R_PJ2);
  run_gemm(lds, (const bf16_t*)(p.ws + O_PB), (const bf16_t*)(p.ws + O_PP) + (size_t)L * 1024 * 256, NTOK, DM, 256, nullptr, 0,
           [=](int row, int col, const f32x4& v) { st_bf16x4(PJ2 + (size_t)row * DM + col, v); });
}
DI void phase_ple_gate(const Params& p, int L, PG8_LAS unsigned char* lds) {
  const bf16_t* PJ2 = (const bf16_t*)(p.ws + O_R + R_PJ2);
  float* x = p.x;
  run_gemm(lds, (const bf16_t*)(p.ws + O_HB), (const bf16_t*)(p.ws + O_PG) + (size_t)L * 1024 * 1024, NTOK, DM, DM, nullptr, 0,
           [=](int row, int col, const f32x4& v) {
             const f32x4 pj = ld_bf16x4(PJ2 + (size_t)row * DM + col);
             float* xp = x + (size_t)row * DM + col; f32x4 xv = *(f32x4*)xp;
             xv[0] += sigmoidf_(v[0]) * pj[0]; xv[1] += sigmoidf_(v[1]) * pj[1]; xv[2] += sigmoidf_(v[2]) * pj[2]; xv[3] += sigmoidf_(v[3]) * pj[3];
             *(f32x4*)xp = xv;
           });
}
DI void phase_final(const Params& p) {
  const int lane = otid() & 63, wid = otid() >> 6;
  const float* g = p.in[35];
  for (int row = obid() * 8 + wid; row < NTOK; row += gridDim.x * 8) {
    float* xr = p.x + (size_t)row * DM;
    f32x4 v[4]; float ss = 0.f;
#pragma unroll
    for (int j = 0; j < 4; ++j) { v[j] = *(const f32x4*)(xr + j * 256 + lane * 4); ss += v[j][0] * v[j][0] + v[j][1] * v[j][1] + v[j][2] * v[j][2] + v[j][3] * v[j][3]; }
    ss = wave_sum(ss);
    const float rstd = rsqrtf(ss * (1.0f / 1024.0f) + 1e-6f);
#pragma unroll
    for (int j = 0; j < 4; ++j) { const f32x4 gg = *(const f32x4*)(g + j * 256 + lane * 4); *(f32x4*)(xr + j * 256 + lane * 4) = v[j] * rstd * gg; }
  }
}


constexpr int RING_BYTES = 131072, LDSCTL_OFF = RING_BYTES, MISC_OFF = LDSCTL_OFF + 320, LDS_BYTES = 147456;
static_assert(2 * SCH * RS * 4 + 2 * SCH * 512 * 4 <= RING_BYTES, "scan LDS");

__global__ void __launch_bounds__(NTHR) __attribute__((target("no-packed-fp32-ops"))) fwd_megakernel(Params p) {
  extern __shared__ __attribute__((aligned(16))) unsigned char lds_raw[];
  LAS unsigned char* ldsp = (LAS unsigned char*)lds_raw;
  char* lds = (char*)lds_raw;
  for (int u = threadIdx.x; u < (LDS_BYTES - LDSCTL_OFF) / 4; u += NTHR) ((LAS unsigned*)(ldsp + LDSCTL_OFF))[u] = 0u;
  __syncthreads();
  XcdBarrier bar = xcd_barrier_post((unsigned*)(p.ws + O_CTL) + CW_BAR, (volatile LAS unsigned*)(ldsp + MISC_OFF) + 8);
#define GBAR() xcd_barrier(bar)
  phase0(olaunder(p), lds);
#if PROBE == 3
  GBAR(); phase0(olaunder(p), lds);
#endif
  cg::this_grid().sync();
  GBAR();
#pragma unroll 1
  for (int L = 0; L < 2; ++L) {
    norm_phase<false>(olaunder(p), p.in[2] + L * DM, nullptr);
    GBAR();
    phase_u(olaunder(p), L, ldsp);
    GBAR();
    phase_prep2(olaunder(p), L, lds);
    GBAR();
#if PROBE == 2
    if (L == 0) { phase_prep2(olaunder(p), L, lds); GBAR(); }
#endif
#if PROBE == 21
    if (L == 0) { phase_prep<1>(olaunder(p), L, lds); GBAR(); }
#endif
#if PROBE == 22
    if (L == 0) { phase_prep<2>(olaunder(p), L, lds); GBAR(); }
#endif
#if PROBE == 23
    if (L == 0) { phase_prep<4>(olaunder(p), L, lds); GBAR(); }
#endif
    phase_mix(olaunder(p), L, lds, L);
    GBAR();
#if PROBE == 1
    if (L == 0) { phase_mix(olaunder(p), L, lds, 2); GBAR(); }
#endif
#if PROBE == 5
    if (L == 0) { phase_mix_attn_only(olaunder(p), L, lds, 2); GBAR(); }
#endif
    phase_scanpost(olaunder(p), L);
    GBAR();
    phase_proj(olaunder(p), L, ldsp);
    GBAR();
    phase_gate(olaunder(p), L, ldsp);
    GBAR();
    phase_bsum(olaunder(p));
    GBAR();
    phase_xadd(olaunder(p), (const bf16_t*)(p.ws + O_R + R_M), (const bf16_t*)(p.ws + O_WOUT) + (size_t)L * 1024 * 1024, DM, ldsp);
    GBAR();
    if (L == 0) {
      norm_phase<false>(olaunder(p), p.in[3] + L * DM, nullptr);
      GBAR();
      phase_ffn_up(olaunder(p), ldsp);
      GBAR();
      phase_xadd(olaunder(p), (const bf16_t*)(p.ws + O_R + R_T), (const bf16_t*)(p.ws + O_FD), FFD, ldsp);
      GBAR();
    } else {
      norm_phase<true>(olaunder(p), p.in[3] + L * DM, p.in[29]);
      GBAR();
      phase_moe_gather(olaunder(p));
      GBAR();
      phase_moe_up(olaunder(p), ldsp);
      GBAR();
      phase_moe_down(olaunder(p), ldsp);
      GBAR();
    }
    if (L == 0) norm_phase<false>(olaunder(p), p.in[4] + L * DM, nullptr);
    else norm_phase<false, true>(olaunder(p), p.in[4] + L * DM, nullptr);
    convert_p(olaunder(p), L);
    GBAR();
    phase_ple_proj(olaunder(p), L, ldsp);
    GBAR();
    phase_ple_gate(olaunder(p), L, ldsp);
    GBAR();
  }
  phase_final(olaunder(p));
}

extern "C" void kernel_launch(void* const* d_in, const int* in_sizes, int n_in, void* d_out, int out_size,
                              void* d_ws, size_t ws_size, hipStream_t stream) {
  static int grid_blocks = 0;
  if (grid_blocks == 0) {
    int dev = 0, cus = 0, per_cu = 0;
    (void)hipGetDevice(&dev);
    (void)hipDeviceGetAttribute(&cus, hipDeviceAttributeMultiprocessorCount, dev);
    if (hipFuncSetAttribute((const void*)fwd_megakernel, hipFuncAttributeMaxDynamicSharedMemorySize, LDS_BYTES) != hipSuccess) { fprintf(stderr, "hipFuncSetAttribute failed\n"); grid_blocks = -1; return; }
    (void)hipOccupancyMaxActiveBlocksPerMultiprocessor(&per_cu, (const void*)fwd_megakernel, NTHR, LDS_BYTES);
    if (per_cu < 1) { fprintf(stderr, "occupancy query says %d blocks per CU\n", per_cu); grid_blocks = -1; return; }
    grid_blocks = cus;
  }
  if (grid_blocks < 0) return;
  if (ws_size < WS_NEED) { fprintf(stderr, "workspace too small: %zu < %zu\n", ws_size, (size_t)WS_NEED); return; }
  (void)hipMemsetAsync((char*)d_ws + O_CTL, 0, CTL_BYTES, stream);
  Params p{};
  for (int i = 0; i < 36; ++i) p.in[i] = (const float*)d_in[i];
  p.x = (float*)d_out;
  p.ws = (char*)d_ws;
  void* args[] = {&p};
  hipError_t e = hipLaunchCooperativeKernel((void*)fwd_megakernel, dim3(grid_blocks), dim3(NTHR), args, LDS_BYTES, stream);
  if (e != hipSuccess) fprintf(stderr, "cooperative launch failed: %s (grid %d)\n", hipGetErrorString(e), grid_blocks);
}
```

```cpp
#include <hip/hip_runtime.h>
#include <hip/hip_cooperative_groups.h>
#include <cstdio>
#include <cstdint>
namespace cg = cooperative_groups;

typedef unsigned short bf16_t;
typedef short bf16x8 __attribute__((ext_vector_type(8)));
typedef short s16x4 __attribute__((ext_vector_type(4)));
typedef float f32x4 __attribute__((ext_vector_type(4)));
typedef float f32x2 __attribute__((ext_vector_type(2)));
typedef float f32x16 __attribute__((ext_vector_type(16)));
typedef unsigned u32x4 __attribute__((ext_vector_type(4)));
typedef unsigned u32x2 __attribute__((ext_vector_type(2)));
typedef __bf16 bf16x2_t __attribute__((ext_vector_type(2)));

#define DI __device__ __forceinline__

#ifndef PROBE
#define PROBE 0
#endif
constexpr int NTOK = 16384, DM = 1024, SEQ = 8192, NBH = 8;
constexpr int INC = 7692, UC = 3600, UN = 3840;
constexpr int OFF_B = 1024, OFF_C = 1792, OFF_D = 2564, OFF_G = 3596;
constexpr int FFD = 2816, FFE = 3584, NEXP = 8;
constexpr int NTHR = 512;
constexpr int MOE_ROWS = 34816;

constexpr size_t al256(size_t x) { return (x + 255) & ~(size_t)255; }
constexpr size_t O_CTL = 0, CTL_BYTES = 1u << 20;
constexpr int CW_BAR = 4096;
constexpr int CW_QCTR = 16384;
constexpr int CW_MOECNT = 16384 + 256;
constexpr size_t O_MGU = CTL_BYTES;
constexpr size_t O_MD = O_MGU + (size_t)NEXP * 2 * FFE * 1024 * 2;
constexpr size_t O_PG = O_MD + (size_t)NEXP * 1024 * FFE * 2;
constexpr size_t O_PP = O_PG + (size_t)2 * 1024 * 1024 * 2;
constexpr size_t O_PB = O_PP + (size_t)2 * 1024 * 256 * 2;
constexpr size_t O_LORA = O_PB + (size_t)NTOK * 256 * 2;
constexpr size_t SZ_LORA = (size_t)256 * 256 * 2;
constexpr size_t O_HB = O_LORA + 2 * SZ_LORA;
constexpr size_t O_SMALL = O_HB + (size_t)NTOK * DM * 2;
constexpr size_t SM_LIST = 0;
constexpr size_t SM_GW = SM_LIST + (size_t)NEXP * NTOK * 4;
constexpr size_t SM_RK = SM_GW + (size_t)NEXP * NTOK * 4;
constexpr size_t SM_LOGF = SM_RK + (size_t)NTOK * 4 * 4;
constexpr size_t SM_GBETA = SM_LOGF + (size_t)NBH * SEQ * 4;
constexpr size_t SM_GA = SM_GBETA + (size_t)NBH * SEQ * 4;
constexpr size_t SM_TEXP = SM_GA + (size_t)NBH * SEQ * 4;
constexpr size_t SM_ROWTOK = SM_TEXP + 1024;
constexpr size_t SM_ROWGW = SM_ROWTOK + (size_t)MOE_ROWS * 4;
constexpr size_t SM_TEXP4 = SM_ROWGW + (size_t)MOE_ROWS * 4;
constexpr size_t SM_TOKSLOT = SM_TEXP4 + 1024;
constexpr size_t SM_SLOTROW = SM_TOKSLOT + (size_t)NTOK * 2 * 4;
constexpr size_t SZ_SMALL = al256(SM_SLOTROW + (size_t)NEXP * NTOK * 4);
constexpr size_t O_ERA = O_SMALL + SZ_SMALL;
constexpr size_t SZ_WIN = al256((size_t)INC * DM * 2);
constexpr size_t O_WIN = O_ERA;
constexpr size_t O_WBO = O_WIN + 2 * SZ_WIN;
constexpr size_t O_WOUT = O_WBO + (size_t)2 * 4 * 1024 * 256 * 2;
constexpr size_t O_FGU = O_WOUT + (size_t)2 * 1024 * 1024 * 2;
constexpr size_t O_FD = O_FGU + (size_t)2 * FFD * 1024 * 2;
constexpr size_t O_R = O_FD + (size_t)1024 * FFD * 2;
constexpr size_t SZ_BH = (size_t)NBH * SEQ * 64 * 2;
constexpr size_t R_U = 0;
constexpr size_t R_Y = 0;
constexpr size_t R_PJ = (size_t)NTOK * DM * 2;
constexpr size_t R_M = R_PJ + (size_t)NTOK * 4096 * 2;
constexpr size_t SZ_U = (size_t)NTOK * UC * 2;
constexpr size_t R_OSCAN = (size_t)NTOK * DM * 2;
static_assert(R_OSCAN + (size_t)2 * NBH * SEQ * 64 * 4 <= SZ_U, "scan outputs inside dead u");
constexpr size_t R_RWA = R_U + SZ_U, R_RWB = R_RWA + SZ_BH, R_RWK = R_RWB + SZ_BH, R_RWR = R_RWK + SZ_BH, R_RWV = R_RWR + SZ_BH;
constexpr size_t R_RWW = R_RWV + SZ_BH;
constexpr size_t R_GQ = R_RWW + 2 * SZ_BH, R_GK = R_GQ + SZ_BH, R_GV = R_GK + SZ_BH;
constexpr size_t R_QD = R_GV + SZ_BH, R_KD = R_QD + SZ_BH, R_VD = R_KD + SZ_BH, R_QF = R_VD + SZ_BH, R_KF = R_QF + SZ_BH, R_VF = R_KF + SZ_BH;
constexpr size_t R_AUXG = R_VF + SZ_BH;
constexpr size_t R_AUXGATE = R_AUXG + (size_t)NTOK * 256 * 2;
constexpr size_t R_END_MIX = R_AUXGATE + (size_t)NTOK * 256 * 2;
static_assert(R_M + (size_t)NTOK * DM * 2 <= R_END_MIX, "M inside region R");
constexpr size_t R_T = 0;
constexpr size_t R_PJ2 = 0;
constexpr size_t O_T2 = O_ERA;
constexpr size_t O_XBUF = O_T2 + (size_t)MOE_ROWS * FFE * 2;
constexpr size_t ERA_B_END = O_XBUF + (size_t)MOE_ROWS * DM * 2;
constexpr size_t ERA_A_END = O_R + R_END_MIX;
constexpr size_t WS_NEED = ERA_A_END > ERA_B_END ? ERA_A_END : ERA_B_END;

struct Params {
  const float* in[36];
  float* x;
  char* ws;
};

DI float bf2f(bf16_t b) { return __uint_as_float(((unsigned)b) << 16); }
DI bf16_t f2bf(float x) { unsigned u = __float_as_uint(x); u += 0x7fffu + ((u >> 16) & 1u); return (bf16_t)(u >> 16); }
DI unsigned pk2(float lo, float hi) { f32x2 v = {lo, hi}; bf16x2_t b = __builtin_convertvector(v, bf16x2_t); return __builtin_bit_cast(unsigned, b); }
DI float sigmoidf_(float x) { return 1.0f / (1.0f + __expf(-x)); }
DI float wave_sum(float x) {
  x += __int_as_float(__builtin_amdgcn_update_dpp(0, __float_as_int(x), 0xB1, 0xF, 0xF, true));
  x += __int_as_float(__builtin_amdgcn_update_dpp(0, __float_as_int(x), 0x4E, 0xF, 0xF, true));
  x += __int_as_float(__builtin_amdgcn_update_dpp(0, __float_as_int(x), 0x141, 0xF, 0xF, true));
  x += __int_as_float(__builtin_amdgcn_update_dpp(0, __float_as_int(x), 0x140, 0xF, 0xF, true));
  { auto rr = __builtin_amdgcn_permlane16_swap(__float_as_uint(x), __float_as_uint(x), false, false); x = __uint_as_float(rr[0]) + __uint_as_float(rr[1]); }
  { auto rr = __builtin_amdgcn_permlane32_swap(__float_as_uint(x), __float_as_uint(x), false, false); x = __uint_as_float(rr[0]) + __uint_as_float(rr[1]); }
  return x;
}
DI int crow(int r, int hi) { return (r & 3) + 8 * (r >> 2) + 4 * hi; }
DI int otid() { int t = threadIdx.x; asm volatile("" : "+v"(t)); return t; }
DI int obid() { int t = blockIdx.x; asm volatile("" : "+s"(t)); return t; }
DI Params olaunder(const Params& p) { Params q = p; size_t o0 = 0, o1 = 0; asm volatile("" : "+s"(o0), "+s"(o1)); q.ws = p.ws + o0; q.x = p.x + o1; return q; }


#define GAS __attribute__((address_space(1)))
#define LAS __attribute__((address_space(3)))
typedef GAS unsigned gu32;
#define RLX_AGENT __ATOMIC_RELAXED, __HIP_MEMORY_SCOPE_AGENT
namespace pg8 {
#define PG8_LAS __attribute__((address_space(3)))
typedef unsigned short bf16_t;
typedef short bf16x8 __attribute__((ext_vector_type(8)));
typedef float f32x4 __attribute__((ext_vector_type(4)));
typedef unsigned u32x4 __attribute__((ext_vector_type(4)));
constexpr int BM = 256, BK = 64, HALF = 128, HTB = HALF * BK * 2  , STAGE_BYTES = 8 * HTB, NXCD = 8, WGM = 8;

__host__ __device__ __forceinline__ int lds_byte(int r, int c) { const int st = (r >> 4) * 2 + (c >> 5), rr = r & 15, cc = c & 31, ob = rr * 64 + cc * 2; return st * 1024 + (ob ^ (((ob >> 9) & 1) << 5)); }
__host__ __device__ __forceinline__ void stage_rc(int b, int& R, int& C) { const int st = b / 1024, sb = b % 1024, swz = sb ^ (((sb >> 9) & 1) << 5); R = (st >> 1) * 16 + swz / 64; C = (st & 1) * 32 + (swz % 64) / 2; }
__host__ __device__ __forceinline__ int perm32(int rho) { const int n = rho >> 4, i = rho & 15; return 8 * (i >> 2) + 4 * n + (i & 3); }

struct Unit { int pm, pn; };
struct Gemm { const bf16_t* A; const bf16_t* Bt; int M, N, K; const int* texp; size_t bstride;
  __device__ __forceinline__ size_t boff(int pm) const { return texp ? (size_t)texp[pm] * bstride : (size_t)0; } };

struct StaticOrder {
    int nM, nN, nwg, G, c;
    __host__ __device__ void init(int M, int N, int G_, int c_) { nM = M / BM; nN = N / BM; nwg = nM * nN; G = G_; c = c_; }
    __host__ __device__ bool next(int i, Unit& u) const {
        const long L = (long)i * G + c; if (L >= nwg) return false;
        int wgid = (int)L; { const int q = nwg / NXCD, r = nwg % NXCD, xcd = wgid % NXCD, off = wgid / NXCD; wgid = (xcd < r ? xcd * (q + 1) : r * (q + 1) + (xcd - r) * q) + off; }
        const int nig = WGM * nN, gid = wgid / nig, fm = gid * WGM, gsz = (nM - fm) < WGM ? (nM - fm) : WGM;
        u.pm = fm + ((wgid % nig) % gsz); u.pn = (wgid % nig) / gsz; return true;
    }
    __device__ __forceinline__ void a_ready(const Unit&) const {}
    __device__ __forceinline__ void done(const Unit&) const {}
};

template <class F> struct EpiFn {
    static constexpr bool PERM = false, AFTER_DRAIN = false;
    F f;
    __device__ __forceinline__ void operator()(const f32x4 (&acc)[2][2][4][2], const Unit& u, int wr, int wc, int fr, int fq) const {
#pragma unroll
        for (int ai = 0; ai < 2; ++ai)
#pragma unroll
            for (int m = 0; m < 4; ++m)
#pragma unroll
                for (int bj = 0; bj < 2; ++bj)
#pragma unroll
                    for (int n = 0; n < 2; ++n)
                        f(u.pm * BM + ai * HALF + wr * 64 + m * 16 + fr, u.pn * BM + bj * HALF + wc * 32 + n * 16 + 4 * fq, acc[ai][bj][m][n]);
    }
};
template <class Epi, class Sched, bool ALIGN_EPI = false, bool SP2 = false>
__device__ __forceinline__ void gemm_phase(PG8_LAS unsigned char* lds, const Gemm g, const Sched& S, const Epi& E) {
    const int tid = otid(), wid = __builtin_amdgcn_readfirstlane(tid >> 6), lane = tid & 63, wr = wid >> 2, wc = wid & 3, fr = lane & 15, fq = lane >> 4;
    const int K = g.K, nt = K / BK;
    unsigned voffA[2], voffB[2];
#pragma unroll
    for (int i = 0; i < 2; ++i) { int R, C; stage_rc(tid * 16 + i * 8192, R, C); const int Rb = Epi::PERM ? ((R & ~31) + perm32(R & 31)) : R;
        voffA[i] = (unsigned)(R * K + C) * 2u; voffB[i] = (unsigned)(Rb * K + C) * 2u; }
    const size_t kstep = (size_t)(BK * 2);
    const size_t hstep = (size_t)HALF * K * 2;
    const size_t tstep = 2 * hstep;
    const unsigned ldsw = (unsigned)wid * 1024u;
    const int aoff = lds_byte(wr * 64 + fr, fq * 8), boff = lds_byte(wc * 32 + fr, fq * 8);
#define PG8_SA(b, h) (((b) * 2 + (h)) * HTB)
#define PG8_SB(b, h) ((4 + (b) * 2 + (h)) * HTB)
#define PG8_STAGE(bufoff, gbase, voff) do { _Pragma("unroll") for (int _i = 0; _i < 2; ++_i) \
        __builtin_amdgcn_global_load_lds((const unsigned*)((const char*)(gbase) + (voff)[_i]), (PG8_LAS unsigned*)(lds + (bufoff) + ldsw + _i * 8192), 16, 0, 0); } while (0)
#define PG8_LDA(dst, b, h) do { _Pragma("unroll") for (int m = 0; m < 4; ++m) _Pragma("unroll") for (int k = 0; k < 2; ++k) dst[m][k] = *(const PG8_LAS bf16x8*)(lds + PG8_SA(b, h) + aoff + m * 2048 + k * 1024); } while (0)
#define PG8_LDB(dst, b, h) do { _Pragma("unroll") for (int n = 0; n < 2; ++n) _Pragma("unroll") for (int k = 0; k < 2; ++k) dst[n][k] = *(const PG8_LAS bf16x8*)(lds + PG8_SB(b, h) + boff + n * 2048 + k * 1024); } while (0)
#define PG8_MMA(ai, bj, At, Bt) do { __builtin_amdgcn_s_setprio(1); _Pragma("unroll") for (int m = 0; m < 4; ++m) _Pragma("unroll") for (int n = 0; n < 2; ++n) _Pragma("unroll") for (int k = 0; k < 2; ++k) \
        acc[ai][bj][m][n] = __builtin_amdgcn_mfma_f32_16x16x32_bf16(Bt[n][k], At[m][k], acc[ai][bj][m][n], 0, 0, 0); __builtin_amdgcn_s_setprio(0); } while (0)
#define PG8_WAIT_V(n) asm volatile("s_waitcnt vmcnt(" #n ")" ::: "memory")
#define PG8_WAIT_L(n) asm volatile("s_waitcnt lgkmcnt(" #n ")" ::: "memory")
#define PG8_BAR __builtin_amdgcn_s_barrier()
#define PG8_SCHED __builtin_amdgcn_sched_barrier(0)
    Unit cur, nxt; int ui = 0;
    if (!S.next(0, cur)) return;
    f32x4 acc[2][2][4][2];
#pragma unroll
    for (int a = 0; a < 2; ++a)
#pragma unroll
        for (int b = 0; b < 2; ++b)
#pragma unroll
            for (int m = 0; m < 4; ++m)
#pragma unroll
                for (int n = 0; n < 2; ++n) acc[a][b][m][n] = (f32x4){0.f, 0.f, 0.f, 0.f};
    bf16x8 At[4][2], B0[2][2], B1[2][2];
    const char* cA = (const char*)g.A + (size_t)cur.pm * tstep; const char* cB = (const char*)g.Bt + g.boff(cur.pm) + (size_t)cur.pn * tstep;
    S.a_ready(cur);
    if constexpr (SP2) {
        PG8_STAGE(PG8_SB(0, 0), cB, voffB); PG8_STAGE(PG8_SB(0, 1), cB + hstep, voffB); PG8_STAGE(PG8_SA(0, 0), cA, voffA); PG8_STAGE(PG8_SA(0, 1), cA + hstep, voffA);
        if (wr == 1) PG8_BAR;
        PG8_WAIT_V(2); PG8_BAR;
        PG8_STAGE(PG8_SB(1, 0), cB + kstep, voffB); PG8_STAGE(PG8_SA(1, 0), cA + kstep, voffA); PG8_STAGE(PG8_SB(1, 1), cB + hstep + kstep, voffB);
        PG8_WAIT_V(6); PG8_BAR;
    } else {
        PG8_STAGE(PG8_SB(0, 0), cB, voffB); PG8_STAGE(PG8_SA(0, 0), cA, voffA); PG8_STAGE(PG8_SB(0, 1), cB + hstep, voffB); PG8_STAGE(PG8_SA(0, 1), cA + hstep, voffA);
        if (wr == 1) PG8_BAR;
        PG8_WAIT_V(4); PG8_BAR;
        PG8_STAGE(PG8_SB(1, 0), cB + kstep, voffB); PG8_STAGE(PG8_SA(1, 0), cA + kstep, voffA); PG8_STAGE(PG8_SB(1, 1), cB + hstep + kstep, voffB);
        PG8_WAIT_V(6); PG8_BAR;
    }
    for (;;) {
        const bool has_next = S.next(ui + 1, nxt);
        const char* nA = has_next ? (const char*)g.A + (size_t)nxt.pm * tstep : cA; const char* nB = has_next ? (const char*)g.Bt + g.boff(nxt.pm) + (size_t)nxt.pn * tstep : cB;
        for (int t = 0; t < nt; t += 2) {
            const bool last = (t == nt - 2);
            const char* a1 = cA + (size_t)(t + 1) * kstep;
            const char* a2 = last ? nA : cA + (size_t)(t + 2) * kstep; const char* b2 = last ? nB : cB + (size_t)(t + 2) * kstep;
            const char* a3 = a2 + kstep; const char* b3 = b2 + kstep;
            if (last && has_next) S.a_ready(nxt);
            if constexpr (SP2) {
            PG8_LDB(B0, 0, 0); PG8_LDB(B1, 0, 1); PG8_SCHED; PG8_LDA(At, 0, 0); PG8_STAGE(PG8_SA(1, 1), a1 + hstep, voffA);
            PG8_WAIT_V(8); PG8_WAIT_L(0); PG8_BAR; PG8_MMA(0, 0, At, B0); PG8_MMA(0, 1, At, B1); PG8_BAR; PG8_SCHED;
            PG8_LDA(At, 0, 1); PG8_STAGE(PG8_SB(0, 0), b2, voffB); PG8_STAGE(PG8_SB(0, 1), b2 + hstep, voffB); PG8_STAGE(PG8_SA(0, 0), a2, voffA);
            PG8_WAIT_V(8); PG8_WAIT_L(0); PG8_BAR; PG8_MMA(1, 0, At, B0); PG8_MMA(1, 1, At, B1); PG8_BAR; PG8_SCHED;
            PG8_LDB(B0, 1, 0); PG8_LDB(B1, 1, 1); PG8_SCHED; PG8_LDA(At, 1, 0); PG8_STAGE(PG8_SA(0, 1), a2 + hstep, voffA);
            PG8_WAIT_V(8); PG8_WAIT_L(0); PG8_BAR; PG8_MMA(0, 0, At, B0); PG8_MMA(0, 1, At, B1); PG8_BAR; PG8_SCHED;
            PG8_LDA(At, 1, 1); PG8_STAGE(PG8_SB(1, 0), b3, voffB); PG8_STAGE(PG8_SB(1, 1), b3 + hstep, voffB); PG8_STAGE(PG8_SA(1, 0), a3, voffA);
            PG8_WAIT_V(8); PG8_WAIT_L(0); PG8_BAR; PG8_MMA(1, 0, At, B0); PG8_MMA(1, 1, At, B1); PG8_BAR; PG8_SCHED;
            } else {
            PG8_LDB(B0, 0, 0); PG8_SCHED; PG8_LDA(At, 0, 0); PG8_STAGE(PG8_SA(1, 1), a1 + hstep, voffA);
            PG8_WAIT_L(8); PG8_BAR; PG8_WAIT_L(0); PG8_MMA(0, 0, At, B0); PG8_BAR; PG8_SCHED;
            PG8_LDB(B1, 0, 1); PG8_STAGE(PG8_SB(0, 0), b2, voffB);
            PG8_BAR; PG8_WAIT_L(0); PG8_MMA(0, 1, At, B1); PG8_BAR;
            PG8_LDA(At, 0, 1); PG8_STAGE(PG8_SA(0, 0), a2, voffA);
            PG8_BAR; PG8_WAIT_L(0); PG8_MMA(1, 0, At, B0); PG8_BAR; PG8_SCHED;
            PG8_STAGE(PG8_SB(0, 1), b2 + hstep, voffB);
            PG8_WAIT_V(6); PG8_BAR; PG8_MMA(1, 1, At, B1); PG8_BAR;
            PG8_LDB(B0, 1, 0); PG8_SCHED; PG8_LDA(At, 1, 0); PG8_STAGE(PG8_SA(0, 1), a2 + hstep, voffA);
            PG8_WAIT_L(8); PG8_BAR; PG8_WAIT_L(0); PG8_MMA(0, 0, At, B0); PG8_BAR; PG8_SCHED;
            PG8_LDB(B1, 1, 1); PG8_STAGE(PG8_SB(1, 0), b3, voffB);
            PG8_BAR; PG8_WAIT_L(0); PG8_MMA(0, 1, At, B1); PG8_BAR;
            PG8_LDA(At, 1, 1); PG8_STAGE(PG8_SA(1, 0), a3, voffA);
            PG8_BAR; PG8_WAIT_L(0); PG8_MMA(1, 0, At, B0); PG8_BAR; PG8_SCHED;
            PG8_STAGE(PG8_SB(1, 1), b3 + hstep, voffB);
            PG8_WAIT_V(6); PG8_BAR; PG8_MMA(1, 1, At, B1); PG8_BAR;
            }
        }
        if constexpr (ALIGN_EPI) { if (wr == 0) PG8_BAR; }
        if constexpr (!Epi::AFTER_DRAIN) { E(acc, cur, wr, wc, fr, fq); S.done(cur); }
        if (!has_next) break;
#pragma unroll
        for (int a = 0; a < 2; ++a)
#pragma unroll
            for (int b = 0; b < 2; ++b)
#pragma unroll
                for (int m = 0; m < 4; ++m)
#pragma unroll
                    for (int n = 0; n < 2; ++n) acc[a][b][m][n] = (f32x4){0.f, 0.f, 0.f, 0.f};
        cur = nxt; cA = nA; cB = nB; ++ui;
        if constexpr (ALIGN_EPI) { if (wr == 1) PG8_BAR; }
    }
    PG8_WAIT_V(0);
    if constexpr (!ALIGN_EPI) { if (wr == 0) PG8_BAR; }
    PG8_BAR;
    if constexpr (Epi::AFTER_DRAIN) { E.fused(acc, cur, wr, wc, fr, fq, lds, wid, lane); S.done(cur); }
#undef PG8_SA
#undef PG8_SB
#undef PG8_STAGE
#undef PG8_LDA
#undef PG8_LDB
#undef PG8_MMA
#undef PG8_WAIT_V
#undef PG8_WAIT_L
#undef PG8_BAR
#undef PG8_SCHED
}
}

#define XB_TMO      128
#define XB_XCNT(j)  (256  + 64 * (j))
#define XB_XSUB(j)  (1280 + 64 * (j))
#define XB_XGEN(j)  (2304 + 64 * (j))
#define XB_TOP      3328
#define XB_TOPGEN   3392
#define XCD_BAR_WORDS 3456
#define XB_SPIN_CAP (1u << 18)

__device__ __forceinline__ unsigned xb_ld(unsigned* p)              { return __hip_atomic_load(p, __ATOMIC_RELAXED, __HIP_MEMORY_SCOPE_AGENT); }
__device__ __forceinline__ unsigned xb_add(unsigned* p, unsigned v) { return __hip_atomic_fetch_add(p, v, __ATOMIC_RELAXED, __HIP_MEMORY_SCOPE_AGENT); }
__device__ __forceinline__ unsigned xb_xcc_id() { return (unsigned)__builtin_amdgcn_s_getreg((3 << 11) | 20) & 0xFu; }
#define XB_SPIN(cond, bar) do { unsigned _sp = 0; while (cond) { __builtin_amdgcn_s_sleep(1); \
    if ((++_sp & 255u) == 0u) { if (xb_ld(&(bar)[XB_TMO])) break; if (_sp > XB_SPIN_CAP) { atomicAdd(&(bar)[XB_TMO], 1u); break; } } } } while (0)

struct XcdBarrier {
    unsigned* bar; unsigned x;
    volatile LAS unsigned* st;
};

__device__ __forceinline__ XcdBarrier xcd_barrier_post(unsigned* bar, volatile LAS unsigned* st) {
    XcdBarrier b; b.bar = bar; b.x = xb_xcc_id(); b.st = st;
    if (threadIdx.x == 0) (void)xb_add(&bar[XB_XCNT(b.x)], 1u);
    return b;
}
__device__ __forceinline__ void xcd_barrier_complete(unsigned* bar, unsigned x, unsigned& nloc, unsigned& nx) {
    const unsigned G = gridDim.x * gridDim.y * gridDim.z;
    unsigned sum, cnt, mine, sp = 0u;
    for (;;) {
        sum = 0u; cnt = 0u; mine = 0u;
#pragma unroll
        for (unsigned j = 0; j < 16; ++j) { const unsigned c = xb_ld(&bar[XB_XCNT(j)]); sum += c; cnt += (c > 0u) ? 1u : 0u; mine = (j == x) ? c : mine; }
        if (sum == G) break;
        __builtin_amdgcn_s_sleep(1);
        if ((++sp & 255u) == 0u) { if (xb_ld(&bar[XB_TMO])) break; if (sp > XB_SPIN_CAP) { atomicAdd(&bar[XB_TMO], 1u); break; } }
    }
    nloc = mine > 0u ? mine : 1u; nx = cnt > 0u ? cnt : 1u;
}

__device__ __forceinline__ void xcd_barrier(const XcdBarrier& b) {
    asm volatile("s_waitcnt vmcnt(0)" ::: "memory");
    __syncthreads();
    if (threadIdx.x == 0) {
        unsigned* bar = b.bar; unsigned bx_ = b.x;
        asm volatile("" : "+s"(bar), "+s"(bx_));
        __builtin_amdgcn_s_waitcnt(0);
        unsigned nloc = b.st[0], nx = b.st[1];
        if (nloc == 0u) { xcd_barrier_complete(bar, bx_, nloc, nx); b.st[0] = nloc; b.st[1] = nx; }
        const unsigned old = xb_add(&bar[XB_XSUB(bx_)], 1u);
        const unsigned gen = old / nloc;
        if (old + 1u == (gen + 1u) * nloc) {
            __builtin_amdgcn_fence(__ATOMIC_RELEASE, "agent");
            asm volatile("s_waitcnt vmcnt(0)" ::: "memory");
            const unsigned og = xb_add(&bar[XB_TOP], 1u);
            const unsigned tg = og / nx;
            if (og + 1u == (tg + 1u) * nx) xb_add(&bar[XB_TOPGEN], 1u);
            else XB_SPIN(xb_ld(&bar[XB_TOPGEN]) == tg, bar);
            __builtin_amdgcn_fence(__ATOMIC_ACQUIRE, "agent");
            xb_add(&bar[XB_XGEN(bx_)], 1u);
            asm volatile("s_waitcnt vmcnt(0)" ::: "memory");
        } else {
            XB_SPIN(xb_ld(&bar[XB_XGEN(bx_)]) == gen, bar);
            __builtin_amdgcn_fence(__ATOMIC_ACQUIRE, "agent");
            asm volatile("s_waitcnt vmcnt(0)" ::: "memory");
        }
    }
    __syncthreads();
}

DI void transpose_tile(const float* __restrict__ src, int K, int N, bf16_t* __restrict__ dst, int rmul, int radd, int t, float* tl, int tid) {
  const int tn = (N + 63) / 64;
  const int k0 = (t / tn) * 64, n0 = (t % tn) * 64;
  __syncthreads();
  {
    const int kr = tid >> 3, nc = (tid & 7) * 4;
#pragma unroll
    for (int i = 0; i < 2; ++i) {
      const int n = n0 + nc + 32 * i;
      f32x4 v = {0.f, 0.f, 0.f, 0.f};
      if (n < N) v = *(const f32x4*)(src + (size_t)(k0 + kr) * N + n);
      float* d = tl + kr * 65 + nc + 32 * i;
      d[0] = v[0]; d[1] = v[1]; d[2] = v[2]; d[3] = v[3];
    }
  }
  __syncthreads();
  {
    const int nr = tid >> 3, kc = (tid & 7) * 8, n = n0 + nr;
    if (n < N) {
      u32x4 w;
      w[0] = pk2(tl[(kc + 0) * 65 + nr], tl[(kc + 1) * 65 + nr]);
      w[1] = pk2(tl[(kc + 2) * 65 + nr], tl[(kc + 3) * 65 + nr]);
      w[2] = pk2(tl[(kc + 4) * 65 + nr], tl[(kc + 5) * 65 + nr]);
      w[3] = pk2(tl[(kc + 6) * 65 + nr], tl[(kc + 7) * 65 + nr]);
      *(u32x4*)(dst + ((size_t)n * rmul + radd) * K + k0 + kc) = w;
    }
  }
}
DI void transpose_job(const float* __restrict__ src, int K, int N, bf16_t* __restrict__ dst, int rmul, int radd, char* lds) {
  float* tl = (float*)lds;
  const int nt = (K / 64) * ((N + 63) / 64), tid = otid();
  for (int t = obid(); t < nt; t += gridDim.x) transpose_tile(src, K, N, dst, rmul, radd, t, tl, tid);
}
constexpr int MOE_TILES_PER_JOB = 896, MOE_CONV_TILES = 24 * 896;
DI void moe_convert_tile(const Params& p, int g, float* tl, int tid) {
  const int job = g / MOE_TILES_PER_JOB, t = g % MOE_TILES_PER_JOB, e = job / 3, w = job % 3;
  if (w == 0) transpose_tile(p.in[30] + (size_t)e * 1024 * FFE, 1024, FFE, (bf16_t*)(p.ws + O_MGU) + (size_t)e * 2 * FFE * 1024, 2, 0, t, tl, tid);
  else if (w == 1) transpose_tile(p.in[31] + (size_t)e * 1024 * FFE, 1024, FFE, (bf16_t*)(p.ws + O_MGU) + (size_t)e * 2 * FFE * 1024, 2, 1, t, tl, tid);
  else transpose_tile(p.in[32] + (size_t)e * FFE * 1024, FFE, 1024, (bf16_t*)(p.ws + O_MD) + (size_t)e * 1024 * FFE, 1, 0, t, tl, tid);
}
DI void phase0(const Params& p, char* lds) {
  char* ws = p.ws;
  const int gtid = obid() * NTHR + otid(), gsz = gridDim.x * NTHR;
  if (gtid < 256) ((int*)(ws + O_SMALL + SM_TEXP4))[gtid] = gtid >> 6;
  {
    const f32x4* s = (const f32x4*)p.in[0]; f32x4* d = (f32x4*)p.x;
    for (int i = gtid; i < NTOK * DM / 4; i += gsz) d[i] = s[i];
  }
  for (int L = 0; L < 2; ++L) {
    transpose_job(p.in[5] + (size_t)L * DM * INC, 1024, INC, (bf16_t*)(ws + O_WIN + L * SZ_WIN), 1, 0, lds);
    for (int b = 0; b < 4; ++b)
      transpose_job(p.in[6] + (size_t)(L * 4 + b) * 256 * 1024, 256, 1024, (bf16_t*)(ws + O_WBO) + (size_t)(L * 4 + b) * 1024 * 256, 1, 0, lds);
    transpose_job(p.in[7] + (size_t)L * 1024 * 1024, 1024, 1024, (bf16_t*)(ws + O_WOUT) + (size_t)L * 1024 * 1024, 1, 0, lds);
    transpose_job(p.in[34] + (size_t)L * 1024 * 1024, 1024, 1024, (bf16_t*)(ws + O_PG) + (size_t)L * 1024 * 1024, 1, 0, lds);
    transpose_job(p.in[33] + (size_t)L * 256 * 1024, 256, 1024, (bf16_t*)(ws + O_PP) + (size_t)L * 1024 * 256, 1, 0, lds);
    transpose_job(p.in[10] + (size_t)L * 64 * 256, 64, 256, (bf16_t*)(ws + O_LORA + L * SZ_LORA), 1, 0, lds);
    transpose_job(p.in[12] + (size_t)L * 64 * 256, 64, 256, (bf16_t*)(ws + O_LORA + L * SZ_LORA) + 256 * 64, 1, 0, lds);
    transpose_job(p.in[13] + (size_t)L * 128 * 256, 128, 256, (bf16_t*)(ws + O_LORA + L * SZ_LORA) + 2 * 256 * 64, 1, 0, lds);
  }
  transpose_job(p.in[26], 1024, FFD, (bf16_t*)(ws + O_FGU), 2, 0, lds);
  transpose_job(p.in[27], 1024, FFD, (bf16_t*)(ws + O_FGU), 2, 1, lds);
  transpose_job(p.in[28], FFD, 1024, (bf16_t*)(ws + O_FD), 1, 0, lds);
}
DI void convert_p(const Params& p, int L) {
  const int gtid = obid() * NTHR + otid(), gsz = gridDim.x * NTHR;
  const f32x4* s = (const f32x4*)(p.in[1] + (size_t)L * NTOK * 256); u32x2* d = (u32x2*)(p.ws + O_PB);
  for (int i = gtid; i < NTOK * 256 / 4; i += gsz) { f32x4 v = s[i]; u32x2 w; w[0] = pk2(v[0], v[1]); w[1] = pk2(v[2], v[3]); d[i] = w; }
}
template <bool ROUTER, bool ADDMOE = false>
DI void norm_phase(const Params& p, const float* __restrict__ g, const float* __restrict__ router) {
  const int lane = otid() & 63, wid = otid() >> 6;
  bf16_t* hb = (bf16_t*)(p.ws + O_HB);
  int* cnt = (int*)(p.ws + O_CTL) + CW_MOECNT;
  int* list = (int*)(p.ws + O_SMALL + SM_LIST);
  float* gw = (float*)(p.ws + O_SMALL + SM_GW);
  int* tokslot = (int*)(p.ws + O_SMALL + SM_TOKSLOT);
  const int* slotrow = (const int*)(p.ws + O_SMALL + SM_SLOTROW);
  const bf16_t* Y2 = (const bf16_t*)(p.ws + O_XBUF);
  for (int row = obid() * 8 + wid; row < NTOK; row += gridDim.x * 8) {
    float* xr = p.x + (size_t)row * DM;
    f32x4 v[4]; float ss = 0.f;
#pragma unroll
    for (int j = 0; j < 4; ++j) v[j] = *(const f32x4*)(xr + j * 256 + lane * 4);
    if (ADDMOE) {
      const int r1 = slotrow[tokslot[row * 2]], r2 = slotrow[tokslot[row * 2 + 1]];
#pragma unroll
      for (int j = 0; j < 4; ++j) {
        const u32x2 a = *(const u32x2*)(Y2 + (size_t)r1 * DM + j * 256 + lane * 4), b = *(const u32x2*)(Y2 + (size_t)r2 * DM + j * 256 + lane * 4);
        v[j][0] += __uint_as_float(a[0] << 16) + __uint_as_float(b[0] << 16); v[j][1] += __uint_as_float(a[0] & 0xffff0000u) + __uint_as_float(b[0] & 0xffff0000u);
        v[j][2] += __uint_as_float(a[1] << 16) + __uint_as_float(b[1] << 16); v[j][3] += __uint_as_float(a[1] & 0xffff0000u) + __uint_as_float(b[1] & 0xffff0000u);
        *(f32x4*)(xr + j * 256 + lane * 4) = v[j];
      }
    }
#pragma unroll
    for (int j = 0; j < 4; ++j) ss += v[j][0] * v[j][0] + v[j][1] * v[j][1] + v[j][2] * v[j][2] + v[j][3] * v[j][3];
    ss = wave_sum(ss);
    const float rstd = rsqrtf(ss * (1.0f / 1024.0f) + 1e-6f);
    float lg[8];
    if (ROUTER) {
#pragma unroll
      for (int e = 0; e < 8; ++e) lg[e] = 0.f;
    }
#pragma unroll
    for (int j = 0; j < 4; ++j) {
      const f32x4 gg = *(const f32x4*)(g + j * 256 + lane * 4);
      f32x4 h = v[j] * rstd * gg;
      u32x2 w; w[0] = pk2(h[0], h[1]); w[1] = pk2(h[2], h[3]);
      *(u32x2*)(hb + (size_t)row * DM + j * 256 + lane * 4) = w;
      if (ROUTER) {
#pragma unroll
        for (int c = 0; c < 4; ++c) {
          const float* rr = router + (size_t)(j * 256 + lane * 4 + c) * 8;
          const f32x4 r0 = *(const f32x4*)rr, r1 = *(const f32x4*)(rr + 4);
          lg[0] += h[c] * r0[0]; lg[1] += h[c] * r0[1]; lg[2] += h[c] * r0[2]; lg[3] += h[c] * r0[3];
          lg[4] += h[c] * r1[0]; lg[5] += h[c] * r1[1]; lg[6] += h[c] * r1[2]; lg[7] += h[c] * r1[3];
        }
      }
    }
    if (ROUTER) {
#pragma unroll
      for (int e = 0; e < 8; ++e) lg[e] = wave_sum(lg[e]);
      if (lane == 0) {
        int e1 = 0; float l1 = lg[0];
#pragma unroll
        for (int e = 1; e < 8; ++e) if (lg[e] > l1) { l1 = lg[e]; e1 = e; }
        int e2 = -1; float l2 = -INFINITY;
#pragma unroll
        for (int e = 0; e < 8; ++e) if (e != e1 && lg[e] > l2) { l2 = lg[e]; e2 = e; }
        const float w1 = 1.0f / (1.0f + __expf(l2 - l1)), w2 = 1.0f - w1;
        int s1 = atomicAdd(cnt + e1, 1); list[e1 * NTOK + s1] = row; gw[e1 * NTOK + s1] = w1;
        int s2 = atomicAdd(cnt + e2, 1); list[e2 * NTOK + s2] = row; gw[e2 * NTOK + s2] = w2;
        tokslot[row * 2] = e1 * NTOK + s1; tokslot[row * 2 + 1] = e2 * NTOK + s2;
      }
    }
  }
}

DI float softplusf_(float z) { return z > 20.f ? z : __logf(1.0f + __expf(z)); }
DI float logsigmoidf_(float z) { return z >= 0.f ? -__logf(1.0f + __expf(-z)) : z - __logf(1.0f + __expf(z)); }

template <int PARTS = 7>
DI void phase_prep(const Params& p, int L, char* lds) {
  float* xw_s = (float*)lds; float* xa_s = xw_s + 8 * 64; float* xg_s = xa_s + 8 * 64;
  char* R = p.ws + O_R;
  const bf16_t* u = (const bf16_t*)(R + R_U);
  bf16_t* rwA = (bf16_t*)(R + R_RWA); bf16_t* rwB = (bf16_t*)(R + R_RWB); bf16_t* rwK = (bf16_t*)(R + R_RWK);
  bf16_t* rwR = (bf16_t*)(R + R_RWR); bf16_t* rwV = (bf16_t*)(R + R_RWV); float* rwW = (float*)(R + R_RWW);
  bf16_t* gq = (bf16_t*)(R + R_GQ); bf16_t* gk = (bf16_t*)(R + R_GK); bf16_t* gv = (bf16_t*)(R + R_GV);
  bf16_t* Qd = (bf16_t*)(R + R_QD); bf16_t* Kd = (bf16_t*)(R + R_KD); bf16_t* Vd = (bf16_t*)(R + R_VD);
  bf16_t* Qf = (bf16_t*)(R + R_QF); bf16_t* Kf = (bf16_t*)(R + R_KF); bf16_t* Vf = (bf16_t*)(R + R_VF);
  bf16_t* auxg = (bf16_t*)(R + R_AUXG); bf16_t* auxgate = (bf16_t*)(R + R_AUXGATE);
  float* rk = (float*)(p.ws + O_SMALL + SM_RK); float* logf_ = (float*)(p.ws + O_SMALL + SM_LOGF);
  float* gbeta = (float*)(p.ws + O_SMALL + SM_GBETA); float* ga = (float*)(p.ws + O_SMALL + SM_GA);
  const float* mu = p.in[8] + L * 1024; const float* w0 = p.in[9] + L * 256; const float* w2 = p.in[10] + L * 64 * 256;
  const float* a0 = p.in[11] + L * 256; const float* a2 = p.in[12] + L * 64 * 256; const float* g2 = p.in[13] + L * 128 * 256;
  const float* kkp = p.in[14] + L * 256; const float* kap = p.in[15] + L * 256; const float* rkp = p.in[16] + L * 256;
  const float* fbias = p.in[21] + L * 4; const float* cw = p.in[22] + L * 768 * 4;
  const float* alog = p.in[23] + L * 4; const float* dtb = p.in[24] + L * 4;
  const int tid = otid(), j = tid & 255, half = tid >> 8, lane = tid & 63, h = j >> 6, dh = j & 63;
  const float QS_D = 0.25503486164919736f, QS_F = 0.18033688011112042f;
  for (int tile = obid(); tile < NTOK / 8; tile += gridDim.x) {
    const int T0 = tile * 8, b = T0 / SEQ, t0 = T0 % SEQ, bh = b * 4 + h;
    if (PARTS & 1) {
    float r[4], k[4], v[4];
    __syncthreads();
#pragma unroll
    for (int i = 0; i < 4; ++i) {
      const int tl = half * 4 + i, tok = T0 + tl, t = t0 + tl;
      const bf16_t* ur = u + (size_t)tok * UC;
#pragma unroll
      for (int seg = 0; seg < 4; ++seg) {
        const int c = seg * 256 + j;
        const float ua = bf2f(ur[c]);
        const float up = t > 0 ? bf2f(ur[c - UC]) : 0.f;
        const float xm = ua + (up - ua) * mu[c];
        if (seg == 0) r[i] = xm; else if (seg == 1) k[i] = xm; else if (seg == 2) v[i] = xm;
        else {
          if (j < 64) xw_s[tl * 64 + j] = 1.0f - 2.0f / (1.0f + __expf(2.0f * xm));
          else if (j < 128) xa_s[tl * 64 + (j - 64)] = xm;
          else xg_s[tl * 128 + (j - 128)] = sigmoidf_(xm);
        }
      }
    }
    __syncthreads();
    float lw[4], alr[4], gg[4];
#pragma unroll
    for (int i = 0; i < 4; ++i) { lw[i] = w0[j]; alr[i] = a0[j]; gg[i] = 0.f; }
    for (int q = 0; q < 64; ++q) {
      const float wv = w2[q * 256 + j], av = a2[q * 256 + j];
#pragma unroll
      for (int i = 0; i < 4; ++i) { lw[i] += xw_s[(half * 4 + i) * 64 + q] * wv; alr[i] += xa_s[(half * 4 + i) * 64 + q] * av; }
    }
    for (int q = 0; q < 128; ++q) {
      const float gvv = g2[q * 256 + j];
#pragma unroll
      for (int i = 0; i < 4; ++i) gg[i] += xg_s[(half * 4 + i) * 128 + q] * gvv;
    }
#pragma unroll
    for (int i = 0; i < 4; ++i) {
      const int tl = half * 4 + i, tok = T0 + tl, t = t0 + tl;
      const float dec = __expf(-0.6065306597126334f * sigmoidf_(lw[i]));
      const float a = sigmoidf_(alr[i]);
      const float kkr = k[i] * kkp[j];
      const float ss = wave_sum(kkr * kkr);
      const float kk = kkr * rsqrtf(ss + 1e-6f);
      const float kp = k[i] * (1.0f + (a - 1.0f) * kap[j]);
      const float rks = wave_sum(r[i] * kp * rkp[j]);
      const size_t idx = ((size_t)bh * SEQ + t) * 64 + dh;
      rwA[idx] = f2bf(-kk); rwW[idx] = dec; rwB[idx] = f2bf(kk * a); rwK[idx] = f2bf(kp); rwR[idx] = f2bf(r[i]); rwV[idx] = f2bf(v[i]);
      auxg[(size_t)tok * 256 + j] = f2bf(gg[i]);
      if (lane == 0) rk[tok * 4 + h] = rks;
    }
    }
    if (PARTS & 2)
    {
      float vd[4], vf[4];
#pragma unroll
      for (int i = 0; i < 4; ++i) {
        const int tl = half * 4 + i, tok = T0 + tl, t = t0 + tl;
        const bf16_t* ur = u + (size_t)tok * UC;
        float q = bf2f(ur[OFF_B + j]), kx = bf2f(ur[OFF_B + 256 + j]);
        vd[i] = bf2f(ur[OFF_B + 512 + j]);
        const int d = dh & 31;
        if (d < 8) {
          const int ii = d & 3;
          const float invrev = ii == 0 ? 0.15915494309189535f : ii == 1 ? 0.005985185712713705f : ii == 2 ? 0.00022507907903927653f : 8.464330808241401e-06f;
          const float rvf = (float)t * invrev;
          const float fr = rvf - floorf(rvf);
          const float sn = __builtin_amdgcn_sinf(fr), cs = __builtin_amdgcn_cosf(fr);
          const int pj = d < 4 ? j + 4 : j - 4;
          const float qp = bf2f(ur[OFF_B + pj]), kpn = bf2f(ur[OFF_B + 256 + pj]);
          if (d < 4) { q = q * cs - qp * sn; kx = kx * cs - kpn * sn; }
          else { q = q * cs + qp * sn; kx = kx * cs + kpn * sn; }
        }
        const size_t idx = ((size_t)bh * SEQ + t) * 64 + dh;
        Qd[idx] = f2bf(q * QS_D); Kd[idx] = f2bf(kx);
        Qf[idx] = f2bf(bf2f(ur[OFF_C + j]) * QS_F); Kf[idx] = ur[OFF_C + 256 + j];
        vf[i] = bf2f(ur[OFF_C + 512 + j]);
        if (j < 4) logf_[(size_t)(b * 4 + j) * SEQ + t] = logsigmoidf_(bf2f(ur[OFF_C + 768 + j]) + fbias[j]);
      }
      const size_t vidx = ((size_t)bh * 64 + dh) * SEQ + t0 + half * 4;
      u32x2 w; w[0] = pk2(vd[0], vd[1]); w[1] = pk2(vd[2], vd[3]); *(u32x2*)(Vd + vidx) = w;
      w[0] = pk2(vf[0], vf[1]); w[1] = pk2(vf[2], vf[3]); *(u32x2*)(Vf + vidx) = w;
    }
    if (PARTS & 4) {
#pragma unroll
    for (int i = 0; i < 4; ++i) {
      const int tl = half * 4 + i, tok = T0 + tl, t = t0 + tl;
      const bf16_t* ur = u + (size_t)tok * UC + OFF_D;
      float y[3];
#pragma unroll
      for (int seg = 0; seg < 3; ++seg) {
        const int c = seg * 256 + j;
        const f32x4 wv = *(const f32x4*)(cw + c * 4);
        float acc = wv[3] * bf2f(ur[c]);
        if (t >= 1) acc += wv[2] * bf2f(ur[c - UC]);
        if (t >= 2) acc += wv[1] * bf2f(ur[c - 2 * UC]);
        if (t >= 3) acc += wv[0] * bf2f(ur[c - 3 * UC]);
        y[seg] = acc * sigmoidf_(acc);
      }
      const float sq = wave_sum(y[0] * y[0]), sk = wave_sum(y[1] * y[1]);
      const float qn = y[0] * rsqrtf(sq + 1e-6f) * 0.125f, kn = y[1] * rsqrtf(sk + 1e-6f);
      const size_t idx = ((size_t)bh * SEQ + t) * 64 + dh;
      gq[idx] = f2bf(qn); gk[idx] = f2bf(kn); gv[idx] = f2bf(y[2]);
      const float gate = bf2f(ur[776 + j]);
      auxgate[(size_t)tok * 256 + j] = f2bf(gate * sigmoidf_(gate));
      if (lane == 0) {
        const float beta = sigmoidf_(bf2f(ur[768 + h]));
        const float gl = -__expf(alog[h]) * softplusf_(bf2f(ur[772 + h]) + dtb[h]);
        gbeta[(size_t)bh * SEQ + t] = beta; ga[(size_t)bh * SEQ + t] = __expf(gl);
      }
    }
    }
  }
}


DI float sum8(float x) {
  x += __int_as_float(__builtin_amdgcn_update_dpp(0, __float_as_int(x), 0xB1, 0xF, 0xF, true));
  x += __int_as_float(__builtin_amdgcn_update_dpp(0, __float_as_int(x), 0x4E, 0xF, 0xF, true));
  x += __int_as_float(__builtin_amdgcn_update_dpp(0, __float_as_int(x), 0x141, 0xF, 0xF, true));
  return x;
}
DI void unpk8(float (&f)[8], const u32x4& w) {
#pragma unroll
  for (int i = 0; i < 4; ++i) { f[2 * i] = __uint_as_float(w[i] << 16); f[2 * i + 1] = __uint_as_float(w[i] & 0xffff0000u); }
}
DI u32x4 pk8(const float (&f)[8]) { u32x4 w; w[0] = pk2(f[0], f[1]); w[1] = pk2(f[2], f[3]); w[2] = pk2(f[4], f[5]); w[3] = pk2(f[6], f[7]); return w; }
DI void ld8f(float (&f)[8], const float* p) { const f32x4 a = *(const f32x4*)p, b = *(const f32x4*)(p + 4); f[0] = a[0]; f[1] = a[1]; f[2] = a[2]; f[3] = a[3]; f[4] = b[0]; f[5] = b[1]; f[6] = b[2]; f[7] = b[3]; }
DI void phase_prep2(const Params& p, int L, char* lds) {
  constexpr int XLD = 264;
  bf16_t* XS = (bf16_t*)lds;
  float* LR = (float*)(lds + 16 * XLD * 2);
  bf16_t* VT = (bf16_t*)(lds + 16 * XLD * 2 + 3 * 16 * 256 * 4);
  char* R = p.ws + O_R;
  const bf16_t* u = (const bf16_t*)(R + R_U);
  bf16_t* rwA = (bf16_t*)(R + R_RWA); bf16_t* rwB = (bf16_t*)(R + R_RWB); bf16_t* rwK = (bf16_t*)(R + R_RWK);
  bf16_t* rwR = (bf16_t*)(R + R_RWR); bf16_t* rwV = (bf16_t*)(R + R_RWV); float* rwW = (float*)(R + R_RWW);
  bf16_t* gq = (bf16_t*)(R + R_GQ); bf16_t* gk = (bf16_t*)(R + R_GK); bf16_t* gv = (bf16_t*)(R + R_GV);
  bf16_t* Qd = (bf16_t*)(R + R_QD); bf16_t* Kd = (bf16_t*)(R + R_KD); bf16_t* Vd = (bf16_t*)(R + R_VD);
  bf16_t* Qf = (bf16_t*)(R + R_QF); bf16_t* Kf = (bf16_t*)(R + R_KF); bf16_t* Vf = (bf16_t*)(R + R_VF);
  bf16_t* auxg = (bf16_t*)(R + R_AUXG); bf16_t* auxgate = (bf16_t*)(R + R_AUXGATE);
  float* rk = (float*)(p.ws + O_SMALL + SM_RK); float* logf_ = (float*)(p.ws + O_SMALL + SM_LOGF);
  float* gbeta = (float*)(p.ws + O_SMALL + SM_GBETA); float* ga = (float*)(p.ws + O_SMALL + SM_GA);
  const float* mu = p.in[8] + L * 1024; const float* w0 = p.in[9] + L * 256; const float* a0 = p.in[11] + L * 256;
  const float* kkp = p.in[14] + L * 256; const float* kap = p.in[15] + L * 256; const float* rkp = p.in[16] + L * 256;
  const float* fbias = p.in[21] + L * 4; const float* cw = p.in[22] + L * 768 * 4;
  const float* alog = p.in[23] + L * 4; const float* dtb = p.in[24] + L * 4;
  const bf16_t* WL = (const bf16_t*)(p.ws + O_LORA + L * SZ_LORA);
  const float QS_D = 0.25503486164919736f, QS_F = 0.18033688011112042f;
#pragma unroll 1
  for (int tile = obid(); tile < NTOK / 16; tile += gridDim.x) {
    const int tid = otid(), tk = tid >> 5, cg = tid & 31, c0 = cg * 8, h = cg >> 3, d0 = (cg & 7) * 8, lane = tid & 63, wid = tid >> 6;
    const int fr = lane & 15, fq = lane >> 4;
    const int T0 = tile * 16, b = T0 / SEQ, t0 = T0 % SEQ, tok = T0 + tk, t = t0 + tk, bh = b * 4 + h;
    const bf16_t* ur = u + (size_t)tok * UC;
    const size_t idx = ((size_t)bh * SEQ + t) * 64 + d0;
    float r[8], k[8], v[8];
    __syncthreads();
    {
#pragma unroll
      for (int seg = 0; seg < 4; ++seg) {
        asm volatile("" ::: "memory");
        float ua[8], up[8], mm[8], xm[8];
        unpk8(ua, *(const u32x4*)(ur + seg * 256 + c0));
        if (t > 0) unpk8(up, *(const u32x4*)(ur - UC + seg * 256 + c0));
        else {
#pragma unroll
          for (int i = 0; i < 8; ++i) up[i] = 0.f;
        }
        ld8f(mm, mu + seg * 256 + c0);
#pragma unroll
        for (int i = 0; i < 8; ++i) xm[i] = ua[i] + (up[i] - ua[i]) * mm[i];
        if (seg == 0) {
#pragma unroll
          for (int i = 0; i < 8; ++i) r[i] = xm[i];
        } else if (seg == 1) {
#pragma unroll
          for (int i = 0; i < 8; ++i) k[i] = xm[i];
        } else if (seg == 2) {
#pragma unroll
          for (int i = 0; i < 8; ++i) v[i] = xm[i];
        } else {
          if (cg < 8) {
#pragma unroll
            for (int i = 0; i < 8; ++i) xm[i] = 1.0f - 2.0f / (1.0f + __expf(2.0f * xm[i]));
          } else if (cg >= 16) {
#pragma unroll
            for (int i = 0; i < 8; ++i) xm[i] = sigmoidf_(xm[i]);
          }
          *(u32x4*)(XS + tk * XLD + c0) = pk8(xm);
        }
      }
    }
    __syncthreads();
    {
#pragma unroll
      for (int nt2 = 0; nt2 < 2; ++nt2) {
        const int nt = wid * 2 + nt2;
        f32x4 aw = {0.f, 0.f, 0.f, 0.f}, aa = aw, ag = aw;
#pragma unroll
        for (int ks = 0; ks < 2; ++ks) {
          const bf16x8 xw = *(const bf16x8*)(XS + fr * XLD + 32 * ks + 8 * fq);
          const bf16x8 xa = *(const bf16x8*)(XS + fr * XLD + 64 + 32 * ks + 8 * fq);
          const bf16x8 ww = *(const bf16x8*)(WL + (size_t)(16 * nt + fr) * 64 + 32 * ks + 8 * fq);
          const bf16x8 wa = *(const bf16x8*)(WL + 256 * 64 + (size_t)(16 * nt + fr) * 64 + 32 * ks + 8 * fq);
          aw = __builtin_amdgcn_mfma_f32_16x16x32_bf16(ww, xw, aw, 0, 0, 0);
          aa = __builtin_amdgcn_mfma_f32_16x16x32_bf16(wa, xa, aa, 0, 0, 0);
        }
#pragma unroll
        for (int ks = 0; ks < 4; ++ks) {
          const bf16x8 xg = *(const bf16x8*)(XS + fr * XLD + 128 + 32 * ks + 8 * fq);
          const bf16x8 wg = *(const bf16x8*)(WL + 2 * 256 * 64 + (size_t)(16 * nt + fr) * 128 + 32 * ks + 8 * fq);
          ag = __builtin_amdgcn_mfma_f32_16x16x32_bf16(wg, xg, ag, 0, 0, 0);
        }
        *(f32x4*)(LR + (0 * 16 + fr) * 256 + 16 * nt + 4 * fq) = aw;
        *(f32x4*)(LR + (1 * 16 + fr) * 256 + 16 * nt + 4 * fq) = aa;
        *(f32x4*)(LR + (2 * 16 + fr) * 256 + 16 * nt + 4 * fq) = ag;
      }
    }
    __syncthreads();
    {
      float lw[8], al[8], gg[8], t8[8], kkv[8], kpv[8], o8[8];
      ld8f(lw, LR + (0 * 16 + tk) * 256 + c0); ld8f(al, LR + (1 * 16 + tk) * 256 + c0); ld8f(gg, LR + (2 * 16 + tk) * 256 + c0);
      ld8f(t8, w0 + c0);
#pragma unroll
      for (int i = 0; i < 8; ++i) lw[i] = __expf(-0.6065306597126334f * sigmoidf_(lw[i] + t8[i]));
      ld8f(t8, a0 + c0);
#pragma unroll
      for (int i = 0; i < 8; ++i) al[i] = sigmoidf_(al[i] + t8[i]);
      ld8f(t8, kkp + c0);
      float ss = 0.f;
#pragma unroll
      for (int i = 0; i < 8; ++i) { kkv[i] = k[i] * t8[i]; ss += kkv[i] * kkv[i]; }
      ss = sum8(ss);
      const float rn = rsqrtf(ss + 1e-6f);
      ld8f(t8, kap + c0);
#pragma unroll
      for (int i = 0; i < 8; ++i) { kkv[i] *= rn; kpv[i] = k[i] * (1.0f + (al[i] - 1.0f) * t8[i]); }
      ld8f(t8, rkp + c0);
      float rks = 0.f;
#pragma unroll
      for (int i = 0; i < 8; ++i) rks += r[i] * kpv[i] * t8[i];
      rks = sum8(rks);
#pragma unroll
      for (int i = 0; i < 8; ++i) o8[i] = -kkv[i];
      *(u32x4*)(rwA + idx) = pk8(o8);
      *(f32x4*)(rwW + idx) = (f32x4){lw[0], lw[1], lw[2], lw[3]}; *(f32x4*)(rwW + idx + 4) = (f32x4){lw[4], lw[5], lw[6], lw[7]};
#pragma unroll
      for (int i = 0; i < 8; ++i) o8[i] = kkv[i] * al[i];
      *(u32x4*)(rwB + idx) = pk8(o8);
      *(u32x4*)(rwK + idx) = pk8(kpv);
      *(u32x4*)(rwR + idx) = pk8(r);
      *(u32x4*)(rwV + idx) = pk8(v);
      *(u32x4*)(auxg + (size_t)tok * 256 + c0) = pk8(gg);
      if ((cg & 7) == 0) rk[tok * 4 + h] = rks;
    }
    asm volatile("" ::: "memory");
    {
      float q[8], kx[8];
      unpk8(q, *(const u32x4*)(ur + OFF_B + c0)); unpk8(kx, *(const u32x4*)(ur + OFF_B + 256 + c0));
      const u32x4 vdw = *(const u32x4*)(ur + OFF_B + 512 + c0);
      if ((cg & 3) == 0) {
#pragma unroll
        for (int i = 0; i < 4; ++i) {
          const float invrev = i == 0 ? 0.15915494309189535f : i == 1 ? 0.005985185712713705f : i == 2 ? 0.00022507907903927653f : 8.464330808241401e-06f;
          const float rvf = (float)t * invrev, fr_ = rvf - floorf(rvf);
          const float sn = __builtin_amdgcn_sinf(fr_), cs = __builtin_amdgcn_cosf(fr_);
          const float q1 = q[i], q2 = q[i + 4], k1 = kx[i], k2 = kx[i + 4];
          q[i] = q1 * cs - q2 * sn; q[i + 4] = q2 * cs + q1 * sn;
          kx[i] = k1 * cs - k2 * sn; kx[i + 4] = k2 * cs + k1 * sn;
        }
      }
#pragma unroll
      for (int i = 0; i < 8; ++i) q[i] *= QS_D;
      *(u32x4*)(Qd + idx) = pk8(q); *(u32x4*)(Kd + idx) = pk8(kx);
      asm volatile("" ::: "memory");
      float fqv[8];
      unpk8(fqv, *(const u32x4*)(ur + OFF_C + c0));
#pragma unroll
      for (int i = 0; i < 8; ++i) fqv[i] *= QS_F;
      *(u32x4*)(Qf + idx) = pk8(fqv);
      *(u32x4*)(Kf + idx) = *(const u32x4*)(ur + OFF_C + 256 + c0);
      const u32x4 vfw = *(const u32x4*)(ur + OFF_C + 512 + c0);
      *(u32x4*)(VT + (0 * 16 + tk) * 256 + c0) = vdw;
      *(u32x4*)(VT + (1 * 16 + tk) * 256 + c0) = vfw;
      if (cg == 0) {
        const u32x2 fl = *(const u32x2*)(ur + OFF_C + 768);
        const float f0 = __uint_as_float(fl[0] << 16), f1 = __uint_as_float(fl[0] & 0xffff0000u), f2 = __uint_as_float(fl[1] << 16), f3 = __uint_as_float(fl[1] & 0xffff0000u);
        logf_[(size_t)(b * 4 + 0) * SEQ + t] = logsigmoidf_(f0 + fbias[0]); logf_[(size_t)(b * 4 + 1) * SEQ + t] = logsigmoidf_(f1 + fbias[1]);
        logf_[(size_t)(b * 4 + 2) * SEQ + t] = logsigmoidf_(f2 + fbias[2]); logf_[(size_t)(b * 4 + 3) * SEQ + t] = logsigmoidf_(f3 + fbias[3]);
      }
    }
    asm volatile("" ::: "memory");
    {
      float y[3][8];
#pragma unroll
      for (int seg = 0; seg < 3; ++seg) {
        asm volatile("" ::: "memory");
#pragma unroll
        for (int i = 0; i < 8; ++i) y[seg][i] = 0.f;
#pragma unroll
        for (int jj = 0; jj < 4; ++jj) {
          if (t - 3 + jj >= 0) {
            const bf16_t* up_ = ur + (jj - 3) * UC + OFF_D + seg * 256 + c0;
            const u32x2 lo = *(const u32x2*)up_, hi = *(const u32x2*)(up_ + 4);
            const u32x4 w4 = {lo[0], lo[1], hi[0], hi[1]};
            float uu[8]; unpk8(uu, w4);
#pragma unroll
            for (int i = 0; i < 8; ++i) y[seg][i] += cw[(seg * 256 + c0 + i) * 4 + jj] * uu[i];
          }
        }
#pragma unroll
        for (int i = 0; i < 8; ++i) y[seg][i] = y[seg][i] * sigmoidf_(y[seg][i]);
      }
      float sq = 0.f, sk = 0.f;
#pragma unroll
      for (int i = 0; i < 8; ++i) { sq += y[0][i] * y[0][i]; sk += y[1][i] * y[1][i]; }
      sq = sum8(sq); sk = sum8(sk);
      const float rq = rsqrtf(sq + 1e-6f) * 0.125f, rkn = rsqrtf(sk + 1e-6f);
#pragma unroll
      for (int i = 0; i < 8; ++i) { y[0][i] *= rq; y[1][i] *= rkn; }
      *(u32x4*)(gq + idx) = pk8(y[0]); *(u32x4*)(gk + idx) = pk8(y[1]); *(u32x4*)(gv + idx) = pk8(y[2]);
      asm volatile("" ::: "memory");
      {
        const bf16_t* gp = ur + OFF_D + 776 + c0;
        const u32x2 lo = *(const u32x2*)gp, hi = *(const u32x2*)(gp + 4);
        const u32x4 w4 = {lo[0], lo[1], hi[0], hi[1]};
        float g8[8]; unpk8(g8, w4);
#pragma unroll
        for (int i = 0; i < 8; ++i) g8[i] = g8[i] * sigmoidf_(g8[i]);
        *(u32x4*)(auxgate + (size_t)tok * 256 + c0) = pk8(g8);
      }
      if ((cg & 7) == 0) {
        const float beta = sigmoidf_(bf2f(ur[OFF_D + 768 + h]));
        const float gl = -__expf(alog[h]) * softplusf_(bf2f(ur[OFF_D + 772 + h]) + dtb[h]);
        gbeta[(size_t)bh * SEQ + t] = beta; ga[(size_t)bh * SEQ + t] = __expf(gl);
      }
    }
    __syncthreads();
    {
      const int ch = tid & 255, hf = tid >> 8;
#pragma unroll
      for (int m = 0; m < 2; ++m) {
        const bf16_t* vs = VT + (m * 16 + hf * 8) * 256 + ch;
        u32x4 w;
        w[0] = (unsigned)vs[0] | ((unsigned)vs[256] << 16); w[1] = (unsigned)vs[512] | ((unsigned)vs[768] << 16);
        w[2] = (unsigned)vs[1024] | ((unsigned)vs[1280] << 16); w[3] = (unsigned)vs[1536] | ((unsigned)vs[1792] << 16);
        bf16_t* dst = (m == 0 ? Vd : Vf) + ((size_t)(b * 4 + (ch >> 6)) * 64 + (ch & 63)) * SEQ + t0 + hf * 8;
        *(u32x4*)dst = w;
      }
    }
  }
}

DI float dpp_sum16(float x) {
  x += __int_as_float(__builtin_amdgcn_update_dpp(0, __float_as_int(x), 0xB1, 0xF, 0xF, true));
  x += __int_as_float(__builtin_amdgcn_update_dpp(0, __float_as_int(x), 0x4E, 0xF, 0xF, true));
  x += __int_as_float(__builtin_amdgcn_update_dpp(0, __float_as_int(x), 0x141, 0xF, 0xF, true));
  x += __int_as_float(__builtin_amdgcn_update_dpp(0, __float_as_int(x), 0x140, 0xF, 0xF, true));
  return x;
}
constexpr int SCH = 16;
constexpr int RS = 448;
DI float sum32(float x) {
  x = dpp_sum16(x);
  auto rr = __builtin_amdgcn_permlane16_swap(__float_as_uint(x), __float_as_uint(x), false, false);
  return __uint_as_float(rr[0]) + __uint_as_float(rr[1]);
}
struct StepIn { f32x4 q0, q1, q2; float V; };
DI void ld_step(StepIn& s, const float* sp, const float* vp) {
  s.q0 = *(const f32x4*)(sp); s.q1 = *(const f32x4*)(sp + 4); s.q2 = *(const f32x4*)(sp + 8); s.V = *vp;
}
template <int WHICH>
DI void scan_block(const Params& p, int L, int bh, int quarter, char* lds) {
  float* buf = (float*)lds;
  float* pbuf = buf + 2 * SCH * RS;
  char* R = p.ws + O_R;
  const int tid = otid();
  const size_t base = (size_t)bh * SEQ * 64;
  float* oout = (float*)(R + R_OSCAN) + (size_t)WHICH * NBH * SEQ * 64 + base;
  constexpr int NCH = SEQ / SCH;
  const int r = tid >> 5, sub = tid & 31, v = quarter * 16 + r;
  const int sst = (tid >> 4) & (SCH - 1), sk = (tid & 15) * 4;
  const bool stager = tid < SCH * 16;
  const u32x2* pA = (const u32x2*)((const bf16_t*)(R + (WHICH == 0 ? R_RWA : R_GK)) + base);
  const u32x2* pB = (const u32x2*)((const bf16_t*)(R + R_RWB) + base);
  const u32x2* pK = (const u32x2*)((const bf16_t*)(R + R_RWK) + base);
  const u32x2* pR = (const u32x2*)((const bf16_t*)(R + (WHICH == 0 ? R_RWR : R_GQ)) + base);
  const u32x2* pV = (const u32x2*)((const bf16_t*)(R + (WHICH == 0 ? R_RWV : R_GV)) + base);
  const f32x4* pW = (const f32x4*)((const float*)(R + R_RWW) + base);
  const float* gbeta = (const float*)(p.ws + O_SMALL + SM_GBETA) + (size_t)bh * SEQ;
  const float* ga = (const float*)(p.ws + O_SMALL + SM_GA) + (size_t)bh * SEQ;
  const u32x2 z2 = {0u, 0u};
  u32x2 ra = z2, ran = z2, rb = z2, rkk = z2, rr = z2, rv = z2; f32x4 rw = {0.f, 0.f, 0.f, 0.f};
  float rbeta = 0.f, raa = 0.f;
#define SCAN_LOAD(c)                                                                           \
  if (stager) {                                                                                \
    const int t_ = (c) * SCH + sst;                                                            \
    const size_t o_ = (size_t)t_ * 16 + (tid & 15);                                            \
    ra = pA[o_]; rr = pR[o_]; rv = pV[o_];                                                     \
    ran = t_ + 1 < SEQ ? pA[o_ + 16] : z2;                                                     \
    if (WHICH == 0) { rb = pB[o_]; rkk = pK[o_]; rw = pW[o_]; }                                \
    else { rbeta = gbeta[t_]; raa = ga[t_]; }                                                  \
  }
#define UNPK4(src) ((f32x4){__uint_as_float(src[0] << 16), __uint_as_float(src[0] & 0xffff0000u), __uint_as_float(src[1] << 16), __uint_as_float(src[1] & 0xffff0000u)})
#define DOT4(a, b) ((a[0] * b[0] + a[1] * b[1]) + (a[2] * b[2] + a[3] * b[3]))
#define SCAN_STAGE(c)                                                                          \
  if (stager) {                                                                                \
    float* rec_ = buf + ((c) & 1) * (SCH * RS) + sst * RS;                                     \
    f32x4 fAn, fW, fB, fK;                                                                     \
    if (WHICH == 0) { fAn = UNPK4(ran); fW = rw; fB = UNPK4(rb); fK = UNPK4(rkk); }            \
    else { const f32x4 k0_ = UNPK4(ra), kn_ = UNPK4(ran); fAn = -kn_; fW = (f32x4){raa, raa, raa, raa}; fB = k0_ * (raa * rbeta); fK = k0_ * rbeta; } \
    const float c1_ = dpp_sum16(DOT4(fB, fAn)), c2_ = dpp_sum16(DOT4(fK, fAn));               \
    const f32x4 fR = UNPK4(rr), fWA = fW * fAn;                                                \
    float* d_ = rec_ + (tid & 15) * 24;                                                        \
    *(f32x4*)(d_) = (f32x4){fWA[0], fWA[1], fW[0], fW[1]}; *(f32x4*)(d_ + 4) = (f32x4){fB[0], fB[1], fK[0], fK[1]}; *(f32x4*)(d_ + 8) = (f32x4){fR[0], fR[1], c1_, c2_};       \
    *(f32x4*)(d_ + 12) = (f32x4){fWA[2], fWA[3], fW[2], fW[3]}; *(f32x4*)(d_ + 16) = (f32x4){fB[2], fB[3], fK[2], fK[3]}; *(f32x4*)(d_ + 20) = (f32x4){fR[2], fR[3], c1_, c2_}; \
    *(f32x4*)(rec_ + 384 + sk) = UNPK4(rv);                                                    \
  }
#define SCAN_FLUSH(c)                                                                          \
  {                                                                                            \
    const float* pb_ = pbuf + ((c) & 1) * (SCH * 512);                                         \
    _Pragma("unroll") for (int ps_ = 0; ps_ < 4; ++ps_) {                                      \
      const int o_ = ps_ * 64 + (tid >> 3);                                                    \
      const f32x4 q_ = *(const f32x4*)(pb_ + o_ * 32 + (tid & 7) * 4);                         \
      float sm_ = (q_[0] + q_[1]) + (q_[2] + q_[3]);                                           \
      sm_ += __int_as_float(__builtin_amdgcn_update_dpp(0, __float_as_int(sm_), 0xB1, 0xF, 0xF, true));   \
      sm_ += __int_as_float(__builtin_amdgcn_update_dpp(0, __float_as_int(sm_), 0x4E, 0xF, 0xF, true));   \
      sm_ += __int_as_float(__builtin_amdgcn_update_dpp(0, __float_as_int(sm_), 0x141, 0xF, 0xF, true));  \
      if ((tid & 7) == 0) oout[((size_t)(c) * SCH + (o_ >> 4)) * 64 + quarter * 16 + (o_ & 15)] = sm_;   \
    }                                                                                          \
  }
  SCAN_LOAD(0);
  __syncthreads();
  SCAN_STAGE(0);
  f32x2 S1 = {0.f, 0.f}; float pre = 0.f, X = 0.f;
#pragma unroll 1
  for (int c = 0; c < NCH; ++c) {
    __syncthreads();
    if (c >= 1) SCAN_FLUSH(c - 1);
    if (c + 1 < NCH) SCAN_LOAD(c + 1);
    const float* cb = buf + (c & 1) * (SCH * RS);
    float* pb = pbuf + (c & 1) * (SCH * 512) + r * 32 + sub;
    StepIn cur, nxt;
    ld_step(cur, cb + sub * 12, cb + 384 + v);
#pragma unroll 4
    for (int st = 0; st < SCH; ++st) {
      const int sn = st + 1 < SCH ? st + 1 : st;
      ld_step(nxt, cb + sn * RS + sub * 12, cb + sn * RS + 384 + v);
      const float sa = X + pre;
      const float Xn = sum32(S1[0] * cur.q0[0] + S1[1] * cur.q0[1]);
      const float s0 = S1[0] * cur.q0[2] + (cur.q1[0] * sa + cur.q1[2] * cur.V);
      const float s1 = S1[1] * cur.q0[3] + (cur.q1[1] * sa + cur.q1[3] * cur.V);
      pre = sa * cur.q2[2] + cur.V * cur.q2[3];
      pb[st * 512] = s0 * cur.q2[0] + s1 * cur.q2[1];
      S1[0] = s0; S1[1] = s1; X = Xn;
      cur = nxt;
    }
    if (c + 1 < NCH) SCAN_STAGE(c + 1);
  }
  __syncthreads();
  SCAN_FLUSH(NCH - 1);
#undef SCAN_LOAD
#undef SCAN_STAGE
#undef SCAN_FLUSH
#undef UNPK4
#undef DOT4
}
DI void phase_scanpost(const Params& p, int L) {
  char* R = p.ws + O_R;
  const float* osc = (const float*)(R + R_OSCAN);
  const float* rk = (const float*)(p.ws + O_SMALL + SM_RK);
  const bf16_t* rwV = (const bf16_t*)(R + R_RWV);
  const bf16_t* auxg = (const bf16_t*)(R + R_AUXG); const bf16_t* auxgate = (const bf16_t*)(R + R_AUXGATE);
  bf16_t* y = (bf16_t*)(R + R_Y);
  const float* lnw = p.in[17] + L * 256; const float* lnb = p.in[18] + L * 256; const float* gnw = p.in[25] + L * 64;
#pragma unroll 1
  for (int it0 = obid() * 64; it0 < 2 * NBH * SEQ; it0 += gridDim.x * 64) {
    const int tid = otid(), item = it0 + (tid >> 3), d0 = (tid & 7) * 8;
    const int which = item >= NBH * SEQ, rem = item - which * NBH * SEQ, bh = rem / SEQ, t = rem % SEQ, b = bh >> 2, h = bh & 3, tok = b * SEQ + t;
    float o[8]; ld8f(o, osc + (size_t)item * 64 + d0);
    float g8[8]; unpk8(g8, *(const u32x4*)((which == 0 ? auxg : auxgate) + (size_t)tok * 256 + h * 64 + d0));
    float out[8];
    if (which == 0) {
      float s1 = 0.f;
#pragma unroll
      for (int i = 0; i < 8; ++i) s1 += o[i];
      const float mean = sum8(s1) * (1.0f / 64.0f);
      float s2 = 0.f;
#pragma unroll
      for (int i = 0; i < 8; ++i) { o[i] -= mean; s2 += o[i] * o[i]; }
      const float rstd = rsqrtf(sum8(s2) * (1.0f / 64.0f) + 64e-5f);
      float w8[8], b8[8], v8[8];
      ld8f(w8, lnw + h * 64 + d0); ld8f(b8, lnb + h * 64 + d0);
      unpk8(v8, *(const u32x4*)(rwV + ((size_t)bh * SEQ + t) * 64 + d0));
      const float rkv = rk[tok * 4 + h];
#pragma unroll
      for (int i = 0; i < 8; ++i) out[i] = (o[i] * rstd * w8[i] + b8[i] + rkv * v8[i]) * g8[i];
      *(u32x4*)(y + ((size_t)0 * NTOK + tok) * 256 + h * 64 + d0) = pk8(out);
    } else {
      float s2 = 0.f;
#pragma unroll
      for (int i = 0; i < 8; ++i) s2 += o[i] * o[i];
      const float rstd = rsqrtf(sum8(s2) * (1.0f / 64.0f) + 1e-6f);
      float w8[8]; ld8f(w8, gnw + d0);
#pragma unroll
      for (int i = 0; i < 8; ++i) out[i] = o[i] * rstd * w8[i] * g8[i];
      *(u32x4*)(y + ((size_t)3 * NTOK + tok) * 256 + h * 64 + d0) = pk8(out);
    }
  }
}

DI bf16x8 packf8(float a0, float a1, float a2, float a3, float a4, float a5, float a6, float a7) {
  u32x4 w; w[0] = pk2(a0, a1); w[1] = pk2(a2, a3); w[2] = pk2(a4, a5); w[3] = pk2(a6, a7);
  return __builtin_bit_cast(bf16x8, w);
}
constexpr int KLD = 72;
template <int TYPE>
DI void attn_unit(const Params& p, int L, int bh, int qt, char* lds) {
  bf16_t* Ks = (bf16_t*)lds;
  bf16_t* Vs = Ks + 64 * KLD;
  float* cs = (float*)(lds + 2 * 64 * KLD * 2);
  float* red = cs + 8192;
  char* R = p.ws + O_R;
  const int tid = otid(), lane = tid & 63, wid = tid >> 6, r32 = lane & 31, hi = lane >> 5;
  const int b = bh >> 2, h = bh & 3;
  const int map = TYPE == 0 ? (wid >> 2) : 0, wq = TYPE == 0 ? (wid & 3) : wid;
  const int QROWS = TYPE == 0 ? 128 : 256;
  const int q0 = qt * QROWS, qw0 = q0 + wq * 32, q = qw0 + r32;
  const bf16_t* Qg = (const bf16_t*)(R + (TYPE == 0 ? R_QD : R_QF)) + (size_t)bh * SEQ * 64;
  const bf16_t* Kg = (const bf16_t*)(R + (TYPE == 0 ? R_KD : R_KF)) + (size_t)bh * SEQ * 64;
  const bf16_t* Vg = (const bf16_t*)(R + (TYPE == 0 ? R_VD : R_VF)) + (size_t)bh * 64 * SEQ;
  const int NT = (q0 + QROWS) / 64;
  __syncthreads();
  const int lrow = tid >> 3, lch = (tid & 7) * 8;
  u32x4 kreg = *(const u32x4*)(Kg + (size_t)lrow * 64 + lch);
  u32x4 vreg = *(const u32x4*)(Vg + (size_t)lrow * SEQ + lch);
  float cq = 0.f;
  if (TYPE == 1) {
    const float* lf = (const float*)(p.ws + O_SMALL + SM_LOGF) + (size_t)bh * SEQ;
    const int n = q0 + 256;
    float loc[16]; float tot = 0.f;
#pragma unroll
    for (int i = 0; i < 16; ++i) { const int e = tid * 16 + i; loc[i] = e < n ? lf[e] : 0.f; tot += loc[i]; }
    float inc = tot;
#pragma unroll
    for (int o = 1; o < 64; o <<= 1) { const float t2 = __shfl_up(inc, o); if (lane >= o) inc += t2; }
    if (lane == 63) red[wid] = inc;
    __syncthreads();
    float pre = inc - tot;
    for (int w = 0; w < wid; ++w) pre += red[w];
#pragma unroll
    for (int i = 0; i < 16; ++i) { pre += loc[i]; const int e = tid * 16 + i; if (e < n) cs[e] = pre * 1.4426950408889634f; }
    __syncthreads();
    cq = cs[q];
  }
  constexpr int NS = TYPE == 0 ? 2 : 4;
  const int sbase = TYPE == 0 ? 2 * map : 0;
  bf16x8 qf[NS];
#pragma unroll
  for (int s = 0; s < NS; ++s) qf[s] = *(const bf16x8*)(Qg + (size_t)q * 64 + 16 * (sbase + s) + 8 * hi);
  float m = -INFINITY, l = 0.f; f32x16 o[2];
#pragma unroll
  for (int r = 0; r < 16; ++r) { o[0][r] = 0.f; o[1][r] = 0.f; }
#pragma unroll 1
  for (int jt = 0; jt < NT; ++jt) {
    const int kv0 = jt * 64;
    __syncthreads();
    *(u32x4*)(Ks + lrow * KLD + lch) = kreg;
    *(u32x4*)(Vs + lrow * KLD + lch) = vreg;
    __syncthreads();
    if (jt + 1 < NT) {
      kreg = *(const u32x4*)(Kg + (size_t)(kv0 + 64 + lrow) * 64 + lch);
      vreg = *(const u32x4*)(Vg + (size_t)lrow * SEQ + kv0 + 64 + lch);
    }
    if (kv0 <= qw0 + 31) {
      const bool needmask = kv0 + 63 > qw0;
      f32x16 p0, p1;
#pragma unroll
      for (int r = 0; r < 16; ++r) { p0[r] = 0.f; p1[r] = 0.f; }
#pragma unroll
      for (int s = 0; s < NS; ++s) {
        const bf16x8 k0 = *(const bf16x8*)(Ks + r32 * KLD + 16 * (sbase + s) + 8 * hi);
        const bf16x8 k1 = *(const bf16x8*)(Ks + (32 + r32) * KLD + 16 * (sbase + s) + 8 * hi);
        p0 = __builtin_amdgcn_mfma_f32_32x32x16_bf16(k0, qf[s], p0, 0, 0, 0);
        p1 = __builtin_amdgcn_mfma_f32_32x32x16_bf16(k1, qf[s], p1, 0, 0, 0);
      }
      if (TYPE == 1) {
#pragma unroll
        for (int r = 0; r < 16; ++r) { p0[r] += cq - cs[kv0 + crow(r, hi)]; p1[r] += cq - cs[kv0 + 32 + crow(r, hi)]; }
      }
      if (needmask) {
#pragma unroll
        for (int r = 0; r < 16; ++r) { if (kv0 + crow(r, hi) > q) p0[r] = -INFINITY; if (kv0 + 32 + crow(r, hi) > q) p1[r] = -INFINITY; }
      }
      float mx = fmaxf(p0[0], p1[0]);
#pragma unroll
      for (int r = 1; r < 16; ++r) mx = fmaxf(mx, fmaxf(p0[r], p1[r]));
      mx = fmaxf(mx, __shfl_xor(mx, 32));
      const float mn = fmaxf(m, mx);
      const float alpha = __builtin_amdgcn_exp2f(m - mn);
      m = mn;
      float rs = 0.f;
#pragma unroll
      for (int r = 0; r < 16; ++r) { p0[r] = __builtin_amdgcn_exp2f(p0[r] - mn); p1[r] = __builtin_amdgcn_exp2f(p1[r] - mn); rs += p0[r] + p1[r]; }
      l = l * alpha + rs;
#pragma unroll
      for (int r = 0; r < 16; ++r) { o[0][r] *= alpha; o[1][r] *= alpha; }
      bf16x8 pf[4];
      pf[0] = packf8(p0[0], p0[1], p0[2], p0[3], p0[4], p0[5], p0[6], p0[7]);
      pf[1] = packf8(p0[8], p0[9], p0[10], p0[11], p0[12], p0[13], p0[14], p0[15]);
      pf[2] = packf8(p1[0], p1[1], p1[2], p1[3], p1[4], p1[5], p1[6], p1[7]);
      pf[3] = packf8(p1[8], p1[9], p1[10], p1[11], p1[12], p1[13], p1[14], p1[15]);
#pragma unroll
      for (int db = 0; db < 2; ++db)
#pragma unroll
        for (int s = 0; s < 4; ++s) {
          const s16x4 lo = *(const s16x4*)(Vs + (32 * db + r32) * KLD + 16 * s + 4 * hi);
          const s16x4 hh = *(const s16x4*)(Vs + (32 * db + r32) * KLD + 16 * s + 8 + 4 * hi);
          const bf16x8 vf = __builtin_shufflevector(lo, hh, 0, 1, 2, 3, 4, 5, 6, 7);
          o[db] = __builtin_amdgcn_mfma_f32_32x32x16_bf16(vf, pf[s], o[db], 0, 0, 0);
        }
    }
  }
  bf16_t* y = (bf16_t*)(R + R_Y);
  const size_t orow = ((size_t)(TYPE == 0 ? 1 : 2) * NTOK + (size_t)b * SEQ + q) * 256 + h * 64;
  const float lt = l + __shfl_xor(l, 32);
  const float li = 1.0f / lt;
  if (TYPE == 1) {
#pragma unroll
    for (int db = 0; db < 2; ++db)
#pragma unroll
      for (int g = 0; g < 4; ++g) {
        u32x2 w; w[0] = pk2(o[db][4 * g] * li, o[db][4 * g + 1] * li); w[1] = pk2(o[db][4 * g + 2] * li, o[db][4 * g + 3] * li);
        *(u32x2*)(y + orow + 32 * db + 8 * g + 4 * hi) = w;
      }
  } else {
    float* xb = cs;
    if (map == 1) {
#pragma unroll
      for (int db = 0; db < 2; ++db)
#pragma unroll
        for (int r = 0; r < 16; ++r) xb[(wq * 32 + db * 16 + r) * 64 + lane] = o[db][r] * li;
    }
    __syncthreads();
    if (map == 0) {
      const float* lp = p.in[19] + L * 128;
      float s01 = 0.f, s23 = 0.f;
      for (int i = 0; i < 32; ++i) { s01 += lp[i] * lp[32 + i]; s23 += lp[64 + i] * lp[96 + i]; }
      const float lam_init = L == 0 ? 0.2f : 0.35550906759096934f;
      const float lam = __expf(s01) - __expf(s23) + lam_init;
      const float* sub = p.in[20] + L * 64;
      float ss = 0.f;
#pragma unroll
      for (int db = 0; db < 2; ++db)
#pragma unroll
        for (int r = 0; r < 16; ++r) { const float vv = o[db][r] * li - lam * xb[(wq * 32 + db * 16 + r) * 64 + lane]; o[db][r] = vv; ss += vv * vv; }
      ss += __shfl_xor(ss, 32);
      const float sc = rsqrtf(ss * (1.0f / 64.0f) + 1e-5f) * (1.0f - lam_init);
#pragma unroll
      for (int db = 0; db < 2; ++db)
#pragma unroll
        for (int g = 0; g < 4; ++g) {
          const int d = 32 * db + 8 * g + 4 * hi;
          const f32x4 sw = *(const f32x4*)(sub + d);
          u32x2 w; w[0] = pk2(o[db][4 * g] * sc * sw[0], o[db][4 * g + 1] * sc * sw[1]); w[1] = pk2(o[db][4 * g + 2] * sc * sw[2], o[db][4 * g + 3] * sc * sw[3]);
          *(u32x2*)(y + orow + d) = w;
        }
    }
  }
}

DI void phase_mix(const Params& p, int L, char* lds, int qslot) {
  int* ctr = (int*)(p.ws + O_CTL) + CW_QCTR + qslot * 64;
  int* s_unit = (int*)(lds + 2 * 64 * KLD * 2 + 8192 * 4 + 64);
  {
    const int bid = obid();
    if (bid < 64) {
      if (bid < 32) scan_block<0>(p, L, (bid >> 2) & 7, bid & 3, lds); else scan_block<1>(p, L, (bid >> 2) & 7, bid & 3, lds);
#if PROBE == 4
      if (L == 0) { __syncthreads(); if (bid < 32) scan_block<0>(p, L, (bid >> 2) & 7, bid & 3, lds); else scan_block<1>(p, L, (bid >> 2) & 7, bid & 3, lds); }
#endif
    }
  }
#pragma unroll 1
  for (;;) {
    __syncthreads();
    if (otid() == 0) *s_unit = atomicAdd(ctr, 1);
    __syncthreads();
    const int u = *s_unit;
    if (u >= 768) break;
    const int level = 31 - u / 24, w = u % 24;
    if (w < 8) attn_unit<1>(p, L, w, level, lds);
    else if (w < 16) attn_unit<0>(p, L, w - 8, 2 * level + 1, lds);
    else attn_unit<0>(p, L, w - 16, 2 * level, lds);
  }
  if (L == 0 && qslot == 0) {
    int* cctr = (int*)(p.ws + O_CTL) + CW_QCTR + 8 * 64;
    float* tl = (float*)lds; const int tid = otid();
#pragma unroll 1
    for (;;) {
      __syncthreads();
      if (tid == 0) *s_unit = atomicAdd(cctr, 8);
      __syncthreads();
      const int g0 = *s_unit;
      if (g0 >= MOE_CONV_TILES) break;
#pragma unroll 1
      for (int g = g0; g < g0 + 8; ++g) moe_convert_tile(p, g, tl, tid);
    }
  }
}
DI void phase_mix_attn_only(const Params& p, int L, char* lds, int qslot) {
  int* ctr = (int*)(p.ws + O_CTL) + CW_QCTR + qslot * 64;
  int* s_unit = (int*)(lds + 2 * 64 * KLD * 2 + 8192 * 4 + 64);
#pragma unroll 1
  for (;;) {
    __syncthreads();
    if (otid() == 0) *s_unit = atomicAdd(ctr, 1);
    __syncthreads();
    const int u = *s_unit;
    if (u >= 768) break;
    const int level = 31 - u / 24, w = u % 24;
    if (w < 8) attn_unit<1>(p, L, w, level, lds);
    else if (w < 16) attn_unit<0>(p, L, w - 8, 2 * level + 1, lds);
    else attn_unit<0>(p, L, w - 16, 2 * level, lds);
  }
}


template <class F>
DI void run_gemm(PG8_LAS unsigned char* lds, const bf16_t* A, const bf16_t* Bt, int M, int N, int K, const int* texp, size_t bstride, F f) {
  pg8::Gemm g{A, Bt, M, N, K, texp, bstride};
  pg8::StaticOrder S; S.init(M, N, (int)gridDim.x, obid());
  pg8::EpiFn<F> E{f};
  pg8::gemm_phase<pg8::EpiFn<F>, pg8::StaticOrder, true, true>(lds, g, S, E);
}
DI void st_bf16x4(bf16_t* dst, const f32x4& v) { u32x2 w; w[0] = pk2(v[0], v[1]); w[1] = pk2(v[2], v[3]); *(u32x2*)dst = w; }
DI f32x4 ld_bf16x4(const bf16_t* src) { const u32x2 w = *(const u32x2*)src; return (f32x4){__uint_as_float(w[0] << 16), __uint_as_float(w[0] & 0xffff0000u), __uint_as_float(w[1] << 16), __uint_as_float(w[1] & 0xffff0000u)}; }

DI void phase_u(const Params& p, int L, PG8_LAS unsigned char* lds) {
  bf16_t* u = (bf16_t*)(p.ws + O_R + R_U);
  run_gemm(lds, (const bf16_t*)(p.ws + O_HB), (const bf16_t*)(p.ws + O_WIN + L * SZ_WIN), NTOK, UN, DM, nullptr, 0,
           [=](int row, int col, const f32x4& v) { if (col < UC) st_bf16x4(u + (size_t)row * UC + col, v); });
}
DI void phase_proj(const Params& p, int L, PG8_LAS unsigned char* lds) {
  bf16_t* PJ = (bf16_t*)(p.ws + O_R + R_PJ);
  run_gemm(lds, (const bf16_t*)(p.ws + O_R + R_Y), (const bf16_t*)(p.ws + O_WBO) + (size_t)L * 4 * 1024 * 256, 4 * NTOK, 1024, 256,
           (const int*)(p.ws + O_SMALL + SM_TEXP4), (size_t)1024 * 256 * 2,
           [=](int row, int col, const f32x4& v) { st_bf16x4(PJ + (size_t)(row & (NTOK - 1)) * 4096 + (row >> 14) * 1024 + col, v); });
}
DI void phase_gate(const Params& p, int L, PG8_LAS unsigned char* lds) {
  bf16_t* PJ = (bf16_t*)(p.ws + O_R + R_PJ);
  run_gemm(lds, (const bf16_t*)(p.ws + O_HB), (const bf16_t*)(p.ws + O_WIN + L * SZ_WIN) + (size_t)OFF_G * DM, NTOK, 4096, DM, nullptr, 0,
           [=](int row, int col, const f32x4& v) {
             bf16_t* q = PJ + (size_t)row * 4096 + col;
             const f32x4 pj = ld_bf16x4(q);
             f32x4 o; o[0] = sigmoidf_(v[0]) * pj[0]; o[1] = sigmoidf_(v[1]) * pj[1]; o[2] = sigmoidf_(v[2]) * pj[2]; o[3] = sigmoidf_(v[3]) * pj[3];
             st_bf16x4(q, o);
           });
}
DI void phase_bsum(const Params& p) {
  const u32x4* GP = (const u32x4*)(p.ws + O_R + R_PJ); u32x4* M = (u32x4*)(p.ws + O_R + R_M);
  const int gtid = obid() * NTHR + otid(), gsz = gridDim.x * NTHR;
  for (int i = gtid; i < NTOK * 128; i += gsz) {
    const int tok = i >> 7, c8 = i & 127;
    float a[8];
#pragma unroll
    for (int k = 0; k < 8; ++k) a[k] = 0.f;
#pragma unroll
    for (int b = 0; b < 4; ++b) {
      const u32x4 w = GP[(size_t)tok * 512 + b * 128 + c8];
#pragma unroll
      for (int k = 0; k < 4; ++k) { a[2 * k] += __uint_as_float(w[k] << 16); a[2 * k + 1] += __uint_as_float(w[k] & 0xffff0000u); }
    }
    u32x4 o; o[0] = pk2(a[0], a[1]); o[1] = pk2(a[2], a[3]); o[2] = pk2(a[4], a[5]); o[3] = pk2(a[6], a[7]);
    M[i] = o;
  }
}
DI void phase_xadd(const Params& p, const bf16_t* A, const bf16_t* Bt, int K, PG8_LAS unsigned char* lds) {
  float* x = p.x;
  run_gemm(lds, A, Bt, NTOK, DM, K, nullptr, 0, [=](int row, int col, const f32x4& v) { float* xp = x + (size_t)row * DM + col; f32x4 xv = *(f32x4*)xp; xv += v; *(f32x4*)xp = xv; });
}
DI void phase_ffn_up(const Params& p, PG8_LAS unsigned char* lds) {
  bf16_t* T = (bf16_t*)(p.ws + O_R + R_T);
  run_gemm(lds, (const bf16_t*)(p.ws + O_HB), (const bf16_t*)(p.ws + O_FGU), NTOK, 2 * FFD, DM, nullptr, 0,
           [=](int row, int col, const f32x4& v) {
             const float t0 = v[0] * sigmoidf_(v[0]) * v[1], t1 = v[2] * sigmoidf_(v[2]) * v[3];
             *(unsigned*)(T + (size_t)row * FFD + (col >> 1)) = pk2(t0, t1);
           });
}
DI void phase_moe_gather(const Params& p) {
  const int* cnt = (const int*)(p.ws + O_CTL) + CW_MOECNT;
  const int* list = (const int*)(p.ws + O_SMALL + SM_LIST);
  const float* gw = (const float*)(p.ws + O_SMALL + SM_GW);
  int* texp = (int*)(p.ws + O_SMALL + SM_TEXP);
  int* rowtok = (int*)(p.ws + O_SMALL + SM_ROWTOK);
  float* rowgw = (float*)(p.ws + O_SMALL + SM_ROWGW);
  int* slotrow = (int*)(p.ws + O_SMALL + SM_SLOTROW);
  const bf16_t* hb = (const bf16_t*)(p.ws + O_HB);
  bf16_t* xbuf = (bf16_t*)(p.ws + O_XBUF);
  const int lane = otid() & 63, wid = otid() >> 6;
  int c[8];
#pragma unroll
  for (int e = 0; e < 8; ++e) c[e] = cnt[e];
  int total = 0;
#pragma unroll
  for (int e = 0; e < 8; ++e) total += (c[e] + 255) & ~255;
  for (int row = obid() * 8 + wid; row < total; row += gridDim.x * 8) {
    int e = 0, s = 0, o = 0;
#pragma unroll
    for (int i = 0; i < 8; ++i) { const int pc = (c[i] + 255) & ~255; if (row >= o && row < o + pc) { e = i; s = row - o; } o += pc; }
    int ce = 0;
#pragma unroll
    for (int i = 0; i < 8; ++i) if (i == e) ce = c[i];
    const bool valid = s < ce;
    const int tok = valid ? list[(size_t)e * NTOK + s] : -1;
    u32x4 v0 = {0u, 0u, 0u, 0u}, v1 = {0u, 0u, 0u, 0u};
    if (valid) { const u32x4* src = (const u32x4*)(hb + (size_t)tok * DM); v0 = src[lane]; v1 = src[64 + lane]; }
    u32x4* dst = (u32x4*)(xbuf + (size_t)row * DM); dst[lane] = v0; dst[64 + lane] = v1;
    if (lane == 0) { rowtok[row] = tok; rowgw[row] = valid ? gw[(size_t)e * NTOK + s] : 0.f; if ((row & 255) == 0) texp[row >> 8] = e; if (valid) slotrow[(size_t)e * NTOK + s] = row; }
  }
}
DI int moe_rows(const Params& p) {
  const int* cnt = (const int*)(p.ws + O_CTL) + CW_MOECNT;
  int total = 0;
#pragma unroll
  for (int e = 0; e < 8; ++e) total += (cnt[e] + 255) & ~255;
  return total;
}
DI void phase_moe_up(const Params& p, PG8_LAS unsigned char* lds) {
  const int Mp = moe_rows(p);
  bf16_t* T = (bf16_t*)(p.ws + O_T2);
  run_gemm(lds, (const bf16_t*)(p.ws + O_XBUF), (const bf16_t*)(p.ws + O_MGU), Mp, 2 * FFE, DM, (const int*)(p.ws + O_SMALL + SM_TEXP), (size_t)2 * FFE * DM * 2,
           [=](int row, int col, const f32x4& v) {
             const float t0 = v[0] * sigmoidf_(v[0]) * v[1], t1 = v[2] * sigmoidf_(v[2]) * v[3];
             *(unsigned*)(T + (size_t)row * FFE + (col >> 1)) = pk2(t0, t1);
           });
}
DI void phase_moe_down(const Params& p, PG8_LAS unsigned char* lds) {
  const int Mp = moe_rows(p);
  const float* rowgw = (const float*)(p.ws + O_SMALL + SM_ROWGW);
  bf16_t* Y2 = (bf16_t*)(p.ws + O_XBUF);
  run_gemm(lds, (const bf16_t*)(p.ws + O_T2), (const bf16_t*)(p.ws + O_MD), Mp, DM, FFE, (const int*)(p.ws + O_SMALL + SM_TEXP), (size_t)DM * FFE * 2,
           [=](int row, int col, const f32x4& v) { const float w = rowgw[row]; st_bf16x4(Y2 + (size_t)row * DM + col, v * w); });
}
DI void phase_ple_proj(const Params& p, int L, PG8_LAS unsigned char* lds) {
  bf16_t* PJ2 = (bf16_t*)(p.ws + O_R + R_PJ2);
  run_gemm(lds, (const bf16_t*)(p.ws + O_PB), (const bf16_t*)(p.ws + O_PP) + (size_t)L * 1024 * 256, NTOK, DM, 256, nullptr, 0,
           [=](int row, int col, const f32x4& v) { st_bf16x4(PJ2 + (size_t)row * DM + col, v); });
}
DI void phase_ple_gate(const Params& p, int L, PG8_LAS unsigned char* lds) {
  const bf16_t* PJ2 = (const bf16_t*)(p.ws + O_R + R_PJ2);
  float* x = p.x;
  run_gemm(lds, (const bf16_t*)(p.ws + O_HB), (const bf16_t*)(p.ws + O_PG) + (size_t)L * 1024 * 1024, NTOK, DM, DM, nullptr, 0,
           [=](int row, int col, const f32x4& v) {
             const f32x4 pj = ld_bf16x4(PJ2 + (size_t)row * DM + col);
             float* xp = x + (size_t)row * DM + col; f32x4 xv = *(f32x4*)xp;
             xv[0] += sigmoidf_(v[0]) * pj[0]; xv[1] += sigmoidf_(v[1]) * pj[1]; xv[2] += sigmoidf_(v[2]) * pj[2]; xv[3] += sigmoidf_(v[3]) * pj[3];
             *(f32x4*)xp = xv;
           });
}
DI void phase_final(const Params& p) {
  const int lane = otid() & 63, wid = otid() >> 6;
  const float* g = p.in[35];
  for (int row = obid() * 8 + wid; row < NTOK; row += gridDim.x * 8) {
    float* xr = p.x + (size_t)row * DM;
    f32x4 v[4]; float ss = 0.f;
#pragma unroll
    for (int j = 0; j < 4; ++j) { v[j] = *(const f32x4*)(xr + j * 256 + lane * 4); ss += v[j][0] * v[j][0] + v[j][1] * v[j][1] + v[j][2] * v[j][2] + v[j][3] * v[j][3]; }
    ss = wave_sum(ss);
    const float rstd = rsqrtf(ss * (1.0f / 1024.0f) + 1e-6f);
#pragma unroll
    for (int j = 0; j < 4; ++j) { const f32x4 gg = *(const f32x4*)(g + j * 256 + lane * 4); *(f32x4*)(xr + j * 256 + lane * 4) = v[j] * rstd * gg; }
  }
}


constexpr int RING_BYTES = 131072, LDSCTL_OFF = RING_BYTES, MISC_OFF = LDSCTL_OFF + 320, LDS_BYTES = 147456;
static_assert(2 * SCH * RS * 4 + 2 * SCH * 512 * 4 <= RING_BYTES, "scan LDS");

__global__ void __launch_bounds__(NTHR) __attribute__((target("no-packed-fp32-ops"))) fwd_megakernel(Params p) {
  extern __shared__ __attribute__((aligned(16))) unsigned char lds_raw[];
  LAS unsigned char* ldsp = (LAS unsigned char*)lds_raw;
  char* lds = (char*)lds_raw;
  for (int u = threadIdx.x; u < (LDS_BYTES - LDSCTL_OFF) / 4; u += NTHR) ((LAS unsigned*)(ldsp + LDSCTL_OFF))[u] = 0u;
  __syncthreads();
  XcdBarrier bar = xcd_barrier_post((unsigned*)(p.ws + O_CTL) + CW_BAR, (volatile LAS unsigned*)(ldsp + MISC_OFF) + 8);
#define GBAR() xcd_barrier(bar)
  phase0(olaunder(p), lds);
#if PROBE == 3
  GBAR(); phase0(olaunder(p), lds);
#endif
  cg::this_grid().sync();
  GBAR();
#pragma unroll 1
  for (int L = 0; L < 2; ++L) {
    norm_phase<false>(olaunder(p), p.in[2] + L * DM, nullptr);
    GBAR();
#if PROBE == 36
    if (L == 0) { norm_phase<false>(olaunder(p), p.in[2] + L * DM, nullptr); GBAR(); norm_phase<false>(olaunder(p), p.in[2] + L * DM, nullptr); GBAR(); norm_phase<false>(olaunder(p), p.in[2] + L * DM, nullptr); GBAR(); norm_phase<false>(olaunder(p), p.in[2] + L * DM, nullptr); GBAR(); }
#endif
#if PROBE == 40
    if (L == 0) { for (int rep = 0; rep < 20; ++rep) GBAR(); }
#endif
    phase_u(olaunder(p), L, ldsp);
    GBAR();
#if PROBE == 31
    if (L == 0) { phase_u(olaunder(p), L, ldsp); GBAR(); }
#endif
    phase_prep2(olaunder(p), L, lds);
    GBAR();
#if PROBE == 2
    if (L == 0) { phase_prep2(olaunder(p), L, lds); GBAR(); }
#endif
#if PROBE == 21
    if (L == 0) { phase_prep<1>(olaunder(p), L, lds); GBAR(); }
#endif
#if PROBE == 22
    if (L == 0) { phase_prep<2>(olaunder(p), L, lds); GBAR(); }
#endif
#if PROBE == 23
    if (L == 0) { phase_prep<4>(olaunder(p), L, lds); GBAR(); }
#endif
    phase_mix(olaunder(p), L, lds, L);
    GBAR();
#if PROBE == 1
    if (L == 0) { phase_mix(olaunder(p), L, lds, 2); GBAR(); }
#endif
#if PROBE == 5
    if (L == 0) { phase_mix_attn_only(olaunder(p), L, lds, 2); GBAR(); }
#endif
    phase_scanpost(olaunder(p), L);
    GBAR();
#if PROBE == 38
    if (L == 0) { phase_scanpost(olaunder(p), L); GBAR(); phase_scanpost(olaunder(p), L); GBAR(); }
#endif
    phase_proj(olaunder(p), L, ldsp);
    GBAR();
#if PROBE == 35
    if (L == 0) { phase_proj(olaunder(p), L, ldsp); GBAR(); }
#endif
    phase_gate(olaunder(p), L, ldsp);
    GBAR();
    phase_bsum(olaunder(p));
    GBAR();
#if PROBE == 37
    if (L == 0) { phase_bsum(olaunder(p)); GBAR(); phase_bsum(olaunder(p)); GBAR(); }
#endif
    phase_xadd(olaunder(p), (const bf16_t*)(p.ws + O_R + R_M), (const bf16_t*)(p.ws + O_WOUT) + (size_t)L * 1024 * 1024, DM, ldsp);
    GBAR();
    if (L == 0) {
      norm_phase<false>(olaunder(p), p.in[3] + L * DM, nullptr);
      GBAR();
      phase_ffn_up(olaunder(p), ldsp);
      GBAR();
#if PROBE == 32
      phase_ffn_up(olaunder(p), ldsp); GBAR();
#endif
      phase_xadd(olaunder(p), (const bf16_t*)(p.ws + O_R + R_T), (const bf16_t*)(p.ws + O_FD), FFD, ldsp);
      GBAR();
    } else {
      norm_phase<true>(olaunder(p), p.in[3] + L * DM, p.in[29]);
      GBAR();
      phase_moe_gather(olaunder(p));
      GBAR();
      phase_moe_up(olaunder(p), ldsp);
      GBAR();
#if PROBE == 33
      phase_moe_up(olaunder(p), ldsp); GBAR();
#endif
#if PROBE == 34
      phase_moe_down(olaunder(p), ldsp); GBAR();
#endif
      phase_moe_down(olaunder(p), ldsp);
      GBAR();
    }
    if (L == 0) norm_phase<false>(olaunder(p), p.in[4] + L * DM, nullptr);
    else norm_phase<false, true>(olaunder(p), p.in[4] + L * DM, nullptr);
    convert_p(olaunder(p), L);
    GBAR();
    phase_ple_proj(olaunder(p), L, ldsp);
    GBAR();
    phase_ple_gate(olaunder(p), L, ldsp);
    GBAR();
  }
  phase_final(olaunder(p));
}

extern "C" void kernel_launch(void* const* d_in, const int* in_sizes, int n_in, void* d_out, int out_size,
                              void* d_ws, size_t ws_size, hipStream_t stream) {
  static int grid_blocks = 0;
  if (grid_blocks == 0) {
    int dev = 0, cus = 0, per_cu = 0;
    (void)hipGetDevice(&dev);
    (void)hipDeviceGetAttribute(&cus, hipDeviceAttributeMultiprocessorCount, dev);
    if (hipFuncSetAttribute((const void*)fwd_megakernel, hipFuncAttributeMaxDynamicSharedMemorySize, LDS_BYTES) != hipSuccess) { fprintf(stderr, "hipFuncSetAttribute failed\n"); grid_blocks = -1; return; }
    (void)hipOccupancyMaxActiveBlocksPerMultiprocessor(&per_cu, (const void*)fwd_megakernel, NTHR, LDS_BYTES);
    if (per_cu < 1) { fprintf(stderr, "occupancy query says %d blocks per CU\n", per_cu); grid_blocks = -1; return; }
    grid_blocks = cus;
  }
  if (grid_blocks < 0) return;
  if (ws_size < WS_NEED) { fprintf(stderr, "workspace too small: %zu < %zu\n", ws_size, (size_t)WS_NEED); return; }
  (void)hipMemsetAsync((char*)d_ws + O_CTL, 0, CTL_BYTES, stream);
  Params p{};
  for (int i = 0; i < 36; ++i) p.in[i] = (const float*)d_in[i];
  p.x = (float*)d_out;
  p.ws = (char*)d_ws;
  void* args[] = {&p};
  hipError_t e = hipLaunchCooperativeKernel((void*)fwd_megakernel, dim3(grid_blocks), dim3(NTHR), args, LDS_BYTES, stream);
  if (e != hipSuccess) fprintf(stderr, "cooperative launch failed: %s (grid %d)\n", hipGetErrorString(e), grid_blocks);
}
```

```cpp
#include <hip/hip_runtime.h>
#include <hip/hip_cooperative_groups.h>
#include <cstdio>
#include <cstdint>
namespace cg = cooperative_groups;

typedef unsigned short bf16_t;
typedef short bf16x8 __attribute__((ext_vector_type(8)));
typedef short s16x4 __attribute__((ext_vector_type(4)));
typedef float f32x4 __attribute__((ext_vector_type(4)));
typedef float f32x2 __attribute__((ext_vector_type(2)));
typedef float f32x16 __attribute__((ext_vector_type(16)));
typedef unsigned u32x4 __attribute__((ext_vector_type(4)));
typedef unsigned u32x2 __attribute__((ext_vector_type(2)));
typedef __bf16 bf16x2_t __attribute__((ext_vector_type(2)));

#define DI __device__ __forceinline__

#ifndef PROBE
#define PROBE 0
#endif
constexpr int NTOK = 16384, DM = 1024, SEQ = 8192, NBH = 8;
constexpr int INC = 7692, UC = 3600, UN = 3840;
constexpr int OFF_B = 1024, OFF_C = 1792, OFF_D = 2564, OFF_G = 3596;
constexpr int FFD = 2816, FFE = 3584, NEXP = 8;
constexpr int NTHR = 512;
constexpr int MOE_ROWS = 34816;

constexpr size_t al256(size_t x) { return (x + 255) & ~(size_t)255; }
constexpr size_t O_CTL = 0, CTL_BYTES = 1u << 20;
constexpr int CW_BAR = 4096;
constexpr int CW_QCTR = 16384;
constexpr int CW_MOECNT = 16384 + 256;
constexpr size_t O_MGU = CTL_BYTES;
constexpr size_t O_MD = O_MGU + (size_t)NEXP * 2 * FFE * 1024 * 2;
constexpr size_t O_PG = O_MD + (size_t)NEXP * 1024 * FFE * 2;
constexpr size_t O_PP = O_PG + (size_t)2 * 1024 * 1024 * 2;
constexpr size_t O_PB = O_PP + (size_t)2 * 1024 * 256 * 2;
constexpr size_t O_LORA = O_PB + (size_t)NTOK * 256 * 2;
constexpr size_t SZ_LORA = (size_t)256 * 256 * 2;
constexpr size_t O_HB = O_LORA + 2 * SZ_LORA;
constexpr size_t O_SMALL = O_HB + (size_t)NTOK * DM * 2;
constexpr size_t SM_LIST = 0;
constexpr size_t SM_GW = SM_LIST + (size_t)NEXP * NTOK * 4;
constexpr size_t SM_RK = SM_GW + (size_t)NEXP * NTOK * 4;
constexpr size_t SM_LOGF = SM_RK + (size_t)NTOK * 4 * 4;
constexpr size_t SM_GBETA = SM_LOGF + (size_t)NBH * SEQ * 4;
constexpr size_t SM_GA = SM_GBETA + (size_t)NBH * SEQ * 4;
constexpr size_t SM_TEXP = SM_GA + (size_t)NBH * SEQ * 4;
constexpr size_t SM_ROWTOK = SM_TEXP + 1024;
constexpr size_t SM_ROWGW = SM_ROWTOK + (size_t)MOE_ROWS * 4;
constexpr size_t SM_TEXP4 = SM_ROWGW + (size_t)MOE_ROWS * 4;
constexpr size_t SM_TOKSLOT = SM_TEXP4 + 1024;
constexpr size_t SM_SLOTROW = SM_TOKSLOT + (size_t)NTOK * 2 * 4;
constexpr size_t SZ_SMALL = al256(SM_SLOTROW + (size_t)NEXP * NTOK * 4);
constexpr size_t O_ERA = O_SMALL + SZ_SMALL;
constexpr size_t SZ_WIN = al256((size_t)INC * DM * 2);
constexpr size_t O_WIN = O_ERA;
constexpr size_t O_WBO = O_WIN + 2 * SZ_WIN;
constexpr size_t O_WOUT = O_WBO + (size_t)2 * 4 * 1024 * 256 * 2;
constexpr size_t O_FGU = O_WOUT + (size_t)2 * 1024 * 1024 * 2;
constexpr size_t O_FD = O_FGU + (size_t)2 * FFD * 1024 * 2;
constexpr size_t O_R = O_FD + (size_t)1024 * FFD * 2;
constexpr size_t SZ_BH = (size_t)NBH * SEQ * 64 * 2;
constexpr size_t R_U = 0;
constexpr size_t R_Y = 0;
constexpr size_t R_PJ = (size_t)NTOK * DM * 2;
constexpr size_t R_M = R_PJ + (size_t)NTOK * 4096 * 2;
constexpr size_t SZ_U = (size_t)NTOK * UC * 2;
constexpr size_t R_OSCAN = (size_t)NTOK * DM * 2;
constexpr size_t R_CHK = R_OSCAN + (size_t)2 * NBH * SEQ * 64 * 4;
constexpr size_t CHK_SZ = (size_t)2 * NBH * (SEQ / 64) * 4096 * 2;
static_assert(R_CHK + 3 * CHK_SZ <= SZ_U, "chunk operators inside dead u");
constexpr size_t R_RWA = R_U + SZ_U, R_RWB = R_RWA + SZ_BH, R_RWK = R_RWB + SZ_BH, R_RWR = R_RWK + SZ_BH, R_RWV = R_RWR + SZ_BH;
constexpr size_t R_RWW = R_RWV + SZ_BH;
constexpr size_t R_GQ = R_RWW + 2 * SZ_BH, R_GK = R_GQ + SZ_BH, R_GV = R_GK + SZ_BH;
constexpr size_t R_QD = R_GV + SZ_BH, R_KD = R_QD + SZ_BH, R_VD = R_KD + SZ_BH, R_QF = R_VD + SZ_BH, R_KF = R_QF + SZ_BH, R_VF = R_KF + SZ_BH;
constexpr size_t R_AUXG = R_VF + SZ_BH;
constexpr size_t R_AUXGATE = R_AUXG + (size_t)NTOK * 256 * 2;
constexpr size_t R_END_MIX = R_AUXGATE + (size_t)NTOK * 256 * 2;
static_assert(R_M + (size_t)NTOK * DM * 2 <= R_END_MIX, "M inside region R");
constexpr size_t R_T = 0;
constexpr size_t R_PJ2 = 0;
constexpr size_t O_T2 = O_ERA;
constexpr size_t O_XBUF = O_T2 + (size_t)MOE_ROWS * FFE * 2;
constexpr size_t ERA_B_END = O_XBUF + (size_t)MOE_ROWS * DM * 2;
constexpr size_t ERA_A_END = O_R + R_END_MIX;
constexpr size_t WS_NEED = ERA_A_END > ERA_B_END ? ERA_A_END : ERA_B_END;

struct Params {
  const float* in[36];
  float* x;
  char* ws;
};

DI float bf2f(bf16_t b) { return __uint_as_float(((unsigned)b) << 16); }
DI bf16_t f2bf(float x) { unsigned u = __float_as_uint(x); u += 0x7fffu + ((u >> 16) & 1u); return (bf16_t)(u >> 16); }
DI unsigned pk2(float lo, float hi) { f32x2 v = {lo, hi}; bf16x2_t b = __builtin_convertvector(v, bf16x2_t); return __builtin_bit_cast(unsigned, b); }
DI float sigmoidf_(float x) { return 1.0f / (1.0f + __expf(-x)); }
DI float wave_sum(float x) {
  x += __int_as_float(__builtin_amdgcn_update_dpp(0, __float_as_int(x), 0xB1, 0xF, 0xF, true));
  x += __int_as_float(__builtin_amdgcn_update_dpp(0, __float_as_int(x), 0x4E, 0xF, 0xF, true));
  x += __int_as_float(__builtin_amdgcn_update_dpp(0, __float_as_int(x), 0x141, 0xF, 0xF, true));
  x += __int_as_float(__builtin_amdgcn_update_dpp(0, __float_as_int(x), 0x140, 0xF, 0xF, true));
  { auto rr = __builtin_amdgcn_permlane16_swap(__float_as_uint(x), __float_as_uint(x), false, false); x = __uint_as_float(rr[0]) + __uint_as_float(rr[1]); }
  { auto rr = __builtin_amdgcn_permlane32_swap(__float_as_uint(x), __float_as_uint(x), false, false); x = __uint_as_float(rr[0]) + __uint_as_float(rr[1]); }
  return x;
}
DI int crow(int r, int hi) { return (r & 3) + 8 * (r >> 2) + 4 * hi; }
DI int otid() { int t = threadIdx.x; asm volatile("" : "+v"(t)); return t; }
DI int obid() { int t = blockIdx.x; asm volatile("" : "+s"(t)); return t; }
DI Params olaunder(const Params& p) { Params q = p; size_t o0 = 0, o1 = 0; asm volatile("" : "+s"(o0), "+s"(o1)); q.ws = p.ws + o0; q.x = p.x + o1; return q; }


#define GAS __attribute__((address_space(1)))
#define LAS __attribute__((address_space(3)))
typedef GAS unsigned gu32;
#define RLX_AGENT __ATOMIC_RELAXED, __HIP_MEMORY_SCOPE_AGENT
namespace pg8 {
#define PG8_LAS __attribute__((address_space(3)))
typedef unsigned short bf16_t;
typedef short bf16x8 __attribute__((ext_vector_type(8)));
typedef float f32x4 __attribute__((ext_vector_type(4)));
typedef unsigned u32x4 __attribute__((ext_vector_type(4)));
constexpr int BM = 256, BK = 64, HALF = 128, HTB = HALF * BK * 2  , STAGE_BYTES = 8 * HTB, NXCD = 8, WGM = 8;

__host__ __device__ __forceinline__ int lds_byte(int r, int c) { const int st = (r >> 4) * 2 + (c >> 5), rr = r & 15, cc = c & 31, ob = rr * 64 + cc * 2; return st * 1024 + (ob ^ (((ob >> 9) & 1) << 5)); }
__host__ __device__ __forceinline__ void stage_rc(int b, int& R, int& C) { const int st = b / 1024, sb = b % 1024, swz = sb ^ (((sb >> 9) & 1) << 5); R = (st >> 1) * 16 + swz / 64; C = (st & 1) * 32 + (swz % 64) / 2; }
__host__ __device__ __forceinline__ int perm32(int rho) { const int n = rho >> 4, i = rho & 15; return 8 * (i >> 2) + 4 * n + (i & 3); }

struct Unit { int pm, pn; };
struct Gemm { const bf16_t* A; const bf16_t* Bt; int M, N, K; const int* texp; size_t bstride;
  __device__ __forceinline__ size_t boff(int pm) const { return texp ? (size_t)texp[pm] * bstride : (size_t)0; } };

struct StaticOrder {
    int nM, nN, nwg, G, c;
    __host__ __device__ void init(int M, int N, int G_, int c_) { nM = M / BM; nN = N / BM; nwg = nM * nN; G = G_; c = c_; }
    __host__ __device__ bool next(int i, Unit& u) const {
        const long L = (long)i * G + c; if (L >= nwg) return false;
        int wgid = (int)L; { const int q = nwg / NXCD, r = nwg % NXCD, xcd = wgid % NXCD, off = wgid / NXCD; wgid = (xcd < r ? xcd * (q + 1) : r * (q + 1) + (xcd - r) * q) + off; }
        const int nig = WGM * nN, gid = wgid / nig, fm = gid * WGM, gsz = (nM - fm) < WGM ? (nM - fm) : WGM;
        u.pm = fm + ((wgid % nig) % gsz); u.pn = (wgid % nig) / gsz; return true;
    }
    __device__ __forceinline__ void a_ready(const Unit&) const {}
    __device__ __forceinline__ void done(const Unit&) const {}
};

template <class F> struct EpiFn {
    static constexpr bool PERM = false, AFTER_DRAIN = false;
    F f;
    __device__ __forceinline__ void operator()(const f32x4 (&acc)[2][2][4][2], const Unit& u, int wr, int wc, int fr, int fq) const {
#pragma unroll
        for (int ai = 0; ai < 2; ++ai)
#pragma unroll
            for (int m = 0; m < 4; ++m)
#pragma unroll
                for (int bj = 0; bj < 2; ++bj)
#pragma unroll
                    for (int n = 0; n < 2; ++n)
                        f(u.pm * BM + ai * HALF + wr * 64 + m * 16 + fr, u.pn * BM + bj * HALF + wc * 32 + n * 16 + 4 * fq, acc[ai][bj][m][n]);
    }
};
template <class Epi, class Sched, bool ALIGN_EPI = false, bool SP2 = false>
__device__ __forceinline__ void gemm_phase(PG8_LAS unsigned char* lds, const Gemm g, const Sched& S, const Epi& E) {
    const int tid = otid(), wid = __builtin_amdgcn_readfirstlane(tid >> 6), lane = tid & 63, wr = wid >> 2, wc = wid & 3, fr = lane & 15, fq = lane >> 4;
    const int K = g.K, nt = K / BK;
    unsigned voffA[2], voffB[2];
#pragma unroll
    for (int i = 0; i < 2; ++i) { int R, C; stage_rc(tid * 16 + i * 8192, R, C); const int Rb = Epi::PERM ? ((R & ~31) + perm32(R & 31)) : R;
        voffA[i] = (unsigned)(R * K + C) * 2u; voffB[i] = (unsigned)(Rb * K + C) * 2u; }
    const size_t kstep = (size_t)(BK * 2);
    const size_t hstep = (size_t)HALF * K * 2;
    const size_t tstep = 2 * hstep;
    const unsigned ldsw = (unsigned)wid * 1024u;
    const int aoff = lds_byte(wr * 64 + fr, fq * 8), boff = lds_byte(wc * 32 + fr, fq * 8);
#define PG8_SA(b, h) (((b) * 2 + (h)) * HTB)
#define PG8_SB(b, h) ((4 + (b) * 2 + (h)) * HTB)
#define PG8_STAGE(bufoff, gbase, voff) do { _Pragma("unroll") for (int _i = 0; _i < 2; ++_i) \
        __builtin_amdgcn_global_load_lds((const unsigned*)((const char*)(gbase) + (voff)[_i]), (PG8_LAS unsigned*)(lds + (bufoff) + ldsw + _i * 8192), 16, 0, 0); } while (0)
#define PG8_LDA(dst, b, h) do { _Pragma("unroll") for (int m = 0; m < 4; ++m) _Pragma("unroll") for (int k = 0; k < 2; ++k) dst[m][k] = *(const PG8_LAS bf16x8*)(lds + PG8_SA(b, h) + aoff + m * 2048 + k * 1024); } while (0)
#define PG8_LDB(dst, b, h) do { _Pragma("unroll") for (int n = 0; n < 2; ++n) _Pragma("unroll") for (int k = 0; k < 2; ++k) dst[n][k] = *(const PG8_LAS bf16x8*)(lds + PG8_SB(b, h) + boff + n * 2048 + k * 1024); } while (0)
#define PG8_MMA(ai, bj, At, Bt) do { __builtin_amdgcn_s_setprio(1); _Pragma("unroll") for (int m = 0; m < 4; ++m) _Pragma("unroll") for (int n = 0; n < 2; ++n) _Pragma("unroll") for (int k = 0; k < 2; ++k) \
        acc[ai][bj][m][n] = __builtin_amdgcn_mfma_f32_16x16x32_bf16(Bt[n][k], At[m][k], acc[ai][bj][m][n], 0, 0, 0); __builtin_amdgcn_s_setprio(0); } while (0)
#define PG8_WAIT_V(n) asm volatile("s_waitcnt vmcnt(" #n ")" ::: "memory")
#define PG8_WAIT_L(n) asm volatile("s_waitcnt lgkmcnt(" #n ")" ::: "memory")
#define PG8_BAR __builtin_amdgcn_s_barrier()
#define PG8_SCHED __builtin_amdgcn_sched_barrier(0)
    Unit cur, nxt; int ui = 0;
    if (!S.next(0, cur)) return;
    f32x4 acc[2][2][4][2];
#pragma unroll
    for (int a = 0; a < 2; ++a)
#pragma unroll
        for (int b = 0; b < 2; ++b)
#pragma unroll
            for (int m = 0; m < 4; ++m)
#pragma unroll
                for (int n = 0; n < 2; ++n) acc[a][b][m][n] = (f32x4){0.f, 0.f, 0.f, 0.f};
    bf16x8 At[4][2], B0[2][2], B1[2][2];
    const char* cA = (const char*)g.A + (size_t)cur.pm * tstep; const char* cB = (const char*)g.Bt + g.boff(cur.pm) + (size_t)cur.pn * tstep;
    S.a_ready(cur);
    if constexpr (SP2) {
        PG8_STAGE(PG8_SB(0, 0), cB, voffB); PG8_STAGE(PG8_SB(0, 1), cB + hstep, voffB); PG8_STAGE(PG8_SA(0, 0), cA, voffA); PG8_STAGE(PG8_SA(0, 1), cA + hstep, voffA);
        if (wr == 1) PG8_BAR;
        PG8_WAIT_V(2); PG8_BAR;
        PG8_STAGE(PG8_SB(1, 0), cB + kstep, voffB); PG8_STAGE(PG8_SA(1, 0), cA + kstep, voffA); PG8_STAGE(PG8_SB(1, 1), cB + hstep + kstep, voffB);
        PG8_WAIT_V(6); PG8_BAR;
    } else {
        PG8_STAGE(PG8_SB(0, 0), cB, voffB); PG8_STAGE(PG8_SA(0, 0), cA, voffA); PG8_STAGE(PG8_SB(0, 1), cB + hstep, voffB); PG8_STAGE(PG8_SA(0, 1), cA + hstep, voffA);
        if (wr == 1) PG8_BAR;
        PG8_WAIT_V(4); PG8_BAR;
        PG8_STAGE(PG8_SB(1, 0), cB + kstep, voffB); PG8_STAGE(PG8_SA(1, 0), cA + kstep, voffA); PG8_STAGE(PG8_SB(1, 1), cB + hstep + kstep, voffB);
        PG8_WAIT_V(6); PG8_BAR;
    }
    for (;;) {
        const bool has_next = S.next(ui + 1, nxt);
        const char* nA = has_next ? (const char*)g.A + (size_t)nxt.pm * tstep : cA; const char* nB = has_next ? (const char*)g.Bt + g.boff(nxt.pm) + (size_t)nxt.pn * tstep : cB;
        for (int t = 0; t < nt; t += 2) {
            const bool last = (t == nt - 2);
            const char* a1 = cA + (size_t)(t + 1) * kstep;
            const char* a2 = last ? nA : cA + (size_t)(t + 2) * kstep; const char* b2 = last ? nB : cB + (size_t)(t + 2) * kstep;
            const char* a3 = a2 + kstep; const char* b3 = b2 + kstep;
            if (last && has_next) S.a_ready(nxt);
            if constexpr (SP2) {
            PG8_LDB(B0, 0, 0); PG8_LDB(B1, 0, 1); PG8_SCHED; PG8_LDA(At, 0, 0); PG8_STAGE(PG8_SA(1, 1), a1 + hstep, voffA);
            PG8_WAIT_V(8); PG8_WAIT_L(0); PG8_BAR; PG8_MMA(0, 0, At, B0); PG8_MMA(0, 1, At, B1); PG8_BAR; PG8_SCHED;
            PG8_LDA(At, 0, 1); PG8_STAGE(PG8_SB(0, 0), b2, voffB); PG8_STAGE(PG8_SB(0, 1), b2 + hstep, voffB); PG8_STAGE(PG8_SA(0, 0), a2, voffA);
            PG8_WAIT_V(8); PG8_WAIT_L(0); PG8_BAR; PG8_MMA(1, 0, At, B0); PG8_MMA(1, 1, At, B1); PG8_BAR; PG8_SCHED;
            PG8_LDB(B0, 1, 0); PG8_LDB(B1, 1, 1); PG8_SCHED; PG8_LDA(At, 1, 0); PG8_STAGE(PG8_SA(0, 1), a2 + hstep, voffA);
            PG8_WAIT_V(8); PG8_WAIT_L(0); PG8_BAR; PG8_MMA(0, 0, At, B0); PG8_MMA(0, 1, At, B1); PG8_BAR; PG8_SCHED;
            PG8_LDA(At, 1, 1); PG8_STAGE(PG8_SB(1, 0), b3, voffB); PG8_STAGE(PG8_SB(1, 1), b3 + hstep, voffB); PG8_STAGE(PG8_SA(1, 0), a3, voffA);
            PG8_WAIT_V(8); PG8_WAIT_L(0); PG8_BAR; PG8_MMA(1, 0, At, B0); PG8_MMA(1, 1, At, B1); PG8_BAR; PG8_SCHED;
            } else {
            PG8_LDB(B0, 0, 0); PG8_SCHED; PG8_LDA(At, 0, 0); PG8_STAGE(PG8_SA(1, 1), a1 + hstep, voffA);
            PG8_WAIT_L(8); PG8_BAR; PG8_WAIT_L(0); PG8_MMA(0, 0, At, B0); PG8_BAR; PG8_SCHED;
            PG8_LDB(B1, 0, 1); PG8_STAGE(PG8_SB(0, 0), b2, voffB);
            PG8_BAR; PG8_WAIT_L(0); PG8_MMA(0, 1, At, B1); PG8_BAR;
            PG8_LDA(At, 0, 1); PG8_STAGE(PG8_SA(0, 0), a2, voffA);
            PG8_BAR; PG8_WAIT_L(0); PG8_MMA(1, 0, At, B0); PG8_BAR; PG8_SCHED;
            PG8_STAGE(PG8_SB(0, 1), b2 + hstep, voffB);
            PG8_WAIT_V(6); PG8_BAR; PG8_MMA(1, 1, At, B1); PG8_BAR;
            PG8_LDB(B0, 1, 0); PG8_SCHED; PG8_LDA(At, 1, 0); PG8_STAGE(PG8_SA(0, 1), a2 + hstep, voffA);
            PG8_WAIT_L(8); PG8_BAR; PG8_WAIT_L(0); PG8_MMA(0, 0, At, B0); PG8_BAR; PG8_SCHED;
            PG8_LDB(B1, 1, 1); PG8_STAGE(PG8_SB(1, 0), b3, voffB);
            PG8_BAR; PG8_WAIT_L(0); PG8_MMA(0, 1, At, B1); PG8_BAR;
            PG8_LDA(At, 1, 1); PG8_STAGE(PG8_SA(1, 0), a3, voffA);
            PG8_BAR; PG8_WAIT_L(0); PG8_MMA(1, 0, At, B0); PG8_BAR; PG8_SCHED;
            PG8_STAGE(PG8_SB(1, 1), b3 + hstep, voffB);
            PG8_WAIT_V(6); PG8_BAR; PG8_MMA(1, 1, At, B1); PG8_BAR;
            }
        }
        if constexpr (ALIGN_EPI) { if (wr == 0) PG8_BAR; }
        if constexpr (!Epi::AFTER_DRAIN) { E(acc, cur, wr, wc, fr, fq); S.done(cur); }
        if (!has_next) break;
#pragma unroll
        for (int a = 0; a < 2; ++a)
#pragma unroll
            for (int b = 0; b < 2; ++b)
#pragma unroll
                for (int m = 0; m < 4; ++m)
#pragma unroll
                    for (int n = 0; n < 2; ++n) acc[a][b][m][n] = (f32x4){0.f, 0.f, 0.f, 0.f};
        cur = nxt; cA = nA; cB = nB; ++ui;
        if constexpr (ALIGN_EPI) { if (wr == 1) PG8_BAR; }
    }
    PG8_WAIT_V(0);
    if constexpr (!ALIGN_EPI) { if (wr == 0) PG8_BAR; }
    PG8_BAR;
    if constexpr (Epi::AFTER_DRAIN) { E.fused(acc, cur, wr, wc, fr, fq, lds, wid, lane); S.done(cur); }
#undef PG8_SA
#undef PG8_SB
#undef PG8_STAGE
#undef PG8_LDA
#undef PG8_LDB
#undef PG8_MMA
#undef PG8_WAIT_V
#undef PG8_WAIT_L
#undef PG8_BAR
#undef PG8_SCHED
}
}

#define XB_TMO      128
#define XB_XCNT(j)  (256  + 64 * (j))
#define XB_XSUB(j)  (1280 + 64 * (j))
#define XB_XGEN(j)  (2304 + 64 * (j))
#define XB_TOP      3328
#define XB_TOPGEN   3392
#define XCD_BAR_WORDS 3456
#define XB_SPIN_CAP (1u << 18)

__device__ __forceinline__ unsigned xb_ld(unsigned* p)              { return __hip_atomic_load(p, __ATOMIC_RELAXED, __HIP_MEMORY_SCOPE_AGENT); }
__device__ __forceinline__ unsigned xb_add(unsigned* p, unsigned v) { return __hip_atomic_fetch_add(p, v, __ATOMIC_RELAXED, __HIP_MEMORY_SCOPE_AGENT); }
__device__ __forceinline__ unsigned xb_xcc_id() { return (unsigned)__builtin_amdgcn_s_getreg((3 << 11) | 20) & 0xFu; }
#define XB_SPIN(cond, bar) do { unsigned _sp = 0; while (cond) { __builtin_amdgcn_s_sleep(1); \
    if ((++_sp & 255u) == 0u) { if (xb_ld(&(bar)[XB_TMO])) break; if (_sp > XB_SPIN_CAP) { atomicAdd(&(bar)[XB_TMO], 1u); break; } } } } while (0)

struct XcdBarrier {
    unsigned* bar; unsigned x;
    volatile LAS unsigned* st;
};

__device__ __forceinline__ XcdBarrier xcd_barrier_post(unsigned* bar, volatile LAS unsigned* st) {
    XcdBarrier b; b.bar = bar; b.x = xb_xcc_id(); b.st = st;
    if (threadIdx.x == 0) (void)xb_add(&bar[XB_XCNT(b.x)], 1u);
    return b;
}
__device__ __forceinline__ void xcd_barrier_complete(unsigned* bar, unsigned x, unsigned& nloc, unsigned& nx) {
    const unsigned G = gridDim.x * gridDim.y * gridDim.z;
    unsigned sum, cnt, mine, sp = 0u;
    for (;;) {
        sum = 0u; cnt = 0u; mine = 0u;
#pragma unroll
        for (unsigned j = 0; j < 16; ++j) { const unsigned c = xb_ld(&bar[XB_XCNT(j)]); sum += c; cnt += (c > 0u) ? 1u : 0u; mine = (j == x) ? c : mine; }
        if (sum == G) break;
        __builtin_amdgcn_s_sleep(1);
        if ((++sp & 255u) == 0u) { if (xb_ld(&bar[XB_TMO])) break; if (sp > XB_SPIN_CAP) { atomicAdd(&bar[XB_TMO], 1u); break; } }
    }
    nloc = mine > 0u ? mine : 1u; nx = cnt > 0u ? cnt : 1u;
}

__device__ __forceinline__ void xcd_barrier(const XcdBarrier& b) {
    asm volatile("s_waitcnt vmcnt(0)" ::: "memory");
    __syncthreads();
    if (threadIdx.x == 0) {
        unsigned* bar = b.bar; unsigned bx_ = b.x;
        asm volatile("" : "+s"(bar), "+s"(bx_));
        __builtin_amdgcn_s_waitcnt(0);
        unsigned nloc = b.st[0], nx = b.st[1];
        if (nloc == 0u) { xcd_barrier_complete(bar, bx_, nloc, nx); b.st[0] = nloc; b.st[1] = nx; }
        const unsigned old = xb_add(&bar[XB_XSUB(bx_)], 1u);
        const unsigned gen = old / nloc;
        if (old + 1u == (gen + 1u) * nloc) {
            __builtin_amdgcn_fence(__ATOMIC_RELEASE, "agent");
            asm volatile("s_waitcnt vmcnt(0)" ::: "memory");
            const unsigned og = xb_add(&bar[XB_TOP], 1u);
            const unsigned tg = og / nx;
            if (og + 1u == (tg + 1u) * nx) xb_add(&bar[XB_TOPGEN], 1u);
            else XB_SPIN(xb_ld(&bar[XB_TOPGEN]) == tg, bar);
            __builtin_amdgcn_fence(__ATOMIC_ACQUIRE, "agent");
            xb_add(&bar[XB_XGEN(bx_)], 1u);
            asm volatile("s_waitcnt vmcnt(0)" ::: "memory");
        } else {
            XB_SPIN(xb_ld(&bar[XB_XGEN(bx_)]) == gen, bar);
            __builtin_amdgcn_fence(__ATOMIC_ACQUIRE, "agent");
            asm volatile("s_waitcnt vmcnt(0)" ::: "memory");
        }
    }
    __syncthreads();
}

DI void transpose_tile(const float* __restrict__ src, int K, int N, bf16_t* __restrict__ dst, int rmul, int radd, int t, float* tl, int tid) {
  const int tn = (N + 63) / 64;
  const int k0 = (t / tn) * 64, n0 = (t % tn) * 64;
  __syncthreads();
  {
    const int kr = tid >> 3, nc = (tid & 7) * 4;
#pragma unroll
    for (int i = 0; i < 2; ++i) {
      const int n = n0 + nc + 32 * i;
      f32x4 v = {0.f, 0.f, 0.f, 0.f};
      if (n < N) v = *(const f32x4*)(src + (size_t)(k0 + kr) * N + n);
      float* d = tl + kr * 65 + nc + 32 * i;
      d[0] = v[0]; d[1] = v[1]; d[2] = v[2]; d[3] = v[3];
    }
  }
  __syncthreads();
  {
    const int nr = tid >> 3, kc = (tid & 7) * 8, n = n0 + nr;
    if (n < N) {
      u32x4 w;
      w[0] = pk2(tl[(kc + 0) * 65 + nr], tl[(kc + 1) * 65 + nr]);
      w[1] = pk2(tl[(kc + 2) * 65 + nr], tl[(kc + 3) * 65 + nr]);
      w[2] = pk2(tl[(kc + 4) * 65 + nr], tl[(kc + 5) * 65 + nr]);
      w[3] = pk2(tl[(kc + 6) * 65 + nr], tl[(kc + 7) * 65 + nr]);
      *(u32x4*)(dst + ((size_t)n * rmul + radd) * K + k0 + kc) = w;
    }
  }
}
DI void transpose_job(const float* __restrict__ src, int K, int N, bf16_t* __restrict__ dst, int rmul, int radd, char* lds) {
  float* tl = (float*)lds;
  const int nt = (K / 64) * ((N + 63) / 64), tid = otid();
  for (int t = obid(); t < nt; t += gridDim.x) transpose_tile(src, K, N, dst, rmul, radd, t, tl, tid);
}
constexpr int MOE_TILES_PER_JOB = 896, MOE_CONV_TILES = 24 * 896;
DI void moe_convert_tile(const Params& p, int g, float* tl, int tid) {
  const int job = g / MOE_TILES_PER_JOB, t = g % MOE_TILES_PER_JOB, e = job / 3, w = job % 3;
  if (w == 0) transpose_tile(p.in[30] + (size_t)e * 1024 * FFE, 1024, FFE, (bf16_t*)(p.ws + O_MGU) + (size_t)e * 2 * FFE * 1024, 2, 0, t, tl, tid);
  else if (w == 1) transpose_tile(p.in[31] + (size_t)e * 1024 * FFE, 1024, FFE, (bf16_t*)(p.ws + O_MGU) + (size_t)e * 2 * FFE * 1024, 2, 1, t, tl, tid);
  else transpose_tile(p.in[32] + (size_t)e * FFE * 1024, FFE, 1024, (bf16_t*)(p.ws + O_MD) + (size_t)e * 1024 * FFE, 1, 0, t, tl, tid);
}
DI void phase0(const Params& p, char* lds) {
  char* ws = p.ws;
  const int gtid = obid() * NTHR + otid(), gsz = gridDim.x * NTHR;
  if (gtid < 256) ((int*)(ws + O_SMALL + SM_TEXP4))[gtid] = gtid >> 6;
  {
    const f32x4* s = (const f32x4*)p.in[0]; f32x4* d = (f32x4*)p.x;
    for (int i = gtid; i < NTOK * DM / 4; i += gsz) d[i] = s[i];
  }
  for (int L = 0; L < 2; ++L) {
    transpose_job(p.in[5] + (size_t)L * DM * INC, 1024, INC, (bf16_t*)(ws + O_WIN + L * SZ_WIN), 1, 0, lds);
    for (int b = 0; b < 4; ++b)
      transpose_job(p.in[6] + (size_t)(L * 4 + b) * 256 * 1024, 256, 1024, (bf16_t*)(ws + O_WBO) + (size_t)(L * 4 + b) * 1024 * 256, 1, 0, lds);
    transpose_job(p.in[7] + (size_t)L * 1024 * 1024, 1024, 1024, (bf16_t*)(ws + O_WOUT) + (size_t)L * 1024 * 1024, 1, 0, lds);
    transpose_job(p.in[34] + (size_t)L * 1024 * 1024, 1024, 1024, (bf16_t*)(ws + O_PG) + (size_t)L * 1024 * 1024, 1, 0, lds);
    transpose_job(p.in[33] + (size_t)L * 256 * 1024, 256, 1024, (bf16_t*)(ws + O_PP) + (size_t)L * 1024 * 256, 1, 0, lds);
    transpose_job(p.in[10] + (size_t)L * 64 * 256, 64, 256, (bf16_t*)(ws + O_LORA + L * SZ_LORA), 1, 0, lds);
    transpose_job(p.in[12] + (size_t)L * 64 * 256, 64, 256, (bf16_t*)(ws + O_LORA + L * SZ_LORA) + 256 * 64, 1, 0, lds);
    transpose_job(p.in[13] + (size_t)L * 128 * 256, 128, 256, (bf16_t*)(ws + O_LORA + L * SZ_LORA) + 2 * 256 * 64, 1, 0, lds);
  }
  transpose_job(p.in[26], 1024, FFD, (bf16_t*)(ws + O_FGU), 2, 0, lds);
  transpose_job(p.in[27], 1024, FFD, (bf16_t*)(ws + O_FGU), 2, 1, lds);
  transpose_job(p.in[28], FFD, 1024, (bf16_t*)(ws + O_FD), 1, 0, lds);
}
DI void convert_p(const Params& p, int L) {
  const int gtid = obid() * NTHR + otid(), gsz = gridDim.x * NTHR;
  const f32x4* s = (const f32x4*)(p.in[1] + (size_t)L * NTOK * 256); u32x2* d = (u32x2*)(p.ws + O_PB);
  for (int i = gtid; i < NTOK * 256 / 4; i += gsz) { f32x4 v = s[i]; u32x2 w; w[0] = pk2(v[0], v[1]); w[1] = pk2(v[2], v[3]); d[i] = w; }
}
template <bool ROUTER, bool ADDMOE = false>
DI void norm_phase(const Params& p, const float* __restrict__ g, const float* __restrict__ router) {
  const int lane = otid() & 63, wid = otid() >> 6;
  bf16_t* hb = (bf16_t*)(p.ws + O_HB);
  int* cnt = (int*)(p.ws + O_CTL) + CW_MOECNT;
  int* list = (int*)(p.ws + O_SMALL + SM_LIST);
  float* gw = (float*)(p.ws + O_SMALL + SM_GW);
  int* tokslot = (int*)(p.ws + O_SMALL + SM_TOKSLOT);
  const int* slotrow = (const int*)(p.ws + O_SMALL + SM_SLOTROW);
  const bf16_t* Y2 = (const bf16_t*)(p.ws + O_XBUF);
  for (int row = obid() * 8 + wid; row < NTOK; row += gridDim.x * 8) {
    float* xr = p.x + (size_t)row * DM;
    f32x4 v[4]; float ss = 0.f;
#pragma unroll
    for (int j = 0; j < 4; ++j) v[j] = *(const f32x4*)(xr + j * 256 + lane * 4);
    if (ADDMOE) {
      const int r1 = slotrow[tokslot[row * 2]], r2 = slotrow[tokslot[row * 2 + 1]];
#pragma unroll
      for (int j = 0; j < 4; ++j) {
        const u32x2 a = *(const u32x2*)(Y2 + (size_t)r1 * DM + j * 256 + lane * 4), b = *(const u32x2*)(Y2 + (size_t)r2 * DM + j * 256 + lane * 4);
        v[j][0] += __uint_as_float(a[0] << 16) + __uint_as_float(b[0] << 16); v[j][1] += __uint_as_float(a[0] & 0xffff0000u) + __uint_as_float(b[0] & 0xffff0000u);
        v[j][2] += __uint_as_float(a[1] << 16) + __uint_as_float(b[1] << 16); v[j][3] += __uint_as_float(a[1] & 0xffff0000u) + __uint_as_float(b[1] & 0xffff0000u);
        *(f32x4*)(xr + j * 256 + lane * 4) = v[j];
      }
    }
#pragma unroll
    for (int j = 0; j < 4; ++j) ss += v[j][0] * v[j][0] + v[j][1] * v[j][1] + v[j][2] * v[j][2] + v[j][3] * v[j][3];
    ss = wave_sum(ss);
    const float rstd = rsqrtf(ss * (1.0f / 1024.0f) + 1e-6f);
    float lg[8];
    if (ROUTER) {
#pragma unroll
      for (int e = 0; e < 8; ++e) lg[e] = 0.f;
    }
#pragma unroll
    for (int j = 0; j < 4; ++j) {
      const f32x4 gg = *(const f32x4*)(g + j * 256 + lane * 4);
      f32x4 h = v[j] * rstd * gg;
      u32x2 w; w[0] = pk2(h[0], h[1]); w[1] = pk2(h[2], h[3]);
      *(u32x2*)(hb + (size_t)row * DM + j * 256 + lane * 4) = w;
      if (ROUTER) {
#pragma unroll
        for (int c = 0; c < 4; ++c) {
          const float* rr = router + (size_t)(j * 256 + lane * 4 + c) * 8;
          const f32x4 r0 = *(const f32x4*)rr, r1 = *(const f32x4*)(rr + 4);
          lg[0] += h[c] * r0[0]; lg[1] += h[c] * r0[1]; lg[2] += h[c] * r0[2]; lg[3] += h[c] * r0[3];
          lg[4] += h[c] * r1[0]; lg[5] += h[c] * r1[1]; lg[6] += h[c] * r1[2]; lg[7] += h[c] * r1[3];
        }
      }
    }
    if (ROUTER) {
#pragma unroll
      for (int e = 0; e < 8; ++e) lg[e] = wave_sum(lg[e]);
      if (lane == 0) {
        int e1 = 0; float l1 = lg[0];
#pragma unroll
        for (int e = 1; e < 8; ++e) if (lg[e] > l1) { l1 = lg[e]; e1 = e; }
        int e2 = -1; float l2 = -INFINITY;
#pragma unroll
        for (int e = 0; e < 8; ++e) if (e != e1 && lg[e] > l2) { l2 = lg[e]; e2 = e; }
        const float w1 = 1.0f / (1.0f + __expf(l2 - l1)), w2 = 1.0f - w1;
        int s1 = atomicAdd(cnt + e1, 1); list[e1 * NTOK + s1] = row; gw[e1 * NTOK + s1] = w1;
        int s2 = atomicAdd(cnt + e2, 1); list[e2 * NTOK + s2] = row; gw[e2 * NTOK + s2] = w2;
        tokslot[row * 2] = e1 * NTOK + s1; tokslot[row * 2 + 1] = e2 * NTOK + s2;
      }
    }
  }
}

DI float softplusf_(float z) { return z > 20.f ? z : __logf(1.0f + __expf(z)); }
DI float logsigmoidf_(float z) { return z >= 0.f ? -__logf(1.0f + __expf(-z)) : z - __logf(1.0f + __expf(z)); }

template <int PARTS = 7>
DI void phase_prep(const Params& p, int L, char* lds) {
  float* xw_s = (float*)lds; float* xa_s = xw_s + 8 * 64; float* xg_s = xa_s + 8 * 64;
  char* R = p.ws + O_R;
  const bf16_t* u = (const bf16_t*)(R + R_U);
  bf16_t* rwA = (bf16_t*)(R + R_RWA); bf16_t* rwB = (bf16_t*)(R + R_RWB); bf16_t* rwK = (bf16_t*)(R + R_RWK);
  bf16_t* rwR = (bf16_t*)(R + R_RWR); bf16_t* rwV = (bf16_t*)(R + R_RWV); float* rwW = (float*)(R + R_RWW);
  bf16_t* gq = (bf16_t*)(R + R_GQ); bf16_t* gk = (bf16_t*)(R + R_GK); bf16_t* gv = (bf16_t*)(R + R_GV);
  bf16_t* Qd = (bf16_t*)(R + R_QD); bf16_t* Kd = (bf16_t*)(R + R_KD); bf16_t* Vd = (bf16_t*)(R + R_VD);
  bf16_t* Qf = (bf16_t*)(R + R_QF); bf16_t* Kf = (bf16_t*)(R + R_KF); bf16_t* Vf = (bf16_t*)(R + R_VF);
  bf16_t* auxg = (bf16_t*)(R + R_AUXG); bf16_t* auxgate = (bf16_t*)(R + R_AUXGATE);
  float* rk = (float*)(p.ws + O_SMALL + SM_RK); float* logf_ = (float*)(p.ws + O_SMALL + SM_LOGF);
  float* gbeta = (float*)(p.ws + O_SMALL + SM_GBETA); float* ga = (float*)(p.ws + O_SMALL + SM_GA);
  const float* mu = p.in[8] + L * 1024; const float* w0 = p.in[9] + L * 256; const float* w2 = p.in[10] + L * 64 * 256;
  const float* a0 = p.in[11] + L * 256; const float* a2 = p.in[12] + L * 64 * 256; const float* g2 = p.in[13] + L * 128 * 256;
  const float* kkp = p.in[14] + L * 256; const float* kap = p.in[15] + L * 256; const float* rkp = p.in[16] + L * 256;
  const float* fbias = p.in[21] + L * 4; const float* cw = p.in[22] + L * 768 * 4;
  const float* alog = p.in[23] + L * 4; const float* dtb = p.in[24] + L * 4;
  const int tid = otid(), j = tid & 255, half = tid >> 8, lane = tid & 63, h = j >> 6, dh = j & 63;
  const float QS_D = 0.25503486164919736f, QS_F = 0.18033688011112042f;
  for (int tile = obid(); tile < NTOK / 8; tile += gridDim.x) {
    const int T0 = tile * 8, b = T0 / SEQ, t0 = T0 % SEQ, bh = b * 4 + h;
    if (PARTS & 1) {
    float r[4], k[4], v[4];
    __syncthreads();
#pragma unroll
    for (int i = 0; i < 4; ++i) {
      const int tl = half * 4 + i, tok = T0 + tl, t = t0 + tl;
      const bf16_t* ur = u + (size_t)tok * UC;
#pragma unroll
      for (int seg = 0; seg < 4; ++seg) {
        const int c = seg * 256 + j;
        const float ua = bf2f(ur[c]);
        const float up = t > 0 ? bf2f(ur[c - UC]) : 0.f;
        const float xm = ua + (up - ua) * mu[c];
        if (seg == 0) r[i] = xm; else if (seg == 1) k[i] = xm; else if (seg == 2) v[i] = xm;
        else {
          if (j < 64) xw_s[tl * 64 + j] = 1.0f - 2.0f / (1.0f + __expf(2.0f * xm));
          else if (j < 128) xa_s[tl * 64 + (j - 64)] = xm;
          else xg_s[tl * 128 + (j - 128)] = sigmoidf_(xm);
        }
      }
    }
    __syncthreads();
    float lw[4], alr[4], gg[4];
#pragma unroll
    for (int i = 0; i < 4; ++i) { lw[i] = w0[j]; alr[i] = a0[j]; gg[i] = 0.f; }
    for (int q = 0; q < 64; ++q) {
      const float wv = w2[q * 256 + j], av = a2[q * 256 + j];
#pragma unroll
      for (int i = 0; i < 4; ++i) { lw[i] += xw_s[(half * 4 + i) * 64 + q] * wv; alr[i] += xa_s[(half * 4 + i) * 64 + q] * av; }
    }
    for (int q = 0; q < 128; ++q) {
      const float gvv = g2[q * 256 + j];
#pragma unroll
      for (int i = 0; i < 4; ++i) gg[i] += xg_s[(half * 4 + i) * 128 + q] * gvv;
    }
#pragma unroll
    for (int i = 0; i < 4; ++i) {
      const int tl = half * 4 + i, tok = T0 + tl, t = t0 + tl;
      const float dec = __expf(-0.6065306597126334f * sigmoidf_(lw[i]));
      const float a = sigmoidf_(alr[i]);
      const float kkr = k[i] * kkp[j];
      const float ss = wave_sum(kkr * kkr);
      const float kk = kkr * rsqrtf(ss + 1e-6f);
      const float kp = k[i] * (1.0f + (a - 1.0f) * kap[j]);
      const float rks = wave_sum(r[i] * kp * rkp[j]);
      const size_t idx = ((size_t)bh * SEQ + t) * 64 + dh;
      rwA[idx] = f2bf(-kk); rwW[idx] = dec; rwB[idx] = f2bf(kk * a); rwK[idx] = f2bf(kp); rwR[idx] = f2bf(r[i]); rwV[idx] = f2bf(v[i]);
      auxg[(size_t)tok * 256 + j] = f2bf(gg[i]);
      if (lane == 0) rk[tok * 4 + h] = rks;
    }
    }
    if (PARTS & 2)
    {
      float vd[4], vf[4];
#pragma unroll
      for (int i = 0; i < 4; ++i) {
        const int tl = half * 4 + i, tok = T0 + tl, t = t0 + tl;
        const bf16_t* ur = u + (size_t)tok * UC;
        float q = bf2f(ur[OFF_B + j]), kx = bf2f(ur[OFF_B + 256 + j]);
        vd[i] = bf2f(ur[OFF_B + 512 + j]);
        const int d = dh & 31;
        if (d < 8) {
          const int ii = d & 3;
          const float invrev = ii == 0 ? 0.15915494309189535f : ii == 1 ? 0.005985185712713705f : ii == 2 ? 0.00022507907903927653f : 8.464330808241401e-06f;
          const float rvf = (float)t * invrev;
          const float fr = rvf - floorf(rvf);
          const float sn = __builtin_amdgcn_sinf(fr), cs = __builtin_amdgcn_cosf(fr);
          const int pj = d < 4 ? j + 4 : j - 4;
          const float qp = bf2f(ur[OFF_B + pj]), kpn = bf2f(ur[OFF_B + 256 + pj]);
          if (d < 4) { q = q * cs - qp * sn; kx = kx * cs - kpn * sn; }
          else { q = q * cs + qp * sn; kx = kx * cs + kpn * sn; }
        }
        const size_t idx = ((size_t)bh * SEQ + t) * 64 + dh;
        Qd[idx] = f2bf(q * QS_D); Kd[idx] = f2bf(kx);
        Qf[idx] = f2bf(bf2f(ur[OFF_C + j]) * QS_F); Kf[idx] = ur[OFF_C + 256 + j];
        vf[i] = bf2f(ur[OFF_C + 512 + j]);
        if (j < 4) logf_[(size_t)(b * 4 + j) * SEQ + t] = logsigmoidf_(bf2f(ur[OFF_C + 768 + j]) + fbias[j]);
      }
      const size_t vidx = ((size_t)bh * 64 + dh) * SEQ + t0 + half * 4;
      u32x2 w; w[0] = pk2(vd[0], vd[1]); w[1] = pk2(vd[2], vd[3]); *(u32x2*)(Vd + vidx) = w;
      w[0] = pk2(vf[0], vf[1]); w[1] = pk2(vf[2], vf[3]); *(u32x2*)(Vf + vidx) = w;
    }
    if (PARTS & 4) {
#pragma unroll
    for (int i = 0; i < 4; ++i) {
      const int tl = half * 4 + i, tok = T0 + tl, t = t0 + tl;
      const bf16_t* ur = u + (size_t)tok * UC + OFF_D;
      float y[3];
#pragma unroll
      for (int seg = 0; seg < 3; ++seg) {
        const int c = seg * 256 + j;
        const f32x4 wv = *(const f32x4*)(cw + c * 4);
        float acc = wv[3] * bf2f(ur[c]);
        if (t >= 1) acc += wv[2] * bf2f(ur[c - UC]);
        if (t >= 2) acc += wv[1] * bf2f(ur[c - 2 * UC]);
        if (t >= 3) acc += wv[0] * bf2f(ur[c - 3 * UC]);
        y[seg] = acc * sigmoidf_(acc);
      }
      const float sq = wave_sum(y[0] * y[0]), sk = wave_sum(y[1] * y[1]);
      const float qn = y[0] * rsqrtf(sq + 1e-6f) * 0.125f, kn = y[1] * rsqrtf(sk + 1e-6f);
      const size_t idx = ((size_t)bh * SEQ + t) * 64 + dh;
      gq[idx] = f2bf(qn); gk[idx] = f2bf(kn); gv[idx] = f2bf(y[2]);
      const float gate = bf2f(ur[776 + j]);
      auxgate[(size_t)tok * 256 + j] = f2bf(gate * sigmoidf_(gate));
      if (lane == 0) {
        const float beta = sigmoidf_(bf2f(ur[768 + h]));
        const float gl = -__expf(alog[h]) * softplusf_(bf2f(ur[772 + h]) + dtb[h]);
        gbeta[(size_t)bh * SEQ + t] = beta; ga[(size_t)bh * SEQ + t] = __expf(gl);
      }
    }
    }
  }
}


DI float sum8(float x) {
  x += __int_as_float(__builtin_amdgcn_update_dpp(0, __float_as_int(x), 0xB1, 0xF, 0xF, true));
  x += __int_as_float(__builtin_amdgcn_update_dpp(0, __float_as_int(x), 0x4E, 0xF, 0xF, true));
  x += __int_as_float(__builtin_amdgcn_update_dpp(0, __float_as_int(x), 0x141, 0xF, 0xF, true));
  return x;
}
DI void unpk8(float (&f)[8], const u32x4& w) {
#pragma unroll
  for (int i = 0; i < 4; ++i) { f[2 * i] = __uint_as_float(w[i] << 16); f[2 * i + 1] = __uint_as_float(w[i] & 0xffff0000u); }
}
DI u32x4 pk8(const float (&f)[8]) { u32x4 w; w[0] = pk2(f[0], f[1]); w[1] = pk2(f[2], f[3]); w[2] = pk2(f[4], f[5]); w[3] = pk2(f[6], f[7]); return w; }
DI void ld8f(float (&f)[8], const float* p) { const f32x4 a = *(const f32x4*)p, b = *(const f32x4*)(p + 4); f[0] = a[0]; f[1] = a[1]; f[2] = a[2]; f[3] = a[3]; f[4] = b[0]; f[5] = b[1]; f[6] = b[2]; f[7] = b[3]; }
DI void phase_prep2(const Params& p, int L, char* lds) {
  constexpr int XLD = 264;
  bf16_t* XS = (bf16_t*)lds;
  float* LR = (float*)(lds + 16 * XLD * 2);
  bf16_t* VT = (bf16_t*)(lds + 16 * XLD * 2 + 3 * 16 * 256 * 4);
  char* R = p.ws + O_R;
  const bf16_t* u = (const bf16_t*)(R + R_U);
  bf16_t* rwA = (bf16_t*)(R + R_RWA); bf16_t* rwB = (bf16_t*)(R + R_RWB); bf16_t* rwK = (bf16_t*)(R + R_RWK);
  bf16_t* rwR = (bf16_t*)(R + R_RWR); bf16_t* rwV = (bf16_t*)(R + R_RWV); float* rwW = (float*)(R + R_RWW);
  bf16_t* gq = (bf16_t*)(R + R_GQ); bf16_t* gk = (bf16_t*)(R + R_GK); bf16_t* gv = (bf16_t*)(R + R_GV);
  bf16_t* Qd = (bf16_t*)(R + R_QD); bf16_t* Kd = (bf16_t*)(R + R_KD); bf16_t* Vd = (bf16_t*)(R + R_VD);
  bf16_t* Qf = (bf16_t*)(R + R_QF); bf16_t* Kf = (bf16_t*)(R + R_KF); bf16_t* Vf = (bf16_t*)(R + R_VF);
  bf16_t* auxg = (bf16_t*)(R + R_AUXG); bf16_t* auxgate = (bf16_t*)(R + R_AUXGATE);
  float* rk = (float*)(p.ws + O_SMALL + SM_RK); float* logf_ = (float*)(p.ws + O_SMALL + SM_LOGF);
  float* gbeta = (float*)(p.ws + O_SMALL + SM_GBETA); float* ga = (float*)(p.ws + O_SMALL + SM_GA);
  const float* mu = p.in[8] + L * 1024; const float* w0 = p.in[9] + L * 256; const float* a0 = p.in[11] + L * 256;
  const float* kkp = p.in[14] + L * 256; const float* kap = p.in[15] + L * 256; const float* rkp = p.in[16] + L * 256;
  const float* fbias = p.in[21] + L * 4; const float* cw = p.in[22] + L * 768 * 4;
  const float* alog = p.in[23] + L * 4; const float* dtb = p.in[24] + L * 4;
  const bf16_t* WL = (const bf16_t*)(p.ws + O_LORA + L * SZ_LORA);
  const float QS_D = 0.25503486164919736f, QS_F = 0.18033688011112042f;
#pragma unroll 1
  for (int tile = obid(); tile < NTOK / 16; tile += gridDim.x) {
    const int tid = otid(), tk = tid >> 5, cg = tid & 31, c0 = cg * 8, h = cg >> 3, d0 = (cg & 7) * 8, lane = tid & 63, wid = tid >> 6;
    const int fr = lane & 15, fq = lane >> 4;
    const int T0 = tile * 16, b = T0 / SEQ, t0 = T0 % SEQ, tok = T0 + tk, t = t0 + tk, bh = b * 4 + h;
    const bf16_t* ur = u + (size_t)tok * UC;
    const size_t idx = ((size_t)bh * SEQ + t) * 64 + d0;
    float r[8], k[8], v[8];
    __syncthreads();
    {
#pragma unroll
      for (int seg = 0; seg < 4; ++seg) {
        asm volatile("" ::: "memory");
        float ua[8], up[8], mm[8], xm[8];
        unpk8(ua, *(const u32x4*)(ur + seg * 256 + c0));
        if (t > 0) unpk8(up, *(const u32x4*)(ur - UC + seg * 256 + c0));
        else {
#pragma unroll
          for (int i = 0; i < 8; ++i) up[i] = 0.f;
        }
        ld8f(mm, mu + seg * 256 + c0);
#pragma unroll
        for (int i = 0; i < 8; ++i) xm[i] = ua[i] + (up[i] - ua[i]) * mm[i];
        if (seg == 0) {
#pragma unroll
          for (int i = 0; i < 8; ++i) r[i] = xm[i];
        } else if (seg == 1) {
#pragma unroll
          for (int i = 0; i < 8; ++i) k[i] = xm[i];
        } else if (seg == 2) {
#pragma unroll
          for (int i = 0; i < 8; ++i) v[i] = xm[i];
        } else {
          if (cg < 8) {
#pragma unroll
            for (int i = 0; i < 8; ++i) xm[i] = 1.0f - 2.0f / (1.0f + __expf(2.0f * xm[i]));
          } else if (cg >= 16) {
#pragma unroll
            for (int i = 0; i < 8; ++i) xm[i] = sigmoidf_(xm[i]);
          }
          *(u32x4*)(XS + tk * XLD + c0) = pk8(xm);
        }
      }
    }
    __syncthreads();
    {
#pragma unroll
      for (int nt2 = 0; nt2 < 2; ++nt2) {
        const int nt = wid * 2 + nt2;
        f32x4 aw = {0.f, 0.f, 0.f, 0.f}, aa = aw, ag = aw;
#pragma unroll
        for (int ks = 0; ks < 2; ++ks) {
          const bf16x8 xw = *(const bf16x8*)(XS + fr * XLD + 32 * ks + 8 * fq);
          const bf16x8 xa = *(const bf16x8*)(XS + fr * XLD + 64 + 32 * ks + 8 * fq);
          const bf16x8 ww = *(const bf16x8*)(WL + (size_t)(16 * nt + fr) * 64 + 32 * ks + 8 * fq);
          const bf16x8 wa = *(const bf16x8*)(WL + 256 * 64 + (size_t)(16 * nt + fr) * 64 + 32 * ks + 8 * fq);
          aw = __builtin_amdgcn_mfma_f32_16x16x32_bf16(ww, xw, aw, 0, 0, 0);
          aa = __builtin_amdgcn_mfma_f32_16x16x32_bf16(wa, xa, aa, 0, 0, 0);
        }
#pragma unroll
        for (int ks = 0; ks < 4; ++ks) {
          const bf16x8 xg = *(const bf16x8*)(XS + fr * XLD + 128 + 32 * ks + 8 * fq);
          const bf16x8 wg = *(const bf16x8*)(WL + 2 * 256 * 64 + (size_t)(16 * nt + fr) * 128 + 32 * ks + 8 * fq);
          ag = __builtin_amdgcn_mfma_f32_16x16x32_bf16(wg, xg, ag, 0, 0, 0);
        }
        *(f32x4*)(LR + (0 * 16 + fr) * 256 + 16 * nt + 4 * fq) = aw;
        *(f32x4*)(LR + (1 * 16 + fr) * 256 + 16 * nt + 4 * fq) = aa;
        *(f32x4*)(LR + (2 * 16 + fr) * 256 + 16 * nt + 4 * fq) = ag;
      }
    }
    __syncthreads();
    {
      float lw[8], al[8], gg[8], t8[8], kkv[8], kpv[8], o8[8];
      ld8f(lw, LR + (0 * 16 + tk) * 256 + c0); ld8f(al, LR + (1 * 16 + tk) * 256 + c0); ld8f(gg, LR + (2 * 16 + tk) * 256 + c0);
      ld8f(t8, w0 + c0);
#pragma unroll
      for (int i = 0; i < 8; ++i) lw[i] = __expf(-0.6065306597126334f * sigmoidf_(lw[i] + t8[i]));
      ld8f(t8, a0 + c0);
#pragma unroll
      for (int i = 0; i < 8; ++i) al[i] = sigmoidf_(al[i] + t8[i]);
      ld8f(t8, kkp + c0);
      float ss = 0.f;
#pragma unroll
      for (int i = 0; i < 8; ++i) { kkv[i] = k[i] * t8[i]; ss += kkv[i] * kkv[i]; }
      ss = sum8(ss);
      const float rn = rsqrtf(ss + 1e-6f);
      ld8f(t8, kap + c0);
#pragma unroll
      for (int i = 0; i < 8; ++i) { kkv[i] *= rn; kpv[i] = k[i] * (1.0f + (al[i] - 1.0f) * t8[i]); }
      ld8f(t8, rkp + c0);
      float rks = 0.f;
#pragma unroll
      for (int i = 0; i < 8; ++i) rks += r[i] * kpv[i] * t8[i];
      rks = sum8(rks);
#pragma unroll
      for (int i = 0; i < 8; ++i) o8[i] = -kkv[i];
      *(u32x4*)(rwA + idx) = pk8(o8);
      *(f32x4*)(rwW + idx) = (f32x4){lw[0], lw[1], lw[2], lw[3]}; *(f32x4*)(rwW + idx + 4) = (f32x4){lw[4], lw[5], lw[6], lw[7]};
#pragma unroll
      for (int i = 0; i < 8; ++i) o8[i] = kkv[i] * al[i];
      *(u32x4*)(rwB + idx) = pk8(o8);
      *(u32x4*)(rwK + idx) = pk8(kpv);
      *(u32x4*)(rwR + idx) = pk8(r);
      *(u32x4*)(rwV + idx) = pk8(v);
      *(u32x4*)(auxg + (size_t)tok * 256 + c0) = pk8(gg);
      if ((cg & 7) == 0) rk[tok * 4 + h] = rks;
    }
    asm volatile("" ::: "memory");
    {
      float q[8], kx[8];
      unpk8(q, *(const u32x4*)(ur + OFF_B + c0)); unpk8(kx, *(const u32x4*)(ur + OFF_B + 256 + c0));
      const u32x4 vdw = *(const u32x4*)(ur + OFF_B + 512 + c0);
      if ((cg & 3) == 0) {
#pragma unroll
        for (int i = 0; i < 4; ++i) {
          const float invrev = i == 0 ? 0.15915494309189535f : i == 1 ? 0.005985185712713705f : i == 2 ? 0.00022507907903927653f : 8.464330808241401e-06f;
          const float rvf = (float)t * invrev, fr_ = rvf - floorf(rvf);
          const float sn = __builtin_amdgcn_sinf(fr_), cs = __builtin_amdgcn_cosf(fr_);
          const float q1 = q[i], q2 = q[i + 4], k1 = kx[i], k2 = kx[i + 4];
          q[i] = q1 * cs - q2 * sn; q[i + 4] = q2 * cs + q1 * sn;
          kx[i] = k1 * cs - k2 * sn; kx[i + 4] = k2 * cs + k1 * sn;
        }
      }
#pragma unroll
      for (int i = 0; i < 8; ++i) q[i] *= QS_D;
      *(u32x4*)(Qd + idx) = pk8(q); *(u32x4*)(Kd + idx) = pk8(kx);
      asm volatile("" ::: "memory");
      float fqv[8];
      unpk8(fqv, *(const u32x4*)(ur + OFF_C + c0));
#pragma unroll
      for (int i = 0; i < 8; ++i) fqv[i] *= QS_F;
      *(u32x4*)(Qf + idx) = pk8(fqv);
      *(u32x4*)(Kf + idx) = *(const u32x4*)(ur + OFF_C + 256 + c0);
      const u32x4 vfw = *(const u32x4*)(ur + OFF_C + 512 + c0);
      *(u32x4*)(VT + (0 * 16 + tk) * 256 + c0) = vdw;
      *(u32x4*)(VT + (1 * 16 + tk) * 256 + c0) = vfw;
      if (cg == 0) {
        const u32x2 fl = *(const u32x2*)(ur + OFF_C + 768);
        const float f0 = __uint_as_float(fl[0] << 16), f1 = __uint_as_float(fl[0] & 0xffff0000u), f2 = __uint_as_float(fl[1] << 16), f3 = __uint_as_float(fl[1] & 0xffff0000u);
        logf_[(size_t)(b * 4 + 0) * SEQ + t] = logsigmoidf_(f0 + fbias[0]); logf_[(size_t)(b * 4 + 1) * SEQ + t] = logsigmoidf_(f1 + fbias[1]);
        logf_[(size_t)(b * 4 + 2) * SEQ + t] = logsigmoidf_(f2 + fbias[2]); logf_[(size_t)(b * 4 + 3) * SEQ + t] = logsigmoidf_(f3 + fbias[3]);
      }
    }
    asm volatile("" ::: "memory");
    {
      float y[3][8];
#pragma unroll
      for (int seg = 0; seg < 3; ++seg) {
        asm volatile("" ::: "memory");
#pragma unroll
        for (int i = 0; i < 8; ++i) y[seg][i] = 0.f;
#pragma unroll
        for (int jj = 0; jj < 4; ++jj) {
          if (t - 3 + jj >= 0) {
            const bf16_t* up_ = ur + (jj - 3) * UC + OFF_D + seg * 256 + c0;
            const u32x2 lo = *(const u32x2*)up_, hi = *(const u32x2*)(up_ + 4);
            const u32x4 w4 = {lo[0], lo[1], hi[0], hi[1]};
            float uu[8]; unpk8(uu, w4);
#pragma unroll
            for (int i = 0; i < 8; ++i) y[seg][i] += cw[(seg * 256 + c0 + i) * 4 + jj] * uu[i];
          }
        }
#pragma unroll
        for (int i = 0; i < 8; ++i) y[seg][i] = y[seg][i] * sigmoidf_(y[seg][i]);
      }
      float sq = 0.f, sk = 0.f;
#pragma unroll
      for (int i = 0; i < 8; ++i) { sq += y[0][i] * y[0][i]; sk += y[1][i] * y[1][i]; }
      sq = sum8(sq); sk = sum8(sk);
      const float rq = rsqrtf(sq + 1e-6f) * 0.125f, rkn = rsqrtf(sk + 1e-6f);
#pragma unroll
      for (int i = 0; i < 8; ++i) { y[0][i] *= rq; y[1][i] *= rkn; }
      *(u32x4*)(gq + idx) = pk8(y[0]); *(u32x4*)(gk + idx) = pk8(y[1]); *(u32x4*)(gv + idx) = pk8(y[2]);
      asm volatile("" ::: "memory");
      {
        const bf16_t* gp = ur + OFF_D + 776 + c0;
        const u32x2 lo = *(const u32x2*)gp, hi = *(const u32x2*)(gp + 4);
        const u32x4 w4 = {lo[0], lo[1], hi[0], hi[1]};
        float g8[8]; unpk8(g8, w4);
#pragma unroll
        for (int i = 0; i < 8; ++i) g8[i] = g8[i] * sigmoidf_(g8[i]);
        *(u32x4*)(auxgate + (size_t)tok * 256 + c0) = pk8(g8);
      }
      if ((cg & 7) == 0) {
        const float beta = sigmoidf_(bf2f(ur[OFF_D + 768 + h]));
        const float gl = -__expf(alog[h]) * softplusf_(bf2f(ur[OFF_D + 772 + h]) + dtb[h]);
        gbeta[(size_t)bh * SEQ + t] = beta; ga[(size_t)bh * SEQ + t] = __expf(gl);
      }
    }
    __syncthreads();
    {
      const int ch = tid & 255, hf = tid >> 8;
#pragma unroll
      for (int m = 0; m < 2; ++m) {
        const bf16_t* vs = VT + (m * 16 + hf * 8) * 256 + ch;
        u32x4 w;
        w[0] = (unsigned)vs[0] | ((unsigned)vs[256] << 16); w[1] = (unsigned)vs[512] | ((unsigned)vs[768] << 16);
        w[2] = (unsigned)vs[1024] | ((unsigned)vs[1280] << 16); w[3] = (unsigned)vs[1536] | ((unsigned)vs[1792] << 16);
        bf16_t* dst = (m == 0 ? Vd : Vf) + ((size_t)(b * 4 + (ch >> 6)) * 64 + (ch & 63)) * SEQ + t0 + hf * 8;
        *(u32x4*)dst = w;
      }
    }
  }
}

DI float dpp_sum16(float x) {
  x += __int_as_float(__builtin_amdgcn_update_dpp(0, __float_as_int(x), 0xB1, 0xF, 0xF, true));
  x += __int_as_float(__builtin_amdgcn_update_dpp(0, __float_as_int(x), 0x4E, 0xF, 0xF, true));
  x += __int_as_float(__builtin_amdgcn_update_dpp(0, __float_as_int(x), 0x141, 0xF, 0xF, true));
  x += __int_as_float(__builtin_amdgcn_update_dpp(0, __float_as_int(x), 0x140, 0xF, 0xF, true));
  return x;
}
constexpr int SCH = 16;
constexpr int RS = 448;
DI float sum32(float x) {
  x = dpp_sum16(x);
  auto rr = __builtin_amdgcn_permlane16_swap(__float_as_uint(x), __float_as_uint(x), false, false);
  return __uint_as_float(rr[0]) + __uint_as_float(rr[1]);
}
struct StepIn { f32x4 q0, q1, q2; float V; };
DI void ld_step(StepIn& s, const float* sp, const float* vp) {
  s.q0 = *(const f32x4*)(sp); s.q1 = *(const f32x4*)(sp + 4); s.q2 = *(const f32x4*)(sp + 8); s.V = *vp;
}
template <int WHICH>
DI void scan_block(const Params& p, int L, int bh, int quarter, char* lds) {
  float* buf = (float*)lds;
  float* pbuf = buf + 2 * SCH * RS;
  char* R = p.ws + O_R;
  const int tid = otid();
  const size_t base = (size_t)bh * SEQ * 64;
  float* oout = (float*)(R + R_OSCAN) + (size_t)WHICH * NBH * SEQ * 64 + base;
  constexpr int NCH = SEQ / SCH;
  const int r = tid >> 5, sub = tid & 31, v = quarter * 16 + r;
  const int sst = (tid >> 4) & (SCH - 1), sk = (tid & 15) * 4;
  const bool stager = tid < SCH * 16;
  const u32x2* pA = (const u32x2*)((const bf16_t*)(R + (WHICH == 0 ? R_RWA : R_GK)) + base);
  const u32x2* pB = (const u32x2*)((const bf16_t*)(R + R_RWB) + base);
  const u32x2* pK = (const u32x2*)((const bf16_t*)(R + R_RWK) + base);
  const u32x2* pR = (const u32x2*)((const bf16_t*)(R + (WHICH == 0 ? R_RWR : R_GQ)) + base);
  const u32x2* pV = (const u32x2*)((const bf16_t*)(R + (WHICH == 0 ? R_RWV : R_GV)) + base);
  const f32x4* pW = (const f32x4*)((const float*)(R + R_RWW) + base);
  const float* gbeta = (const float*)(p.ws + O_SMALL + SM_GBETA) + (size_t)bh * SEQ;
  const float* ga = (const float*)(p.ws + O_SMALL + SM_GA) + (size_t)bh * SEQ;
  const u32x2 z2 = {0u, 0u};
  u32x2 ra = z2, ran = z2, rb = z2, rkk = z2, rr = z2, rv = z2; f32x4 rw = {0.f, 0.f, 0.f, 0.f};
  float rbeta = 0.f, raa = 0.f;
#define SCAN_LOAD(c)                                                                           \
  if (stager) {                                                                                \
    const int t_ = (c) * SCH + sst;                                                            \
    const size_t o_ = (size_t)t_ * 16 + (tid & 15);                                            \
    ra = pA[o_]; rr = pR[o_]; rv = pV[o_];                                                     \
    ran = t_ + 1 < SEQ ? pA[o_ + 16] : z2;                                                     \
    if (WHICH == 0) { rb = pB[o_]; rkk = pK[o_]; rw = pW[o_]; }                                \
    else { rbeta = gbeta[t_]; raa = ga[t_]; }                                                  \
  }
#define UNPK4(src) ((f32x4){__uint_as_float(src[0] << 16), __uint_as_float(src[0] & 0xffff0000u), __uint_as_float(src[1] << 16), __uint_as_float(src[1] & 0xffff0000u)})
#define DOT4(a, b) ((a[0] * b[0] + a[1] * b[1]) + (a[2] * b[2] + a[3] * b[3]))
#define SCAN_STAGE(c)                                                                          \
  if (stager) {                                                                                \
    float* rec_ = buf + ((c) & 1) * (SCH * RS) + sst * RS;                                     \
    f32x4 fAn, fW, fB, fK;                                                                     \
    if (WHICH == 0) { fAn = UNPK4(ran); fW = rw; fB = UNPK4(rb); fK = UNPK4(rkk); }            \
    else { const f32x4 k0_ = UNPK4(ra), kn_ = UNPK4(ran); fAn = -kn_; fW = (f32x4){raa, raa, raa, raa}; fB = k0_ * (raa * rbeta); fK = k0_ * rbeta; } \
    const float c1_ = dpp_sum16(DOT4(fB, fAn)), c2_ = dpp_sum16(DOT4(fK, fAn));               \
    const f32x4 fR = UNPK4(rr), fWA = fW * fAn;                                                \
    float* d_ = rec_ + (tid & 15) * 24;                                                        \
    *(f32x4*)(d_) = (f32x4){fWA[0], fWA[1], fW[0], fW[1]}; *(f32x4*)(d_ + 4) = (f32x4){fB[0], fB[1], fK[0], fK[1]}; *(f32x4*)(d_ + 8) = (f32x4){fR[0], fR[1], c1_, c2_};       \
    *(f32x4*)(d_ + 12) = (f32x4){fWA[2], fWA[3], fW[2], fW[3]}; *(f32x4*)(d_ + 16) = (f32x4){fB[2], fB[3], fK[2], fK[3]}; *(f32x4*)(d_ + 20) = (f32x4){fR[2], fR[3], c1_, c2_}; \
    *(f32x4*)(rec_ + 384 + sk) = UNPK4(rv);                                                    \
  }
#define SCAN_FLUSH(c)                                                                          \
  {                                                                                            \
    const float* pb_ = pbuf + ((c) & 1) * (SCH * 512);                                         \
    _Pragma("unroll") for (int ps_ = 0; ps_ < 4; ++ps_) {                                      \
      const int o_ = ps_ * 64 + (tid >> 3);                                                    \
      const f32x4 q_ = *(const f32x4*)(pb_ + o_ * 32 + (tid & 7) * 4);                         \
      float sm_ = (q_[0] + q_[1]) + (q_[2] + q_[3]);                                           \
      sm_ += __int_as_float(__builtin_amdgcn_update_dpp(0, __float_as_int(sm_), 0xB1, 0xF, 0xF, true));   \
      sm_ += __int_as_float(__builtin_amdgcn_update_dpp(0, __float_as_int(sm_), 0x4E, 0xF, 0xF, true));   \
      sm_ += __int_as_float(__builtin_amdgcn_update_dpp(0, __float_as_int(sm_), 0x141, 0xF, 0xF, true));  \
      if ((tid & 7) == 0) oout[((size_t)(c) * SCH + (o_ >> 4)) * 64 + quarter * 16 + (o_ & 15)] = sm_;   \
    }                                                                                          \
  }
  SCAN_LOAD(0);
  __syncthreads();
  SCAN_STAGE(0);
  f32x2 S1 = {0.f, 0.f}; float pre = 0.f, X = 0.f;
#pragma unroll 1
  for (int c = 0; c < NCH; ++c) {
    __syncthreads();
    if (c >= 1) SCAN_FLUSH(c - 1);
    if (c + 1 < NCH) SCAN_LOAD(c + 1);
    const float* cb = buf + (c & 1) * (SCH * RS);
    float* pb = pbuf + (c & 1) * (SCH * 512) + r * 32 + sub;
    StepIn cur, nxt;
    ld_step(cur, cb + sub * 12, cb + 384 + v);
#pragma unroll 4
    for (int st = 0; st < SCH; ++st) {
      const int sn = st + 1 < SCH ? st + 1 : st;
      ld_step(nxt, cb + sn * RS + sub * 12, cb + sn * RS + 384 + v);
      const float sa = X + pre;
      const float Xn = sum32(S1[0] * cur.q0[0] + S1[1] * cur.q0[1]);
      const float s0 = S1[0] * cur.q0[2] + (cur.q1[0] * sa + cur.q1[2] * cur.V);
      const float s1 = S1[1] * cur.q0[3] + (cur.q1[1] * sa + cur.q1[3] * cur.V);
      pre = sa * cur.q2[2] + cur.V * cur.q2[3];
      pb[st * 512] = s0 * cur.q2[0] + s1 * cur.q2[1];
      S1[0] = s0; S1[1] = s1; X = Xn;
      cur = nxt;
    }
    if (c + 1 < NCH) SCAN_STAGE(c + 1);
  }
  __syncthreads();
  SCAN_FLUSH(NCH - 1);
#undef SCAN_LOAD
#undef SCAN_STAGE
#undef SCAN_FLUSH
#undef UNPK4
#undef DOT4
}

constexpr int CLD = 72;
constexpr int CMB = 64 * CLD * 2;
constexpr int NCHK = SEQ / 64;
template <class F> DI void mm64(const bf16_t* X, const bf16_t* Y, int wid, int lane, F f) {
  const int fr = lane & 15, fq = lane >> 4;
#pragma unroll
  for (int q = 0; q < 2; ++q) {
    const int tile = wid * 2 + q, ti = tile >> 2, tj = tile & 3;
    f32x4 acc = {0.f, 0.f, 0.f, 0.f};
#pragma unroll
    for (int ks = 0; ks < 2; ++ks) {
      const bf16x8 yf = *(const bf16x8*)(Y + (16 * tj + fr) * CLD + 32 * ks + 8 * fq);
      const bf16x8 xf = *(const bf16x8*)(X + (16 * ti + fr) * CLD + 32 * ks + 8 * fq);
      acc = __builtin_amdgcn_mfma_f32_16x16x32_bf16(yf, xf, acc, 0, 0, 0);
    }
    f(16 * ti + fr, 16 * tj + 4 * fq, acc);
  }
}
DI void st4bf(bf16_t* d, const f32x4& v) { u32x2 w; w[0] = pk2(v[0], v[1]); w[1] = pk2(v[2], v[3]); *(u32x2*)d = w; }

template <int WHICH>
DI void chunk_pre(const Params& p, int bh, int c, char* lds) {
  bf16_t* M[11];
#pragma unroll
  for (int i = 0; i < 11; ++i) M[i] = (bf16_t*)(lds + i * CMB);
  float* NF = (float*)(lds + 11 * CMB);
  float* SC = NF + 64 * 65;
  char* R = p.ws + O_R;
  const int tid = otid(), lane = tid & 63, wid = tid >> 6;
  const int item = (WHICH * NBH + bh) * NCHK + c;
  const size_t base = ((size_t)bh * SEQ + (size_t)c * 64) * 64;
  const bf16_t* gA = (const bf16_t*)(R + (WHICH == 0 ? R_RWA : R_GK)) + base;
  const bf16_t* gB = (const bf16_t*)(R + R_RWB) + base;
  const bf16_t* gK = (const bf16_t*)(R + R_RWK) + base;
  const bf16_t* gR = (const bf16_t*)(R + (WHICH == 0 ? R_RWR : R_GQ)) + base;
  const bf16_t* gV = (const bf16_t*)(R + (WHICH == 0 ? R_RWV : R_GV)) + base;
  const float* gW = (const float*)(R + R_RWW) + base;
  bf16_t* oRh = (bf16_t*)(R + R_CHK) + (size_t)item * 4096;
  bf16_t* oGh = (bf16_t*)(R + R_CHK + CHK_SZ) + (size_t)item * 4096;
  bf16_t* oSV = (bf16_t*)(R + R_CHK + 2 * CHK_SZ) + (size_t)item * 4096;
  float* oout = (float*)(R + R_OSCAN) + (size_t)WHICH * NBH * SEQ * 64 + base;
  __syncthreads();
  if (WHICH == 0) {
    const int k = tid & 63, seg = tid >> 6;
    float lg[8]; float run = 0.f;
#pragma unroll
    for (int i = 0; i < 8; ++i) { run += __logf(gW[(size_t)(seg * 8 + i) * 64 + k]); lg[i] = run; }
    SC[seg * 64 + k] = run;
    __syncthreads();
    float off = 0.f;
    for (int s2 = 0; s2 < seg; ++s2) off += SC[s2 * 64 + k];
#pragma unroll
    for (int i = 0; i < 8; ++i) NF[(seg * 8 + i) * 65 + k] = lg[i] + off;
    __syncthreads();
    if (tid < 64) SC[512 + tid] = __expf(NF[63 * 65 + tid]);
  } else {
    if (tid < 64) {
      const float a = ((const float*)(p.ws + O_SMALL + SM_GA))[(size_t)bh * SEQ + c * 64 + tid];
      const float be = ((const float*)(p.ws + O_SMALL + SM_GBETA))[(size_t)bh * SEQ + c * 64 + tid];
      float g = __logf(a);
#pragma unroll
      for (int o = 1; o < 64; o <<= 1) { const float t2 = __shfl_up(g, o); if (lane >= o) g += t2; }
      SC[tid] = g; SC[64 + tid] = a * be; SC[128 + tid] = be;
    }
    __syncthreads();
    if (tid < 64) SC[512 + tid] = __expf(SC[63]);
  }
  __syncthreads();
  {
    const int t = tid >> 3, kg = (tid & 7) * 8;
    float a8[8], r8[8], b8[8], k8[8], e0[8], e1[8], em[8], ee[8];
    unpk8(a8, *(const u32x4*)(gA + t * 64 + kg)); unpk8(r8, *(const u32x4*)(gR + t * 64 + kg));
    const u32x4 vraw = *(const u32x4*)(gV + t * 64 + kg);
    if (WHICH == 0) {
      unpk8(b8, *(const u32x4*)(gB + t * 64 + kg)); unpk8(k8, *(const u32x4*)(gK + t * 64 + kg));
#pragma unroll
      for (int i = 0; i < 8; ++i) {
        const float g1 = NF[t * 65 + kg + i], g0 = t > 0 ? NF[(t - 1) * 65 + kg + i] : 0.f, gl = NF[63 * 65 + kg + i];
        e0[i] = __expf(g0); e1[i] = __expf(g1); em[i] = __expf(-g1); ee[i] = __expf(gl - g1);
      }
    } else {
      const float g1 = SC[t], g0 = t > 0 ? SC[t - 1] : 0.f, gl = SC[63], ab = SC[64 + t], be = SC[128 + t];
      const float x0 = __expf(g0), x1 = __expf(g1), xe = __expf(gl - g1);
#pragma unroll
      for (int i = 0; i < 8; ++i) { const float kv = a8[i]; b8[i] = ab * kv; k8[i] = be * kv; a8[i] = -kv; e0[i] = x0; e1[i] = x1; em[i] = 1.f; ee[i] = xe; }
    }
    float o8[8];
#pragma unroll
    for (int i = 0; i < 8; ++i) o8[i] = a8[i] * e0[i];
    *(u32x4*)(M[0] + t * CLD + kg) = pk8(o8);
#pragma unroll
    for (int i = 0; i < 8; ++i) M[1][(kg + i) * CLD + t] = f2bf(o8[i]);
#pragma unroll
    for (int i = 0; i < 8; ++i) o8[i] = r8[i] * e1[i];
    *(u32x4*)(M[2] + t * CLD + kg) = pk8(o8);
    if (WHICH == 0) {
#pragma unroll
      for (int i = 0; i < 8; ++i) o8[i] = b8[i] * em[i];
      *(u32x4*)(M[3] + t * CLD + kg) = pk8(o8);
#pragma unroll
      for (int i = 0; i < 8; ++i) o8[i] = k8[i] * em[i];
      *(u32x4*)(M[4] + t * CLD + kg) = pk8(o8);
    } else {
#pragma unroll
      for (int i = 0; i < 8; ++i) o8[i] = -a8[i];
      *(u32x4*)(M[3] + t * CLD + kg) = pk8(o8);
      *(u32x4*)(M[4] + t * CLD + kg) = pk8(r8);
    }
#pragma unroll
    for (int i = 0; i < 8; ++i) M[5][(kg + i) * CLD + t] = f2bf(b8[i] * ee[i]);
#pragma unroll
    for (int i = 0; i < 8; ++i) o8[i] = k8[i] * ee[i];
    *(u32x4*)(M[6] + t * CLD + kg) = pk8(o8);
    M[7][(kg + 0) * CLD + t] = (bf16_t)(vraw[0] & 0xffffu); M[7][(kg + 1) * CLD + t] = (bf16_t)(vraw[0] >> 16);
    M[7][(kg + 2) * CLD + t] = (bf16_t)(vraw[1] & 0xffffu); M[7][(kg + 3) * CLD + t] = (bf16_t)(vraw[1] >> 16);
    M[7][(kg + 4) * CLD + t] = (bf16_t)(vraw[2] & 0xffffu); M[7][(kg + 5) * CLD + t] = (bf16_t)(vraw[2] >> 16);
    M[7][(kg + 6) * CLD + t] = (bf16_t)(vraw[3] & 0xffffu); M[7][(kg + 7) * CLD + t] = (bf16_t)(vraw[3] >> 16);
  }
  __syncthreads();
  if (WHICH == 0) {
    mm64(M[3], M[0], wid, lane, [&](int j, int t0, const f32x4& v) {
#pragma unroll
      for (int r = 0; r < 4; ++r) NF[j * 65 + t0 + r] = (j < t0 + r) ? v[r] : 0.f; });
    mm64(M[4], M[0], wid, lane, [&](int i, int t0, const f32x4& v) {
      f32x4 w;
#pragma unroll
      for (int r = 0; r < 4; ++r) w[r] = (i < t0 + r) ? v[r] : 0.f;
      st4bf(M[8] + i * CLD + t0, w); });
    mm64(M[2], M[3], wid, lane, [&](int t, int j0, const f32x4& v) {
      f32x4 w;
#pragma unroll
      for (int r = 0; r < 4; ++r) w[r] = (j0 + r <= t) ? v[r] : 0.f;
      st4bf(M[9] + t * CLD + j0, w); });
    mm64(M[2], M[4], wid, lane, [&](int t, int i0, const f32x4& v) {
      f32x4 w;
#pragma unroll
      for (int r = 0; r < 4; ++r) w[r] = (i0 + r <= t) ? v[r] : 0.f;
      st4bf(M[10] + t * CLD + i0, w); });
  } else {
    mm64(M[3], M[3], wid, lane, [&](int j, int t0, const f32x4& v) {
      const float gj = SC[j], abj = SC[64 + j], bej = SC[128 + j];
      f32x4 w;
#pragma unroll
      for (int r = 0; r < 4; ++r) {
        const int t = t0 + r;
        const float d = (j < t) ? __expf(SC[t - 1 > 0 ? t - 1 : 0] - gj) * v[r] : 0.f;
        NF[j * 65 + t] = -abj * d; w[r] = -bej * d;
      }
      st4bf(M[8] + j * CLD + t0, w); });
    mm64(M[4], M[3], wid, lane, [&](int t, int j0, const f32x4& v) {
      const float gt = SC[t];
      f32x4 w1, w2;
#pragma unroll
      for (int r = 0; r < 4; ++r) {
        const int j = j0 + r;
        const float d = (j <= t) ? __expf(gt - SC[j]) * v[r] : 0.f;
        w1[r] = SC[64 + j] * d; w2[r] = SC[128 + j] * d;
      }
      st4bf(M[9] + t * CLD + j0, w1); st4bf(M[10] + t * CLD + j0, w2); });
  }
  __syncthreads();
  {
    const int i = tid >> 3, sidx = tid & 7;
    float tr[8];
#pragma unroll
    for (int m = 0; m < 8; ++m) tr[m] = 0.f;
#pragma unroll
    for (int t = 0; t < 64; ++t) {
      float part = 0.f;
#pragma unroll
      for (int m = 0; m < 8; ++m) if (8 * m < t) part += tr[m] * NF[(sidx + 8 * m) * 65 + t];
      const float val = sum8(part) + (i == t ? 1.f : 0.f);
      if (sidx == (t & 7)) { tr[t >> 3] = val; M[0][t * CLD + i] = f2bf(val); }
    }
  }
  __syncthreads();
  mm64(M[1], M[0], wid, lane, [&](int k, int t0, const f32x4& v) { st4bf(M[3] + k * CLD + t0, v); });
  mm64(M[8], M[0], wid, lane, [&](int i, int t0, const f32x4& v) { st4bf(M[4] + i * CLD + t0, v); });
  __syncthreads();
  mm64(M[9], M[3], wid, lane, [&](int t, int k0, const f32x4& v) {
    float rr[8]; const u32x2 rw = *(const u32x2*)(M[2] + t * CLD + k0);
    const f32x4 o = {v[0] + __uint_as_float(rw[0] << 16), v[1] + __uint_as_float(rw[0] & 0xffff0000u), v[2] + __uint_as_float(rw[1] << 16), v[3] + __uint_as_float(rw[1] & 0xffff0000u)};
    (void)rr; st4bf(oRh + t * 64 + k0, o); });
  mm64(M[9], M[4], wid, lane, [&](int t, int i0, const f32x4& v) {
    const u32x2 rw = *(const u32x2*)(M[10] + t * CLD + i0);
    const f32x4 o = {v[0] + __uint_as_float(rw[0] << 16), v[1] + __uint_as_float(rw[0] & 0xffff0000u), v[2] + __uint_as_float(rw[1] << 16), v[3] + __uint_as_float(rw[1] & 0xffff0000u)};
    st4bf(M[1] + t * CLD + i0, o); });
  mm64(M[5], M[3], wid, lane, [&](int kp, int k0, const f32x4& v) {
    f32x4 o = v;
#pragma unroll
    for (int r = 0; r < 4; ++r) if (k0 + r == kp) o[r] += SC[512 + kp];
    st4bf(oGh + kp * 64 + k0, o); });
  __syncthreads();
  mm64(M[5], M[4], wid, lane, [&](int kp, int i0, const f32x4& v) {
    f32x4 o;
#pragma unroll
    for (int r = 0; r < 4; ++r) o[r] = v[r] + bf2f(M[6][(i0 + r) * CLD + kp]);
    st4bf(M[8] + kp * CLD + i0, o); });
  __syncthreads();
  mm64(M[7], M[1], wid, lane, [&](int v, int t0, const f32x4& val) {
#pragma unroll
    for (int r = 0; r < 4; ++r) oout[(size_t)(t0 + r) * 64 + v] = val[r]; });
  mm64(M[7], M[8], wid, lane, [&](int v, int k0, const f32x4& val) { st4bf(oSV + v * 64 + k0, val); });
}

template <int WHICH>
DI void chunk_seq(const Params& p, int bh, char* lds) {
  bf16_t* SH = (bf16_t*)lds;
  bf16_t* SL = (bf16_t*)(lds + CMB);
  bf16_t* SR = (bf16_t*)(lds + 2 * CMB);
  bf16_t* SG = (bf16_t*)(lds + 4 * CMB);
  char* R = p.ws + O_R;
  const int tid = otid(), lane = tid & 63, wid = tid >> 6, fr = lane & 15, fq = lane >> 4;
  const size_t item0 = (size_t)(WHICH * NBH + bh) * NCHK;
  const bf16_t* gRh = (const bf16_t*)(R + R_CHK) + item0 * 4096;
  const bf16_t* gGh = (const bf16_t*)(R + R_CHK + CHK_SZ) + item0 * 4096;
  const bf16_t* gSV = (const bf16_t*)(R + R_CHK + 2 * CHK_SZ) + item0 * 4096;
  float* oout = (float*)(R + R_OSCAN) + (size_t)WHICH * NBH * SEQ * 64 + (size_t)bh * SEQ * 64;
  f32x4 st[2];
  st[0] = (f32x4){0.f, 0.f, 0.f, 0.f}; st[1] = st[0];
  const int lrow = tid >> 3, lch = (tid & 7) * 8;
  u32x4 rreg = *(const u32x4*)(gRh + lrow * 64 + lch), greg = *(const u32x4*)(gGh + lrow * 64 + lch);
  __syncthreads();
#pragma unroll 1
  for (int c = 0; c < NCHK; ++c) {
    bf16_t* sr = SR + (c & 1) * (64 * CLD); bf16_t* sg = SG + (c & 1) * (64 * CLD);
#pragma unroll
    for (int q = 0; q < 2; ++q) {
      const int tile = wid * 2 + q, ti = tile >> 2, tj = tile & 3, v = 16 * ti + fr, k0 = 16 * tj + 4 * fq;
      f32x4 hi, lo;
#pragma unroll
      for (int r = 0; r < 4; ++r) { const float h = bf2f(f2bf(st[q][r])); hi[r] = h; lo[r] = st[q][r] - h; }
      st4bf(SH + v * CLD + k0, hi); st4bf(SL + v * CLD + k0, lo);
    }
    *(u32x4*)(sr + lrow * CLD + lch) = rreg; *(u32x4*)(sg + lrow * CLD + lch) = greg;
    __syncthreads();
    if (c + 1 < NCHK) { rreg = *(const u32x4*)(gRh + (size_t)(c + 1) * 4096 + lrow * 64 + lch); greg = *(const u32x4*)(gGh + (size_t)(c + 1) * 4096 + lrow * 64 + lch); }
#pragma unroll
    for (int q = 0; q < 2; ++q) {
      const int tile = wid * 2 + q, ti = tile >> 2, tj = tile & 3;
      f32x4 acc = {0.f, 0.f, 0.f, 0.f};
#pragma unroll
      for (int ks = 0; ks < 2; ++ks) {
        const bf16x8 sf = *(const bf16x8*)(SH + (16 * ti + fr) * CLD + 32 * ks + 8 * fq);
        const bf16x8 rf = *(const bf16x8*)(sr + (16 * tj + fr) * CLD + 32 * ks + 8 * fq);
        acc = __builtin_amdgcn_mfma_f32_16x16x32_bf16(sf, rf, acc, 0, 0, 0);
      }
      float* op = oout + ((size_t)c * 64 + 16 * tj + fr) * 64 + 16 * ti + 4 * fq;
      f32x4 ov = *(f32x4*)op; ov += acc; *(f32x4*)op = ov;
    }
#pragma unroll
    for (int q = 0; q < 2; ++q) {
      const int tile = wid * 2 + q, ti = tile >> 2, tj = tile & 3, v = 16 * ti + fr, k0 = 16 * tj + 4 * fq;
      const u32x2 svw = *(const u32x2*)(gSV + (size_t)c * 4096 + v * 64 + k0);
      f32x4 acc = {__uint_as_float(svw[0] << 16), __uint_as_float(svw[0] & 0xffff0000u), __uint_as_float(svw[1] << 16), __uint_as_float(svw[1] & 0xffff0000u)};
#pragma unroll
      for (int ks = 0; ks < 2; ++ks) {
        const bf16x8 gf = *(const bf16x8*)(sg + (16 * tj + fr) * CLD + 32 * ks + 8 * fq);
        const bf16x8 hf = *(const bf16x8*)(SH + (16 * ti + fr) * CLD + 32 * ks + 8 * fq);
        const bf16x8 lf = *(const bf16x8*)(SL + (16 * ti + fr) * CLD + 32 * ks + 8 * fq);
        acc = __builtin_amdgcn_mfma_f32_16x16x32_bf16(gf, hf, acc, 0, 0, 0);
        acc = __builtin_amdgcn_mfma_f32_16x16x32_bf16(gf, lf, acc, 0, 0, 0);
      }
      st[q] = acc;
    }
    __syncthreads();
  }
}

DI void phase_scanpost(const Params& p, int L) {
  char* R = p.ws + O_R;
  const float* osc = (const float*)(R + R_OSCAN);
  const float* rk = (const float*)(p.ws + O_SMALL + SM_RK);
  const bf16_t* rwV = (const bf16_t*)(R + R_RWV);
  const bf16_t* auxg = (const bf16_t*)(R + R_AUXG); const bf16_t* auxgate = (const bf16_t*)(R + R_AUXGATE);
  bf16_t* y = (bf16_t*)(R + R_Y);
  const float* lnw = p.in[17] + L * 256; const float* lnb = p.in[18] + L * 256; const float* gnw = p.in[25] + L * 64;
#pragma unroll 1
  for (int it0 = obid() * 64; it0 < 2 * NBH * SEQ; it0 += gridDim.x * 64) {
    const int tid = otid(), item = it0 + (tid >> 3), d0 = (tid & 7) * 8;
    const int which = item >= NBH * SEQ, rem = item - which * NBH * SEQ, bh = rem / SEQ, t = rem % SEQ, b = bh >> 2, h = bh & 3, tok = b * SEQ + t;
    float o[8]; ld8f(o, osc + (size_t)item * 64 + d0);
    float g8[8]; unpk8(g8, *(const u32x4*)((which == 0 ? auxg : auxgate) + (size_t)tok * 256 + h * 64 + d0));
    float out[8];
    if (which == 0) {
      float s1 = 0.f;
#pragma unroll
      for (int i = 0; i < 8; ++i) s1 += o[i];
      const float mean = sum8(s1) * (1.0f / 64.0f);
      float s2 = 0.f;
#pragma unroll
      for (int i = 0; i < 8; ++i) { o[i] -= mean; s2 += o[i] * o[i]; }
      const float rstd = rsqrtf(sum8(s2) * (1.0f / 64.0f) + 64e-5f);
      float w8[8], b8[8], v8[8];
      ld8f(w8, lnw + h * 64 + d0); ld8f(b8, lnb + h * 64 + d0);
      unpk8(v8, *(const u32x4*)(rwV + ((size_t)bh * SEQ + t) * 64 + d0));
      const float rkv = rk[tok * 4 + h];
#pragma unroll
      for (int i = 0; i < 8; ++i) out[i] = (o[i] * rstd * w8[i] + b8[i] + rkv * v8[i]) * g8[i];
      *(u32x4*)(y + ((size_t)0 * NTOK + tok) * 256 + h * 64 + d0) = pk8(out);
    } else {
      float s2 = 0.f;
#pragma unroll
      for (int i = 0; i < 8; ++i) s2 += o[i] * o[i];
      const float rstd = rsqrtf(sum8(s2) * (1.0f / 64.0f) + 1e-6f);
      float w8[8]; ld8f(w8, gnw + d0);
#pragma unroll
      for (int i = 0; i < 8; ++i) out[i] = o[i] * rstd * w8[i] * g8[i];
      *(u32x4*)(y + ((size_t)3 * NTOK + tok) * 256 + h * 64 + d0) = pk8(out);
    }
  }
}

DI bf16x8 packf8(float a0, float a1, float a2, float a3, float a4, float a5, float a6, float a7) {
  u32x4 w; w[0] = pk2(a0, a1); w[1] = pk2(a2, a3); w[2] = pk2(a4, a5); w[3] = pk2(a6, a7);
  return __builtin_bit_cast(bf16x8, w);
}
constexpr int KLD = 72;
template <int TYPE>
DI void attn_unit(const Params& p, int L, int bh, int qt, char* lds) {
  bf16_t* Ks = (bf16_t*)lds;
  bf16_t* Vs = Ks + 64 * KLD;
  float* cs = (float*)(lds + 2 * 64 * KLD * 2);
  float* red = cs + 8192;
  char* R = p.ws + O_R;
  const int tid = otid(), lane = tid & 63, wid = tid >> 6, r32 = lane & 31, hi = lane >> 5;
  const int b = bh >> 2, h = bh & 3;
  const int map = TYPE == 0 ? (wid >> 2) : 0, wq = TYPE == 0 ? (wid & 3) : wid;
  const int QROWS = TYPE == 0 ? 128 : 256;
  const int q0 = qt * QROWS, qw0 = q0 + wq * 32, q = qw0 + r32;
  const bf16_t* Qg = (const bf16_t*)(R + (TYPE == 0 ? R_QD : R_QF)) + (size_t)bh * SEQ * 64;
  const bf16_t* Kg = (const bf16_t*)(R + (TYPE == 0 ? R_KD : R_KF)) + (size_t)bh * SEQ * 64;
  const bf16_t* Vg = (const bf16_t*)(R + (TYPE == 0 ? R_VD : R_VF)) + (size_t)bh * 64 * SEQ;
  const int NT = (q0 + QROWS) / 64;
  __syncthreads();
  const int lrow = tid >> 3, lch = (tid & 7) * 8;
  u32x4 kreg = *(const u32x4*)(Kg + (size_t)lrow * 64 + lch);
  u32x4 vreg = *(const u32x4*)(Vg + (size_t)lrow * SEQ + lch);
  float cq = 0.f;
  if (TYPE == 1) {
    const float* lf = (const float*)(p.ws + O_SMALL + SM_LOGF) + (size_t)bh * SEQ;
    const int n = q0 + 256;
    float loc[16]; float tot = 0.f;
#pragma unroll
    for (int i = 0; i < 16; ++i) { const int e = tid * 16 + i; loc[i] = e < n ? lf[e] : 0.f; tot += loc[i]; }
    float inc = tot;
#pragma unroll
    for (int o = 1; o < 64; o <<= 1) { const float t2 = __shfl_up(inc, o); if (lane >= o) inc += t2; }
    if (lane == 63) red[wid] = inc;
    __syncthreads();
    float pre = inc - tot;
    for (int w = 0; w < wid; ++w) pre += red[w];
#pragma unroll
    for (int i = 0; i < 16; ++i) { pre += loc[i]; const int e = tid * 16 + i; if (e < n) cs[e] = pre * 1.4426950408889634f; }
    __syncthreads();
    cq = cs[q];
  }
  constexpr int NS = TYPE == 0 ? 2 : 4;
  const int sbase = TYPE == 0 ? 2 * map : 0;
  bf16x8 qf[NS];
#pragma unroll
  for (int s = 0; s < NS; ++s) qf[s] = *(const bf16x8*)(Qg + (size_t)q * 64 + 16 * (sbase + s) + 8 * hi);
  float m = -INFINITY, l = 0.f; f32x16 o[2];
#pragma unroll
  for (int r = 0; r < 16; ++r) { o[0][r] = 0.f; o[1][r] = 0.f; }
#pragma unroll 1
  for (int jt = 0; jt < NT; ++jt) {
    const int kv0 = jt * 64;
    __syncthreads();
    *(u32x4*)(Ks + lrow * KLD + lch) = kreg;
    *(u32x4*)(Vs + lrow * KLD + lch) = vreg;
    __syncthreads();
    if (jt + 1 < NT) {
      kreg = *(const u32x4*)(Kg + (size_t)(kv0 + 64 + lrow) * 64 + lch);
      vreg = *(const u32x4*)(Vg + (size_t)lrow * SEQ + kv0 + 64 + lch);
    }
    if (kv0 <= qw0 + 31) {
      const bool needmask = kv0 + 63 > qw0;
      f32x16 p0, p1;
#pragma unroll
      for (int r = 0; r < 16; ++r) { p0[r] = 0.f; p1[r] = 0.f; }
#pragma unroll
      for (int s = 0; s < NS; ++s) {
        const bf16x8 k0 = *(const bf16x8*)(Ks + r32 * KLD + 16 * (sbase + s) + 8 * hi);
        const bf16x8 k1 = *(const bf16x8*)(Ks + (32 + r32) * KLD + 16 * (sbase + s) + 8 * hi);
        p0 = __builtin_amdgcn_mfma_f32_32x32x16_bf16(k0, qf[s], p0, 0, 0, 0);
        p1 = __builtin_amdgcn_mfma_f32_32x32x16_bf16(k1, qf[s], p1, 0, 0, 0);
      }
      if (TYPE == 1) {
#pragma unroll
        for (int r = 0; r < 16; ++r) { p0[r] += cq - cs[kv0 + crow(r, hi)]; p1[r] += cq - cs[kv0 + 32 + crow(r, hi)]; }
      }
      if (needmask) {
#pragma unroll
        for (int r = 0; r < 16; ++r) { if (kv0 + crow(r, hi) > q) p0[r] = -INFINITY; if (kv0 + 32 + crow(r, hi) > q) p1[r] = -INFINITY; }
      }
      float mx = fmaxf(p0[0], p1[0]);
#pragma unroll
      for (int r = 1; r < 16; ++r) mx = fmaxf(mx, fmaxf(p0[r], p1[r]));
      mx = fmaxf(mx, __shfl_xor(mx, 32));
      const float mn = fmaxf(m, mx);
      const float alpha = __builtin_amdgcn_exp2f(m - mn);
      m = mn;
      float rs = 0.f;
#pragma unroll
      for (int r = 0; r < 16; ++r) { p0[r] = __builtin_amdgcn_exp2f(p0[r] - mn); p1[r] = __builtin_amdgcn_exp2f(p1[r] - mn); rs += p0[r] + p1[r]; }
      l = l * alpha + rs;
#pragma unroll
      for (int r = 0; r < 16; ++r) { o[0][r] *= alpha; o[1][r] *= alpha; }
      bf16x8 pf[4];
      pf[0] = packf8(p0[0], p0[1], p0[2], p0[3], p0[4], p0[5], p0[6], p0[7]);
      pf[1] = packf8(p0[8], p0[9], p0[10], p0[11], p0[12], p0[13], p0[14], p0[15]);
      pf[2] = packf8(p1[0], p1[1], p1[2], p1[3], p1[4], p1[5], p1[6], p1[7]);
      pf[3] = packf8(p1[8], p1[9], p1[10], p1[11], p1[12], p1[13], p1[14], p1[15]);
#pragma unroll
      for (int db = 0; db < 2; ++db)
#pragma unroll
        for (int s = 0; s < 4; ++s) {
          const s16x4 lo = *(const s16x4*)(Vs + (32 * db + r32) * KLD + 16 * s + 4 * hi);
          const s16x4 hh = *(const s16x4*)(Vs + (32 * db + r32) * KLD + 16 * s + 8 + 4 * hi);
          const bf16x8 vf = __builtin_shufflevector(lo, hh, 0, 1, 2, 3, 4, 5, 6, 7);
          o[db] = __builtin_amdgcn_mfma_f32_32x32x16_bf16(vf, pf[s], o[db], 0, 0, 0);
        }
    }
  }
  bf16_t* y = (bf16_t*)(R + R_Y);
  const size_t orow = ((size_t)(TYPE == 0 ? 1 : 2) * NTOK + (size_t)b * SEQ + q) * 256 + h * 64;
  const float lt = l + __shfl_xor(l, 32);
  const float li = 1.0f / lt;
  if (TYPE == 1) {
#pragma unroll
    for (int db = 0; db < 2; ++db)
#pragma unroll
      for (int g = 0; g < 4; ++g) {
        u32x2 w; w[0] = pk2(o[db][4 * g] * li, o[db][4 * g + 1] * li); w[1] = pk2(o[db][4 * g + 2] * li, o[db][4 * g + 3] * li);
        *(u32x2*)(y + orow + 32 * db + 8 * g + 4 * hi) = w;
      }
  } else {
    float* xb = cs;
    if (map == 1) {
#pragma unroll
      for (int db = 0; db < 2; ++db)
#pragma unroll
        for (int r = 0; r < 16; ++r) xb[(wq * 32 + db * 16 + r) * 64 + lane] = o[db][r] * li;
    }
    __syncthreads();
    if (map == 0) {
      const float* lp = p.in[19] + L * 128;
      float s01 = 0.f, s23 = 0.f;
      for (int i = 0; i < 32; ++i) { s01 += lp[i] * lp[32 + i]; s23 += lp[64 + i] * lp[96 + i]; }
      const float lam_init = L == 0 ? 0.2f : 0.35550906759096934f;
      const float lam = __expf(s01) - __expf(s23) + lam_init;
      const float* sub = p.in[20] + L * 64;
      float ss = 0.f;
#pragma unroll
      for (int db = 0; db < 2; ++db)
#pragma unroll
        for (int r = 0; r < 16; ++r) { const float vv = o[db][r] * li - lam * xb[(wq * 32 + db * 16 + r) * 64 + lane]; o[db][r] = vv; ss += vv * vv; }
      ss += __shfl_xor(ss, 32);
      const float sc = rsqrtf(ss * (1.0f / 64.0f) + 1e-5f) * (1.0f - lam_init);
#pragma unroll
      for (int db = 0; db < 2; ++db)
#pragma unroll
        for (int g = 0; g < 4; ++g) {
          const int d = 32 * db + 8 * g + 4 * hi;
          const f32x4 sw = *(const f32x4*)(sub + d);
          u32x2 w; w[0] = pk2(o[db][4 * g] * sc * sw[0], o[db][4 * g + 1] * sc * sw[1]); w[1] = pk2(o[db][4 * g + 2] * sc * sw[2], o[db][4 * g + 3] * sc * sw[3]);
          *(u32x2*)(y + orow + d) = w;
        }
    }
  }
}

template <class BarF>
DI void phase_mix(const Params& p, int L, char* lds, int qslot, BarF gbar) {
  int* ctr = (int*)(p.ws + O_CTL) + CW_QCTR + qslot * 64;
  int* s_unit = (int*)(lds + 2 * 64 * KLD * 2 + 8192 * 4 + 64);
#pragma unroll 1
  for (int item = obid(); item < 2 * NBH * NCHK; item += gridDim.x) {
    const int bh = (item >> 7) & 7, c = item & 127;
    if (item < NBH * NCHK) chunk_pre<0>(p, bh, c, lds); else chunk_pre<1>(p, bh, c, lds);
  }
  gbar();
  {
    const int bid = obid();
    if (bid < 16) { if (bid < 8) chunk_seq<0>(p, bid & 7, lds); else chunk_seq<1>(p, bid & 7, lds); }
  }
#pragma unroll 1
  for (;;) {
    __syncthreads();
    if (otid() == 0) *s_unit = atomicAdd(ctr, 1);
    __syncthreads();
    const int u = *s_unit;
    if (u >= 768) break;
    const int level = 31 - u / 24, w = u % 24;
    if (w < 8) attn_unit<1>(p, L, w, level, lds);
    else if (w < 16) attn_unit<0>(p, L, w - 8, 2 * level + 1, lds);
    else attn_unit<0>(p, L, w - 16, 2 * level, lds);
  }
  if (L == 0 && qslot == 0) {
    int* cctr = (int*)(p.ws + O_CTL) + CW_QCTR + 8 * 64;
    float* tl = (float*)lds; const int tid = otid();
#pragma unroll 1
    for (;;) {
      __syncthreads();
      if (tid == 0) *s_unit = atomicAdd(cctr, 8);
      __syncthreads();
      const int g0 = *s_unit;
      if (g0 >= MOE_CONV_TILES) break;
#pragma unroll 1
      for (int g = g0; g < g0 + 8; ++g) moe_convert_tile(p, g, tl, tid);
    }
  }
}
DI void phase_mix_attn_only(const Params& p, int L, char* lds, int qslot) {
  int* ctr = (int*)(p.ws + O_CTL) + CW_QCTR + qslot * 64;
  int* s_unit = (int*)(lds + 2 * 64 * KLD * 2 + 8192 * 4 + 64);
#pragma unroll 1
  for (;;) {
    __syncthreads();
    if (otid() == 0) *s_unit = atomicAdd(ctr, 1);
    __syncthreads();
    const int u = *s_unit;
    if (u >= 768) break;
    const int level = 31 - u / 24, w = u % 24;
    if (w < 8) attn_unit<1>(p, L, w, level, lds);
    else if (w < 16) attn_unit<0>(p, L, w - 8, 2 * level + 1, lds);
    else attn_unit<0>(p, L, w - 16, 2 * level, lds);
  }
}


template <class F>
DI void run_gemm(PG8_LAS unsigned char* lds, const bf16_t* A, const bf16_t* Bt, int M, int N, int K, const int* texp, size_t bstride, F f) {
  pg8::Gemm g{A, Bt, M, N, K, texp, bstride};
  pg8::StaticOrder S; S.init(M, N, (int)gridDim.x, obid());
  pg8::EpiFn<F> E{f};
  pg8::gemm_phase<pg8::EpiFn<F>, pg8::StaticOrder, true, true>(lds, g, S, E);
}
DI void st_bf16x4(bf16_t* dst, const f32x4& v) { u32x2 w; w[0] = pk2(v[0], v[1]); w[1] = pk2(v[2], v[3]); *(u32x2*)dst = w; }
DI f32x4 ld_bf16x4(const bf16_t* src) { const u32x2 w = *(const u32x2*)src; return (f32x4){__uint_as_float(w[0] << 16), __uint_as_float(w[0] & 0xffff0000u), __uint_as_float(w[1] << 16), __uint_as_float(w[1] & 0xffff0000u)}; }

DI void phase_u(const Params& p, int L, PG8_LAS unsigned char* lds) {
  bf16_t* u = (bf16_t*)(p.ws + O_R + R_U);
  run_gemm(lds, (const bf16_t*)(p.ws + O_HB), (const bf16_t*)(p.ws + O_WIN + L * SZ_WIN), NTOK, UN, DM, nullptr, 0,
           [=](int row, int col, const f32x4& v) { if (col < UC) st_bf16x4(u + (size_t)row * UC + col, v); });
}
DI void phase_proj(const Params& p, int L, PG8_LAS unsigned char* lds) {
  bf16_t* PJ = (bf16_t*)(p.ws + O_R + R_PJ);
  run_gemm(lds, (const bf16_t*)(p.ws + O_R + R_Y), (const bf16_t*)(p.ws + O_WBO) + (size_t)L * 4 * 1024 * 256, 4 * NTOK, 1024, 256,
           (const int*)(p.ws + O_SMALL + SM_TEXP4), (size_t)1024 * 256 * 2,
           [=](int row, int col, const f32x4& v) { st_bf16x4(PJ + (size_t)(row & (NTOK - 1)) * 4096 + (row >> 14) * 1024 + col, v); });
}
DI void phase_gate(const Params& p, int L, PG8_LAS unsigned char* lds) {
  bf16_t* PJ = (bf16_t*)(p.ws + O_R + R_PJ);
  run_gemm(lds, (const bf16_t*)(p.ws + O_HB), (const bf16_t*)(p.ws + O_WIN + L * SZ_WIN) + (size_t)OFF_G * DM, NTOK, 4096, DM, nullptr, 0,
           [=](int row, int col, const f32x4& v) {
             bf16_t* q = PJ + (size_t)row * 4096 + col;
             const f32x4 pj = ld_bf16x4(q);
             f32x4 o; o[0] = sigmoidf_(v[0]) * pj[0]; o[1] = sigmoidf_(v[1]) * pj[1]; o[2] = sigmoidf_(v[2]) * pj[2]; o[3] = sigmoidf_(v[3]) * pj[3];
             st_bf16x4(q, o);
           });
}
DI void phase_bsum(const Params& p) {
  const u32x4* GP = (const u32x4*)(p.ws + O_R + R_PJ); u32x4* M = (u32x4*)(p.ws + O_R + R_M);
  const int gtid = obid() * NTHR + otid(), gsz = gridDim.x * NTHR;
  for (int i = gtid; i < NTOK * 128; i += gsz) {
    const int tok = i >> 7, c8 = i & 127;
    float a[8];
#pragma unroll
    for (int k = 0; k < 8; ++k) a[k] = 0.f;
#pragma unroll
    for (int b = 0; b < 4; ++b) {
      const u32x4 w = GP[(size_t)tok * 512 + b * 128 + c8];
#pragma unroll
      for (int k = 0; k < 4; ++k) { a[2 * k] += __uint_as_float(w[k] << 16); a[2 * k + 1] += __uint_as_float(w[k] & 0xffff0000u); }
    }
    u32x4 o; o[0] = pk2(a[0], a[1]); o[1] = pk2(a[2], a[3]); o[2] = pk2(a[4], a[5]); o[3] = pk2(a[6], a[7]);
    M[i] = o;
  }
}
DI void phase_xadd(const Params& p, const bf16_t* A, const bf16_t* Bt, int K, PG8_LAS unsigned char* lds) {
  float* x = p.x;
  run_gemm(lds, A, Bt, NTOK, DM, K, nullptr, 0, [=](int row, int col, const f32x4& v) { float* xp = x + (size_t)row * DM + col; f32x4 xv = *(f32x4*)xp; xv += v; *(f32x4*)xp = xv; });
}
DI void phase_ffn_up(const Params& p, PG8_LAS unsigned char* lds) {
  bf16_t* T = (bf16_t*)(p.ws + O_R + R_T);
  run_gemm(lds, (const bf16_t*)(p.ws + O_HB), (const bf16_t*)(p.ws + O_FGU), NTOK, 2 * FFD, DM, nullptr, 0,
           [=](int row, int col, const f32x4& v) {
             const float t0 = v[0] * sigmoidf_(v[0]) * v[1], t1 = v[2] * sigmoidf_(v[2]) * v[3];
             *(unsigned*)(T + (size_t)row * FFD + (col >> 1)) = pk2(t0, t1);
           });
}
DI void phase_moe_gather(const Params& p) {
  const int* cnt = (const int*)(p.ws + O_CTL) + CW_MOECNT;
  const int* list = (const int*)(p.ws + O_SMALL + SM_LIST);
  const float* gw = (const float*)(p.ws + O_SMALL + SM_GW);
  int* texp = (int*)(p.ws + O_SMALL + SM_TEXP);
  int* rowtok = (int*)(p.ws + O_SMALL + SM_ROWTOK);
  float* rowgw = (float*)(p.ws + O_SMALL + SM_ROWGW);
  int* slotrow = (int*)(p.ws + O_SMALL + SM_SLOTROW);
  const bf16_t* hb = (const bf16_t*)(p.ws + O_HB);
  bf16_t* xbuf = (bf16_t*)(p.ws + O_XBUF);
  const int lane = otid() & 63, wid = otid() >> 6;
  int c[8];
#pragma unroll
  for (int e = 0; e < 8; ++e) c[e] = cnt[e];
  int total = 0;
#pragma unroll
  for (int e = 0; e < 8; ++e) total += (c[e] + 255) & ~255;
  for (int row = obid() * 8 + wid; row < total; row += gridDim.x * 8) {
    int e = 0, s = 0, o = 0;
#pragma unroll
    for (int i = 0; i < 8; ++i) { const int pc = (c[i] + 255) & ~255; if (row >= o && row < o + pc) { e = i; s = row - o; } o += pc; }
    int ce = 0;
#pragma unroll
    for (int i = 0; i < 8; ++i) if (i == e) ce = c[i];
    const bool valid = s < ce;
    const int tok = valid ? list[(size_t)e * NTOK + s] : -1;
    u32x4 v0 = {0u, 0u, 0u, 0u}, v1 = {0u, 0u, 0u, 0u};
    if (valid) { const u32x4* src = (const u32x4*)(hb + (size_t)tok * DM); v0 = src[lane]; v1 = src[64 + lane]; }
    u32x4* dst = (u32x4*)(xbuf + (size_t)row * DM); dst[lane] = v0; dst[64 + lane] = v1;
    if (lane == 0) { rowtok[row] = tok; rowgw[row] = valid ? gw[(size_t)e * NTOK + s] : 0.f; if ((row & 255) == 0) texp[row >> 8] = e; if (valid) slotrow[(size_t)e * NTOK + s] = row; }
  }
}
DI int moe_rows(const Params& p) {
  const int* cnt = (const int*)(p.ws + O_CTL) + CW_MOECNT;
  int total = 0;
#pragma unroll
  for (int e = 0; e < 8; ++e) total += (cnt[e] + 255) & ~255;
  return total;
}
DI void phase_moe_up(const Params& p, PG8_LAS unsigned char* lds) {
  const int Mp = moe_rows(p);
  bf16_t* T = (bf16_t*)(p.ws + O_T2);
  run_gemm(lds, (const bf16_t*)(p.ws + O_XBUF), (const bf16_t*)(p.ws + O_MGU), Mp, 2 * FFE, DM, (const int*)(p.ws + O_SMALL + SM_TEXP), (size_t)2 * FFE * DM * 2,
           [=](int row, int col, const f32x4& v) {
             const float t0 = v[0] * sigmoidf_(v[0]) * v[1], t1 = v[2] * sigmoidf_(v[2]) * v[3];
             *(unsigned*)(T + (size_t)row * FFE + (col >> 1)) = pk2(t0, t1);
           });
}
DI void phase_moe_down(const Params& p, PG8_LAS unsigned char* lds) {
  const int Mp = moe_rows(p);
  const float* rowgw = (const float*)(p.ws + O_SMALL + SM_ROWGW);
  bf16_t* Y2 = (bf16_t*)(p.ws + O_XBUF);
  run_gemm(lds, (const bf16_t*)(p.ws + O_T2), (const bf16_t*)(p.ws + O_MD), Mp, DM, FFE, (const int*)(p.ws + O_SMALL + SM_TEXP), (size_t)DM * FFE * 2,
           [=](int row, int col, const f32x4& v) { const float w = rowgw[row]; st_bf16x4(Y2 + (size_t)row * DM + col, v * w); });
}
DI void phase_ple_proj(const Params& p, int L, PG8_LAS unsigned char* lds) {
  bf16_t* PJ2 = (bf16_t*)(p.ws + O_R + R_PJ2);
  run_gemm(lds, (const bf16_t*)(p.ws + O_PB), (const bf16_t*)(p.ws + O_PP) + (size_t)L * 1024 * 256, NTOK, DM, 256, nullptr, 0,
           [=](int row, int col, const f32x4& v) { st_bf16x4(PJ2 + (size_t)row * DM + col, v); });
}
DI void phase_ple_gate(const Params& p, int L, PG8_LAS unsigned char* lds) {
  const bf16_t* PJ2 = (const bf16_t*)(p.ws + O_R + R_PJ2);
  float* x = p.x;
  run_gemm(lds, (const bf16_t*)(p.ws + O_HB), (const bf16_t*)(p.ws + O_PG) + (size_t)L * 1024 * 1024, NTOK, DM, DM, nullptr, 0,
           [=](int row, int col, const f32x4& v) {
             const f32x4 pj = ld_bf16x4(PJ2 + (size_t)row * DM + col);
             float* xp = x + (size_t)row * DM + col; f32x4 xv = *(f32x4*)xp;
             xv[0] += sigmoidf_(v[0]) * pj[0]; xv[1] += sigmoidf_(v[1]) * pj[1]; xv[2] += sigmoidf_(v[2]) * pj[2]; xv[3] += sigmoidf_(v[3]) * pj[3];
             *(f32x4*)xp = xv;
           });
}
DI void phase_final(const Params& p) {
  const int lane = otid() & 63, wid = otid() >> 6;
  const float* g = p.in[35];
  for (int row = obid() * 8 + wid; row < NTOK; row += gridDim.x * 8) {
    float* xr = p.x + (size_t)row * DM;
    f32x4 v[4]; float ss = 0.f;
#pragma unroll
    for (int j = 0; j < 4; ++j) { v[j] = *(const f32x4*)(xr + j * 256 + lane * 4); ss += v[j][0] * v[j][0] + v[j][1] * v[j][1] + v[j][2] * v[j][2] + v[j][3] * v[j][3]; }
    ss = wave_sum(ss);
    const float rstd = rsqrtf(ss * (1.0f / 1024.0f) + 1e-6f);
#pragma unroll
    for (int j = 0; j < 4; ++j) { const f32x4 gg = *(const f32x4*)(g + j * 256 + lane * 4); *(f32x4*)(xr + j * 256 + lane * 4) = v[j] * rstd * gg; }
  }
}


constexpr int RING_BYTES = 131072, LDSCTL_OFF = RING_BYTES, MISC_OFF = LDSCTL_OFF + 320, LDS_BYTES = 147456;
static_assert(2 * SCH * RS * 4 + 2 * SCH * 512 * 4 <= RING_BYTES, "scan LDS");

__global__ void __launch_bounds__(NTHR) __attribute__((target("no-packed-fp32-ops"))) fwd_megakernel(Params p) {
  extern __shared__ __attribute__((aligned(16))) unsigned char lds_raw[];
  LAS unsigned char* ldsp = (LAS unsigned char*)lds_raw;
  char* lds = (char*)lds_raw;
  for (int u = threadIdx.x; u < (LDS_BYTES - LDSCTL_OFF) / 4; u += NTHR) ((LAS unsigned*)(ldsp + LDSCTL_OFF))[u] = 0u;
  __syncthreads();
  XcdBarrier bar = xcd_barrier_post((unsigned*)(p.ws + O_CTL) + CW_BAR, (volatile LAS unsigned*)(ldsp + MISC_OFF) + 8);
#define GBAR() xcd_barrier(bar)
  phase0(olaunder(p), lds);
#if PROBE == 3
  GBAR(); phase0(olaunder(p), lds);
#endif
  cg::this_grid().sync();
  GBAR();
#pragma unroll 1
  for (int L = 0; L < 2; ++L) {
    norm_phase<false>(olaunder(p), p.in[2] + L * DM, nullptr);
    GBAR();
#if PROBE == 36
    if (L == 0) { norm_phase<false>(olaunder(p), p.in[2] + L * DM, nullptr); GBAR(); norm_phase<false>(olaunder(p), p.in[2] + L * DM, nullptr); GBAR(); norm_phase<false>(olaunder(p), p.in[2] + L * DM, nullptr); GBAR(); norm_phase<false>(olaunder(p), p.in[2] + L * DM, nullptr); GBAR(); }
#endif
#if PROBE == 40
    if (L == 0) { for (int rep = 0; rep < 20; ++rep) GBAR(); }
#endif
    phase_u(olaunder(p), L, ldsp);
    GBAR();
#if PROBE == 31
    if (L == 0) { phase_u(olaunder(p), L, ldsp); GBAR(); }
#endif
    phase_prep2(olaunder(p), L, lds);
    GBAR();
#if PROBE == 2
    if (L == 0) { phase_prep2(olaunder(p), L, lds); GBAR(); }
#endif
#if PROBE == 21
    if (L == 0) { phase_prep<1>(olaunder(p), L, lds); GBAR(); }
#endif
#if PROBE == 22
    if (L == 0) { phase_prep<2>(olaunder(p), L, lds); GBAR(); }
#endif
#if PROBE == 23
    if (L == 0) { phase_prep<4>(olaunder(p), L, lds); GBAR(); }
#endif
    phase_mix(olaunder(p), L, lds, L, [&]() { xcd_barrier(bar); });
    GBAR();
#if PROBE == 1
    if (L == 0) { phase_mix(olaunder(p), L, lds, 2, [&]() { xcd_barrier(bar); }); GBAR(); }
#endif
#if PROBE == 5
    if (L == 0) { phase_mix_attn_only(olaunder(p), L, lds, 2); GBAR(); }
#endif
    phase_scanpost(olaunder(p), L);
    GBAR();
#if PROBE == 38
    if (L == 0) { phase_scanpost(olaunder(p), L); GBAR(); phase_scanpost(olaunder(p), L); GBAR(); }
#endif
    phase_proj(olaunder(p), L, ldsp);
    GBAR();
#if PROBE == 35
    if (L == 0) { phase_proj(olaunder(p), L, ldsp); GBAR(); }
#endif
    phase_gate(olaunder(p), L, ldsp);
    GBAR();
    phase_bsum(olaunder(p));
    GBAR();
#if PROBE == 37
    if (L == 0) { phase_bsum(olaunder(p)); GBAR(); phase_bsum(olaunder(p)); GBAR(); }
#endif
    phase_xadd(olaunder(p), (const bf16_t*)(p.ws + O_R + R_M), (const bf16_t*)(p.ws + O_WOUT) + (size_t)L * 1024 * 1024, DM, ldsp);
    GBAR();
    if (L == 0) {
      norm_phase<false>(olaunder(p), p.in[3] + L * DM, nullptr);
      GBAR();
      phase_ffn_up(olaunder(p), ldsp);
      GBAR();
#if PROBE == 32
      phase_ffn_up(olaunder(p), ldsp); GBAR();
#endif
      phase_xadd(olaunder(p), (const bf16_t*)(p.ws + O_R + R_T), (const bf16_t*)(p.ws + O_FD), FFD, ldsp);
      GBAR();
    } else {
      norm_phase<true>(olaunder(p), p.in[3] + L * DM, p.in[29]);
      GBAR();
      phase_moe_gather(olaunder(p));
      GBAR();
      phase_moe_up(olaunder(p), ldsp);
      GBAR();
#if PROBE == 33
      phase_moe_up(olaunder(p), ldsp); GBAR();
#endif
#if PROBE == 34
      phase_moe_down(olaunder(p), ldsp); GBAR();
#endif
      phase_moe_down(olaunder(p), ldsp);
      GBAR();
    }
    if (L == 0) norm_phase<false>(olaunder(p), p.in[4] + L * DM, nullptr);
    else norm_phase<false, true>(olaunder(p), p.in[4] + L * DM, nullptr);
    convert_p(olaunder(p), L);
    GBAR();
    phase_ple_proj(olaunder(p), L, ldsp);
    GBAR();
    phase_ple_gate(olaunder(p), L, ldsp);
    GBAR();
  }
  phase_final(olaunder(p));
}

extern "C" void kernel_launch(void* const* d_in, const int* in_sizes, int n_in, void* d_out, int out_size,
                              void* d_ws, size_t ws_size, hipStream_t stream) {
  static int grid_blocks = 0;
  if (grid_blocks == 0) {
    int dev = 0, cus = 0, per_cu = 0;
    (void)hipGetDevice(&dev);
    (void)hipDeviceGetAttribute(&cus, hipDeviceAttributeMultiprocessorCount, dev);
    if (hipFuncSetAttribute((const void*)fwd_megakernel, hipFuncAttributeMaxDynamicSharedMemorySize, LDS_BYTES) != hipSuccess) { fprintf(stderr, "hipFuncSetAttribute failed\n"); grid_blocks = -1; return; }
    (void)hipOccupancyMaxActiveBlocksPerMultiprocessor(&per_cu, (const void*)fwd_megakernel, NTHR, LDS_BYTES);
    if (per_cu < 1) { fprintf(stderr, "occupancy query says %d blocks per CU\n", per_cu); grid_blocks = -1; return; }
    grid_blocks = cus;
  }
  if (grid_blocks < 0) return;
  if (ws_size < WS_NEED) { fprintf(stderr, "workspace too small: %zu < %zu\n", ws_size, (size_t)WS_NEED); return; }
  (void)hipMemsetAsync((char*)d_ws + O_CTL, 0, CTL_BYTES, stream);
  Params p{};
  for (int i = 0; i < 36; ++i) p.in[i] = (const float*)d_in[i];
  p.x = (float*)d_out;
  p.ws = (char*)d_ws;
  void* args[] = {&p};
  hipError_t e = hipLaunchCooperativeKernel((void*)fwd_megakernel, dim3(grid_blocks), dim3(NTHR), args, LDS_BYTES, stream);
  if (e != hipSuccess) fprintf(stderr, "cooperative launch failed: %s (grid %d)\n", hipGetErrorString(e), grid_blocks);
}
```

```cpp
#include <hip/hip_runtime.h>
#include <hip/hip_cooperative_groups.h>
#include <cstdio>
#include <cstdint>
namespace cg = cooperative_groups;

typedef unsigned short bf16_t;
typedef short bf16x8 __attribute__((ext_vector_type(8)));
typedef short s16x4 __attribute__((ext_vector_type(4)));
typedef float f32x4 __attribute__((ext_vector_type(4)));
typedef float f32x2 __attribute__((ext_vector_type(2)));
typedef float f32x16 __attribute__((ext_vector_type(16)));
typedef unsigned u32x4 __attribute__((ext_vector_type(4)));
typedef unsigned u32x2 __attribute__((ext_vector_type(2)));
typedef __bf16 bf16x2_t __attribute__((ext_vector_type(2)));

#define DI __device__ __forceinline__

#ifndef PROBE
#define PROBE 0
#endif
constexpr int NTOK = 16384, DM = 1024, SEQ = 8192, NBH = 8;
constexpr int INC = 7692, UC = 3600, UN = 3840;
constexpr int OFF_B = 1024, OFF_C = 1792, OFF_D = 2564, OFF_G = 3596;
constexpr int FFD = 2816, FFE = 3584, NEXP = 8;
constexpr int NTHR = 512;
constexpr int MOE_ROWS = 34816;

constexpr size_t al256(size_t x) { return (x + 255) & ~(size_t)255; }
constexpr size_t O_CTL = 0, CTL_BYTES = 1u << 20;
constexpr int CW_BAR = 4096;
constexpr int CW_QCTR = 16384;
constexpr int CW_MOECNT = 16384 + 256;
constexpr size_t O_MGU = CTL_BYTES;
constexpr size_t O_MD = O_MGU + (size_t)NEXP * 2 * FFE * 1024 * 2;
constexpr size_t O_PG = O_MD + (size_t)NEXP * 1024 * FFE * 2;
constexpr size_t O_PP = O_PG + (size_t)2 * 1024 * 1024 * 2;
constexpr size_t O_PB = O_PP + (size_t)2 * 1024 * 256 * 2;
constexpr size_t O_LORA = O_PB + (size_t)NTOK * 256 * 2;
constexpr size_t SZ_LORA = (size_t)256 * 256 * 2;
constexpr size_t O_HB = O_LORA + 2 * SZ_LORA;
constexpr size_t O_SMALL = O_HB + (size_t)NTOK * DM * 2;
constexpr size_t SM_LIST = 0;
constexpr size_t SM_GW = SM_LIST + (size_t)NEXP * NTOK * 4;
constexpr size_t SM_RK = SM_GW + (size_t)NEXP * NTOK * 4;
constexpr size_t SM_LOGF = SM_RK + (size_t)NTOK * 4 * 4;
constexpr size_t SM_GBETA = SM_LOGF + (size_t)NBH * SEQ * 4;
constexpr size_t SM_GA = SM_GBETA + (size_t)NBH * SEQ * 4;
constexpr size_t SM_TEXP = SM_GA + (size_t)NBH * SEQ * 4;
constexpr size_t SM_ROWTOK = SM_TEXP + 1024;
constexpr size_t SM_ROWGW = SM_ROWTOK + (size_t)MOE_ROWS * 4;
constexpr size_t SM_TEXP4 = SM_ROWGW + (size_t)MOE_ROWS * 4;
constexpr size_t SM_TOKSLOT = SM_TEXP4 + 1024;
constexpr size_t SM_SLOTROW = SM_TOKSLOT + (size_t)NTOK * 2 * 4;
constexpr size_t SZ_SMALL = al256(SM_SLOTROW + (size_t)NEXP * NTOK * 4);
constexpr size_t O_ERA = O_SMALL + SZ_SMALL;
constexpr size_t SZ_WIN = al256((size_t)INC * DM * 2);
constexpr size_t O_WIN = O_ERA;
constexpr size_t O_WBO = O_WIN + 2 * SZ_WIN;
constexpr size_t O_WOUT = O_WBO + (size_t)2 * 4 * 1024 * 256 * 2;
constexpr size_t O_FGU = O_WOUT + (size_t)2 * 1024 * 1024 * 2;
constexpr size_t O_FD = O_FGU + (size_t)2 * FFD * 1024 * 2;
constexpr size_t O_R = O_FD + (size_t)1024 * FFD * 2;
constexpr size_t SZ_BH = (size_t)NBH * SEQ * 64 * 2;
constexpr size_t R_U = 0;
constexpr size_t R_Y = 0;
constexpr size_t R_PJ = (size_t)NTOK * DM * 2;
constexpr size_t R_M = R_PJ + (size_t)NTOK * 4096 * 2;
constexpr size_t SZ_U = (size_t)NTOK * UC * 2;
constexpr size_t R_OSCAN = (size_t)NTOK * DM * 2;
constexpr size_t R_CHK = R_OSCAN + (size_t)2 * NBH * SEQ * 64 * 4;
constexpr size_t CHK_SZ = (size_t)2 * NBH * (SEQ / 64) * 4096 * 2;
static_assert(R_CHK + 3 * CHK_SZ <= SZ_U, "chunk operators inside dead u");
constexpr size_t R_RWA = R_U + SZ_U, R_RWB = R_RWA + SZ_BH, R_RWK = R_RWB + SZ_BH, R_RWR = R_RWK + SZ_BH, R_RWV = R_RWR + SZ_BH;
constexpr size_t R_RWW = R_RWV + SZ_BH;
constexpr size_t R_GQ = R_RWW + 2 * SZ_BH, R_GK = R_GQ + SZ_BH, R_GV = R_GK + SZ_BH;
constexpr size_t R_QD = R_GV + SZ_BH, R_KD = R_QD + SZ_BH, R_VD = R_KD + SZ_BH, R_QF = R_VD + SZ_BH, R_KF = R_QF + SZ_BH, R_VF = R_KF + SZ_BH;
constexpr size_t R_AUXG = R_VF + SZ_BH;
constexpr size_t R_AUXGATE = R_AUXG + (size_t)NTOK * 256 * 2;
constexpr size_t R_END_MIX = R_AUXGATE + (size_t)NTOK * 256 * 2;
static_assert(R_M + (size_t)NTOK * DM * 2 <= R_END_MIX, "M inside region R");
constexpr size_t R_T = 0;
constexpr size_t R_PJ2 = 0;
constexpr size_t O_T2 = O_ERA;
constexpr size_t O_XBUF = O_T2 + (size_t)MOE_ROWS * FFE * 2;
constexpr size_t ERA_B_END = O_XBUF + (size_t)MOE_ROWS * DM * 2;
constexpr size_t ERA_A_END = O_R + R_END_MIX;
constexpr size_t WS_NEED = ERA_A_END > ERA_B_END ? ERA_A_END : ERA_B_END;

struct Params {
  const float* in[36];
  float* x;
  char* ws;
};

DI float bf2f(bf16_t b) { return __uint_as_float(((unsigned)b) << 16); }
DI bf16_t f2bf(float x) { unsigned u = __float_as_uint(x); u += 0x7fffu + ((u >> 16) & 1u); return (bf16_t)(u >> 16); }
DI unsigned pk2(float lo, float hi) { f32x2 v = {lo, hi}; bf16x2_t b = __builtin_convertvector(v, bf16x2_t); return __builtin_bit_cast(unsigned, b); }
DI float sigmoidf_(float x) { return 1.0f / (1.0f + __expf(-x)); }
DI float wave_sum(float x) {
  x += __int_as_float(__builtin_amdgcn_update_dpp(0, __float_as_int(x), 0xB1, 0xF, 0xF, true));
  x += __int_as_float(__builtin_amdgcn_update_dpp(0, __float_as_int(x), 0x4E, 0xF, 0xF, true));
  x += __int_as_float(__builtin_amdgcn_update_dpp(0, __float_as_int(x), 0x141, 0xF, 0xF, true));
  x += __int_as_float(__builtin_amdgcn_update_dpp(0, __float_as_int(x), 0x140, 0xF, 0xF, true));
  { auto rr = __builtin_amdgcn_permlane16_swap(__float_as_uint(x), __float_as_uint(x), false, false); x = __uint_as_float(rr[0]) + __uint_as_float(rr[1]); }
  { auto rr = __builtin_amdgcn_permlane32_swap(__float_as_uint(x), __float_as_uint(x), false, false); x = __uint_as_float(rr[0]) + __uint_as_float(rr[1]); }
  return x;
}
DI float shfl_up_l(float x, int o, int lane) { return __int_as_float(__builtin_amdgcn_ds_bpermute(((lane - o) & 63) << 2, __float_as_int(x))); }
DI float xsum32(float x) { auto rr = __builtin_amdgcn_permlane32_swap(__float_as_uint(x), __float_as_uint(x), false, false); return __uint_as_float(rr[0]) + __uint_as_float(rr[1]); }
DI int crow(int r, int hi) { return (r & 3) + 8 * (r >> 2) + 4 * hi; }
DI int otid() { int t = threadIdx.x; asm volatile("" : "+v"(t)); return t; }
DI int obid() { int t = blockIdx.x; asm volatile("" : "+s"(t)); return t; }
DI Params olaunder(const Params& p) { Params q = p; size_t o0 = 0, o1 = 0; asm volatile("" : "+s"(o0), "+s"(o1)); q.ws = p.ws + o0; q.x = p.x + o1; return q; }


#define GAS __attribute__((address_space(1)))
#define LAS __attribute__((address_space(3)))
typedef GAS unsigned gu32;
#define RLX_AGENT __ATOMIC_RELAXED, __HIP_MEMORY_SCOPE_AGENT
namespace pg8 {
#define PG8_LAS __attribute__((address_space(3)))
typedef unsigned short bf16_t;
typedef short bf16x8 __attribute__((ext_vector_type(8)));
typedef float f32x4 __attribute__((ext_vector_type(4)));
typedef unsigned u32x4 __attribute__((ext_vector_type(4)));
constexpr int BM = 256, BK = 64, HALF = 128, HTB = HALF * BK * 2  , STAGE_BYTES = 8 * HTB, NXCD = 8, WGM = 8;

__host__ __device__ __forceinline__ int lds_byte(int r, int c) { const int st = (r >> 4) * 2 + (c >> 5), rr = r & 15, cc = c & 31, ob = rr * 64 + cc * 2; return st * 1024 + (ob ^ (((ob >> 9) & 1) << 5)); }
__host__ __device__ __forceinline__ void stage_rc(int b, int& R, int& C) { const int st = b / 1024, sb = b % 1024, swz = sb ^ (((sb >> 9) & 1) << 5); R = (st >> 1) * 16 + swz / 64; C = (st & 1) * 32 + (swz % 64) / 2; }
__host__ __device__ __forceinline__ int perm32(int rho) { const int n = rho >> 4, i = rho & 15; return 8 * (i >> 2) + 4 * n + (i & 3); }

struct Unit { int pm, pn; };
struct Gemm { const bf16_t* A; const bf16_t* Bt; int M, N, K; const int* texp; size_t bstride;
  __device__ __forceinline__ size_t boff(int pm) const { return texp ? (size_t)texp[pm] * bstride : (size_t)0; } };

struct StaticOrder {
    int nM, nN, nwg, G, c;
    __host__ __device__ void init(int M, int N, int G_, int c_) { nM = M / BM; nN = N / BM; nwg = nM * nN; G = G_; c = c_; }
    __host__ __device__ bool next(int i, Unit& u) const {
        const long L = (long)i * G + c; if (L >= nwg) return false;
        int wgid = (int)L; { const int q = nwg / NXCD, r = nwg % NXCD, xcd = wgid % NXCD, off = wgid / NXCD; wgid = (xcd < r ? xcd * (q + 1) : r * (q + 1) + (xcd - r) * q) + off; }
        const int nig = WGM * nN, gid = wgid / nig, fm = gid * WGM, gsz = (nM - fm) < WGM ? (nM - fm) : WGM;
        u.pm = fm + ((wgid % nig) % gsz); u.pn = (wgid % nig) / gsz; return true;
    }
    __device__ __forceinline__ void a_ready(const Unit&) const {}
    __device__ __forceinline__ void done(const Unit&) const {}
};

template <class F> struct EpiFn {
    static constexpr bool PERM = false, AFTER_DRAIN = false;
    F f;
    __device__ __forceinline__ void operator()(const f32x4 (&acc)[2][2][4][2], const Unit& u, int wr, int wc, int fr, int fq) const {
#pragma unroll
        for (int ai = 0; ai < 2; ++ai)
#pragma unroll
            for (int m = 0; m < 4; ++m)
#pragma unroll
                for (int bj = 0; bj < 2; ++bj)
#pragma unroll
                    for (int n = 0; n < 2; ++n)
                        f(u.pm * BM + ai * HALF + wr * 64 + m * 16 + fr, u.pn * BM + bj * HALF + wc * 32 + n * 16 + 4 * fq, acc[ai][bj][m][n]);
    }
};
template <class Epi, class Sched, bool ALIGN_EPI = false, bool SP2 = false>
__device__ __forceinline__ void gemm_phase(PG8_LAS unsigned char* lds, const Gemm g, const Sched& S, const Epi& E) {
    const int tid = otid(), wid = __builtin_amdgcn_readfirstlane(tid >> 6), lane = tid & 63, wr = wid >> 2, wc = wid & 3, fr = lane & 15, fq = lane >> 4;
    const int K = g.K, nt = K / BK;
    unsigned voffA[2], voffB[2];
#pragma unroll
    for (int i = 0; i < 2; ++i) { int R, C; stage_rc(tid * 16 + i * 8192, R, C); const int Rb = Epi::PERM ? ((R & ~31) + perm32(R & 31)) : R;
        voffA[i] = (unsigned)(R * K + C) * 2u; voffB[i] = (unsigned)(Rb * K + C) * 2u; }
    const size_t kstep = (size_t)(BK * 2);
    const size_t hstep = (size_t)HALF * K * 2;
    const size_t tstep = 2 * hstep;
    const unsigned ldsw = (unsigned)wid * 1024u;
    const int aoff = lds_byte(wr * 64 + fr, fq * 8), boff = lds_byte(wc * 32 + fr, fq * 8);
#define PG8_SA(b, h) (((b) * 2 + (h)) * HTB)
#define PG8_SB(b, h) ((4 + (b) * 2 + (h)) * HTB)
#define PG8_STAGE(bufoff, gbase, voff) do { _Pragma("unroll") for (int _i = 0; _i < 2; ++_i) \
        __builtin_amdgcn_global_load_lds((const unsigned*)((const char*)(gbase) + (voff)[_i]), (PG8_LAS unsigned*)(lds + (bufoff) + ldsw + _i * 8192), 16, 0, 0); } while (0)
#define PG8_LDA(dst, b, h) do { _Pragma("unroll") for (int m = 0; m < 4; ++m) _Pragma("unroll") for (int k = 0; k < 2; ++k) dst[m][k] = *(const PG8_LAS bf16x8*)(lds + PG8_SA(b, h) + aoff + m * 2048 + k * 1024); } while (0)
#define PG8_LDB(dst, b, h) do { _Pragma("unroll") for (int n = 0; n < 2; ++n) _Pragma("unroll") for (int k = 0; k < 2; ++k) dst[n][k] = *(const PG8_LAS bf16x8*)(lds + PG8_SB(b, h) + boff + n * 2048 + k * 1024); } while (0)
#define PG8_MMA(ai, bj, At, Bt) do { __builtin_amdgcn_s_setprio(1); _Pragma("unroll") for (int m = 0; m < 4; ++m) _Pragma("unroll") for (int n = 0; n < 2; ++n) _Pragma("unroll") for (int k = 0; k < 2; ++k) \
        acc[ai][bj][m][n] = __builtin_amdgcn_mfma_f32_16x16x32_bf16(Bt[n][k], At[m][k], acc[ai][bj][m][n], 0, 0, 0); __builtin_amdgcn_s_setprio(0); } while (0)
#define PG8_WAIT_V(n) asm volatile("s_waitcnt vmcnt(" #n ")" ::: "memory")
#define PG8_WAIT_L(n) asm volatile("s_waitcnt lgkmcnt(" #n ")" ::: "memory")
#define PG8_BAR __builtin_amdgcn_s_barrier()
#define PG8_SCHED __builtin_amdgcn_sched_barrier(0)
    Unit cur, nxt; int ui = 0;
    if (!S.next(0, cur)) return;
    f32x4 acc[2][2][4][2];
#pragma unroll
    for (int a = 0; a < 2; ++a)
#pragma unroll
        for (int b = 0; b < 2; ++b)
#pragma unroll
            for (int m = 0; m < 4; ++m)
#pragma unroll
                for (int n = 0; n < 2; ++n) acc[a][b][m][n] = (f32x4){0.f, 0.f, 0.f, 0.f};
    bf16x8 At[4][2], B0[2][2], B1[2][2];
    const char* cA = (const char*)g.A + (size_t)cur.pm * tstep; const char* cB = (const char*)g.Bt + g.boff(cur.pm) + (size_t)cur.pn * tstep;
    S.a_ready(cur);
    if constexpr (SP2) {
        PG8_STAGE(PG8_SB(0, 0), cB, voffB); PG8_STAGE(PG8_SB(0, 1), cB + hstep, voffB); PG8_STAGE(PG8_SA(0, 0), cA, voffA); PG8_STAGE(PG8_SA(0, 1), cA + hstep, voffA);
        if (wr == 1) PG8_BAR;
        PG8_WAIT_V(2); PG8_BAR;
        PG8_STAGE(PG8_SB(1, 0), cB + kstep, voffB); PG8_STAGE(PG8_SA(1, 0), cA + kstep, voffA); PG8_STAGE(PG8_SB(1, 1), cB + hstep + kstep, voffB);
        PG8_WAIT_V(6); PG8_BAR;
    } else {
        PG8_STAGE(PG8_SB(0, 0), cB, voffB); PG8_STAGE(PG8_SA(0, 0), cA, voffA); PG8_STAGE(PG8_SB(0, 1), cB + hstep, voffB); PG8_STAGE(PG8_SA(0, 1), cA + hstep, voffA);
        if (wr == 1) PG8_BAR;
        PG8_WAIT_V(4); PG8_BAR;
        PG8_STAGE(PG8_SB(1, 0), cB + kstep, voffB); PG8_STAGE(PG8_SA(1, 0), cA + kstep, voffA); PG8_STAGE(PG8_SB(1, 1), cB + hstep + kstep, voffB);
        PG8_WAIT_V(6); PG8_BAR;
    }
    for (;;) {
        const bool has_next = S.next(ui + 1, nxt);
        const char* nA = has_next ? (const char*)g.A + (size_t)nxt.pm * tstep : cA; const char* nB = has_next ? (const char*)g.Bt + g.boff(nxt.pm) + (size_t)nxt.pn * tstep : cB;
        for (int t = 0; t < nt; t += 2) {
            const bool last = (t == nt - 2);
            const char* a1 = cA + (size_t)(t + 1) * kstep;
            const char* a2 = last ? nA : cA + (size_t)(t + 2) * kstep; const char* b2 = last ? nB : cB + (size_t)(t + 2) * kstep;
            const char* a3 = a2 + kstep; const char* b3 = b2 + kstep;
            if (last && has_next) S.a_ready(nxt);
            if constexpr (SP2) {
            PG8_LDB(B0, 0, 0); PG8_LDB(B1, 0, 1); PG8_SCHED; PG8_LDA(At, 0, 0); PG8_STAGE(PG8_SA(1, 1), a1 + hstep, voffA);
            PG8_WAIT_V(8); PG8_WAIT_L(0); PG8_BAR; PG8_MMA(0, 0, At, B0); PG8_MMA(0, 1, At, B1); PG8_BAR; PG8_SCHED;
            PG8_LDA(At, 0, 1); PG8_STAGE(PG8_SB(0, 0), b2, voffB); PG8_STAGE(PG8_SB(0, 1), b2 + hstep, voffB); PG8_STAGE(PG8_SA(0, 0), a2, voffA);
            PG8_WAIT_V(8); PG8_WAIT_L(0); PG8_BAR; PG8_MMA(1, 0, At, B0); PG8_MMA(1, 1, At, B1); PG8_BAR; PG8_SCHED;
            PG8_LDB(B0, 1, 0); PG8_LDB(B1, 1, 1); PG8_SCHED; PG8_LDA(At, 1, 0); PG8_STAGE(PG8_SA(0, 1), a2 + hstep, voffA);
            PG8_WAIT_V(8); PG8_WAIT_L(0); PG8_BAR; PG8_MMA(0, 0, At, B0); PG8_MMA(0, 1, At, B1); PG8_BAR; PG8_SCHED;
            PG8_LDA(At, 1, 1); PG8_STAGE(PG8_SB(1, 0), b3, voffB); PG8_STAGE(PG8_SB(1, 1), b3 + hstep, voffB); PG8_STAGE(PG8_SA(1, 0), a3, voffA);
            PG8_WAIT_V(8); PG8_WAIT_L(0); PG8_BAR; PG8_MMA(1, 0, At, B0); PG8_MMA(1, 1, At, B1); PG8_BAR; PG8_SCHED;
            } else {
            PG8_LDB(B0, 0, 0); PG8_SCHED; PG8_LDA(At, 0, 0); PG8_STAGE(PG8_SA(1, 1), a1 + hstep, voffA);
            PG8_WAIT_L(8); PG8_BAR; PG8_WAIT_L(0); PG8_MMA(0, 0, At, B0); PG8_BAR; PG8_SCHED;
            PG8_LDB(B1, 0, 1); PG8_STAGE(PG8_SB(0, 0), b2, voffB);
            PG8_BAR; PG8_WAIT_L(0); PG8_MMA(0, 1, At, B1); PG8_BAR;
            PG8_LDA(At, 0, 1); PG8_STAGE(PG8_SA(0, 0), a2, voffA);
            PG8_BAR; PG8_WAIT_L(0); PG8_MMA(1, 0, At, B0); PG8_BAR; PG8_SCHED;
            PG8_STAGE(PG8_SB(0, 1), b2 + hstep, voffB);
            PG8_WAIT_V(6); PG8_BAR; PG8_MMA(1, 1, At, B1); PG8_BAR;
            PG8_LDB(B0, 1, 0); PG8_SCHED; PG8_LDA(At, 1, 0); PG8_STAGE(PG8_SA(0, 1), a2 + hstep, voffA);
            PG8_WAIT_L(8); PG8_BAR; PG8_WAIT_L(0); PG8_MMA(0, 0, At, B0); PG8_BAR; PG8_SCHED;
            PG8_LDB(B1, 1, 1); PG8_STAGE(PG8_SB(1, 0), b3, voffB);
            PG8_BAR; PG8_WAIT_L(0); PG8_MMA(0, 1, At, B1); PG8_BAR;
            PG8_LDA(At, 1, 1); PG8_STAGE(PG8_SA(1, 0), a3, voffA);
            PG8_BAR; PG8_WAIT_L(0); PG8_MMA(1, 0, At, B0); PG8_BAR; PG8_SCHED;
            PG8_STAGE(PG8_SB(1, 1), b3 + hstep, voffB);
            PG8_WAIT_V(6); PG8_BAR; PG8_MMA(1, 1, At, B1); PG8_BAR;
            }
        }
        if constexpr (ALIGN_EPI) { if (wr == 0) PG8_BAR; }
        if constexpr (!Epi::AFTER_DRAIN) { E(acc, cur, wr, wc, fr, fq); S.done(cur); }
        if (!has_next) break;
#pragma unroll
        for (int a = 0; a < 2; ++a)
#pragma unroll
            for (int b = 0; b < 2; ++b)
#pragma unroll
                for (int m = 0; m < 4; ++m)
#pragma unroll
                    for (int n = 0; n < 2; ++n) acc[a][b][m][n] = (f32x4){0.f, 0.f, 0.f, 0.f};
        cur = nxt; cA = nA; cB = nB; ++ui;
        if constexpr (ALIGN_EPI) { if (wr == 1) PG8_BAR; }
    }
    PG8_WAIT_V(0);
    if constexpr (!ALIGN_EPI) { if (wr == 0) PG8_BAR; }
    PG8_BAR;
    if constexpr (Epi::AFTER_DRAIN) { E.fused(acc, cur, wr, wc, fr, fq, lds, wid, lane); S.done(cur); }
#undef PG8_SA
#undef PG8_SB
#undef PG8_STAGE
#undef PG8_LDA
#undef PG8_LDB
#undef PG8_MMA
#undef PG8_WAIT_V
#undef PG8_WAIT_L
#undef PG8_BAR
#undef PG8_SCHED
}
}

#define XB_TMO      128
#define XB_XCNT(j)  (256  + 64 * (j))
#define XB_XSUB(j)  (1280 + 64 * (j))
#define XB_XGEN(j)  (2304 + 64 * (j))
#define XB_TOP      3328
#define XB_TOPGEN   3392
#define XCD_BAR_WORDS 3456
#define XB_SPIN_CAP (1u << 18)

__device__ __forceinline__ unsigned xb_ld(unsigned* p)              { return __hip_atomic_load(p, __ATOMIC_RELAXED, __HIP_MEMORY_SCOPE_AGENT); }
__device__ __forceinline__ unsigned xb_add(unsigned* p, unsigned v) { return __hip_atomic_fetch_add(p, v, __ATOMIC_RELAXED, __HIP_MEMORY_SCOPE_AGENT); }
__device__ __forceinline__ unsigned xb_xcc_id() { return (unsigned)__builtin_amdgcn_s_getreg((3 << 11) | 20) & 0xFu; }
#define XB_SPIN(cond, bar) do { unsigned _sp = 0; while (cond) { __builtin_amdgcn_s_sleep(1); \
    if ((++_sp & 255u) == 0u) { if (xb_ld(&(bar)[XB_TMO])) break; if (_sp > XB_SPIN_CAP) { atomicAdd(&(bar)[XB_TMO], 1u); break; } } } } while (0)

struct XcdBarrier {
    unsigned* bar; unsigned x;
    volatile LAS unsigned* st;
};

__device__ __forceinline__ XcdBarrier xcd_barrier_post(unsigned* bar, volatile LAS unsigned* st) {
    XcdBarrier b; b.bar = bar; b.x = xb_xcc_id(); b.st = st;
    if (threadIdx.x == 0) (void)xb_add(&bar[XB_XCNT(b.x)], 1u);
    return b;
}
__device__ __forceinline__ void xcd_barrier_complete(unsigned* bar, unsigned x, unsigned& nloc, unsigned& nx) {
    const unsigned G = gridDim.x * gridDim.y * gridDim.z;
    unsigned sum, cnt, mine, sp = 0u;
    for (;;) {
        sum = 0u; cnt = 0u; mine = 0u;
#pragma unroll
        for (unsigned j = 0; j < 16; ++j) { const unsigned c = xb_ld(&bar[XB_XCNT(j)]); sum += c; cnt += (c > 0u) ? 1u : 0u; mine = (j == x) ? c : mine; }
        if (sum == G) break;
        __builtin_amdgcn_s_sleep(1);
        if ((++sp & 255u) == 0u) { if (xb_ld(&bar[XB_TMO])) break; if (sp > XB_SPIN_CAP) { atomicAdd(&bar[XB_TMO], 1u); break; } }
    }
    nloc = mine > 0u ? mine : 1u; nx = cnt > 0u ? cnt : 1u;
}

__device__ __forceinline__ void xcd_barrier(const XcdBarrier& b) {
    asm volatile("s_waitcnt vmcnt(0)" ::: "memory");
    __syncthreads();
    if (threadIdx.x == 0) {
        unsigned* bar = b.bar; unsigned bx_ = b.x;
        asm volatile("" : "+s"(bar), "+s"(bx_));
        __builtin_amdgcn_s_waitcnt(0);
        unsigned nloc = b.st[0], nx = b.st[1];
        if (nloc == 0u) { xcd_barrier_complete(bar, bx_, nloc, nx); b.st[0] = nloc; b.st[1] = nx; }
        const unsigned old = xb_add(&bar[XB_XSUB(bx_)], 1u);
        const unsigned gen = old / nloc;
        if (old + 1u == (gen + 1u) * nloc) {
            __builtin_amdgcn_fence(__ATOMIC_RELEASE, "agent");
            asm volatile("s_waitcnt vmcnt(0)" ::: "memory");
            const unsigned og = xb_add(&bar[XB_TOP], 1u);
            const unsigned tg = og / nx;
            if (og + 1u == (tg + 1u) * nx) xb_add(&bar[XB_TOPGEN], 1u);
            else XB_SPIN(xb_ld(&bar[XB_TOPGEN]) == tg, bar);
            __builtin_amdgcn_fence(__ATOMIC_ACQUIRE, "agent");
            xb_add(&bar[XB_XGEN(bx_)], 1u);
            asm volatile("s_waitcnt vmcnt(0)" ::: "memory");
        } else {
            XB_SPIN(xb_ld(&bar[XB_XGEN(bx_)]) == gen, bar);
            __builtin_amdgcn_fence(__ATOMIC_ACQUIRE, "agent");
            asm volatile("s_waitcnt vmcnt(0)" ::: "memory");
        }
    }
    __syncthreads();
}

DI void transpose_tile(const float* __restrict__ src, int K, int N, bf16_t* __restrict__ dst, int rmul, int radd, int t, float* tl, int tid) {
  const int tn = (N + 63) / 64;
  const int k0 = (t / tn) * 64, n0 = (t % tn) * 64;
  __syncthreads();
  {
    const int kr = tid >> 3, nc = (tid & 7) * 4;
#pragma unroll
    for (int i = 0; i < 2; ++i) {
      const int n = n0 + nc + 32 * i;
      f32x4 v = {0.f, 0.f, 0.f, 0.f};
      if (n < N) v = *(const f32x4*)(src + (size_t)(k0 + kr) * N + n);
      float* d = tl + kr * 65 + nc + 32 * i;
      d[0] = v[0]; d[1] = v[1]; d[2] = v[2]; d[3] = v[3];
    }
  }
  __syncthreads();
  {
    const int nr = tid >> 3, kc = (tid & 7) * 8, n = n0 + nr;
    if (n < N) {
      u32x4 w;
      w[0] = pk2(tl[(kc + 0) * 65 + nr], tl[(kc + 1) * 65 + nr]);
      w[1] = pk2(tl[(kc + 2) * 65 + nr], tl[(kc + 3) * 65 + nr]);
      w[2] = pk2(tl[(kc + 4) * 65 + nr], tl[(kc + 5) * 65 + nr]);
      w[3] = pk2(tl[(kc + 6) * 65 + nr], tl[(kc + 7) * 65 + nr]);
      *(u32x4*)(dst + ((size_t)n * rmul + radd) * K + k0 + kc) = w;
    }
  }
}
DI void transpose_job(const float* __restrict__ src, int K, int N, bf16_t* __restrict__ dst, int rmul, int radd, char* lds) {
  float* tl = (float*)lds;
  const int nt = (K / 64) * ((N + 63) / 64), tid = otid();
  for (int t = obid(); t < nt; t += gridDim.x) transpose_tile(src, K, N, dst, rmul, radd, t, tl, tid);
}
constexpr int MOE_TILES_PER_JOB = 896, MOE_CONV_TILES = 24 * 896;
DI void moe_convert_tile(const Params& p, int g, float* tl, int tid) {
  const int job = g / MOE_TILES_PER_JOB, t = g % MOE_TILES_PER_JOB, e = job / 3, w = job % 3;
  if (w == 0) transpose_tile(p.in[30] + (size_t)e * 1024 * FFE, 1024, FFE, (bf16_t*)(p.ws + O_MGU) + (size_t)e * 2 * FFE * 1024, 2, 0, t, tl, tid);
  else if (w == 1) transpose_tile(p.in[31] + (size_t)e * 1024 * FFE, 1024, FFE, (bf16_t*)(p.ws + O_MGU) + (size_t)e * 2 * FFE * 1024, 2, 1, t, tl, tid);
  else transpose_tile(p.in[32] + (size_t)e * FFE * 1024, FFE, 1024, (bf16_t*)(p.ws + O_MD) + (size_t)e * 1024 * FFE, 1, 0, t, tl, tid);
}
DI void phase0(const Params& p, char* lds) {
  char* ws = p.ws;
  const int gtid = obid() * NTHR + otid(), gsz = gridDim.x * NTHR;
  if (gtid < 256) ((int*)(ws + O_SMALL + SM_TEXP4))[gtid] = gtid >> 6;
  {
    const f32x4* s = (const f32x4*)p.in[0]; f32x4* d = (f32x4*)p.x;
    for (int i = gtid; i < NTOK * DM / 4; i += gsz) d[i] = s[i];
  }
  for (int L = 0; L < 2; ++L) {
    transpose_job(p.in[5] + (size_t)L * DM * INC, 1024, INC, (bf16_t*)(ws + O_WIN + L * SZ_WIN), 1, 0, lds);
    for (int b = 0; b < 4; ++b)
      transpose_job(p.in[6] + (size_t)(L * 4 + b) * 256 * 1024, 256, 1024, (bf16_t*)(ws + O_WBO) + (size_t)(L * 4 + b) * 1024 * 256, 1, 0, lds);
    transpose_job(p.in[7] + (size_t)L * 1024 * 1024, 1024, 1024, (bf16_t*)(ws + O_WOUT) + (size_t)L * 1024 * 1024, 1, 0, lds);
    transpose_job(p.in[34] + (size_t)L * 1024 * 1024, 1024, 1024, (bf16_t*)(ws + O_PG) + (size_t)L * 1024 * 1024, 1, 0, lds);
    transpose_job(p.in[33] + (size_t)L * 256 * 1024, 256, 1024, (bf16_t*)(ws + O_PP) + (size_t)L * 1024 * 256, 1, 0, lds);
    transpose_job(p.in[10] + (size_t)L * 64 * 256, 64, 256, (bf16_t*)(ws + O_LORA + L * SZ_LORA), 1, 0, lds);
    transpose_job(p.in[12] + (size_t)L * 64 * 256, 64, 256, (bf16_t*)(ws + O_LORA + L * SZ_LORA) + 256 * 64, 1, 0, lds);
    transpose_job(p.in[13] + (size_t)L * 128 * 256, 128, 256, (bf16_t*)(ws + O_LORA + L * SZ_LORA) + 2 * 256 * 64, 1, 0, lds);
  }
  transpose_job(p.in[26], 1024, FFD, (bf16_t*)(ws + O_FGU), 2, 0, lds);
  transpose_job(p.in[27], 1024, FFD, (bf16_t*)(ws + O_FGU), 2, 1, lds);
  transpose_job(p.in[28], FFD, 1024, (bf16_t*)(ws + O_FD), 1, 0, lds);
}
DI void convert_p(const Params& p, int L) {
  const int gtid = obid() * NTHR + otid(), gsz = gridDim.x * NTHR;
  const f32x4* s = (const f32x4*)(p.in[1] + (size_t)L * NTOK * 256); u32x2* d = (u32x2*)(p.ws + O_PB);
  for (int i = gtid; i < NTOK * 256 / 4; i += gsz) { f32x4 v = s[i]; u32x2 w; w[0] = pk2(v[0], v[1]); w[1] = pk2(v[2], v[3]); d[i] = w; }
}
template <bool ROUTER, bool ADDMOE = false>
DI void norm_phase(const Params& p, const float* __restrict__ g, const float* __restrict__ router) {
  const int lane = otid() & 63, wid = otid() >> 6;
  bf16_t* hb = (bf16_t*)(p.ws + O_HB);
  int* cnt = (int*)(p.ws + O_CTL) + CW_MOECNT;
  int* list = (int*)(p.ws + O_SMALL + SM_LIST);
  float* gw = (float*)(p.ws + O_SMALL + SM_GW);
  int* tokslot = (int*)(p.ws + O_SMALL + SM_TOKSLOT);
  const int* slotrow = (const int*)(p.ws + O_SMALL + SM_SLOTROW);
  const bf16_t* Y2 = (const bf16_t*)(p.ws + O_XBUF);
  for (int row = obid() * 8 + wid; row < NTOK; row += gridDim.x * 8) {
    float* xr = p.x + (size_t)row * DM;
    f32x4 v[4]; float ss = 0.f;
#pragma unroll
    for (int j = 0; j < 4; ++j) v[j] = *(const f32x4*)(xr + j * 256 + lane * 4);
    if (ADDMOE) {
      const int r1 = slotrow[tokslot[row * 2]], r2 = slotrow[tokslot[row * 2 + 1]];
#pragma unroll
      for (int j = 0; j < 4; ++j) {
        const u32x2 a = *(const u32x2*)(Y2 + (size_t)r1 * DM + j * 256 + lane * 4), b = *(const u32x2*)(Y2 + (size_t)r2 * DM + j * 256 + lane * 4);
        v[j][0] += __uint_as_float(a[0] << 16) + __uint_as_float(b[0] << 16); v[j][1] += __uint_as_float(a[0] & 0xffff0000u) + __uint_as_float(b[0] & 0xffff0000u);
        v[j][2] += __uint_as_float(a[1] << 16) + __uint_as_float(b[1] << 16); v[j][3] += __uint_as_float(a[1] & 0xffff0000u) + __uint_as_float(b[1] & 0xffff0000u);
        *(f32x4*)(xr + j * 256 + lane * 4) = v[j];
      }
    }
#pragma unroll
    for (int j = 0; j < 4; ++j) ss += v[j][0] * v[j][0] + v[j][1] * v[j][1] + v[j][2] * v[j][2] + v[j][3] * v[j][3];
    ss = wave_sum(ss);
    const float rstd = rsqrtf(ss * (1.0f / 1024.0f) + 1e-6f);
    float lg[8];
    if (ROUTER) {
#pragma unroll
      for (int e = 0; e < 8; ++e) lg[e] = 0.f;
    }
#pragma unroll
    for (int j = 0; j < 4; ++j) {
      const f32x4 gg = *(const f32x4*)(g + j * 256 + lane * 4);
      f32x4 h = v[j] * rstd * gg;
      u32x2 w; w[0] = pk2(h[0], h[1]); w[1] = pk2(h[2], h[3]);
      *(u32x2*)(hb + (size_t)row * DM + j * 256 + lane * 4) = w;
      if (ROUTER) {
#pragma unroll
        for (int c = 0; c < 4; ++c) {
          const float* rr = router + (size_t)(j * 256 + lane * 4 + c) * 8;
          const f32x4 r0 = *(const f32x4*)rr, r1 = *(const f32x4*)(rr + 4);
          lg[0] += h[c] * r0[0]; lg[1] += h[c] * r0[1]; lg[2] += h[c] * r0[2]; lg[3] += h[c] * r0[3];
          lg[4] += h[c] * r1[0]; lg[5] += h[c] * r1[1]; lg[6] += h[c] * r1[2]; lg[7] += h[c] * r1[3];
        }
      }
    }
    if (ROUTER) {
#pragma unroll
      for (int e = 0; e < 8; ++e) lg[e] = wave_sum(lg[e]);
      if (lane == 0) {
        int e1 = 0; float l1 = lg[0];
#pragma unroll
        for (int e = 1; e < 8; ++e) if (lg[e] > l1) { l1 = lg[e]; e1 = e; }
        int e2 = -1; float l2 = -INFINITY;
#pragma unroll
        for (int e = 0; e < 8; ++e) if (e != e1 && lg[e] > l2) { l2 = lg[e]; e2 = e; }
        const float w1 = 1.0f / (1.0f + __expf(l2 - l1)), w2 = 1.0f - w1;
        int s1 = atomicAdd(cnt + e1, 1); list[e1 * NTOK + s1] = row; gw[e1 * NTOK + s1] = w1;
        int s2 = atomicAdd(cnt + e2, 1); list[e2 * NTOK + s2] = row; gw[e2 * NTOK + s2] = w2;
        tokslot[row * 2] = e1 * NTOK + s1; tokslot[row * 2 + 1] = e2 * NTOK + s2;
      }
    }
  }
}

DI float softplusf_(float z) { return z > 20.f ? z : __logf(1.0f + __expf(z)); }
DI float logsigmoidf_(float z) { return z >= 0.f ? -__logf(1.0f + __expf(-z)) : z - __logf(1.0f + __expf(z)); }

template <int PARTS = 7>
DI void phase_prep(const Params& p, int L, char* lds) {
  float* xw_s = (float*)lds; float* xa_s = xw_s + 8 * 64; float* xg_s = xa_s + 8 * 64;
  char* R = p.ws + O_R;
  const bf16_t* u = (const bf16_t*)(R + R_U);
  bf16_t* rwA = (bf16_t*)(R + R_RWA); bf16_t* rwB = (bf16_t*)(R + R_RWB); bf16_t* rwK = (bf16_t*)(R + R_RWK);
  bf16_t* rwR = (bf16_t*)(R + R_RWR); bf16_t* rwV = (bf16_t*)(R + R_RWV); float* rwW = (float*)(R + R_RWW);
  bf16_t* gq = (bf16_t*)(R + R_GQ); bf16_t* gk = (bf16_t*)(R + R_GK); bf16_t* gv = (bf16_t*)(R + R_GV);
  bf16_t* Qd = (bf16_t*)(R + R_QD); bf16_t* Kd = (bf16_t*)(R + R_KD); bf16_t* Vd = (bf16_t*)(R + R_VD);
  bf16_t* Qf = (bf16_t*)(R + R_QF); bf16_t* Kf = (bf16_t*)(R + R_KF); bf16_t* Vf = (bf16_t*)(R + R_VF);
  bf16_t* auxg = (bf16_t*)(R + R_AUXG); bf16_t* auxgate = (bf16_t*)(R + R_AUXGATE);
  float* rk = (float*)(p.ws + O_SMALL + SM_RK); float* logf_ = (float*)(p.ws + O_SMALL + SM_LOGF);
  float* gbeta = (float*)(p.ws + O_SMALL + SM_GBETA); float* ga = (float*)(p.ws + O_SMALL + SM_GA);
  const float* mu = p.in[8] + L * 1024; const float* w0 = p.in[9] + L * 256; const float* w2 = p.in[10] + L * 64 * 256;
  const float* a0 = p.in[11] + L * 256; const float* a2 = p.in[12] + L * 64 * 256; const float* g2 = p.in[13] + L * 128 * 256;
  const float* kkp = p.in[14] + L * 256; const float* kap = p.in[15] + L * 256; const float* rkp = p.in[16] + L * 256;
  const float* fbias = p.in[21] + L * 4; const float* cw = p.in[22] + L * 768 * 4;
  const float* alog = p.in[23] + L * 4; const float* dtb = p.in[24] + L * 4;
  const int tid = otid(), j = tid & 255, half = tid >> 8, lane = tid & 63, h = j >> 6, dh = j & 63;
  const float QS_D = 0.25503486164919736f, QS_F = 0.18033688011112042f;
  for (int tile = obid(); tile < NTOK / 8; tile += gridDim.x) {
    const int T0 = tile * 8, b = T0 / SEQ, t0 = T0 % SEQ, bh = b * 4 + h;
    if (PARTS & 1) {
    float r[4], k[4], v[4];
    __syncthreads();
#pragma unroll
    for (int i = 0; i < 4; ++i) {
      const int tl = half * 4 + i, tok = T0 + tl, t = t0 + tl;
      const bf16_t* ur = u + (size_t)tok * UC;
#pragma unroll
      for (int seg = 0; seg < 4; ++seg) {
        const int c = seg * 256 + j;
        const float ua = bf2f(ur[c]);
        const float up = t > 0 ? bf2f(ur[c - UC]) : 0.f;
        const float xm = ua + (up - ua) * mu[c];
        if (seg == 0) r[i] = xm; else if (seg == 1) k[i] = xm; else if (seg == 2) v[i] = xm;
        else {
          if (j < 64) xw_s[tl * 64 + j] = 1.0f - 2.0f / (1.0f + __expf(2.0f * xm));
          else if (j < 128) xa_s[tl * 64 + (j - 64)] = xm;
          else xg_s[tl * 128 + (j - 128)] = sigmoidf_(xm);
        }
      }
    }
    __syncthreads();
    float lw[4], alr[4], gg[4];
#pragma unroll
    for (int i = 0; i < 4; ++i) { lw[i] = w0[j]; alr[i] = a0[j]; gg[i] = 0.f; }
    for (int q = 0; q < 64; ++q) {
      const float wv = w2[q * 256 + j], av = a2[q * 256 + j];
#pragma unroll
      for (int i = 0; i < 4; ++i) { lw[i] += xw_s[(half * 4 + i) * 64 + q] * wv; alr[i] += xa_s[(half * 4 + i) * 64 + q] * av; }
    }
    for (int q = 0; q < 128; ++q) {
      const float gvv = g2[q * 256 + j];
#pragma unroll
      for (int i = 0; i < 4; ++i) gg[i] += xg_s[(half * 4 + i) * 128 + q] * gvv;
    }
#pragma unroll
    for (int i = 0; i < 4; ++i) {
      const int tl = half * 4 + i, tok = T0 + tl, t = t0 + tl;
      const float dec = __expf(-0.6065306597126334f * sigmoidf_(lw[i]));
      const float a = sigmoidf_(alr[i]);
      const float kkr = k[i] * kkp[j];
      const float ss = wave_sum(kkr * kkr);
      const float kk = kkr * rsqrtf(ss + 1e-6f);
      const float kp = k[i] * (1.0f + (a - 1.0f) * kap[j]);
      const float rks = wave_sum(r[i] * kp * rkp[j]);
      const size_t idx = ((size_t)bh * SEQ + t) * 64 + dh;
      rwA[idx] = f2bf(-kk); rwW[idx] = dec; rwB[idx] = f2bf(kk * a); rwK[idx] = f2bf(kp); rwR[idx] = f2bf(r[i]); rwV[idx] = f2bf(v[i]);
      auxg[(size_t)tok * 256 + j] = f2bf(gg[i]);
      if (lane == 0) rk[tok * 4 + h] = rks;
    }
    }
    if (PARTS & 2)
    {
      float vd[4], vf[4];
#pragma unroll
      for (int i = 0; i < 4; ++i) {
        const int tl = half * 4 + i, tok = T0 + tl, t = t0 + tl;
        const bf16_t* ur = u + (size_t)tok * UC;
        float q = bf2f(ur[OFF_B + j]), kx = bf2f(ur[OFF_B + 256 + j]);
        vd[i] = bf2f(ur[OFF_B + 512 + j]);
        const int d = dh & 31;
        if (d < 8) {
          const int ii = d & 3;
          const float invrev = ii == 0 ? 0.15915494309189535f : ii == 1 ? 0.005985185712713705f : ii == 2 ? 0.00022507907903927653f : 8.464330808241401e-06f;
          const float rvf = (float)t * invrev;
          const float fr = rvf - floorf(rvf);
          const float sn = __builtin_amdgcn_sinf(fr), cs = __builtin_amdgcn_cosf(fr);
          const int pj = d < 4 ? j + 4 : j - 4;
          const float qp = bf2f(ur[OFF_B + pj]), kpn = bf2f(ur[OFF_B + 256 + pj]);
          if (d < 4) { q = q * cs - qp * sn; kx = kx * cs - kpn * sn; }
          else { q = q * cs + qp * sn; kx = kx * cs + kpn * sn; }
        }
        const size_t idx = ((size_t)bh * SEQ + t) * 64 + dh;
        Qd[idx] = f2bf(q * QS_D); Kd[idx] = f2bf(kx);
        Qf[idx] = f2bf(bf2f(ur[OFF_C + j]) * QS_F); Kf[idx] = ur[OFF_C + 256 + j];
        vf[i] = bf2f(ur[OFF_C + 512 + j]);
        if (j < 4) logf_[(size_t)(b * 4 + j) * SEQ + t] = logsigmoidf_(bf2f(ur[OFF_C + 768 + j]) + fbias[j]);
      }
      const size_t vidx = ((size_t)bh * 64 + dh) * SEQ + t0 + half * 4;
      u32x2 w; w[0] = pk2(vd[0], vd[1]); w[1] = pk2(vd[2], vd[3]); *(u32x2*)(Vd + vidx) = w;
      w[0] = pk2(vf[0], vf[1]); w[1] = pk2(vf[2], vf[3]); *(u32x2*)(Vf + vidx) = w;
    }
    if (PARTS & 4) {
#pragma unroll
    for (int i = 0; i < 4; ++i) {
      const int tl = half * 4 + i, tok = T0 + tl, t = t0 + tl;
      const bf16_t* ur = u + (size_t)tok * UC + OFF_D;
      float y[3];
#pragma unroll
      for (int seg = 0; seg < 3; ++seg) {
        const int c = seg * 256 + j;
        const f32x4 wv = *(const f32x4*)(cw + c * 4);
        float acc = wv[3] * bf2f(ur[c]);
        if (t >= 1) acc += wv[2] * bf2f(ur[c - UC]);
        if (t >= 2) acc += wv[1] * bf2f(ur[c - 2 * UC]);
        if (t >= 3) acc += wv[0] * bf2f(ur[c - 3 * UC]);
        y[seg] = acc * sigmoidf_(acc);
      }
      const float sq = wave_sum(y[0] * y[0]), sk = wave_sum(y[1] * y[1]);
      const float qn = y[0] * rsqrtf(sq + 1e-6f) * 0.125f, kn = y[1] * rsqrtf(sk + 1e-6f);
      const size_t idx = ((size_t)bh * SEQ + t) * 64 + dh;
      gq[idx] = f2bf(qn); gk[idx] = f2bf(kn); gv[idx] = f2bf(y[2]);
      const float gate = bf2f(ur[776 + j]);
      auxgate[(size_t)tok * 256 + j] = f2bf(gate * sigmoidf_(gate));
      if (lane == 0) {
        const float beta = sigmoidf_(bf2f(ur[768 + h]));
        const float gl = -__expf(alog[h]) * softplusf_(bf2f(ur[772 + h]) + dtb[h]);
        gbeta[(size_t)bh * SEQ + t] = beta; ga[(size_t)bh * SEQ + t] = __expf(gl);
      }
    }
    }
  }
}


DI float sum8(float x) {
  x += __int_as_float(__builtin_amdgcn_update_dpp(0, __float_as_int(x), 0xB1, 0xF, 0xF, true));
  x += __int_as_float(__builtin_amdgcn_update_dpp(0, __float_as_int(x), 0x4E, 0xF, 0xF, true));
  x += __int_as_float(__builtin_amdgcn_update_dpp(0, __float_as_int(x), 0x141, 0xF, 0xF, true));
  return x;
}
DI void unpk8(float (&f)[8], const u32x4& w) {
#pragma unroll
  for (int i = 0; i < 4; ++i) { f[2 * i] = __uint_as_float(w[i] << 16); f[2 * i + 1] = __uint_as_float(w[i] & 0xffff0000u); }
}
DI u32x4 pk8(const float (&f)[8]) { u32x4 w; w[0] = pk2(f[0], f[1]); w[1] = pk2(f[2], f[3]); w[2] = pk2(f[4], f[5]); w[3] = pk2(f[6], f[7]); return w; }
DI void ld8f(float (&f)[8], const float* p) { const f32x4 a = *(const f32x4*)p, b = *(const f32x4*)(p + 4); f[0] = a[0]; f[1] = a[1]; f[2] = a[2]; f[3] = a[3]; f[4] = b[0]; f[5] = b[1]; f[6] = b[2]; f[7] = b[3]; }
DI void phase_prep2(const Params& p, int L, char* lds) {
  constexpr int XLD = 264;
  bf16_t* XS = (bf16_t*)lds;
  float* LR = (float*)(lds + 16 * XLD * 2);
  bf16_t* VT = (bf16_t*)(lds + 16 * XLD * 2 + 3 * 16 * 256 * 4);
  char* R = p.ws + O_R;
  const bf16_t* u = (const bf16_t*)(R + R_U);
  bf16_t* rwA = (bf16_t*)(R + R_RWA); bf16_t* rwB = (bf16_t*)(R + R_RWB); bf16_t* rwK = (bf16_t*)(R + R_RWK);
  bf16_t* rwR = (bf16_t*)(R + R_RWR); bf16_t* rwV = (bf16_t*)(R + R_RWV); float* rwW = (float*)(R + R_RWW);
  bf16_t* gq = (bf16_t*)(R + R_GQ); bf16_t* gk = (bf16_t*)(R + R_GK); bf16_t* gv = (bf16_t*)(R + R_GV);
  bf16_t* Qd = (bf16_t*)(R + R_QD); bf16_t* Kd = (bf16_t*)(R + R_KD); bf16_t* Vd = (bf16_t*)(R + R_VD);
  bf16_t* Qf = (bf16_t*)(R + R_QF); bf16_t* Kf = (bf16_t*)(R + R_KF); bf16_t* Vf = (bf16_t*)(R + R_VF);
  bf16_t* auxg = (bf16_t*)(R + R_AUXG); bf16_t* auxgate = (bf16_t*)(R + R_AUXGATE);
  float* rk = (float*)(p.ws + O_SMALL + SM_RK); float* logf_ = (float*)(p.ws + O_SMALL + SM_LOGF);
  float* gbeta = (float*)(p.ws + O_SMALL + SM_GBETA); float* ga = (float*)(p.ws + O_SMALL + SM_GA);
  const float* mu = p.in[8] + L * 1024; const float* w0 = p.in[9] + L * 256; const float* a0 = p.in[11] + L * 256;
  const float* kkp = p.in[14] + L * 256; const float* kap = p.in[15] + L * 256; const float* rkp = p.in[16] + L * 256;
  const float* fbias = p.in[21] + L * 4; const float* cw = p.in[22] + L * 768 * 4;
  const float* alog = p.in[23] + L * 4; const float* dtb = p.in[24] + L * 4;
  const bf16_t* WL = (const bf16_t*)(p.ws + O_LORA + L * SZ_LORA);
  const float QS_D = 0.25503486164919736f, QS_F = 0.18033688011112042f;
#pragma unroll 1
  for (int tile = obid(); tile < NTOK / 16; tile += gridDim.x) {
    const int tid = otid(), tk = tid >> 5, cg = tid & 31, c0 = cg * 8, h = cg >> 3, d0 = (cg & 7) * 8, lane = tid & 63, wid = tid >> 6;
    const int fr = lane & 15, fq = lane >> 4;
    const int T0 = tile * 16, b = T0 / SEQ, t0 = T0 % SEQ, tok = T0 + tk, t = t0 + tk, bh = b * 4 + h;
    const bf16_t* ur = u + (size_t)tok * UC;
    const size_t idx = ((size_t)bh * SEQ + t) * 64 + d0;
    float r[8], k[8], v[8];
    __syncthreads();
    {
#pragma unroll
      for (int seg = 0; seg < 4; ++seg) {
        asm volatile("" ::: "memory");
        float ua[8], up[8], mm[8], xm[8];
        unpk8(ua, *(const u32x4*)(ur + seg * 256 + c0));
        if (t > 0) unpk8(up, *(const u32x4*)(ur - UC + seg * 256 + c0));
        else {
#pragma unroll
          for (int i = 0; i < 8; ++i) up[i] = 0.f;
        }
        ld8f(mm, mu + seg * 256 + c0);
#pragma unroll
        for (int i = 0; i < 8; ++i) xm[i] = ua[i] + (up[i] - ua[i]) * mm[i];
        if (seg == 0) {
#pragma unroll
          for (int i = 0; i < 8; ++i) r[i] = xm[i];
        } else if (seg == 1) {
#pragma unroll
          for (int i = 0; i < 8; ++i) k[i] = xm[i];
        } else if (seg == 2) {
#pragma unroll
          for (int i = 0; i < 8; ++i) v[i] = xm[i];
        } else {
          if (cg < 8) {
#pragma unroll
            for (int i = 0; i < 8; ++i) xm[i] = 1.0f - 2.0f / (1.0f + __expf(2.0f * xm[i]));
          } else if (cg >= 16) {
#pragma unroll
            for (int i = 0; i < 8; ++i) xm[i] = sigmoidf_(xm[i]);
          }
          *(u32x4*)(XS + tk * XLD + c0) = pk8(xm);
        }
      }
    }
    __syncthreads();
    {
#pragma unroll
      for (int nt2 = 0; nt2 < 2; ++nt2) {
        const int nt = wid * 2 + nt2;
        f32x4 aw = {0.f, 0.f, 0.f, 0.f}, aa = aw, ag = aw;
#pragma unroll
        for (int ks = 0; ks < 2; ++ks) {
          const bf16x8 xw = *(const bf16x8*)(XS + fr * XLD + 32 * ks + 8 * fq);
          const bf16x8 xa = *(const bf16x8*)(XS + fr * XLD + 64 + 32 * ks + 8 * fq);
          const bf16x8 ww = *(const bf16x8*)(WL + (size_t)(16 * nt + fr) * 64 + 32 * ks + 8 * fq);
          const bf16x8 wa = *(const bf16x8*)(WL + 256 * 64 + (size_t)(16 * nt + fr) * 64 + 32 * ks + 8 * fq);
          aw = __builtin_amdgcn_mfma_f32_16x16x32_bf16(ww, xw, aw, 0, 0, 0);
          aa = __builtin_amdgcn_mfma_f32_16x16x32_bf16(wa, xa, aa, 0, 0, 0);
        }
#pragma unroll
        for (int ks = 0; ks < 4; ++ks) {
          const bf16x8 xg = *(const bf16x8*)(XS + fr * XLD + 128 + 32 * ks + 8 * fq);
          const bf16x8 wg = *(const bf16x8*)(WL + 2 * 256 * 64 + (size_t)(16 * nt + fr) * 128 + 32 * ks + 8 * fq);
          ag = __builtin_amdgcn_mfma_f32_16x16x32_bf16(wg, xg, ag, 0, 0, 0);
        }
        *(f32x4*)(LR + (0 * 16 + fr) * 256 + 16 * nt + 4 * fq) = aw;
        *(f32x4*)(LR + (1 * 16 + fr) * 256 + 16 * nt + 4 * fq) = aa;
        *(f32x4*)(LR + (2 * 16 + fr) * 256 + 16 * nt + 4 * fq) = ag;
      }
    }
    __syncthreads();
    {
      float lw[8], al[8], gg[8], t8[8], kkv[8], kpv[8], o8[8];
      ld8f(lw, LR + (0 * 16 + tk) * 256 + c0); ld8f(al, LR + (1 * 16 + tk) * 256 + c0); ld8f(gg, LR + (2 * 16 + tk) * 256 + c0);
      ld8f(t8, w0 + c0);
#pragma unroll
      for (int i = 0; i < 8; ++i) lw[i] = __expf(-0.6065306597126334f * sigmoidf_(lw[i] + t8[i]));
      ld8f(t8, a0 + c0);
#pragma unroll
      for (int i = 0; i < 8; ++i) al[i] = sigmoidf_(al[i] + t8[i]);
      ld8f(t8, kkp + c0);
      float ss = 0.f;
#pragma unroll
      for (int i = 0; i < 8; ++i) { kkv[i] = k[i] * t8[i]; ss += kkv[i] * kkv[i]; }
      ss = sum8(ss);
      const float rn = rsqrtf(ss + 1e-6f);
      ld8f(t8, kap + c0);
#pragma unroll
      for (int i = 0; i < 8; ++i) { kkv[i] *= rn; kpv[i] = k[i] * (1.0f + (al[i] - 1.0f) * t8[i]); }
      ld8f(t8, rkp + c0);
      float rks = 0.f;
#pragma unroll
      for (int i = 0; i < 8; ++i) rks += r[i] * kpv[i] * t8[i];
      rks = sum8(rks);
#pragma unroll
      for (int i = 0; i < 8; ++i) o8[i] = -kkv[i];
      *(u32x4*)(rwA + idx) = pk8(o8);
      *(f32x4*)(rwW + idx) = (f32x4){lw[0], lw[1], lw[2], lw[3]}; *(f32x4*)(rwW + idx + 4) = (f32x4){lw[4], lw[5], lw[6], lw[7]};
#pragma unroll
      for (int i = 0; i < 8; ++i) o8[i] = kkv[i] * al[i];
      *(u32x4*)(rwB + idx) = pk8(o8);
      *(u32x4*)(rwK + idx) = pk8(kpv);
      *(u32x4*)(rwR + idx) = pk8(r);
      *(u32x4*)(rwV + idx) = pk8(v);
      *(u32x4*)(auxg + (size_t)tok * 256 + c0) = pk8(gg);
      if ((cg & 7) == 0) rk[tok * 4 + h] = rks;
    }
    asm volatile("" ::: "memory");
    {
      float q[8], kx[8];
      unpk8(q, *(const u32x4*)(ur + OFF_B + c0)); unpk8(kx, *(const u32x4*)(ur + OFF_B + 256 + c0));
      const u32x4 vdw = *(const u32x4*)(ur + OFF_B + 512 + c0);
      if ((cg & 3) == 0) {
#pragma unroll
        for (int i = 0; i < 4; ++i) {
          const float invrev = i == 0 ? 0.15915494309189535f : i == 1 ? 0.005985185712713705f : i == 2 ? 0.00022507907903927653f : 8.464330808241401e-06f;
          const float rvf = (float)t * invrev, fr_ = rvf - floorf(rvf);
          const float sn = __builtin_amdgcn_sinf(fr_), cs = __builtin_amdgcn_cosf(fr_);
          const float q1 = q[i], q2 = q[i + 4], k1 = kx[i], k2 = kx[i + 4];
          q[i] = q1 * cs - q2 * sn; q[i + 4] = q2 * cs + q1 * sn;
          kx[i] = k1 * cs - k2 * sn; kx[i + 4] = k2 * cs + k1 * sn;
        }
      }
#pragma unroll
      for (int i = 0; i < 8; ++i) q[i] *= QS_D;
      *(u32x4*)(Qd + idx) = pk8(q); *(u32x4*)(Kd + idx) = pk8(kx);
      asm volatile("" ::: "memory");
      float fqv[8];
      unpk8(fqv, *(const u32x4*)(ur + OFF_C + c0));
#pragma unroll
      for (int i = 0; i < 8; ++i) fqv[i] *= QS_F;
      *(u32x4*)(Qf + idx) = pk8(fqv);
      *(u32x4*)(Kf + idx) = *(const u32x4*)(ur + OFF_C + 256 + c0);
      const u32x4 vfw = *(const u32x4*)(ur + OFF_C + 512 + c0);
      *(u32x4*)(VT + (0 * 16 + tk) * 256 + c0) = vdw;
      *(u32x4*)(VT + (1 * 16 + tk) * 256 + c0) = vfw;
      if (cg == 0) {
        const u32x2 fl = *(const u32x2*)(ur + OFF_C + 768);
        const float f0 = __uint_as_float(fl[0] << 16), f1 = __uint_as_float(fl[0] & 0xffff0000u), f2 = __uint_as_float(fl[1] << 16), f3 = __uint_as_float(fl[1] & 0xffff0000u);
        logf_[(size_t)(b * 4 + 0) * SEQ + t] = logsigmoidf_(f0 + fbias[0]); logf_[(size_t)(b * 4 + 1) * SEQ + t] = logsigmoidf_(f1 + fbias[1]);
        logf_[(size_t)(b * 4 + 2) * SEQ + t] = logsigmoidf_(f2 + fbias[2]); logf_[(size_t)(b * 4 + 3) * SEQ + t] = logsigmoidf_(f3 + fbias[3]);
      }
    }
    asm volatile("" ::: "memory");
    {
      float y[3][8];
#pragma unroll
      for (int seg = 0; seg < 3; ++seg) {
        asm volatile("" ::: "memory");
#pragma unroll
        for (int i = 0; i < 8; ++i) y[seg][i] = 0.f;
#pragma unroll
        for (int jj = 0; jj < 4; ++jj) {
          if (t - 3 + jj >= 0) {
            const bf16_t* up_ = ur + (jj - 3) * UC + OFF_D + seg * 256 + c0;
            const u32x2 lo = *(const u32x2*)up_, hi = *(const u32x2*)(up_ + 4);
            const u32x4 w4 = {lo[0], lo[1], hi[0], hi[1]};
            float uu[8]; unpk8(uu, w4);
#pragma unroll
            for (int i = 0; i < 8; ++i) y[seg][i] += cw[(seg * 256 + c0 + i) * 4 + jj] * uu[i];
          }
        }
#pragma unroll
        for (int i = 0; i < 8; ++i) y[seg][i] = y[seg][i] * sigmoidf_(y[seg][i]);
      }
      float sq = 0.f, sk = 0.f;
#pragma unroll
      for (int i = 0; i < 8; ++i) { sq += y[0][i] * y[0][i]; sk += y[1][i] * y[1][i]; }
      sq = sum8(sq); sk = sum8(sk);
      const float rq = rsqrtf(sq + 1e-6f) * 0.125f, rkn = rsqrtf(sk + 1e-6f);
#pragma unroll
      for (int i = 0; i < 8; ++i) { y[0][i] *= rq; y[1][i] *= rkn; }
      *(u32x4*)(gq + idx) = pk8(y[0]); *(u32x4*)(gk + idx) = pk8(y[1]); *(u32x4*)(gv + idx) = pk8(y[2]);
      asm volatile("" ::: "memory");
      {
        const bf16_t* gp = ur + OFF_D + 776 + c0;
        const u32x2 lo = *(const u32x2*)gp, hi = *(const u32x2*)(gp + 4);
        const u32x4 w4 = {lo[0], lo[1], hi[0], hi[1]};
        float g8[8]; unpk8(g8, w4);
#pragma unroll
        for (int i = 0; i < 8; ++i) g8[i] = g8[i] * sigmoidf_(g8[i]);
        *(u32x4*)(auxgate + (size_t)tok * 256 + c0) = pk8(g8);
      }
      if ((cg & 7) == 0) {
        const float beta = sigmoidf_(bf2f(ur[OFF_D + 768 + h]));
        const float gl = -__expf(alog[h]) * softplusf_(bf2f(ur[OFF_D + 772 + h]) + dtb[h]);
        gbeta[(size_t)bh * SEQ + t] = beta; ga[(size_t)bh * SEQ + t] = __expf(gl);
      }
    }
    __syncthreads();
    {
      const int ch = tid & 255, hf = tid >> 8;
#pragma unroll
      for (int m = 0; m < 2; ++m) {
        const bf16_t* vs = VT + (m * 16 + hf * 8) * 256 + ch;
        u32x4 w;
        w[0] = (unsigned)vs[0] | ((unsigned)vs[256] << 16); w[1] = (unsigned)vs[512] | ((unsigned)vs[768] << 16);
        w[2] = (unsigned)vs[1024] | ((unsigned)vs[1280] << 16); w[3] = (unsigned)vs[1536] | ((unsigned)vs[1792] << 16);
        bf16_t* dst = (m == 0 ? Vd : Vf) + ((size_t)(b * 4 + (ch >> 6)) * 64 + (ch & 63)) * SEQ + t0 + hf * 8;
        *(u32x4*)dst = w;
      }
    }
  }
}

DI float dpp_sum16(float x) {
  x += __int_as_float(__builtin_amdgcn_update_dpp(0, __float_as_int(x), 0xB1, 0xF, 0xF, true));
  x += __int_as_float(__builtin_amdgcn_update_dpp(0, __float_as_int(x), 0x4E, 0xF, 0xF, true));
  x += __int_as_float(__builtin_amdgcn_update_dpp(0, __float_as_int(x), 0x141, 0xF, 0xF, true));
  x += __int_as_float(__builtin_amdgcn_update_dpp(0, __float_as_int(x), 0x140, 0xF, 0xF, true));
  return x;
}
constexpr int SCH = 16;
constexpr int RS = 448;
DI float sum32(float x) {
  x = dpp_sum16(x);
  auto rr = __builtin_amdgcn_permlane16_swap(__float_as_uint(x), __float_as_uint(x), false, false);
  return __uint_as_float(rr[0]) + __uint_as_float(rr[1]);
}
struct StepIn { f32x4 q0, q1, q2; float V; };
DI void ld_step(StepIn& s, const float* sp, const float* vp) {
  s.q0 = *(const f32x4*)(sp); s.q1 = *(const f32x4*)(sp + 4); s.q2 = *(const f32x4*)(sp + 8); s.V = *vp;
}
template <int WHICH>
DI void scan_block(const Params& p, int L, int bh, int quarter, char* lds) {
  float* buf = (float*)lds;
  float* pbuf = buf + 2 * SCH * RS;
  char* R = p.ws + O_R;
  const int tid = otid();
  const size_t base = (size_t)bh * SEQ * 64;
  float* oout = (float*)(R + R_OSCAN) + (size_t)WHICH * NBH * SEQ * 64 + base;
  constexpr int NCH = SEQ / SCH;
  const int r = tid >> 5, sub = tid & 31, v = quarter * 16 + r;
  const int sst = (tid >> 4) & (SCH - 1), sk = (tid & 15) * 4;
  const bool stager = tid < SCH * 16;
  const u32x2* pA = (const u32x2*)((const bf16_t*)(R + (WHICH == 0 ? R_RWA : R_GK)) + base);
  const u32x2* pB = (const u32x2*)((const bf16_t*)(R + R_RWB) + base);
  const u32x2* pK = (const u32x2*)((const bf16_t*)(R + R_RWK) + base);
  const u32x2* pR = (const u32x2*)((const bf16_t*)(R + (WHICH == 0 ? R_RWR : R_GQ)) + base);
  const u32x2* pV = (const u32x2*)((const bf16_t*)(R + (WHICH == 0 ? R_RWV : R_GV)) + base);
  const f32x4* pW = (const f32x4*)((const float*)(R + R_RWW) + base);
  const float* gbeta = (const float*)(p.ws + O_SMALL + SM_GBETA) + (size_t)bh * SEQ;
  const float* ga = (const float*)(p.ws + O_SMALL + SM_GA) + (size_t)bh * SEQ;
  const u32x2 z2 = {0u, 0u};
  u32x2 ra = z2, ran = z2, rb = z2, rkk = z2, rr = z2, rv = z2; f32x4 rw = {0.f, 0.f, 0.f, 0.f};
  float rbeta = 0.f, raa = 0.f;
#define SCAN_LOAD(c)                                                                           \
  if (stager) {                                                                                \
    const int t_ = (c) * SCH + sst;                                                            \
    const size_t o_ = (size_t)t_ * 16 + (tid & 15);                                            \
    ra = pA[o_]; rr = pR[o_]; rv = pV[o_];                                                     \
    ran = t_ + 1 < SEQ ? pA[o_ + 16] : z2;                                                     \
    if (WHICH == 0) { rb = pB[o_]; rkk = pK[o_]; rw = pW[o_]; }                                \
    else { rbeta = gbeta[t_]; raa = ga[t_]; }                                                  \
  }
#define UNPK4(src) ((f32x4){__uint_as_float(src[0] << 16), __uint_as_float(src[0] & 0xffff0000u), __uint_as_float(src[1] << 16), __uint_as_float(src[1] & 0xffff0000u)})
#define DOT4(a, b) ((a[0] * b[0] + a[1] * b[1]) + (a[2] * b[2] + a[3] * b[3]))
#define SCAN_STAGE(c)                                                                          \
  if (stager) {                                                                                \
    float* rec_ = buf + ((c) & 1) * (SCH * RS) + sst * RS;                                     \
    f32x4 fAn, fW, fB, fK;                                                                     \
    if (WHICH == 0) { fAn = UNPK4(ran); fW = rw; fB = UNPK4(rb); fK = UNPK4(rkk); }            \
    else { const f32x4 k0_ = UNPK4(ra), kn_ = UNPK4(ran); fAn = -kn_; fW = (f32x4){raa, raa, raa, raa}; fB = k0_ * (raa * rbeta); fK = k0_ * rbeta; } \
    const float c1_ = dpp_sum16(DOT4(fB, fAn)), c2_ = dpp_sum16(DOT4(fK, fAn));               \
    const f32x4 fR = UNPK4(rr), fWA = fW * fAn;                                                \
    float* d_ = rec_ + (tid & 15) * 24;                                                        \
    *(f32x4*)(d_) = (f32x4){fWA[0], fWA[1], fW[0], fW[1]}; *(f32x4*)(d_ + 4) = (f32x4){fB[0], fB[1], fK[0], fK[1]}; *(f32x4*)(d_ + 8) = (f32x4){fR[0], fR[1], c1_, c2_};       \
    *(f32x4*)(d_ + 12) = (f32x4){fWA[2], fWA[3], fW[2], fW[3]}; *(f32x4*)(d_ + 16) = (f32x4){fB[2], fB[3], fK[2], fK[3]}; *(f32x4*)(d_ + 20) = (f32x4){fR[2], fR[3], c1_, c2_}; \
    *(f32x4*)(rec_ + 384 + sk) = UNPK4(rv);                                                    \
  }
#define SCAN_FLUSH(c)                                                                          \
  {                                                                                            \
    const float* pb_ = pbuf + ((c) & 1) * (SCH * 512);                                         \
    _Pragma("unroll") for (int ps_ = 0; ps_ < 4; ++ps_) {                                      \
      const int o_ = ps_ * 64 + (tid >> 3);                                                    \
      const f32x4 q_ = *(const f32x4*)(pb_ + o_ * 32 + (tid & 7) * 4);                         \
      float sm_ = (q_[0] + q_[1]) + (q_[2] + q_[3]);                                           \
      sm_ += __int_as_float(__builtin_amdgcn_update_dpp(0, __float_as_int(sm_), 0xB1, 0xF, 0xF, true));   \
      sm_ += __int_as_float(__builtin_amdgcn_update_dpp(0, __float_as_int(sm_), 0x4E, 0xF, 0xF, true));   \
      sm_ += __int_as_float(__builtin_amdgcn_update_dpp(0, __float_as_int(sm_), 0x141, 0xF, 0xF, true));  \
      if ((tid & 7) == 0) oout[((size_t)(c) * SCH + (o_ >> 4)) * 64 + quarter * 16 + (o_ & 15)] = sm_;   \
    }                                                                                          \
  }
  SCAN_LOAD(0);
  __syncthreads();
  SCAN_STAGE(0);
  f32x2 S1 = {0.f, 0.f}; float pre = 0.f, X = 0.f;
#pragma unroll 1
  for (int c = 0; c < NCH; ++c) {
    __syncthreads();
    if (c >= 1) SCAN_FLUSH(c - 1);
    if (c + 1 < NCH) SCAN_LOAD(c + 1);
    const float* cb = buf + (c & 1) * (SCH * RS);
    float* pb = pbuf + (c & 1) * (SCH * 512) + r * 32 + sub;
    StepIn cur, nxt;
    ld_step(cur, cb + sub * 12, cb + 384 + v);
#pragma unroll 4
    for (int st = 0; st < SCH; ++st) {
      const int sn = st + 1 < SCH ? st + 1 : st;
      ld_step(nxt, cb + sn * RS + sub * 12, cb + sn * RS + 384 + v);
      const float sa = X + pre;
      const float Xn = sum32(S1[0] * cur.q0[0] + S1[1] * cur.q0[1]);
      const float s0 = S1[0] * cur.q0[2] + (cur.q1[0] * sa + cur.q1[2] * cur.V);
      const float s1 = S1[1] * cur.q0[3] + (cur.q1[1] * sa + cur.q1[3] * cur.V);
      pre = sa * cur.q2[2] + cur.V * cur.q2[3];
      pb[st * 512] = s0 * cur.q2[0] + s1 * cur.q2[1];
      S1[0] = s0; S1[1] = s1; X = Xn;
      cur = nxt;
    }
    if (c + 1 < NCH) SCAN_STAGE(c + 1);
  }
  __syncthreads();
  SCAN_FLUSH(NCH - 1);
#undef SCAN_LOAD
#undef SCAN_STAGE
#undef SCAN_FLUSH
#undef UNPK4
#undef DOT4
}

constexpr int CLD = 72;
constexpr int CMB = 64 * CLD * 2;
constexpr int NCHK = SEQ / 64;
template <class F> DI void mm64(const bf16_t* X, const bf16_t* Y, int wid, int lane, F f) {
  const int fr = lane & 15, fq = lane >> 4;
#pragma unroll
  for (int q = 0; q < 2; ++q) {
    const int tile = wid * 2 + q, ti = tile >> 2, tj = tile & 3;
    f32x4 acc = {0.f, 0.f, 0.f, 0.f};
#pragma unroll
    for (int ks = 0; ks < 2; ++ks) {
      const bf16x8 yf = *(const bf16x8*)(Y + (16 * tj + fr) * CLD + 32 * ks + 8 * fq);
      const bf16x8 xf = *(const bf16x8*)(X + (16 * ti + fr) * CLD + 32 * ks + 8 * fq);
      acc = __builtin_amdgcn_mfma_f32_16x16x32_bf16(yf, xf, acc, 0, 0, 0);
    }
    f(16 * ti + fr, 16 * tj + 4 * fq, acc);
  }
}
DI void st4bf(bf16_t* d, const f32x4& v) { u32x2 w; w[0] = pk2(v[0], v[1]); w[1] = pk2(v[2], v[3]); *(u32x2*)d = w; }

template <int WHICH>
DI void chunk_pre(const Params& p, int bh, int c, char* lds) {
  bf16_t* M[11];
#pragma unroll
  for (int i = 0; i < 11; ++i) M[i] = (bf16_t*)(lds + i * CMB);
  float* NF = (float*)(lds + 11 * CMB);
  float* SC = NF + 64 * 65;
  char* R = p.ws + O_R;
  const int tid = otid(), lane = tid & 63, wid = tid >> 6;
  const int item = (WHICH * NBH + bh) * NCHK + c;
  const size_t base = ((size_t)bh * SEQ + (size_t)c * 64) * 64;
  const bf16_t* gA = (const bf16_t*)(R + (WHICH == 0 ? R_RWA : R_GK)) + base;
  const bf16_t* gB = (const bf16_t*)(R + R_RWB) + base;
  const bf16_t* gK = (const bf16_t*)(R + R_RWK) + base;
  const bf16_t* gR = (const bf16_t*)(R + (WHICH == 0 ? R_RWR : R_GQ)) + base;
  const bf16_t* gV = (const bf16_t*)(R + (WHICH == 0 ? R_RWV : R_GV)) + base;
  const float* gW = (const float*)(R + R_RWW) + base;
  bf16_t* oRh = (bf16_t*)(R + R_CHK) + (size_t)item * 4096;
  bf16_t* oGh = (bf16_t*)(R + R_CHK + CHK_SZ) + (size_t)item * 4096;
  bf16_t* oSV = (bf16_t*)(R + R_CHK + 2 * CHK_SZ) + (size_t)item * 4096;
  float* oout = (float*)(R + R_OSCAN) + (size_t)WHICH * NBH * SEQ * 64 + base;
  __syncthreads();
  if (WHICH == 0) {
    const int k = tid & 63, seg = tid >> 6;
    float lg[8]; float run = 0.f;
#pragma unroll
    for (int i = 0; i < 8; ++i) { run += __logf(gW[(size_t)(seg * 8 + i) * 64 + k]); lg[i] = run; }
    SC[seg * 64 + k] = run;
    __syncthreads();
    float off = 0.f;
    for (int s2 = 0; s2 < seg; ++s2) off += SC[s2 * 64 + k];
#pragma unroll
    for (int i = 0; i < 8; ++i) NF[(seg * 8 + i) * 65 + k] = lg[i] + off;
    __syncthreads();
    if (tid < 64) SC[512 + tid] = __expf(NF[63 * 65 + tid]);
  } else {
    if (tid < 64) {
      const float a = ((const float*)(p.ws + O_SMALL + SM_GA))[(size_t)bh * SEQ + c * 64 + tid];
      const float be = ((const float*)(p.ws + O_SMALL + SM_GBETA))[(size_t)bh * SEQ + c * 64 + tid];
      float g = __logf(a);
#pragma unroll
      for (int o = 1; o < 64; o <<= 1) { const float t2 = shfl_up_l(g, o, lane); if (lane >= o) g += t2; }
      SC[tid] = g; SC[64 + tid] = a * be; SC[128 + tid] = be;
    }
    __syncthreads();
    if (tid < 64) SC[512 + tid] = __expf(SC[63]);
  }
  __syncthreads();
  {
    const int t = tid >> 3, kg = (tid & 7) * 8;
    float a8[8], r8[8], b8[8], k8[8], e0[8], e1[8], em[8], ee[8];
    unpk8(a8, *(const u32x4*)(gA + t * 64 + kg)); unpk8(r8, *(const u32x4*)(gR + t * 64 + kg));
    const u32x4 vraw = *(const u32x4*)(gV + t * 64 + kg);
    if (WHICH == 0) {
      unpk8(b8, *(const u32x4*)(gB + t * 64 + kg)); unpk8(k8, *(const u32x4*)(gK + t * 64 + kg));
#pragma unroll
      for (int i = 0; i < 8; ++i) {
        const float g1 = NF[t * 65 + kg + i], g0 = t > 0 ? NF[(t - 1) * 65 + kg + i] : 0.f, gl = NF[63 * 65 + kg + i];
        e0[i] = __expf(g0); e1[i] = __expf(g1); em[i] = __expf(-g1); ee[i] = __expf(gl - g1);
      }
    } else {
      const float g1 = SC[t], g0 = t > 0 ? SC[t - 1] : 0.f, gl = SC[63], ab = SC[64 + t], be = SC[128 + t];
      const float x0 = __expf(g0), x1 = __expf(g1), xe = __expf(gl - g1);
#pragma unroll
      for (int i = 0; i < 8; ++i) { const float kv = a8[i]; b8[i] = ab * kv; k8[i] = be * kv; a8[i] = -kv; e0[i] = x0; e1[i] = x1; em[i] = 1.f; ee[i] = xe; }
    }
    float o8[8];
#pragma unroll
    for (int i = 0; i < 8; ++i) o8[i] = a8[i] * e0[i];
    *(u32x4*)(M[0] + t * CLD + kg) = pk8(o8);
#pragma unroll
    for (int i = 0; i < 8; ++i) M[1][(kg + i) * CLD + t] = f2bf(o8[i]);
#pragma unroll
    for (int i = 0; i < 8; ++i) o8[i] = r8[i] * e1[i];
    *(u32x4*)(M[2] + t * CLD + kg) = pk8(o8);
    if (WHICH == 0) {
#pragma unroll
      for (int i = 0; i < 8; ++i) o8[i] = b8[i] * em[i];
      *(u32x4*)(M[3] + t * CLD + kg) = pk8(o8);
#pragma unroll
      for (int i = 0; i < 8; ++i) o8[i] = k8[i] * em[i];
      *(u32x4*)(M[4] + t * CLD + kg) = pk8(o8);
    } else {
#pragma unroll
      for (int i = 0; i < 8; ++i) o8[i] = -a8[i];
      *(u32x4*)(M[3] + t * CLD + kg) = pk8(o8);
      *(u32x4*)(M[4] + t * CLD + kg) = pk8(r8);
    }
#pragma unroll
    for (int i = 0; i < 8; ++i) M[5][(kg + i) * CLD + t] = f2bf(b8[i] * ee[i]);
#pragma unroll
    for (int i = 0; i < 8; ++i) o8[i] = k8[i] * ee[i];
    *(u32x4*)(M[6] + t * CLD + kg) = pk8(o8);
    M[7][(kg + 0) * CLD + t] = (bf16_t)(vraw[0] & 0xffffu); M[7][(kg + 1) * CLD + t] = (bf16_t)(vraw[0] >> 16);
    M[7][(kg + 2) * CLD + t] = (bf16_t)(vraw[1] & 0xffffu); M[7][(kg + 3) * CLD + t] = (bf16_t)(vraw[1] >> 16);
    M[7][(kg + 4) * CLD + t] = (bf16_t)(vraw[2] & 0xffffu); M[7][(kg + 5) * CLD + t] = (bf16_t)(vraw[2] >> 16);
    M[7][(kg + 6) * CLD + t] = (bf16_t)(vraw[3] & 0xffffu); M[7][(kg + 7) * CLD + t] = (bf16_t)(vraw[3] >> 16);
  }
  __syncthreads();
  if (WHICH == 0) {
    mm64(M[3], M[0], wid, lane, [&](int j, int t0, const f32x4& v) {
#pragma unroll
      for (int r = 0; r < 4; ++r) NF[j * 65 + t0 + r] = (j < t0 + r) ? v[r] : 0.f; });
    mm64(M[4], M[0], wid, lane, [&](int i, int t0, const f32x4& v) {
      f32x4 w;
#pragma unroll
      for (int r = 0; r < 4; ++r) w[r] = (i < t0 + r) ? v[r] : 0.f;
      st4bf(M[8] + i * CLD + t0, w); });
    mm64(M[2], M[3], wid, lane, [&](int t, int j0, const f32x4& v) {
      f32x4 w;
#pragma unroll
      for (int r = 0; r < 4; ++r) w[r] = (j0 + r <= t) ? v[r] : 0.f;
      st4bf(M[9] + t * CLD + j0, w); });
    mm64(M[2], M[4], wid, lane, [&](int t, int i0, const f32x4& v) {
      f32x4 w;
#pragma unroll
      for (int r = 0; r < 4; ++r) w[r] = (i0 + r <= t) ? v[r] : 0.f;
      st4bf(M[10] + t * CLD + i0, w); });
  } else {
    mm64(M[3], M[3], wid, lane, [&](int j, int t0, const f32x4& v) {
      const float gj = SC[j], abj = SC[64 + j], bej = SC[128 + j];
      f32x4 w;
#pragma unroll
      for (int r = 0; r < 4; ++r) {
        const int t = t0 + r;
        const float d = (j < t) ? __expf(SC[t - 1 > 0 ? t - 1 : 0] - gj) * v[r] : 0.f;
        NF[j * 65 + t] = -abj * d; w[r] = -bej * d;
      }
      st4bf(M[8] + j * CLD + t0, w); });
    mm64(M[4], M[3], wid, lane, [&](int t, int j0, const f32x4& v) {
      const float gt = SC[t];
      f32x4 w1, w2;
#pragma unroll
      for (int r = 0; r < 4; ++r) {
        const int j = j0 + r;
        const float d = (j <= t) ? __expf(gt - SC[j]) * v[r] : 0.f;
        w1[r] = SC[64 + j] * d; w2[r] = SC[128 + j] * d;
      }
      st4bf(M[9] + t * CLD + j0, w1); st4bf(M[10] + t * CLD + j0, w2); });
  }
  __syncthreads();
  {
    const int i = tid >> 3, sidx = tid & 7;
    float tr[8];
#pragma unroll
    for (int m = 0; m < 8; ++m) tr[m] = 0.f;
#pragma unroll
    for (int t = 0; t < 64; ++t) {
      float part = 0.f;
#pragma unroll
      for (int m = 0; m < 8; ++m) if (8 * m < t) part += tr[m] * NF[(sidx + 8 * m) * 65 + t];
      const float val = sum8(part) + (i == t ? 1.f : 0.f);
      if (sidx == (t & 7)) { tr[t >> 3] = val; M[0][t * CLD + i] = f2bf(val); }
    }
  }
  __syncthreads();
  mm64(M[1], M[0], wid, lane, [&](int k, int t0, const f32x4& v) { st4bf(M[3] + k * CLD + t0, v); });
  mm64(M[8], M[0], wid, lane, [&](int i, int t0, const f32x4& v) { st4bf(M[4] + i * CLD + t0, v); });
  __syncthreads();
  mm64(M[9], M[3], wid, lane, [&](int t, int k0, const f32x4& v) {
    float rr[8]; const u32x2 rw = *(const u32x2*)(M[2] + t * CLD + k0);
    const f32x4 o = {v[0] + __uint_as_float(rw[0] << 16), v[1] + __uint_as_float(rw[0] & 0xffff0000u), v[2] + __uint_as_float(rw[1] << 16), v[3] + __uint_as_float(rw[1] & 0xffff0000u)};
    (void)rr; st4bf(oRh + t * 64 + k0, o); });
  mm64(M[9], M[4], wid, lane, [&](int t, int i0, const f32x4& v) {
    const u32x2 rw = *(const u32x2*)(M[10] + t * CLD + i0);
    const f32x4 o = {v[0] + __uint_as_float(rw[0] << 16), v[1] + __uint_as_float(rw[0] & 0xffff0000u), v[2] + __uint_as_float(rw[1] << 16), v[3] + __uint_as_float(rw[1] & 0xffff0000u)};
    st4bf(M[1] + t * CLD + i0, o); });
  mm64(M[5], M[3], wid, lane, [&](int kp, int k0, const f32x4& v) {
    f32x4 o = v;
#pragma unroll
    for (int r = 0; r < 4; ++r) if (k0 + r == kp) o[r] += SC[512 + kp];
    st4bf(oGh + kp * 64 + k0, o); });
  __syncthreads();
  mm64(M[5], M[4], wid, lane, [&](int kp, int i0, const f32x4& v) {
    f32x4 o;
#pragma unroll
    for (int r = 0; r < 4; ++r) o[r] = v[r] + bf2f(M[6][(i0 + r) * CLD + kp]);
    st4bf(M[8] + kp * CLD + i0, o); });
  __syncthreads();
  mm64(M[7], M[1], wid, lane, [&](int v, int t0, const f32x4& val) {
#pragma unroll
    for (int r = 0; r < 4; ++r) oout[(size_t)(t0 + r) * 64 + v] = val[r]; });
  mm64(M[7], M[8], wid, lane, [&](int v, int k0, const f32x4& val) { st4bf(oSV + v * 64 + k0, val); });
}

template <int WHICH>
DI void chunk_seq(const Params& p, int bh, char* lds) {
  bf16_t* SH = (bf16_t*)lds;
  bf16_t* SL = (bf16_t*)(lds + CMB);
  bf16_t* SR = (bf16_t*)(lds + 2 * CMB);
  bf16_t* SG = (bf16_t*)(lds + 4 * CMB);
  char* R = p.ws + O_R;
  const int tid = otid(), lane = tid & 63, wid = tid >> 6, fr = lane & 15, fq = lane >> 4;
  const size_t item0 = (size_t)(WHICH * NBH + bh) * NCHK;
  const bf16_t* gRh = (const bf16_t*)(R + R_CHK) + item0 * 4096;
  const bf16_t* gGh = (const bf16_t*)(R + R_CHK + CHK_SZ) + item0 * 4096;
  const bf16_t* gSV = (const bf16_t*)(R + R_CHK + 2 * CHK_SZ) + item0 * 4096;
  float* oout = (float*)(R + R_OSCAN) + (size_t)WHICH * NBH * SEQ * 64 + (size_t)bh * SEQ * 64;
  f32x4 st[2];
  st[0] = (f32x4){0.f, 0.f, 0.f, 0.f}; st[1] = st[0];
  const int lrow = tid >> 3, lch = (tid & 7) * 8;
  int sv_off[2], ov_off[2];
#pragma unroll
  for (int q = 0; q < 2; ++q) { const int tile = wid * 2 + q, ti = tile >> 2, tj = tile & 3; sv_off[q] = (16 * ti + fr) * 64 + 16 * tj + 4 * fq; ov_off[q] = (16 * tj + fr) * 64 + 16 * ti + 4 * fq; }
  u32x4 rreg = *(const u32x4*)(gRh + lrow * 64 + lch), greg = *(const u32x4*)(gGh + lrow * 64 + lch);
  u32x2 svr[2]; f32x4 ovr[2];
#pragma unroll
  for (int q = 0; q < 2; ++q) { svr[q] = *(const u32x2*)(gSV + sv_off[q]); ovr[q] = *(const f32x4*)(oout + ov_off[q]); }
  __syncthreads();
#pragma unroll 1
  for (int c = 0; c < NCHK; ++c) {
    bf16_t* sr = SR + (c & 1) * (64 * CLD); bf16_t* sg = SG + (c & 1) * (64 * CLD);
#pragma unroll
    for (int q = 0; q < 2; ++q) {
      const int tile = wid * 2 + q, ti = tile >> 2, tj = tile & 3, v = 16 * ti + fr, k0 = 16 * tj + 4 * fq;
      f32x4 hi, lo;
#pragma unroll
      for (int r = 0; r < 4; ++r) { const float h = bf2f(f2bf(st[q][r])); hi[r] = h; lo[r] = st[q][r] - h; }
      st4bf(SH + v * CLD + k0, hi); st4bf(SL + v * CLD + k0, lo);
    }
    *(u32x4*)(sr + lrow * CLD + lch) = rreg; *(u32x4*)(sg + lrow * CLD + lch) = greg;
    const u32x2 sv0 = svr[0], sv1 = svr[1]; const f32x4 ov0 = ovr[0], ov1 = ovr[1];
    __syncthreads();
    if (c + 1 < NCHK) {
      rreg = *(const u32x4*)(gRh + (size_t)(c + 1) * 4096 + lrow * 64 + lch); greg = *(const u32x4*)(gGh + (size_t)(c + 1) * 4096 + lrow * 64 + lch);
#pragma unroll
      for (int q = 0; q < 2; ++q) { svr[q] = *(const u32x2*)(gSV + (size_t)(c + 1) * 4096 + sv_off[q]); ovr[q] = *(const f32x4*)(oout + (size_t)(c + 1) * 4096 + ov_off[q]); }
    }
#pragma unroll
    for (int q = 0; q < 2; ++q) {
      const int tile = wid * 2 + q, ti = tile >> 2, tj = tile & 3;
      f32x4 acc = q == 0 ? ov0 : ov1;
#pragma unroll
      for (int ks = 0; ks < 2; ++ks) {
        const bf16x8 sf = *(const bf16x8*)(SH + (16 * ti + fr) * CLD + 32 * ks + 8 * fq);
        const bf16x8 rf = *(const bf16x8*)(sr + (16 * tj + fr) * CLD + 32 * ks + 8 * fq);
        acc = __builtin_amdgcn_mfma_f32_16x16x32_bf16(sf, rf, acc, 0, 0, 0);
      }
      *(f32x4*)(oout + (size_t)c * 4096 + ov_off[q]) = acc;
    }
#pragma unroll
    for (int q = 0; q < 2; ++q) {
      const int tile = wid * 2 + q, ti = tile >> 2, tj = tile & 3;
      const u32x2 svw = q == 0 ? sv0 : sv1;
      f32x4 acc = {__uint_as_float(svw[0] << 16), __uint_as_float(svw[0] & 0xffff0000u), __uint_as_float(svw[1] << 16), __uint_as_float(svw[1] & 0xffff0000u)};
#pragma unroll
      for (int ks = 0; ks < 2; ++ks) {
        const bf16x8 gf = *(const bf16x8*)(sg + (16 * tj + fr) * CLD + 32 * ks + 8 * fq);
        const bf16x8 hf = *(const bf16x8*)(SH + (16 * ti + fr) * CLD + 32 * ks + 8 * fq);
        const bf16x8 lf = *(const bf16x8*)(SL + (16 * ti + fr) * CLD + 32 * ks + 8 * fq);
        acc = __builtin_amdgcn_mfma_f32_16x16x32_bf16(gf, hf, acc, 0, 0, 0);
        acc = __builtin_amdgcn_mfma_f32_16x16x32_bf16(gf, lf, acc, 0, 0, 0);
      }
      st[q] = acc;
    }
    __syncthreads();
  }
}

DI void phase_scanpost(const Params& p, int L) {
  char* R = p.ws + O_R;
  const float* osc = (const float*)(R + R_OSCAN);
  const float* rk = (const float*)(p.ws + O_SMALL + SM_RK);
  const bf16_t* rwV = (const bf16_t*)(R + R_RWV);
  const bf16_t* auxg = (const bf16_t*)(R + R_AUXG); const bf16_t* auxgate = (const bf16_t*)(R + R_AUXGATE);
  bf16_t* y = (bf16_t*)(R + R_Y);
  const float* lnw = p.in[17] + L * 256; const float* lnb = p.in[18] + L * 256; const float* gnw = p.in[25] + L * 64;
#pragma unroll 1
  for (int it0 = obid() * 64; it0 < 2 * NBH * SEQ; it0 += gridDim.x * 64) {
    const int tid = otid(), item = it0 + (tid >> 3), d0 = (tid & 7) * 8;
    const int which = item >= NBH * SEQ, rem = item - which * NBH * SEQ, bh = rem / SEQ, t = rem % SEQ, b = bh >> 2, h = bh & 3, tok = b * SEQ + t;
    float o[8]; ld8f(o, osc + (size_t)item * 64 + d0);
    float g8[8]; unpk8(g8, *(const u32x4*)((which == 0 ? auxg : auxgate) + (size_t)tok * 256 + h * 64 + d0));
    float out[8];
    if (which == 0) {
      float s1 = 0.f;
#pragma unroll
      for (int i = 0; i < 8; ++i) s1 += o[i];
      const float mean = sum8(s1) * (1.0f / 64.0f);
      float s2 = 0.f;
#pragma unroll
      for (int i = 0; i < 8; ++i) { o[i] -= mean; s2 += o[i] * o[i]; }
      const float rstd = rsqrtf(sum8(s2) * (1.0f / 64.0f) + 64e-5f);
      float w8[8], b8[8], v8[8];
      ld8f(w8, lnw + h * 64 + d0); ld8f(b8, lnb + h * 64 + d0);
      unpk8(v8, *(const u32x4*)(rwV + ((size_t)bh * SEQ + t) * 64 + d0));
      const float rkv = rk[tok * 4 + h];
#pragma unroll
      for (int i = 0; i < 8; ++i) out[i] = (o[i] * rstd * w8[i] + b8[i] + rkv * v8[i]) * g8[i];
      *(u32x4*)(y + ((size_t)0 * NTOK + tok) * 256 + h * 64 + d0) = pk8(out);
    } else {
      float s2 = 0.f;
#pragma unroll
      for (int i = 0; i < 8; ++i) s2 += o[i] * o[i];
      const float rstd = rsqrtf(sum8(s2) * (1.0f / 64.0f) + 1e-6f);
      float w8[8]; ld8f(w8, gnw + d0);
#pragma unroll
      for (int i = 0; i < 8; ++i) out[i] = o[i] * rstd * w8[i] * g8[i];
      *(u32x4*)(y + ((size_t)3 * NTOK + tok) * 256 + h * 64 + d0) = pk8(out);
    }
  }
}

DI bf16x8 packf8(float a0, float a1, float a2, float a3, float a4, float a5, float a6, float a7) {
  u32x4 w; w[0] = pk2(a0, a1); w[1] = pk2(a2, a3); w[2] = pk2(a4, a5); w[3] = pk2(a6, a7);
  return __builtin_bit_cast(bf16x8, w);
}
constexpr int KLD = 72;
constexpr int ATT_KV_OFF = 2 * 64 * KLD * 2 + 8192 * 4 + 256;
constexpr int ATT_XB_OFF = ATT_KV_OFF + 4 * 64 * KLD * 2;
template <int TYPE>
DI void attn_unit(const Params& p, int L, int bh, int qt, char* lds) {
  bf16_t* KV = (bf16_t*)(lds + ATT_KV_OFF);
  float* cs = (float*)(lds + 2 * 64 * KLD * 2);
  float* red = cs + 8192;
  char* R = p.ws + O_R;
  const int tid = otid(), lane = tid & 63, wid = tid >> 6, r32 = lane & 31, hi = lane >> 5;
  const int b = bh >> 2, h = bh & 3;
  const int map = TYPE == 0 ? (wid >> 2) : 0, wq = TYPE == 0 ? (wid & 3) : wid;
  const int QROWS = TYPE == 0 ? 128 : 256;
  const int q0 = qt * QROWS, qw0 = q0 + wq * 32, q = qw0 + r32;
  const bf16_t* Qg = (const bf16_t*)(R + (TYPE == 0 ? R_QD : R_QF)) + (size_t)bh * SEQ * 64;
  const bf16_t* Kg = (const bf16_t*)(R + (TYPE == 0 ? R_KD : R_KF)) + (size_t)bh * SEQ * 64;
  const bf16_t* Vg = (const bf16_t*)(R + (TYPE == 0 ? R_VD : R_VF)) + (size_t)bh * 64 * SEQ;
  const int NT = (q0 + QROWS) / 64;
  __syncthreads();
  const int lrow = tid >> 3, lch = (tid & 7) * 8;
  u32x4 kreg = *(const u32x4*)(Kg + (size_t)lrow * 64 + lch);
  u32x4 vreg = *(const u32x4*)(Vg + (size_t)lrow * SEQ + lch);
  float cq = 0.f;
  if (TYPE == 1) {
    const float* lf = (const float*)(p.ws + O_SMALL + SM_LOGF) + (size_t)bh * SEQ;
    const int n = q0 + 256;
    float loc[16]; float tot = 0.f;
#pragma unroll
    for (int i = 0; i < 16; ++i) { const int e = tid * 16 + i; loc[i] = e < n ? lf[e] : 0.f; tot += loc[i]; }
    float inc = tot;
#pragma unroll
    for (int o = 1; o < 64; o <<= 1) { const float t2 = shfl_up_l(inc, o, lane); if (lane >= o) inc += t2; }
    if (lane == 63) red[wid] = inc;
    __syncthreads();
    float pre = inc - tot;
    for (int w = 0; w < wid; ++w) pre += red[w];
#pragma unroll
    for (int i = 0; i < 16; ++i) { pre += loc[i]; const int e = tid * 16 + i; if (e < n) cs[e] = pre * 1.4426950408889634f; }
    __syncthreads();
    cq = cs[q];
  }
  constexpr int NS = TYPE == 0 ? 2 : 4;
  const int sbase = TYPE == 0 ? 2 * map : 0;
  bf16x8 qf[NS];
#pragma unroll
  for (int s = 0; s < NS; ++s) qf[s] = *(const bf16x8*)(Qg + (size_t)q * 64 + 16 * (sbase + s) + 8 * hi);
  constexpr float ATHR = 8.0f;
  float mref = 0.f, l = 0.f; f32x16 o[2];
#pragma unroll
  for (int r = 0; r < 16; ++r) { o[0][r] = 0.f; o[1][r] = 0.f; }
  bf16_t* Kb = (bf16_t*)(lds + ATT_KV_OFF);
  bf16_t* Vb = Kb + 2 * 64 * KLD;
  const int vpos = (lch & ~15) + ((lch & 8) ? 4 : 0);
  const int tmax = (qw0 + 31) >> 6;
#define ST_K(buf) { *(u32x4*)(Kb + (buf) * (64 * KLD) + lrow * KLD + lch) = kreg; }
#define ST_V(buf) { bf16_t* vb_ = Vb + (buf) * (64 * KLD) + lrow * KLD + vpos; *(u32x2*)(vb_) = (u32x2){vreg[0], vreg[1]}; *(u32x2*)(vb_ + 8) = (u32x2){vreg[2], vreg[3]}; }
#define LD_K(t_) { kreg = *(const u32x4*)(Kg + (size_t)((t_) * 64 + lrow) * 64 + lch); }
#define LD_V(t_) { vreg = *(const u32x4*)(Vg + (size_t)lrow * SEQ + (t_) * 64 + lch); }
#define QK_TILE(P0, P1, t_)                                                                    \
  {                                                                                            \
    const bf16_t* Ks_ = Kb + ((t_) & 1) * (64 * KLD); const int kv_ = (t_) * 64;               \
    if (TYPE == 1) {                                                                           \
      const float cm_ = cq - mref;                                                             \
      _Pragma("unroll") for (int g = 0; g < 4; ++g) {                                          \
        const f32x4 c0_ = *(const f32x4*)(cs + kv_ + 8 * g + 4 * hi), c1_ = *(const f32x4*)(cs + kv_ + 32 + 8 * g + 4 * hi); \
        _Pragma("unroll") for (int i = 0; i < 4; ++i) { P0[4 * g + i] = cm_ - c0_[i]; P1[4 * g + i] = cm_ - c1_[i]; } }      \
    } else { _Pragma("unroll") for (int r = 0; r < 16; ++r) { P0[r] = -mref; P1[r] = -mref; } } \
    bf16x8 kf0_[NS], kf1_[NS];                                                                 \
    _Pragma("unroll") for (int s = 0; s < NS; ++s) {                                           \
      kf0_[s] = *(const bf16x8*)(Ks_ + r32 * KLD + 16 * (sbase + s) + 8 * hi);                 \
      kf1_[s] = *(const bf16x8*)(Ks_ + (32 + r32) * KLD + 16 * (sbase + s) + 8 * hi); }        \
    __builtin_amdgcn_sched_barrier(0);                                                         \
    _Pragma("unroll") for (int s = 0; s < NS; ++s) {                                           \
      P0 = __builtin_amdgcn_mfma_f32_32x32x16_bf16(kf0_[s], qf[s], P0, 0, 0, 0);               \
      P1 = __builtin_amdgcn_mfma_f32_32x32x16_bf16(kf1_[s], qf[s], P1, 0, 0, 0); }             \
  }
  f32x16 p0, p1, n0, n1;
#pragma unroll
  for (int r = 0; r < 16; ++r) { p0[r] = 0.f; p1[r] = 0.f; n0[r] = 0.f; n1[r] = 0.f; }
  __syncthreads();
  ST_K(0); ST_V(0);
  if (NT > 1) { LD_K(1); LD_V(1); }
  __syncthreads();
  if (NT > 1) ST_K(1);
  if (NT > 2) LD_K(2);
  QK_TILE(p0, p1, 0);
  __syncthreads();
#pragma unroll 1
  for (int jt = 0; jt < NT; ++jt) {
    const int kv0 = jt * 64;
    if (jt + 2 < NT) ST_K(jt & 1);
    if (jt + 1 < NT) ST_V((jt + 1) & 1);
    if (jt + 3 < NT) LD_K(jt + 3);
    if (jt + 2 < NT) LD_V(jt + 2);
    const bool has_next = jt + 1 <= tmax && jt + 1 < NT;
    if (has_next) QK_TILE(n0, n1, jt + 1);
    if (jt <= tmax) {
      bf16x8 vfr[8];
      {
        const bf16_t* Vs = Vb + (jt & 1) * (64 * KLD);
#pragma unroll
        for (int db = 0; db < 2; ++db)
#pragma unroll
          for (int s = 0; s < 4; ++s) vfr[db * 4 + s] = *(const bf16x8*)(Vs + (32 * db + r32) * KLD + 16 * s + 8 * hi);
        __builtin_amdgcn_sched_barrier(0);
      }
      if (kv0 + 63 > qw0) {
        asm volatile("" ::: "memory");
#pragma unroll
        for (int r = 0; r < 16; ++r) { if (kv0 + crow(r, hi) > q) p0[r] = -INFINITY; if (kv0 + 32 + crow(r, hi) > q) p1[r] = -INFINITY; }
      }
      float mx = fmaxf(p0[0], p1[0]);
#pragma unroll
      for (int r = 1; r < 16; ++r) mx = fmaxf(mx, fmaxf(p0[r], p1[r]));
      { auto rr = __builtin_amdgcn_permlane32_swap(__float_as_uint(mx), __float_as_uint(mx), false, false); mx = fmaxf(__uint_as_float(rr[0]), __uint_as_float(rr[1])); }
      if (__any(mx > ATHR)) {
        const float dl = fmaxf(mx, 0.f);
        mref += dl;
        const float f = __builtin_amdgcn_exp2f(-dl);
        l *= f;
#pragma unroll
        for (int r = 0; r < 16; ++r) { p0[r] -= dl; p1[r] -= dl; n0[r] -= dl; n1[r] -= dl; o[0][r] *= f; o[1][r] *= f; }
      }
      float rs = 0.f;
#pragma unroll
      for (int r = 0; r < 16; ++r) { p0[r] = __builtin_amdgcn_exp2f(p0[r]); p1[r] = __builtin_amdgcn_exp2f(p1[r]); rs += p0[r] + p1[r]; }
      l += rs;
      bf16x8 pf[4];
      pf[0] = packf8(p0[0], p0[1], p0[2], p0[3], p0[4], p0[5], p0[6], p0[7]);
      pf[1] = packf8(p0[8], p0[9], p0[10], p0[11], p0[12], p0[13], p0[14], p0[15]);
      pf[2] = packf8(p1[0], p1[1], p1[2], p1[3], p1[4], p1[5], p1[6], p1[7]);
      pf[3] = packf8(p1[8], p1[9], p1[10], p1[11], p1[12], p1[13], p1[14], p1[15]);
#pragma unroll
      for (int db = 0; db < 2; ++db)
#pragma unroll
        for (int s = 0; s < 4; ++s) o[db] = __builtin_amdgcn_mfma_f32_32x32x16_bf16(vfr[db * 4 + s], pf[s], o[db], 0, 0, 0);
    }
    p0 = n0; p1 = n1;
    __syncthreads();
  }
#undef ST_K
#undef ST_V
#undef LD_K
#undef LD_V
#undef QK_TILE
  bf16_t* y = (bf16_t*)(R + R_Y);
  const int tid_e = otid(), lane_e = tid_e & 63, wid_e = tid_e >> 6, hi_e = lane_e >> 5;
  const int wq_e = TYPE == 0 ? (wid_e & 3) : wid_e, q_e = q0 + wq_e * 32 + (lane_e & 31);
  const size_t orow = ((size_t)(TYPE == 0 ? 1 : 2) * NTOK + (size_t)b * SEQ + q_e) * 256 + h * 64;
  const float lt = xsum32(l);
  const float li = 1.0f / lt;
  if (TYPE == 1) {
#pragma unroll
    for (int db = 0; db < 2; ++db)
#pragma unroll
      for (int g = 0; g < 4; ++g) {
        u32x2 w; w[0] = pk2(o[db][4 * g] * li, o[db][4 * g + 1] * li); w[1] = pk2(o[db][4 * g + 2] * li, o[db][4 * g + 3] * li);
        *(u32x2*)(y + orow + 32 * db + 8 * g + 4 * hi_e) = w;
      }
  } else {
    float* xb = (float*)(lds + ATT_XB_OFF);
    if (map == 1) {
#pragma unroll
      for (int db = 0; db < 2; ++db)
#pragma unroll
        for (int r = 0; r < 16; ++r) xb[(wq_e * 32 + db * 16 + r) * 64 + lane_e] = o[db][r] * li;
    }
    __syncthreads();
    if (map == 0) {
      const float* lp = p.in[19] + L * 128;
      float s01 = 0.f, s23 = 0.f;
      for (int i = 0; i < 32; ++i) { s01 += lp[i] * lp[32 + i]; s23 += lp[64 + i] * lp[96 + i]; }
      const float lam_init = L == 0 ? 0.2f : 0.35550906759096934f;
      const float lam = __expf(s01) - __expf(s23) + lam_init;
      const float* sub = p.in[20] + L * 64;
      float ss = 0.f;
#pragma unroll
      for (int db = 0; db < 2; ++db)
#pragma unroll
        for (int r = 0; r < 16; ++r) { const float vv = o[db][r] * li - lam * xb[(wq_e * 32 + db * 16 + r) * 64 + lane_e]; o[db][r] = vv; ss += vv * vv; }
      ss = xsum32(ss);
      const float sc = rsqrtf(ss * (1.0f / 64.0f) + 1e-5f) * (1.0f - lam_init);
#pragma unroll
      for (int db = 0; db < 2; ++db)
#pragma unroll
        for (int g = 0; g < 4; ++g) {
          const int d = 32 * db + 8 * g + 4 * hi_e;
          const f32x4 sw = *(const f32x4*)(sub + d);
          u32x2 w; w[0] = pk2(o[db][4 * g] * sc * sw[0], o[db][4 * g + 1] * sc * sw[1]); w[1] = pk2(o[db][4 * g + 2] * sc * sw[2], o[db][4 * g + 3] * sc * sw[3]);
          *(u32x2*)(y + orow + d) = w;
        }
    }
  }
}

template <class BarF>
DI void phase_mix(const Params& p, int L, char* lds, int qslot, BarF gbar) {
  int* ctr = (int*)(p.ws + O_CTL) + CW_QCTR + qslot * 64;
  int* s_unit = (int*)(lds + 2 * 64 * KLD * 2 + 8192 * 4 + 64);
#pragma unroll 1
  for (int item = obid(); item < 2 * NBH * NCHK; item += gridDim.x) {
    const int bh = (item >> 7) & 7, c = item & 127;
    if (item < NBH * NCHK) chunk_pre<0>(p, bh, c, lds); else chunk_pre<1>(p, bh, c, lds);
  }
  gbar();
  {
    const int bid = obid();
    if (bid < 16) { if (bid < 8) chunk_seq<0>(p, bid & 7, lds); else chunk_seq<1>(p, bid & 7, lds); }
  }
#pragma unroll 1
  for (;;) {
    __syncthreads();
    if (otid() == 0) *s_unit = atomicAdd(ctr, 1);
    __syncthreads();
    const int u = *s_unit;
    if (u >= 768) break;
    const int level = 31 - u / 24, w = u % 24;
    if (w < 8) attn_unit<1>(p, L, w, level, lds);
    else if (w < 16) attn_unit<0>(p, L, w - 8, 2 * level + 1, lds);
    else attn_unit<0>(p, L, w - 16, 2 * level, lds);
  }
  if (L == 0 && qslot == 0) {
    int* cctr = (int*)(p.ws + O_CTL) + CW_QCTR + 8 * 64;
    float* tl = (float*)lds; const int tid = otid();
#pragma unroll 1
    for (;;) {
      __syncthreads();
      if (tid == 0) *s_unit = atomicAdd(cctr, 8);
      __syncthreads();
      const int g0 = *s_unit;
      if (g0 >= MOE_CONV_TILES) break;
#pragma unroll 1
      for (int g = g0; g < g0 + 8; ++g) moe_convert_tile(p, g, tl, tid);
    }
  }
}
DI void phase_mix_attn_only(const Params& p, int L, char* lds, int qslot) {
  int* ctr = (int*)(p.ws + O_CTL) + CW_QCTR + qslot * 64;
  int* s_unit = (int*)(lds + 2 * 64 * KLD * 2 + 8192 * 4 + 64);
#pragma unroll 1
  for (;;) {
    __syncthreads();
    if (otid() == 0) *s_unit = atomicAdd(ctr, 1);
    __syncthreads();
    const int u = *s_unit;
    if (u >= 768) break;
    const int level = 31 - u / 24, w = u % 24;
    if (w < 8) attn_unit<1>(p, L, w, level, lds);
    else if (w < 16) attn_unit<0>(p, L, w - 8, 2 * level + 1, lds);
    else attn_unit<0>(p, L, w - 16, 2 * level, lds);
  }
}


template <class F>
DI void run_gemm(PG8_LAS unsigned char* lds, const bf16_t* A, const bf16_t* Bt, int M, int N, int K, const int* texp, size_t bstride, F f) {
  pg8::Gemm g{A, Bt, M, N, K, texp, bstride};
  pg8::StaticOrder S; S.init(M, N, (int)gridDim.x, obid());
  pg8::EpiFn<F> E{f};
  pg8::gemm_phase<pg8::EpiFn<F>, pg8::StaticOrder, true, true>(lds, g, S, E);
}
DI void st_bf16x4(bf16_t* dst, const f32x4& v) { u32x2 w; w[0] = pk2(v[0], v[1]); w[1] = pk2(v[2], v[3]); *(u32x2*)dst = w; }
DI f32x4 ld_bf16x4(const bf16_t* src) { const u32x2 w = *(const u32x2*)src; return (f32x4){__uint_as_float(w[0] << 16), __uint_as_float(w[0] & 0xffff0000u), __uint_as_float(w[1] << 16), __uint_as_float(w[1] & 0xffff0000u)}; }

DI void phase_u(const Params& p, int L, PG8_LAS unsigned char* lds) {
  bf16_t* u = (bf16_t*)(p.ws + O_R + R_U);
  run_gemm(lds, (const bf16_t*)(p.ws + O_HB), (const bf16_t*)(p.ws + O_WIN + L * SZ_WIN), NTOK, UN, DM, nullptr, 0,
           [=](int row, int col, const f32x4& v) { if (col < UC) st_bf16x4(u + (size_t)row * UC + col, v); });
}
DI void phase_proj(const Params& p, int L, PG8_LAS unsigned char* lds) {
  bf16_t* PJ = (bf16_t*)(p.ws + O_R + R_PJ);
  run_gemm(lds, (const bf16_t*)(p.ws + O_R + R_Y), (const bf16_t*)(p.ws + O_WBO) + (size_t)L * 4 * 1024 * 256, 4 * NTOK, 1024, 256,
           (const int*)(p.ws + O_SMALL + SM_TEXP4), (size_t)1024 * 256 * 2,
           [=](int row, int col, const f32x4& v) { st_bf16x4(PJ + (size_t)(row & (NTOK - 1)) * 4096 + (row >> 14) * 1024 + col, v); });
}
DI void phase_gate(const Params& p, int L, PG8_LAS unsigned char* lds) {
  bf16_t* PJ = (bf16_t*)(p.ws + O_R + R_PJ);
  run_gemm(lds, (const bf16_t*)(p.ws + O_HB), (const bf16_t*)(p.ws + O_WIN + L * SZ_WIN) + (size_t)OFF_G * DM, NTOK, 4096, DM, nullptr, 0,
           [=](int row, int col, const f32x4& v) {
             bf16_t* q = PJ + (size_t)row * 4096 + col;
             const f32x4 pj = ld_bf16x4(q);
             f32x4 o; o[0] = sigmoidf_(v[0]) * pj[0]; o[1] = sigmoidf_(v[1]) * pj[1]; o[2] = sigmoidf_(v[2]) * pj[2]; o[3] = sigmoidf_(v[3]) * pj[3];
             st_bf16x4(q, o);
           });
}
DI void phase_bsum(const Params& p) {
  const u32x4* GP = (const u32x4*)(p.ws + O_R + R_PJ); u32x4* M = (u32x4*)(p.ws + O_R + R_M);
  const int gtid = obid() * NTHR + otid(), gsz = gridDim.x * NTHR;
  for (int i = gtid; i < NTOK * 128; i += gsz) {
    const int tok = i >> 7, c8 = i & 127;
    float a[8];
#pragma unroll
    for (int k = 0; k < 8; ++k) a[k] = 0.f;
#pragma unroll
    for (int b = 0; b < 4; ++b) {
      const u32x4 w = GP[(size_t)tok * 512 + b * 128 + c8];
#pragma unroll
      for (int k = 0; k < 4; ++k) { a[2 * k] += __uint_as_float(w[k] << 16); a[2 * k + 1] += __uint_as_float(w[k] & 0xffff0000u); }
    }
    u32x4 o; o[0] = pk2(a[0], a[1]); o[1] = pk2(a[2], a[3]); o[2] = pk2(a[4], a[5]); o[3] = pk2(a[6], a[7]);
    M[i] = o;
  }
}
DI void phase_xadd(const Params& p, const bf16_t* A, const bf16_t* Bt, int K, PG8_LAS unsigned char* lds) {
  float* x = p.x;
  run_gemm(lds, A, Bt, NTOK, DM, K, nullptr, 0, [=](int row, int col, const f32x4& v) { float* xp = x + (size_t)row * DM + col; f32x4 xv = *(f32x4*)xp; xv += v; *(f32x4*)xp = xv; });
}
DI void phase_ffn_up(const Params& p, PG8_LAS unsigned char* lds) {
  bf16_t* T = (bf16_t*)(p.ws + O_R + R_T);
  run_gemm(lds, (const bf16_t*)(p.ws + O_HB), (const bf16_t*)(p.ws + O_FGU), NTOK, 2 * FFD, DM, nullptr, 0,
           [=](int row, int col, const f32x4& v) {
             const float t0 = v[0] * sigmoidf_(v[0]) * v[1], t1 = v[2] * sigmoidf_(v[2]) * v[3];
             *(unsigned*)(T + (size_t)row * FFD + (col >> 1)) = pk2(t0, t1);
           });
}
DI void phase_moe_gather(const Params& p) {
  const int* cnt = (const int*)(p.ws + O_CTL) + CW_MOECNT;
  const int* list = (const int*)(p.ws + O_SMALL + SM_LIST);
  const float* gw = (const float*)(p.ws + O_SMALL + SM_GW);
  int* texp = (int*)(p.ws + O_SMALL + SM_TEXP);
  int* rowtok = (int*)(p.ws + O_SMALL + SM_ROWTOK);
  float* rowgw = (float*)(p.ws + O_SMALL + SM_ROWGW);
  int* slotrow = (int*)(p.ws + O_SMALL + SM_SLOTROW);
  const bf16_t* hb = (const bf16_t*)(p.ws + O_HB);
  bf16_t* xbuf = (bf16_t*)(p.ws + O_XBUF);
  const int lane = otid() & 63, wid = otid() >> 6;
  int c[8];
#pragma unroll
  for (int e = 0; e < 8; ++e) c[e] = cnt[e];
  int total = 0;
#pragma unroll
  for (int e = 0; e < 8; ++e) total += (c[e] + 255) & ~255;
  for (int row = obid() * 8 + wid; row < total; row += gridDim.x * 8) {
    int e = 0, s = 0, o = 0;
#pragma unroll
    for (int i = 0; i < 8; ++i) { const int pc = (c[i] + 255) & ~255; if (row >= o && row < o + pc) { e = i; s = row - o; } o += pc; }
    int ce = 0;
#pragma unroll
    for (int i = 0; i < 8; ++i) if (i == e) ce = c[i];
    const bool valid = s < ce;
    const int tok = valid ? list[(size_t)e * NTOK + s] : -1;
    u32x4 v0 = {0u, 0u, 0u, 0u}, v1 = {0u, 0u, 0u, 0u};
    if (valid) { const u32x4* src = (const u32x4*)(hb + (size_t)tok * DM); v0 = src[lane]; v1 = src[64 + lane]; }
    u32x4* dst = (u32x4*)(xbuf + (size_t)row * DM); dst[lane] = v0; dst[64 + lane] = v1;
    if (lane == 0) { rowtok[row] = tok; rowgw[row] = valid ? gw[(size_t)e * NTOK + s] : 0.f; if ((row & 255) == 0) texp[row >> 8] = e; if (valid) slotrow[(size_t)e * NTOK + s] = row; }
  }
}
DI int moe_rows(const Params& p) {
  const int* cnt = (const int*)(p.ws + O_CTL) + CW_MOECNT;
  int total = 0;
#pragma unroll
  for (int e = 0; e < 8; ++e) total += (cnt[e] + 255) & ~255;
  return total;
}
DI void phase_moe_up(const Params& p, PG8_LAS unsigned char* lds) {
  const int Mp = moe_rows(p);
  bf16_t* T = (bf16_t*)(p.ws + O_T2);
  run_gemm(lds, (const bf16_t*)(p.ws + O_XBUF), (const bf16_t*)(p.ws + O_MGU), Mp, 2 * FFE, DM, (const int*)(p.ws + O_SMALL + SM_TEXP), (size_t)2 * FFE * DM * 2,
           [=](int row, int col, const f32x4& v) {
             const float t0 = v[0] * sigmoidf_(v[0]) * v[1], t1 = v[2] * sigmoidf_(v[2]) * v[3];
             *(unsigned*)(T + (size_t)row * FFE + (col >> 1)) = pk2(t0, t1);
           });
}
DI void phase_moe_down(const Params& p, PG8_LAS unsigned char* lds) {
  const int Mp = moe_rows(p);
  const float* rowgw = (const float*)(p.ws + O_SMALL + SM_ROWGW);
  bf16_t* Y2 = (bf16_t*)(p.ws + O_XBUF);
  run_gemm(lds, (const bf16_t*)(p.ws + O_T2), (const bf16_t*)(p.ws + O_MD), Mp, DM, FFE, (const int*)(p.ws + O_SMALL + SM_TEXP), (size_t)DM * FFE * 2,
           [=](int row, int col, const f32x4& v) { const float w = rowgw[row]; st_bf16x4(Y2 + (size_t)row * DM + col, v * w); });
}
DI void phase_ple_proj(const Params& p, int L, PG8_LAS unsigned char* lds) {
  bf16_t* PJ2 = (bf16_t*)(p.ws + O_R + R_PJ2);
  run_gemm(lds, (const bf16_t*)(p.ws + O_PB), (const bf16_t*)(p.ws + O_PP) + (size_t)L * 1024 * 256, NTOK, DM, 256, nullptr, 0,
           [=](int row, int col, const f32x4& v) { st_bf16x4(PJ2 + (size_t)row * DM + col, v); });
}
DI void phase_ple_gate(const Params& p, int L, PG8_LAS unsigned char* lds) {
  const bf16_t* PJ2 = (const bf16_t*)(p.ws + O_R + R_PJ2);
  float* x = p.x;
  run_gemm(lds, (const bf16_t*)(p.ws + O_HB), (const bf16_t*)(p.ws + O_PG) + (size_t)L * 1024 * 1024, NTOK, DM, DM, nullptr, 0,
           [=](int row, int col, const f32x4& v) {
             const f32x4 pj = ld_bf16x4(PJ2 + (size_t)row * DM + col);
             float* xp = x + (size_t)row * DM + col; f32x4 xv = *(f32x4*)xp;
             xv[0] += sigmoidf_(v[0]) * pj[0]; xv[1] += sigmoidf_(v[1]) * pj[1]; xv[2] += sigmoidf_(v[2]) * pj[2]; xv[3] += sigmoidf_(v[3]) * pj[3];
             *(f32x4*)xp = xv;
           });
}
DI void phase_final(const Params& p) {
  const int lane = otid() & 63, wid = otid() >> 6;
  const float* g = p.in[35];
  for (int row = obid() * 8 + wid; row < NTOK; row += gridDim.x * 8) {
    float* xr = p.x + (size_t)row * DM;
    f32x4 v[4]; float ss = 0.f;
#pragma unroll
    for (int j = 0; j < 4; ++j) { v[j] = *(const f32x4*)(xr + j * 256 + lane * 4); ss += v[j][0] * v[j][0] + v[j][1] * v[j][1] + v[j][2] * v[j][2] + v[j][3] * v[j][3]; }
    ss = wave_sum(ss);
    const float rstd = rsqrtf(ss * (1.0f / 1024.0f) + 1e-6f);
#pragma unroll
    for (int j = 0; j < 4; ++j) { const f32x4 gg = *(const f32x4*)(g + j * 256 + lane * 4); *(f32x4*)(xr + j * 256 + lane * 4) = v[j] * rstd * gg; }
  }
}


constexpr int RING_BYTES = 131072, LDSCTL_OFF = RING_BYTES, MISC_OFF = LDSCTL_OFF + 320, LDS_BYTES = 147456;
static_assert(2 * SCH * RS * 4 + 2 * SCH * 512 * 4 <= RING_BYTES, "scan LDS");

__global__ void __launch_bounds__(NTHR) __attribute__((target("no-packed-fp32-ops"))) fwd_megakernel(Params p) {
  extern __shared__ __attribute__((aligned(16))) unsigned char lds_raw[];
  LAS unsigned char* ldsp = (LAS unsigned char*)lds_raw;
  char* lds = (char*)lds_raw;
  for (int u = threadIdx.x; u < (LDS_BYTES - LDSCTL_OFF) / 4; u += NTHR) ((LAS unsigned*)(ldsp + LDSCTL_OFF))[u] = 0u;
  __syncthreads();
  XcdBarrier bar = xcd_barrier_post((unsigned*)(p.ws + O_CTL) + CW_BAR, (volatile LAS unsigned*)(ldsp + MISC_OFF) + 8);
#define GBAR() xcd_barrier(bar)
  phase0(olaunder(p), lds);
#if PROBE == 3
  GBAR(); phase0(olaunder(p), lds);
#endif
  cg::this_grid().sync();
  GBAR();
  {
    constexpr int L = 0;
    norm_phase<false>(olaunder(p), p.in[2] + L * DM, nullptr);
    GBAR();
#if PROBE == 36
    if (L == 0) {
#pragma unroll 1
      for (int rep = 0; rep < 4; ++rep) { norm_phase<false>(olaunder(p), p.in[2] + L * DM, nullptr); GBAR(); }
    }
#endif
#if PROBE == 40
    if (L == 0) { for (int rep = 0; rep < 20; ++rep) GBAR(); }
#endif
    phase_u(olaunder(p), L, ldsp);
    GBAR();
#if PROBE == 31
    if (L == 0) { phase_u(olaunder(p), L, ldsp); GBAR(); }
#endif
    phase_prep2(olaunder(p), L, lds);
    GBAR();
#if PROBE == 2
    if (L == 0) { phase_prep2(olaunder(p), L, lds); GBAR(); }
#endif
#if PROBE == 21
    if (L == 0) { phase_prep<1>(olaunder(p), L, lds); GBAR(); }
#endif
#if PROBE == 22
    if (L == 0) { phase_prep<2>(olaunder(p), L, lds); GBAR(); }
#endif
#if PROBE == 23
    if (L == 0) { phase_prep<4>(olaunder(p), L, lds); GBAR(); }
#endif
    phase_mix(olaunder(p), L, lds, L, [&]() { xcd_barrier(bar); });
    GBAR();
#if PROBE == 1
    if (L == 0) { phase_mix(olaunder(p), L, lds, 2, [&]() { xcd_barrier(bar); }); GBAR(); }
#endif
#if PROBE == 5
    if (L == 0) { phase_mix_attn_only(olaunder(p), L, lds, 2); GBAR(); }
#endif
    phase_scanpost(olaunder(p), L);
    GBAR();
#if PROBE == 38
    if (L == 0) { phase_scanpost(olaunder(p), L); GBAR(); phase_scanpost(olaunder(p), L); GBAR(); }
#endif
    phase_proj(olaunder(p), L, ldsp);
    GBAR();
#if PROBE == 35
    if (L == 0) { phase_proj(olaunder(p), L, ldsp); GBAR(); }
#endif
    phase_gate(olaunder(p), L, ldsp);
    GBAR();
    phase_bsum(olaunder(p));
    GBAR();
#if PROBE == 37
    if (L == 0) {
#pragma unroll 1
      for (int rep = 0; rep < 4; ++rep) { phase_bsum(olaunder(p)); GBAR(); }
    }
#endif
    phase_xadd(olaunder(p), (const bf16_t*)(p.ws + O_R + R_M), (const bf16_t*)(p.ws + O_WOUT) + (size_t)L * 1024 * 1024, DM, ldsp);
    GBAR();
    if (L == 0) {
      norm_phase<false>(olaunder(p), p.in[3] + L * DM, nullptr);
      GBAR();
      phase_ffn_up(olaunder(p), ldsp);
      GBAR();
#if PROBE == 32
      phase_ffn_up(olaunder(p), ldsp); GBAR();
#endif
      phase_xadd(olaunder(p), (const bf16_t*)(p.ws + O_R + R_T), (const bf16_t*)(p.ws + O_FD), FFD, ldsp);
      GBAR();
    } else {
      norm_phase<true>(olaunder(p), p.in[3] + L * DM, p.in[29]);
      GBAR();
      phase_moe_gather(olaunder(p));
      GBAR();
      phase_moe_up(olaunder(p), ldsp);
      GBAR();
#if PROBE == 33
      phase_moe_up(olaunder(p), ldsp); GBAR();
#endif
#if PROBE == 34
      phase_moe_down(olaunder(p), ldsp); GBAR();
#endif
      phase_moe_down(olaunder(p), ldsp);
      GBAR();
    }
    if (L == 0) norm_phase<false>(olaunder(p), p.in[4] + L * DM, nullptr);
    else norm_phase<false, true>(olaunder(p), p.in[4] + L * DM, nullptr);
    convert_p(olaunder(p), L);
    GBAR();
    phase_ple_proj(olaunder(p), L, ldsp);
    GBAR();
    phase_ple_gate(olaunder(p), L, ldsp);
    GBAR();
    }
  {
    constexpr int L = 1;
    norm_phase<false>(olaunder(p), p.in[2] + L * DM, nullptr);
    GBAR();
#if PROBE == 36
    if (L == 0) {
#pragma unroll 1
      for (int rep = 0; rep < 4; ++rep) { norm_phase<false>(olaunder(p), p.in[2] + L * DM, nullptr); GBAR(); }
    }
#endif
#if PROBE == 40
    if (L == 0) { for (int rep = 0; rep < 20; ++rep) GBAR(); }
#endif
    phase_u(olaunder(p), L, ldsp);
    GBAR();
#if PROBE == 31
    if (L == 0) { phase_u(olaunder(p), L, ldsp); GBAR(); }
#endif
    phase_prep2(olaunder(p), L, lds);
    GBAR();
#if PROBE == 2
    if (L == 0) { phase_prep2(olaunder(p), L, lds); GBAR(); }
#endif
#if PROBE == 21
    if (L == 0) { phase_prep<1>(olaunder(p), L, lds); GBAR(); }
#endif
#if PROBE == 22
    if (L == 0) { phase_prep<2>(olaunder(p), L, lds); GBAR(); }
#endif
#if PROBE == 23
    if (L == 0) { phase_prep<4>(olaunder(p), L, lds); GBAR(); }
#endif
    phase_mix(olaunder(p), L, lds, L, [&]() { xcd_barrier(bar); });
    GBAR();
#if PROBE == 1
    if (L == 0) { phase_mix(olaunder(p), L, lds, 2, [&]() { xcd_barrier(bar); }); GBAR(); }
#endif
#if PROBE == 5
    if (L == 0) { phase_mix_attn_only(olaunder(p), L, lds, 2); GBAR(); }
#endif
    phase_scanpost(olaunder(p), L);
    GBAR();
#if PROBE == 38
    if (L == 0) { phase_scanpost(olaunder(p), L); GBAR(); phase_scanpost(olaunder(p), L); GBAR(); }
#endif
    phase_proj(olaunder(p), L, ldsp);
    GBAR();
#if PROBE == 35
    if (L == 0) { phase_proj(olaunder(p), L, ldsp); GBAR(); }
#endif
    phase_gate(olaunder(p), L, ldsp);
    GBAR();
    phase_bsum(olaunder(p));
    GBAR();
#if PROBE == 37
    if (L == 0) {
#pragma unroll 1
      for (int rep = 0; rep < 4; ++rep) { phase_bsum(olaunder(p)); GBAR(); }
    }
#endif
    phase_xadd(olaunder(p), (const bf16_t*)(p.ws + O_R + R_M), (const bf16_t*)(p.ws + O_WOUT) + (size_t)L * 1024 * 1024, DM, ldsp);
    GBAR();
    if (L == 0) {
      norm_phase<false>(olaunder(p), p.in[3] + L * DM, nullptr);
      GBAR();
      phase_ffn_up(olaunder(p), ldsp);
      GBAR();
#if PROBE == 32
      phase_ffn_up(olaunder(p), ldsp); GBAR();
#endif
      phase_xadd(olaunder(p), (const bf16_t*)(p.ws + O_R + R_T), (const bf16_t*)(p.ws + O_FD), FFD, ldsp);
      GBAR();
    } else {
      norm_phase<true>(olaunder(p), p.in[3] + L * DM, p.in[29]);
      GBAR();
      phase_moe_gather(olaunder(p));
      GBAR();
      phase_moe_up(olaunder(p), ldsp);
      GBAR();
#if PROBE == 33
      phase_moe_up(olaunder(p), ldsp); GBAR();
#endif
#if PROBE == 34
      phase_moe_down(olaunder(p), ldsp); GBAR();
#endif
      phase_moe_down(olaunder(p), ldsp);
      GBAR();
    }
    if (L == 0) norm_phase<false>(olaunder(p), p.in[4] + L * DM, nullptr);
    else norm_phase<false, true>(olaunder(p), p.in[4] + L * DM, nullptr);
    convert_p(olaunder(p), L);
    GBAR();
    phase_ple_proj(olaunder(p), L, ldsp);
    GBAR();
    phase_ple_gate(olaunder(p), L, ldsp);
    GBAR();
    }
  phase_final(olaunder(p));
}

extern "C" void kernel_launch(void* const* d_in, const int* in_sizes, int n_in, void* d_out, int out_size,
                              void* d_ws, size_t ws_size, hipStream_t stream) {
  static int grid_blocks = 0;
  if (grid_blocks == 0) {
    int dev = 0, cus = 0, per_cu = 0;
    (void)hipGetDevice(&dev);
    (void)hipDeviceGetAttribute(&cus, hipDeviceAttributeMultiprocessorCount, dev);
    if (hipFuncSetAttribute((const void*)fwd_megakernel, hipFuncAttributeMaxDynamicSharedMemorySize, LDS_BYTES) != hipSuccess) { fprintf(stderr, "hipFuncSetAttribute failed\n"); grid_blocks = -1; return; }
    (void)hipOccupancyMaxActiveBlocksPerMultiprocessor(&per_cu, (const void*)fwd_megakernel, NTHR, LDS_BYTES);
    if (per_cu < 1) { fprintf(stderr, "occupancy query says %d blocks per CU\n", per_cu); grid_blocks = -1; return; }
    grid_blocks = cus;
  }
  if (grid_blocks < 0) return;
  if (ws_size < WS_NEED) { fprintf(stderr, "workspace too small: %zu < %zu\n", ws_size, (size_t)WS_NEED); return; }
  (void)hipMemsetAsync((char*)d_ws + O_CTL, 0, CTL_BYTES, stream);
  Params p{};
  for (int i = 0; i < 36; ++i) p.in[i] = (const float*)d_in[i];
  p.x = (float*)d_out;
  p.ws = (char*)d_ws;
  void* args[] = {&p};
  hipError_t e = hipLaunchCooperativeKernel((void*)fwd_megakernel, dim3(grid_blocks), dim3(NTHR), args, LDS_BYTES, stream);
  if (e != hipSuccess) fprintf(stderr, "cooperative launch failed: %s (grid %d)\n", hipGetErrorString(e), grid_blocks);
}
```

```cpp
#include <hip/hip_runtime.h>
#include <hip/hip_cooperative_groups.h>
#include <cstdio>
#include <cstdint>
namespace cg = cooperative_groups;

typedef unsigned short bf16_t;
typedef short bf16x8 __attribute__((ext_vector_type(8)));
typedef short s16x4 __attribute__((ext_vector_type(4)));
typedef float f32x4 __attribute__((ext_vector_type(4)));
typedef float f32x2 __attribute__((ext_vector_type(2)));
typedef float f32x16 __attribute__((ext_vector_type(16)));
typedef unsigned u32x4 __attribute__((ext_vector_type(4)));
typedef unsigned u32x2 __attribute__((ext_vector_type(2)));
typedef __bf16 bf16x2_t __attribute__((ext_vector_type(2)));

#define DI __device__ __forceinline__

#ifndef PROBE
#define PROBE 0
#endif
constexpr int NTOK = 16384, DM = 1024, SEQ = 8192, NBH = 8;
constexpr int INC = 7692, UC = 3600, UN = 3840;
constexpr int OFF_B = 1024, OFF_C = 1792, OFF_D = 2564, OFF_G = 3596;
constexpr int FFD = 2816, FFE = 3584, NEXP = 8;
constexpr int NTHR = 512;
constexpr int MOE_ROWS = 34816;

constexpr size_t al256(size_t x) { return (x + 255) & ~(size_t)255; }
constexpr size_t O_CTL = 0, CTL_BYTES = 1u << 20;
constexpr int CW_BAR = 4096;
constexpr int CW_QCTR = 16384;
constexpr int CW_MOECNT = 16384 + 256;
constexpr size_t O_MGU = CTL_BYTES;
constexpr size_t O_MD = O_MGU + (size_t)NEXP * 2 * FFE * 1024 * 2;
constexpr size_t O_PG = O_MD + (size_t)NEXP * 1024 * FFE * 2;
constexpr size_t O_PP = O_PG + (size_t)2 * 1024 * 1024 * 2;
constexpr size_t O_PB = O_PP + (size_t)2 * 1024 * 256 * 2;
constexpr size_t O_LORA = O_PB + (size_t)NTOK * 256 * 2;
constexpr size_t SZ_LORA = (size_t)256 * 256 * 2;
constexpr size_t O_HB = O_LORA + 2 * SZ_LORA;
constexpr size_t O_SMALL = O_HB + (size_t)NTOK * DM * 2;
constexpr size_t SM_LIST = 0;
constexpr size_t SM_GW = SM_LIST + (size_t)NEXP * NTOK * 4;
constexpr size_t SM_RK = SM_GW + (size_t)NEXP * NTOK * 4;
constexpr size_t SM_LOGF = SM_RK + (size_t)NTOK * 4 * 4;
constexpr size_t SM_GBETA = SM_LOGF + (size_t)NBH * SEQ * 4;
constexpr size_t SM_GA = SM_GBETA + (size_t)NBH * SEQ * 4;
constexpr size_t SM_TEXP = SM_GA + (size_t)NBH * SEQ * 4;
constexpr size_t SM_ROWTOK = SM_TEXP + 1024;
constexpr size_t SM_ROWGW = SM_ROWTOK + (size_t)MOE_ROWS * 4;
constexpr size_t SM_TEXP4 = SM_ROWGW + (size_t)MOE_ROWS * 4;
constexpr size_t SM_TOKSLOT = SM_TEXP4 + 1024;
constexpr size_t SM_SLOTROW = SM_TOKSLOT + (size_t)NTOK * 2 * 4;
constexpr size_t SZ_SMALL = al256(SM_SLOTROW + (size_t)NEXP * NTOK * 4);
constexpr size_t O_ERA = O_SMALL + SZ_SMALL;
constexpr size_t SZ_WIN = al256((size_t)INC * DM * 2);
constexpr size_t O_WIN = O_ERA;
constexpr size_t O_WBO = O_WIN + 2 * SZ_WIN;
constexpr size_t O_WOUT = O_WBO + (size_t)2 * 4 * 1024 * 256 * 2;
constexpr size_t O_FGU = O_WOUT + (size_t)2 * 1024 * 1024 * 2;
constexpr size_t O_FD = O_FGU + (size_t)2 * FFD * 1024 * 2;
constexpr size_t O_R = O_FD + (size_t)1024 * FFD * 2;
constexpr size_t SZ_BH = (size_t)NBH * SEQ * 64 * 2;
constexpr size_t R_U = 0;
constexpr size_t R_Y = 0;
constexpr size_t R_PJ = (size_t)NTOK * DM * 2;
constexpr size_t R_M = R_PJ + (size_t)NTOK * 4096 * 2;
constexpr size_t SZ_U = (size_t)NTOK * UC * 2;
constexpr size_t R_OSCAN = (size_t)NTOK * DM * 2;
constexpr size_t R_CHK = R_OSCAN + (size_t)2 * NBH * SEQ * 64 * 4;
constexpr size_t CHK_SZ = (size_t)2 * NBH * (SEQ / 64) * 4096 * 2;
static_assert(R_CHK + 3 * CHK_SZ <= SZ_U, "chunk operators inside dead u");
constexpr size_t R_RWA = R_U + SZ_U, R_RWB = R_RWA + SZ_BH, R_RWK = R_RWB + SZ_BH, R_RWR = R_RWK + SZ_BH, R_RWV = R_RWR + SZ_BH;
constexpr size_t R_RWW = R_RWV + SZ_BH;
constexpr size_t R_GQ = R_RWW + 2 * SZ_BH, R_GK = R_GQ + SZ_BH, R_GV = R_GK + SZ_BH;
constexpr size_t R_QD = R_GV + SZ_BH, R_KD = R_QD + SZ_BH, R_VD = R_KD + SZ_BH, R_QF = R_VD + SZ_BH, R_KF = R_QF + SZ_BH, R_VF = R_KF + SZ_BH;
constexpr size_t R_AUXG = R_VF + SZ_BH;
constexpr size_t R_AUXGATE = R_AUXG + (size_t)NTOK * 256 * 2;
constexpr size_t R_END_MIX = R_AUXGATE + (size_t)NTOK * 256 * 2;
static_assert(R_M + (size_t)NTOK * DM * 2 <= R_END_MIX, "M inside region R");
constexpr size_t R_T = 0;
constexpr size_t R_PJ2 = 0;
constexpr size_t O_T2 = O_ERA;
constexpr size_t O_XBUF = O_T2 + (size_t)MOE_ROWS * FFE * 2;
constexpr size_t ERA_B_END = O_XBUF + (size_t)MOE_ROWS * DM * 2;
constexpr size_t ERA_A_END = O_R + R_END_MIX;
constexpr size_t WS_NEED = ERA_A_END > ERA_B_END ? ERA_A_END : ERA_B_END;

struct Params {
  const float* in[36];
  float* x;
  char* ws;
};

DI float bf2f(bf16_t b) { return __uint_as_float(((unsigned)b) << 16); }
DI bf16_t f2bf(float x) { unsigned u = __float_as_uint(x); u += 0x7fffu + ((u >> 16) & 1u); return (bf16_t)(u >> 16); }
DI unsigned pk2(float lo, float hi) { f32x2 v = {lo, hi}; bf16x2_t b = __builtin_convertvector(v, bf16x2_t); return __builtin_bit_cast(unsigned, b); }
DI float sigmoidf_(float x) { return 1.0f / (1.0f + __expf(-x)); }
DI float wave_sum(float x) {
  x += __int_as_float(__builtin_amdgcn_update_dpp(0, __float_as_int(x), 0xB1, 0xF, 0xF, true));
  x += __int_as_float(__builtin_amdgcn_update_dpp(0, __float_as_int(x), 0x4E, 0xF, 0xF, true));
  x += __int_as_float(__builtin_amdgcn_update_dpp(0, __float_as_int(x), 0x141, 0xF, 0xF, true));
  x += __int_as_float(__builtin_amdgcn_update_dpp(0, __float_as_int(x), 0x140, 0xF, 0xF, true));
  { auto rr = __builtin_amdgcn_permlane16_swap(__float_as_uint(x), __float_as_uint(x), false, false); x = __uint_as_float(rr[0]) + __uint_as_float(rr[1]); }
  { auto rr = __builtin_amdgcn_permlane32_swap(__float_as_uint(x), __float_as_uint(x), false, false); x = __uint_as_float(rr[0]) + __uint_as_float(rr[1]); }
  return x;
}
DI float shfl_up_l(float x, int o, int lane) { return __int_as_float(__builtin_amdgcn_ds_bpermute(((lane - o) & 63) << 2, __float_as_int(x))); }
DI float xsum32(float x) { auto rr = __builtin_amdgcn_permlane32_swap(__float_as_uint(x), __float_as_uint(x), false, false); return __uint_as_float(rr[0]) + __uint_as_float(rr[1]); }
DI int crow(int r, int hi) { return (r & 3) + 8 * (r >> 2) + 4 * hi; }
DI int otid() { int t = threadIdx.x; asm volatile("" : "+v"(t)); return t; }
DI int obid() { int t = blockIdx.x; asm volatile("" : "+s"(t)); return t; }
DI Params olaunder(const Params& p) { Params q = p; size_t o0 = 0, o1 = 0; asm volatile("" : "+s"(o0), "+s"(o1)); q.ws = p.ws + o0; q.x = p.x + o1; return q; }


#define GAS __attribute__((address_space(1)))
#define LAS __attribute__((address_space(3)))
typedef GAS unsigned gu32;
#define RLX_AGENT __ATOMIC_RELAXED, __HIP_MEMORY_SCOPE_AGENT
namespace pg8 {
#define PG8_LAS __attribute__((address_space(3)))
typedef unsigned short bf16_t;
typedef short bf16x8 __attribute__((ext_vector_type(8)));
typedef float f32x4 __attribute__((ext_vector_type(4)));
typedef unsigned u32x4 __attribute__((ext_vector_type(4)));
constexpr int BM = 256, BK = 64, HALF = 128, HTB = HALF * BK * 2  , STAGE_BYTES = 8 * HTB, NXCD = 8, WGM = 8;

__host__ __device__ __forceinline__ int lds_byte(int r, int c) { const int st = (r >> 4) * 2 + (c >> 5), rr = r & 15, cc = c & 31, ob = rr * 64 + cc * 2; return st * 1024 + (ob ^ (((ob >> 9) & 1) << 5)); }
__host__ __device__ __forceinline__ void stage_rc(int b, int& R, int& C) { const int st = b / 1024, sb = b % 1024, swz = sb ^ (((sb >> 9) & 1) << 5); R = (st >> 1) * 16 + swz / 64; C = (st & 1) * 32 + (swz % 64) / 2; }
__host__ __device__ __forceinline__ int perm32(int rho) { const int n = rho >> 4, i = rho & 15; return 8 * (i >> 2) + 4 * n + (i & 3); }

struct Unit { int pm, pn; };
struct Gemm { const bf16_t* A; const bf16_t* Bt; int M, N, K; const int* texp; size_t bstride;
  __device__ __forceinline__ size_t boff(int pm) const { return texp ? (size_t)texp[pm] * bstride : (size_t)0; } };

struct StaticOrder {
    int nM, nN, nwg, G, c;
    __host__ __device__ void init(int M, int N, int G_, int c_) { nM = M / BM; nN = N / BM; nwg = nM * nN; G = G_; c = c_; }
    __host__ __device__ bool next(int i, Unit& u) const {
        const long L = (long)i * G + c; if (L >= nwg) return false;
        int wgid = (int)L; { const int q = nwg / NXCD, r = nwg % NXCD, xcd = wgid % NXCD, off = wgid / NXCD; wgid = (xcd < r ? xcd * (q + 1) : r * (q + 1) + (xcd - r) * q) + off; }
        const int nig = WGM * nN, gid = wgid / nig, fm = gid * WGM, gsz = (nM - fm) < WGM ? (nM - fm) : WGM;
        u.pm = fm + ((wgid % nig) % gsz); u.pn = (wgid % nig) / gsz; return true;
    }
    __device__ __forceinline__ void a_ready(const Unit&) const {}
    __device__ __forceinline__ void done(const Unit&) const {}
};

template <class F> struct EpiFn {
    static constexpr bool PERM = false, AFTER_DRAIN = false;
    F f;
    __device__ __forceinline__ void operator()(const f32x4 (&acc)[2][2][4][2], const Unit& u, int wr, int wc, int fr, int fq) const {
#pragma unroll
        for (int ai = 0; ai < 2; ++ai)
#pragma unroll
            for (int m = 0; m < 4; ++m)
#pragma unroll
                for (int bj = 0; bj < 2; ++bj)
#pragma unroll
                    for (int n = 0; n < 2; ++n)
                        f(u.pm * BM + ai * HALF + wr * 64 + m * 16 + fr, u.pn * BM + bj * HALF + wc * 32 + n * 16 + 4 * fq, acc[ai][bj][m][n]);
    }
};
template <class F> struct EpiFn8 {
    static constexpr bool PERM = true, AFTER_DRAIN = false;
    F f;
    __device__ __forceinline__ void operator()(const f32x4 (&acc)[2][2][4][2], const Unit& u, int wr, int wc, int fr, int fq) const {
#pragma unroll
        for (int ai = 0; ai < 2; ++ai)
#pragma unroll
            for (int m = 0; m < 4; ++m)
#pragma unroll
                for (int bj = 0; bj < 2; ++bj)
                    f(u.pm * BM + ai * HALF + wr * 64 + m * 16 + fr, u.pn * BM + bj * HALF + wc * 32 + 8 * fq, acc[ai][bj][m][0], acc[ai][bj][m][1]);
    }
};
template <class Epi, class Sched, bool ALIGN_EPI = false, bool SP2 = false>
__device__ __forceinline__ void gemm_phase(PG8_LAS unsigned char* lds, const Gemm g, const Sched& S, const Epi& E) {
    const int tid = otid(), wid = __builtin_amdgcn_readfirstlane(tid >> 6), lane = tid & 63, wr = wid >> 2, wc = wid & 3, fr = lane & 15, fq = lane >> 4;
    const int K = g.K, nt = K / BK;
    unsigned voffA[2], voffB[2];
#pragma unroll
    for (int i = 0; i < 2; ++i) { int R, C; stage_rc(tid * 16 + i * 8192, R, C); const int Rb = Epi::PERM ? ((R & ~31) + perm32(R & 31)) : R;
        voffA[i] = (unsigned)(R * K + C) * 2u; voffB[i] = (unsigned)(Rb * K + C) * 2u; }
    const size_t kstep = (size_t)(BK * 2);
    const size_t hstep = (size_t)HALF * K * 2;
    const size_t tstep = 2 * hstep;
    const unsigned ldsw = (unsigned)wid * 1024u;
    const int aoff = lds_byte(wr * 64 + fr, fq * 8), boff = lds_byte(wc * 32 + fr, fq * 8);
#define PG8_SA(b, h) (((b) * 2 + (h)) * HTB)
#define PG8_SB(b, h) ((4 + (b) * 2 + (h)) * HTB)
#define PG8_STAGE(bufoff, gbase, voff) do { _Pragma("unroll") for (int _i = 0; _i < 2; ++_i) \
        __builtin_amdgcn_global_load_lds((const unsigned*)((const char*)(gbase) + (voff)[_i]), (PG8_LAS unsigned*)(lds + (bufoff) + ldsw + _i * 8192), 16, 0, 0); } while (0)
#define PG8_LDA(dst, b, h) do { _Pragma("unroll") for (int m = 0; m < 4; ++m) _Pragma("unroll") for (int k = 0; k < 2; ++k) dst[m][k] = *(const PG8_LAS bf16x8*)(lds + PG8_SA(b, h) + aoff + m * 2048 + k * 1024); } while (0)
#define PG8_LDB(dst, b, h) do { _Pragma("unroll") for (int n = 0; n < 2; ++n) _Pragma("unroll") for (int k = 0; k < 2; ++k) dst[n][k] = *(const PG8_LAS bf16x8*)(lds + PG8_SB(b, h) + boff + n * 2048 + k * 1024); } while (0)
#define PG8_MMA(ai, bj, At, Bt) do { __builtin_amdgcn_s_setprio(1); _Pragma("unroll") for (int m = 0; m < 4; ++m) _Pragma("unroll") for (int n = 0; n < 2; ++n) _Pragma("unroll") for (int k = 0; k < 2; ++k) \
        acc[ai][bj][m][n] = __builtin_amdgcn_mfma_f32_16x16x32_bf16(Bt[n][k], At[m][k], acc[ai][bj][m][n], 0, 0, 0); __builtin_amdgcn_s_setprio(0); } while (0)
#define PG8_WAIT_V(n) asm volatile("s_waitcnt vmcnt(" #n ")" ::: "memory")
#define PG8_WAIT_L(n) asm volatile("s_waitcnt lgkmcnt(" #n ")" ::: "memory")
#define PG8_BAR __builtin_amdgcn_s_barrier()
#define PG8_SCHED __builtin_amdgcn_sched_barrier(0)
    Unit cur, nxt; int ui = 0;
    if (!S.next(0, cur)) return;
    f32x4 acc[2][2][4][2];
#pragma unroll
    for (int a = 0; a < 2; ++a)
#pragma unroll
        for (int b = 0; b < 2; ++b)
#pragma unroll
            for (int m = 0; m < 4; ++m)
#pragma unroll
                for (int n = 0; n < 2; ++n) acc[a][b][m][n] = (f32x4){0.f, 0.f, 0.f, 0.f};
    bf16x8 At[4][2], B0[2][2], B1[2][2];
    const char* cA = (const char*)g.A + (size_t)cur.pm * tstep; const char* cB = (const char*)g.Bt + g.boff(cur.pm) + (size_t)cur.pn * tstep;
    S.a_ready(cur);
    if constexpr (SP2) {
        PG8_STAGE(PG8_SB(0, 0), cB, voffB); PG8_STAGE(PG8_SB(0, 1), cB + hstep, voffB); PG8_STAGE(PG8_SA(0, 0), cA, voffA); PG8_STAGE(PG8_SA(0, 1), cA + hstep, voffA);
        if (wr == 1) PG8_BAR;
        PG8_WAIT_V(2); PG8_BAR;
        PG8_STAGE(PG8_SB(1, 0), cB + kstep, voffB); PG8_STAGE(PG8_SA(1, 0), cA + kstep, voffA); PG8_STAGE(PG8_SB(1, 1), cB + hstep + kstep, voffB);
        PG8_WAIT_V(6); PG8_BAR;
    } else {
        PG8_STAGE(PG8_SB(0, 0), cB, voffB); PG8_STAGE(PG8_SA(0, 0), cA, voffA); PG8_STAGE(PG8_SB(0, 1), cB + hstep, voffB); PG8_STAGE(PG8_SA(0, 1), cA + hstep, voffA);
        if (wr == 1) PG8_BAR;
        PG8_WAIT_V(4); PG8_BAR;
        PG8_STAGE(PG8_SB(1, 0), cB + kstep, voffB); PG8_STAGE(PG8_SA(1, 0), cA + kstep, voffA); PG8_STAGE(PG8_SB(1, 1), cB + hstep + kstep, voffB);
        PG8_WAIT_V(6); PG8_BAR;
    }
    for (;;) {
        const bool has_next = S.next(ui + 1, nxt);
        const char* nA = has_next ? (const char*)g.A + (size_t)nxt.pm * tstep : cA; const char* nB = has_next ? (const char*)g.Bt + g.boff(nxt.pm) + (size_t)nxt.pn * tstep : cB;
        for (int t = 0; t < nt; t += 2) {
            const bool last = (t == nt - 2);
            const char* a1 = cA + (size_t)(t + 1) * kstep;
            const char* a2 = last ? nA : cA + (size_t)(t + 2) * kstep; const char* b2 = last ? nB : cB + (size_t)(t + 2) * kstep;
            const char* a3 = a2 + kstep; const char* b3 = b2 + kstep;
            if (last && has_next) S.a_ready(nxt);
            if constexpr (SP2) {
            PG8_LDB(B0, 0, 0); PG8_LDB(B1, 0, 1); PG8_SCHED; PG8_LDA(At, 0, 0); PG8_STAGE(PG8_SA(1, 1), a1 + hstep, voffA);
            PG8_WAIT_V(8); PG8_WAIT_L(0); PG8_BAR; PG8_MMA(0, 0, At, B0); PG8_MMA(0, 1, At, B1); PG8_BAR; PG8_SCHED;
            PG8_LDA(At, 0, 1); PG8_STAGE(PG8_SB(0, 0), b2, voffB); PG8_STAGE(PG8_SB(0, 1), b2 + hstep, voffB); PG8_STAGE(PG8_SA(0, 0), a2, voffA);
            PG8_WAIT_V(8); PG8_WAIT_L(0); PG8_BAR; PG8_MMA(1, 0, At, B0); PG8_MMA(1, 1, At, B1); PG8_BAR; PG8_SCHED;
            PG8_LDB(B0, 1, 0); PG8_LDB(B1, 1, 1); PG8_SCHED; PG8_LDA(At, 1, 0); PG8_STAGE(PG8_SA(0, 1), a2 + hstep, voffA);
            PG8_WAIT_V(8); PG8_WAIT_L(0); PG8_BAR; PG8_MMA(0, 0, At, B0); PG8_MMA(0, 1, At, B1); PG8_BAR; PG8_SCHED;
            PG8_LDA(At, 1, 1); PG8_STAGE(PG8_SB(1, 0), b3, voffB); PG8_STAGE(PG8_SB(1, 1), b3 + hstep, voffB); PG8_STAGE(PG8_SA(1, 0), a3, voffA);
            PG8_WAIT_V(8); PG8_WAIT_L(0); PG8_BAR; PG8_MMA(1, 0, At, B0); PG8_MMA(1, 1, At, B1); PG8_BAR; PG8_SCHED;
            } else {
            PG8_LDB(B0, 0, 0); PG8_SCHED; PG8_LDA(At, 0, 0); PG8_STAGE(PG8_SA(1, 1), a1 + hstep, voffA);
            PG8_WAIT_L(8); PG8_BAR; PG8_WAIT_L(0); PG8_MMA(0, 0, At, B0); PG8_BAR; PG8_SCHED;
            PG8_LDB(B1, 0, 1); PG8_STAGE(PG8_SB(0, 0), b2, voffB);
            PG8_BAR; PG8_WAIT_L(0); PG8_MMA(0, 1, At, B1); PG8_BAR;
            PG8_LDA(At, 0, 1); PG8_STAGE(PG8_SA(0, 0), a2, voffA);
            PG8_BAR; PG8_WAIT_L(0); PG8_MMA(1, 0, At, B0); PG8_BAR; PG8_SCHED;
            PG8_STAGE(PG8_SB(0, 1), b2 + hstep, voffB);
            PG8_WAIT_V(6); PG8_BAR; PG8_MMA(1, 1, At, B1); PG8_BAR;
            PG8_LDB(B0, 1, 0); PG8_SCHED; PG8_LDA(At, 1, 0); PG8_STAGE(PG8_SA(0, 1), a2 + hstep, voffA);
            PG8_WAIT_L(8); PG8_BAR; PG8_WAIT_L(0); PG8_MMA(0, 0, At, B0); PG8_BAR; PG8_SCHED;
            PG8_LDB(B1, 1, 1); PG8_STAGE(PG8_SB(1, 0), b3, voffB);
            PG8_BAR; PG8_WAIT_L(0); PG8_MMA(0, 1, At, B1); PG8_BAR;
            PG8_LDA(At, 1, 1); PG8_STAGE(PG8_SA(1, 0), a3, voffA);
            PG8_BAR; PG8_WAIT_L(0); PG8_MMA(1, 0, At, B0); PG8_BAR; PG8_SCHED;
            PG8_STAGE(PG8_SB(1, 1), b3 + hstep, voffB);
            PG8_WAIT_V(6); PG8_BAR; PG8_MMA(1, 1, At, B1); PG8_BAR;
            }
        }
        if constexpr (ALIGN_EPI) { if (wr == 0) PG8_BAR; }
        if constexpr (!Epi::AFTER_DRAIN) { E(acc, cur, wr, wc, fr, fq); S.done(cur); }
        if (!has_next) break;
#pragma unroll
        for (int a = 0; a < 2; ++a)
#pragma unroll
            for (int b = 0; b < 2; ++b)
#pragma unroll
                for (int m = 0; m < 4; ++m)
#pragma unroll
                    for (int n = 0; n < 2; ++n) acc[a][b][m][n] = (f32x4){0.f, 0.f, 0.f, 0.f};
        cur = nxt; cA = nA; cB = nB; ++ui;
        if constexpr (ALIGN_EPI) { if (wr == 1) PG8_BAR; }
    }
    PG8_WAIT_V(0);
    if constexpr (!ALIGN_EPI) { if (wr == 0) PG8_BAR; }
    PG8_BAR;
    if constexpr (Epi::AFTER_DRAIN) { E.fused(acc, cur, wr, wc, fr, fq, lds, wid, lane); S.done(cur); }
#undef PG8_SA
#undef PG8_SB
#undef PG8_STAGE
#undef PG8_LDA
#undef PG8_LDB
#undef PG8_MMA
#undef PG8_WAIT_V
#undef PG8_WAIT_L
#undef PG8_BAR
#undef PG8_SCHED
}
}

#define XB_TMO      128
#define XB_XCNT(j)  (256  + 64 * (j))
#define XB_XSUB(j)  (1280 + 64 * (j))
#define XB_XGEN(j)  (2304 + 64 * (j))
#define XB_TOP      3328
#define XB_TOPGEN   3392
#define XCD_BAR_WORDS 3456
#define XB_SPIN_CAP (1u << 18)

__device__ __forceinline__ unsigned xb_ld(unsigned* p)              { return __hip_atomic_load(p, __ATOMIC_RELAXED, __HIP_MEMORY_SCOPE_AGENT); }
__device__ __forceinline__ unsigned xb_add(unsigned* p, unsigned v) { return __hip_atomic_fetch_add(p, v, __ATOMIC_RELAXED, __HIP_MEMORY_SCOPE_AGENT); }
__device__ __forceinline__ unsigned xb_xcc_id() { return (unsigned)__builtin_amdgcn_s_getreg((3 << 11) | 20) & 0xFu; }
#define XB_SPIN(cond, bar) do { unsigned _sp = 0; while (cond) { __builtin_amdgcn_s_sleep(1); \
    if ((++_sp & 255u) == 0u) { if (xb_ld(&(bar)[XB_TMO])) break; if (_sp > XB_SPIN_CAP) { atomicAdd(&(bar)[XB_TMO], 1u); break; } } } } while (0)

struct XcdBarrier {
    unsigned* bar; unsigned x;
    volatile LAS unsigned* st;
};

__device__ __forceinline__ XcdBarrier xcd_barrier_post(unsigned* bar, volatile LAS unsigned* st) {
    XcdBarrier b; b.bar = bar; b.x = xb_xcc_id(); b.st = st;
    if (threadIdx.x == 0) (void)xb_add(&bar[XB_XCNT(b.x)], 1u);
    return b;
}
__device__ __forceinline__ void xcd_barrier_complete(unsigned* bar, unsigned x, unsigned& nloc, unsigned& nx) {
    const unsigned G = gridDim.x * gridDim.y * gridDim.z;
    unsigned sum, cnt, mine, sp = 0u;
    for (;;) {
        sum = 0u; cnt = 0u; mine = 0u;
#pragma unroll
        for (unsigned j = 0; j < 16; ++j) { const unsigned c = xb_ld(&bar[XB_XCNT(j)]); sum += c; cnt += (c > 0u) ? 1u : 0u; mine = (j == x) ? c : mine; }
        if (sum == G) break;
        __builtin_amdgcn_s_sleep(1);
        if ((++sp & 255u) == 0u) { if (xb_ld(&bar[XB_TMO])) break; if (sp > XB_SPIN_CAP) { atomicAdd(&bar[XB_TMO], 1u); break; } }
    }
    nloc = mine > 0u ? mine : 1u; nx = cnt > 0u ? cnt : 1u;
}

__device__ __forceinline__ void xcd_barrier(const XcdBarrier& b) {
    asm volatile("s_waitcnt vmcnt(0)" ::: "memory");
    __syncthreads();
    if (threadIdx.x == 0) {
        unsigned* bar = b.bar; unsigned bx_ = b.x;
        asm volatile("" : "+s"(bar), "+s"(bx_));
        __builtin_amdgcn_s_waitcnt(0);
        unsigned nloc = b.st[0], nx = b.st[1];
        if (nloc == 0u) { xcd_barrier_complete(bar, bx_, nloc, nx); b.st[0] = nloc; b.st[1] = nx; }
        const unsigned old = xb_add(&bar[XB_XSUB(bx_)], 1u);
        const unsigned gen = old / nloc;
        if (old + 1u == (gen + 1u) * nloc) {
            __builtin_amdgcn_fence(__ATOMIC_RELEASE, "agent");
            asm volatile("s_waitcnt vmcnt(0)" ::: "memory");
            const unsigned og = xb_add(&bar[XB_TOP], 1u);
            const unsigned tg = og / nx;
            if (og + 1u == (tg + 1u) * nx) xb_add(&bar[XB_TOPGEN], 1u);
            else XB_SPIN(xb_ld(&bar[XB_TOPGEN]) == tg, bar);
            __builtin_amdgcn_fence(__ATOMIC_ACQUIRE, "agent");
            xb_add(&bar[XB_XGEN(bx_)], 1u);
            asm volatile("s_waitcnt vmcnt(0)" ::: "memory");
        } else {
            XB_SPIN(xb_ld(&bar[XB_XGEN(bx_)]) == gen, bar);
            __builtin_amdgcn_fence(__ATOMIC_ACQUIRE, "agent");
            asm volatile("s_waitcnt vmcnt(0)" ::: "memory");
        }
    }
    __syncthreads();
}

DI void transpose_tile(const float* __restrict__ src, int K, int N, bf16_t* __restrict__ dst, int rmul, int radd, int t, float* tl, int tid) {
  const int tn = (N + 255) / 256;
  const int k0 = (t / tn) * 64, n0 = (t % tn) * 256;
  __syncthreads();
  {
    const int kr = tid >> 3, nc = (tid & 7) * 4;
    f32x4 v[8];
#pragma unroll
    for (int i = 0; i < 8; ++i) {
      const int n = n0 + nc + 32 * i;
      v[i] = (f32x4){0.f, 0.f, 0.f, 0.f};
      if (n < N) v[i] = *(const f32x4*)(src + (size_t)(k0 + kr) * N + n);
    }
#pragma unroll
    for (int i = 0; i < 8; ++i) { float* d = tl + kr * 257 + nc + 32 * i; d[0] = v[i][0]; d[1] = v[i][1]; d[2] = v[i][2]; d[3] = v[i][3]; }
  }
  __syncthreads();
  {
    const int nr = tid >> 1, kc = (tid & 1) * 32, n = n0 + nr;
    if (n < N) {
      const size_t drow = rmul == 2 ? ((size_t)(n >> 7) << 8) + radd * 128 + (n & 127) : (size_t)n * rmul + radd;
      bf16_t* dp = dst + drow * K + k0 + kc;
#pragma unroll
      for (int g = 0; g < 4; ++g) {
        u32x4 w;
        w[0] = pk2(tl[(kc + 8 * g + 0) * 257 + nr], tl[(kc + 8 * g + 1) * 257 + nr]);
        w[1] = pk2(tl[(kc + 8 * g + 2) * 257 + nr], tl[(kc + 8 * g + 3) * 257 + nr]);
        w[2] = pk2(tl[(kc + 8 * g + 4) * 257 + nr], tl[(kc + 8 * g + 5) * 257 + nr]);
        w[3] = pk2(tl[(kc + 8 * g + 6) * 257 + nr], tl[(kc + 8 * g + 7) * 257 + nr]);
        *(u32x4*)(dp + 8 * g) = w;
      }
    }
  }
}
DI void transpose_job(const float* __restrict__ src, int K, int N, bf16_t* __restrict__ dst, int rmul, int radd, char* lds) {
  float* tl = (float*)lds;
  const int nt = (K / 64) * ((N + 255) / 256), tid = otid();
  for (int t = obid(); t < nt; t += gridDim.x) transpose_tile(src, K, N, dst, rmul, radd, t, tl, tid);
}
constexpr int MOE_TILES_PER_JOB = 224, MOE_CONV_TILES = 24 * 224;
DI void moe_convert_tile(const Params& p, int g, float* tl, int tid) {
  const int job = g / MOE_TILES_PER_JOB, t = g % MOE_TILES_PER_JOB, e = job / 3, w = job % 3;
  if (w == 0) transpose_tile(p.in[30] + (size_t)e * 1024 * FFE, 1024, FFE, (bf16_t*)(p.ws + O_MGU) + (size_t)e * 2 * FFE * 1024, 2, 0, t, tl, tid);
  else if (w == 1) transpose_tile(p.in[31] + (size_t)e * 1024 * FFE, 1024, FFE, (bf16_t*)(p.ws + O_MGU) + (size_t)e * 2 * FFE * 1024, 2, 1, t, tl, tid);
  else transpose_tile(p.in[32] + (size_t)e * FFE * 1024, FFE, 1024, (bf16_t*)(p.ws + O_MD) + (size_t)e * 1024 * FFE, 1, 0, t, tl, tid);
}
DI void phase0(const Params& p, char* lds) {
  char* ws = p.ws;
  const int gtid = obid() * NTHR + otid(), gsz = gridDim.x * NTHR;
  if (gtid < 256) ((int*)(ws + O_SMALL + SM_TEXP4))[gtid] = gtid >> 6;
  {
    const f32x4* s = (const f32x4*)p.in[0]; f32x4* d = (f32x4*)p.x;
    for (int i = gtid; i < NTOK * DM / 4; i += gsz) d[i] = s[i];
  }
  for (int L = 0; L < 2; ++L) {
    transpose_job(p.in[5] + (size_t)L * DM * INC, 1024, INC, (bf16_t*)(ws + O_WIN + L * SZ_WIN), 1, 0, lds);
    for (int b = 0; b < 4; ++b)
      transpose_job(p.in[6] + (size_t)(L * 4 + b) * 256 * 1024, 256, 1024, (bf16_t*)(ws + O_WBO) + (size_t)(L * 4 + b) * 1024 * 256, 1, 0, lds);
    transpose_job(p.in[7] + (size_t)L * 1024 * 1024, 1024, 1024, (bf16_t*)(ws + O_WOUT) + (size_t)L * 1024 * 1024, 1, 0, lds);
    transpose_job(p.in[34] + (size_t)L * 1024 * 1024, 1024, 1024, (bf16_t*)(ws + O_PG) + (size_t)L * 1024 * 1024, 1, 0, lds);
    transpose_job(p.in[33] + (size_t)L * 256 * 1024, 256, 1024, (bf16_t*)(ws + O_PP) + (size_t)L * 1024 * 256, 1, 0, lds);
    transpose_job(p.in[10] + (size_t)L * 64 * 256, 64, 256, (bf16_t*)(ws + O_LORA + L * SZ_LORA), 1, 0, lds);
    transpose_job(p.in[12] + (size_t)L * 64 * 256, 64, 256, (bf16_t*)(ws + O_LORA + L * SZ_LORA) + 256 * 64, 1, 0, lds);
    transpose_job(p.in[13] + (size_t)L * 128 * 256, 128, 256, (bf16_t*)(ws + O_LORA + L * SZ_LORA) + 2 * 256 * 64, 1, 0, lds);
  }
  transpose_job(p.in[26], 1024, FFD, (bf16_t*)(ws + O_FGU), 2, 0, lds);
  transpose_job(p.in[27], 1024, FFD, (bf16_t*)(ws + O_FGU), 2, 1, lds);
  transpose_job(p.in[28], FFD, 1024, (bf16_t*)(ws + O_FD), 1, 0, lds);
}
DI void convert_p(const Params& p, int L) {
  const int gtid = obid() * NTHR + otid(), gsz = gridDim.x * NTHR;
  const f32x4* s = (const f32x4*)(p.in[1] + (size_t)L * NTOK * 256); u32x2* d = (u32x2*)(p.ws + O_PB);
  for (int i = gtid; i < NTOK * 256 / 4; i += gsz) { f32x4 v = s[i]; u32x2 w; w[0] = pk2(v[0], v[1]); w[1] = pk2(v[2], v[3]); d[i] = w; }
}
template <bool ROUTER, bool ADDMOE = false>
DI void norm_phase(const Params& p, const float* __restrict__ g, const float* __restrict__ router) {
  const int lane = otid() & 63, wid = otid() >> 6;
  bf16_t* hb = (bf16_t*)(p.ws + O_HB);
  int* cnt = (int*)(p.ws + O_CTL) + CW_MOECNT;
  int* list = (int*)(p.ws + O_SMALL + SM_LIST);
  float* gw = (float*)(p.ws + O_SMALL + SM_GW);
  int* tokslot = (int*)(p.ws + O_SMALL + SM_TOKSLOT);
  const int* slotrow = (const int*)(p.ws + O_SMALL + SM_SLOTROW);
  const bf16_t* Y2 = (const bf16_t*)(p.ws + O_XBUF);
  for (int row = obid() * 8 + wid; row < NTOK; row += gridDim.x * 8) {
    float* xr = p.x + (size_t)row * DM;
    f32x4 v[4]; float ss = 0.f;
#pragma unroll
    for (int j = 0; j < 4; ++j) v[j] = *(const f32x4*)(xr + j * 256 + lane * 4);
    if (ADDMOE) {
      const int r1 = slotrow[tokslot[row * 2]], r2 = slotrow[tokslot[row * 2 + 1]];
#pragma unroll
      for (int j = 0; j < 4; ++j) {
        const u32x2 a = *(const u32x2*)(Y2 + (size_t)r1 * DM + j * 256 + lane * 4), b = *(const u32x2*)(Y2 + (size_t)r2 * DM + j * 256 + lane * 4);
        v[j][0] += __uint_as_float(a[0] << 16) + __uint_as_float(b[0] << 16); v[j][1] += __uint_as_float(a[0] & 0xffff0000u) + __uint_as_float(b[0] & 0xffff0000u);
        v[j][2] += __uint_as_float(a[1] << 16) + __uint_as_float(b[1] << 16); v[j][3] += __uint_as_float(a[1] & 0xffff0000u) + __uint_as_float(b[1] & 0xffff0000u);
        *(f32x4*)(xr + j * 256 + lane * 4) = v[j];
      }
    }
#pragma unroll
    for (int j = 0; j < 4; ++j) ss += v[j][0] * v[j][0] + v[j][1] * v[j][1] + v[j][2] * v[j][2] + v[j][3] * v[j][3];
    ss = wave_sum(ss);
    const float rstd = rsqrtf(ss * (1.0f / 1024.0f) + 1e-6f);
    float lg[8];
    if (ROUTER) {
#pragma unroll
      for (int e = 0; e < 8; ++e) lg[e] = 0.f;
    }
#pragma unroll
    for (int j = 0; j < 4; ++j) {
      const f32x4 gg = *(const f32x4*)(g + j * 256 + lane * 4);
      f32x4 h = v[j] * rstd * gg;
      u32x2 w; w[0] = pk2(h[0], h[1]); w[1] = pk2(h[2], h[3]);
      *(u32x2*)(hb + (size_t)row * DM + j * 256 + lane * 4) = w;
      if (ROUTER) {
#pragma unroll
        for (int c = 0; c < 4; ++c) {
          const float* rr = router + (size_t)(j * 256 + lane * 4 + c) * 8;
          const f32x4 r0 = *(const f32x4*)rr, r1 = *(const f32x4*)(rr + 4);
          lg[0] += h[c] * r0[0]; lg[1] += h[c] * r0[1]; lg[2] += h[c] * r0[2]; lg[3] += h[c] * r0[3];
          lg[4] += h[c] * r1[0]; lg[5] += h[c] * r1[1]; lg[6] += h[c] * r1[2]; lg[7] += h[c] * r1[3];
        }
      }
    }
    if (ROUTER) {
#pragma unroll
      for (int e = 0; e < 8; ++e) lg[e] = wave_sum(lg[e]);
      if (lane == 0) {
        int e1 = 0; float l1 = lg[0];
#pragma unroll
        for (int e = 1; e < 8; ++e) if (lg[e] > l1) { l1 = lg[e]; e1 = e; }
        int e2 = -1; float l2 = -INFINITY;
#pragma unroll
        for (int e = 0; e < 8; ++e) if (e != e1 && lg[e] > l2) { l2 = lg[e]; e2 = e; }
        const float w1 = 1.0f / (1.0f + __expf(l2 - l1)), w2 = 1.0f - w1;
        int s1 = atomicAdd(cnt + e1, 1); list[e1 * NTOK + s1] = row; gw[e1 * NTOK + s1] = w1;
        int s2 = atomicAdd(cnt + e2, 1); list[e2 * NTOK + s2] = row; gw[e2 * NTOK + s2] = w2;
        tokslot[row * 2] = e1 * NTOK + s1; tokslot[row * 2 + 1] = e2 * NTOK + s2;
      }
    }
  }
}

DI float softplusf_(float z) { return z > 20.f ? z : __logf(1.0f + __expf(z)); }
DI float logsigmoidf_(float z) { return z >= 0.f ? -__logf(1.0f + __expf(-z)) : z - __logf(1.0f + __expf(z)); }

template <int PARTS = 7>
DI void phase_prep(const Params& p, int L, char* lds) {
  float* xw_s = (float*)lds; float* xa_s = xw_s + 8 * 64; float* xg_s = xa_s + 8 * 64;
  char* R = p.ws + O_R;
  const bf16_t* u = (const bf16_t*)(R + R_U);
  bf16_t* rwA = (bf16_t*)(R + R_RWA); bf16_t* rwB = (bf16_t*)(R + R_RWB); bf16_t* rwK = (bf16_t*)(R + R_RWK);
  bf16_t* rwR = (bf16_t*)(R + R_RWR); bf16_t* rwV = (bf16_t*)(R + R_RWV); float* rwW = (float*)(R + R_RWW);
  bf16_t* gq = (bf16_t*)(R + R_GQ); bf16_t* gk = (bf16_t*)(R + R_GK); bf16_t* gv = (bf16_t*)(R + R_GV);
  bf16_t* Qd = (bf16_t*)(R + R_QD); bf16_t* Kd = (bf16_t*)(R + R_KD); bf16_t* Vd = (bf16_t*)(R + R_VD);
  bf16_t* Qf = (bf16_t*)(R + R_QF); bf16_t* Kf = (bf16_t*)(R + R_KF); bf16_t* Vf = (bf16_t*)(R + R_VF);
  bf16_t* auxg = (bf16_t*)(R + R_AUXG); bf16_t* auxgate = (bf16_t*)(R + R_AUXGATE);
  float* rk = (float*)(p.ws + O_SMALL + SM_RK); float* logf_ = (float*)(p.ws + O_SMALL + SM_LOGF);
  float* gbeta = (float*)(p.ws + O_SMALL + SM_GBETA); float* ga = (float*)(p.ws + O_SMALL + SM_GA);
  const float* mu = p.in[8] + L * 1024; const float* w0 = p.in[9] + L * 256; const float* w2 = p.in[10] + L * 64 * 256;
  const float* a0 = p.in[11] + L * 256; const float* a2 = p.in[12] + L * 64 * 256; const float* g2 = p.in[13] + L * 128 * 256;
  const float* kkp = p.in[14] + L * 256; const float* kap = p.in[15] + L * 256; const float* rkp = p.in[16] + L * 256;
  const float* fbias = p.in[21] + L * 4; const float* cw = p.in[22] + L * 768 * 4;
  const float* alog = p.in[23] + L * 4; const float* dtb = p.in[24] + L * 4;
  const int tid = otid(), j = tid & 255, half = tid >> 8, lane = tid & 63, h = j >> 6, dh = j & 63;
  const float QS_D = 0.25503486164919736f, QS_F = 0.18033688011112042f;
  for (int tile = obid(); tile < NTOK / 8; tile += gridDim.x) {
    const int T0 = tile * 8, b = T0 / SEQ, t0 = T0 % SEQ, bh = b * 4 + h;
    if (PARTS & 1) {
    float r[4], k[4], v[4];
    __syncthreads();
#pragma unroll
    for (int i = 0; i < 4; ++i) {
      const int tl = half * 4 + i, tok = T0 + tl, t = t0 + tl;
      const bf16_t* ur = u + (size_t)tok * UC;
#pragma unroll
      for (int seg = 0; seg < 4; ++seg) {
        const int c = seg * 256 + j;
        const float ua = bf2f(ur[c]);
        const float up = t > 0 ? bf2f(ur[c - UC]) : 0.f;
        const float xm = ua + (up - ua) * mu[c];
        if (seg == 0) r[i] = xm; else if (seg == 1) k[i] = xm; else if (seg == 2) v[i] = xm;
        else {
          if (j < 64) xw_s[tl * 64 + j] = 1.0f - 2.0f / (1.0f + __expf(2.0f * xm));
          else if (j < 128) xa_s[tl * 64 + (j - 64)] = xm;
          else xg_s[tl * 128 + (j - 128)] = sigmoidf_(xm);
        }
      }
    }
    __syncthreads();
    float lw[4], alr[4], gg[4];
#pragma unroll
    for (int i = 0; i < 4; ++i) { lw[i] = w0[j]; alr[i] = a0[j]; gg[i] = 0.f; }
    for (int q = 0; q < 64; ++q) {
      const float wv = w2[q * 256 + j], av = a2[q * 256 + j];
#pragma unroll
      for (int i = 0; i < 4; ++i) { lw[i] += xw_s[(half * 4 + i) * 64 + q] * wv; alr[i] += xa_s[(half * 4 + i) * 64 + q] * av; }
    }
    for (int q = 0; q < 128; ++q) {
      const float gvv = g2[q * 256 + j];
#pragma unroll
      for (int i = 0; i < 4; ++i) gg[i] += xg_s[(half * 4 + i) * 128 + q] * gvv;
    }
#pragma unroll
    for (int i = 0; i < 4; ++i) {
      const int tl = half * 4 + i, tok = T0 + tl, t = t0 + tl;
      const float dec = __expf(-0.6065306597126334f * sigmoidf_(lw[i]));
      const float a = sigmoidf_(alr[i]);
      const float kkr = k[i] * kkp[j];
      const float ss = wave_sum(kkr * kkr);
      const float kk = kkr * rsqrtf(ss + 1e-6f);
      const float kp = k[i] * (1.0f + (a - 1.0f) * kap[j]);
      const float rks = wave_sum(r[i] * kp * rkp[j]);
      const size_t idx = ((size_t)bh * SEQ + t) * 64 + dh;
      rwA[idx] = f2bf(-kk); rwW[idx] = dec; rwB[idx] = f2bf(kk * a); rwK[idx] = f2bf(kp); rwR[idx] = f2bf(r[i]); rwV[idx] = f2bf(v[i]);
      auxg[(size_t)tok * 256 + j] = f2bf(gg[i]);
      if (lane == 0) rk[tok * 4 + h] = rks;
    }
    }
    if (PARTS & 2)
    {
      float vd[4], vf[4];
#pragma unroll
      for (int i = 0; i < 4; ++i) {
        const int tl = half * 4 + i, tok = T0 + tl, t = t0 + tl;
        const bf16_t* ur = u + (size_t)tok * UC;
        float q = bf2f(ur[OFF_B + j]), kx = bf2f(ur[OFF_B + 256 + j]);
        vd[i] = bf2f(ur[OFF_B + 512 + j]);
        const int d = dh & 31;
        if (d < 8) {
          const int ii = d & 3;
          const float invrev = ii == 0 ? 0.15915494309189535f : ii == 1 ? 0.005985185712713705f : ii == 2 ? 0.00022507907903927653f : 8.464330808241401e-06f;
          const float rvf = (float)t * invrev;
          const float fr = rvf - floorf(rvf);
          const float sn = __builtin_amdgcn_sinf(fr), cs = __builtin_amdgcn_cosf(fr);
          const int pj = d < 4 ? j + 4 : j - 4;
          const float qp = bf2f(ur[OFF_B + pj]), kpn = bf2f(ur[OFF_B + 256 + pj]);
          if (d < 4) { q = q * cs - qp * sn; kx = kx * cs - kpn * sn; }
          else { q = q * cs + qp * sn; kx = kx * cs + kpn * sn; }
        }
        const size_t idx = ((size_t)bh * SEQ + t) * 64 + dh;
        Qd[idx] = f2bf(q * QS_D); Kd[idx] = f2bf(kx);
        Qf[idx] = f2bf(bf2f(ur[OFF_C + j]) * QS_F); Kf[idx] = ur[OFF_C + 256 + j];
        vf[i] = bf2f(ur[OFF_C + 512 + j]);
        if (j < 4) logf_[(size_t)(b * 4 + j) * SEQ + t] = logsigmoidf_(bf2f(ur[OFF_C + 768 + j]) + fbias[j]);
      }
      const size_t vidx = ((size_t)bh * 64 + dh) * SEQ + t0 + half * 4;
      u32x2 w; w[0] = pk2(vd[0], vd[1]); w[1] = pk2(vd[2], vd[3]); *(u32x2*)(Vd + vidx) = w;
      w[0] = pk2(vf[0], vf[1]); w[1] = pk2(vf[2], vf[3]); *(u32x2*)(Vf + vidx) = w;
    }
    if (PARTS & 4) {
#pragma unroll
    for (int i = 0; i < 4; ++i) {
      const int tl = half * 4 + i, tok = T0 + tl, t = t0 + tl;
      const bf16_t* ur = u + (size_t)tok * UC + OFF_D;
      float y[3];
#pragma unroll
      for (int seg = 0; seg < 3; ++seg) {
        const int c = seg * 256 + j;
        const f32x4 wv = *(const f32x4*)(cw + c * 4);
        float acc = wv[3] * bf2f(ur[c]);
        if (t >= 1) acc += wv[2] * bf2f(ur[c - UC]);
        if (t >= 2) acc += wv[1] * bf2f(ur[c - 2 * UC]);
        if (t >= 3) acc += wv[0] * bf2f(ur[c - 3 * UC]);
        y[seg] = acc * sigmoidf_(acc);
      }
      const float sq = wave_sum(y[0] * y[0]), sk = wave_sum(y[1] * y[1]);
      const float qn = y[0] * rsqrtf(sq + 1e-6f) * 0.125f, kn = y[1] * rsqrtf(sk + 1e-6f);
      const size_t idx = ((size_t)bh * SEQ + t) * 64 + dh;
      gq[idx] = f2bf(qn); gk[idx] = f2bf(kn); gv[idx] = f2bf(y[2]);
      const float gate = bf2f(ur[776 + j]);
      auxgate[(size_t)tok * 256 + j] = f2bf(gate * sigmoidf_(gate));
      if (lane == 0) {
        const float beta = sigmoidf_(bf2f(ur[768 + h]));
        const float gl = -__expf(alog[h]) * softplusf_(bf2f(ur[772 + h]) + dtb[h]);
        gbeta[(size_t)bh * SEQ + t] = beta; ga[(size_t)bh * SEQ + t] = __expf(gl);
      }
    }
    }
  }
}


DI float sum8(float x) {
  x += __int_as_float(__builtin_amdgcn_update_dpp(0, __float_as_int(x), 0xB1, 0xF, 0xF, true));
  x += __int_as_float(__builtin_amdgcn_update_dpp(0, __float_as_int(x), 0x4E, 0xF, 0xF, true));
  x += __int_as_float(__builtin_amdgcn_update_dpp(0, __float_as_int(x), 0x141, 0xF, 0xF, true));
  return x;
}
DI void unpk8(float (&f)[8], const u32x4& w) {
#pragma unroll
  for (int i = 0; i < 4; ++i) { f[2 * i] = __uint_as_float(w[i] << 16); f[2 * i + 1] = __uint_as_float(w[i] & 0xffff0000u); }
}
DI u32x4 pk8(const float (&f)[8]) { u32x4 w; w[0] = pk2(f[0], f[1]); w[1] = pk2(f[2], f[3]); w[2] = pk2(f[4], f[5]); w[3] = pk2(f[6], f[7]); return w; }
DI void ld8f(float (&f)[8], const float* p) { const f32x4 a = *(const f32x4*)p, b = *(const f32x4*)(p + 4); f[0] = a[0]; f[1] = a[1]; f[2] = a[2]; f[3] = a[3]; f[4] = b[0]; f[5] = b[1]; f[6] = b[2]; f[7] = b[3]; }
DI void phase_prep2(const Params& p, int L, char* lds) {
  constexpr int XLD = 264;
  bf16_t* XS = (bf16_t*)lds;
  float* LR = (float*)(lds + 16 * XLD * 2);
  bf16_t* VT = (bf16_t*)(lds + 16 * XLD * 2 + 3 * 16 * 256 * 4);
  char* R = p.ws + O_R;
  const bf16_t* u = (const bf16_t*)(R + R_U);
  bf16_t* rwA = (bf16_t*)(R + R_RWA); bf16_t* rwB = (bf16_t*)(R + R_RWB); bf16_t* rwK = (bf16_t*)(R + R_RWK);
  bf16_t* rwR = (bf16_t*)(R + R_RWR); bf16_t* rwV = (bf16_t*)(R + R_RWV); float* rwW = (float*)(R + R_RWW);
  bf16_t* gq = (bf16_t*)(R + R_GQ); bf16_t* gk = (bf16_t*)(R + R_GK); bf16_t* gv = (bf16_t*)(R + R_GV);
  bf16_t* Qd = (bf16_t*)(R + R_QD); bf16_t* Kd = (bf16_t*)(R + R_KD); bf16_t* Vd = (bf16_t*)(R + R_VD);
  bf16_t* Qf = (bf16_t*)(R + R_QF); bf16_t* Kf = (bf16_t*)(R + R_KF); bf16_t* Vf = (bf16_t*)(R + R_VF);
  bf16_t* auxg = (bf16_t*)(R + R_AUXG); bf16_t* auxgate = (bf16_t*)(R + R_AUXGATE);
  float* rk = (float*)(p.ws + O_SMALL + SM_RK); float* logf_ = (float*)(p.ws + O_SMALL + SM_LOGF);
  float* gbeta = (float*)(p.ws + O_SMALL + SM_GBETA); float* ga = (float*)(p.ws + O_SMALL + SM_GA);
  const float* mu = p.in[8] + L * 1024; const float* w0 = p.in[9] + L * 256; const float* a0 = p.in[11] + L * 256;
  const float* kkp = p.in[14] + L * 256; const float* kap = p.in[15] + L * 256; const float* rkp = p.in[16] + L * 256;
  const float* fbias = p.in[21] + L * 4; const float* cw = p.in[22] + L * 768 * 4;
  const float* alog = p.in[23] + L * 4; const float* dtb = p.in[24] + L * 4;
  const bf16_t* WL = (const bf16_t*)(p.ws + O_LORA + L * SZ_LORA);
  const float QS_D = 0.25503486164919736f, QS_F = 0.18033688011112042f;
#pragma unroll 1
  for (int tile = obid(); tile < NTOK / 16; tile += gridDim.x) {
    const int tid = otid(), tk = tid >> 5, cg = tid & 31, c0 = cg * 8, h = cg >> 3, d0 = (cg & 7) * 8, lane = tid & 63, wid = tid >> 6;
    const int fr = lane & 15, fq = lane >> 4;
    const int T0 = tile * 16, b = T0 / SEQ, t0 = T0 % SEQ, tok = T0 + tk, t = t0 + tk, bh = b * 4 + h;
    const bf16_t* ur = u + (size_t)tok * UC;
    const size_t idx = ((size_t)bh * SEQ + t) * 64 + d0;
    float r[8], k[8], v[8];
    __syncthreads();
    {
#pragma unroll
      for (int seg = 0; seg < 4; ++seg) {
        asm volatile("" ::: "memory");
        float ua[8], up[8], mm[8], xm[8];
        unpk8(ua, *(const u32x4*)(ur + seg * 256 + c0));
        if (t > 0) unpk8(up, *(const u32x4*)(ur - UC + seg * 256 + c0));
        else {
#pragma unroll
          for (int i = 0; i < 8; ++i) up[i] = 0.f;
        }
        ld8f(mm, mu + seg * 256 + c0);
#pragma unroll
        for (int i = 0; i < 8; ++i) xm[i] = ua[i] + (up[i] - ua[i]) * mm[i];
        if (seg == 0) {
#pragma unroll
          for (int i = 0; i < 8; ++i) r[i] = xm[i];
        } else if (seg == 1) {
#pragma unroll
          for (int i = 0; i < 8; ++i) k[i] = xm[i];
        } else if (seg == 2) {
#pragma unroll
          for (int i = 0; i < 8; ++i) v[i] = xm[i];
        } else {
          if (cg < 8) {
#pragma unroll
            for (int i = 0; i < 8; ++i) xm[i] = 1.0f - 2.0f / (1.0f + __expf(2.0f * xm[i]));
          } else if (cg >= 16) {
#pragma unroll
            for (int i = 0; i < 8; ++i) xm[i] = sigmoidf_(xm[i]);
          }
          *(u32x4*)(XS + tk * XLD + c0) = pk8(xm);
        }
      }
    }
    __syncthreads();
    {
#pragma unroll
      for (int nt2 = 0; nt2 < 2; ++nt2) {
        const int nt = wid * 2 + nt2;
        f32x4 aw = {0.f, 0.f, 0.f, 0.f}, aa = aw, ag = aw;
#pragma unroll
        for (int ks = 0; ks < 2; ++ks) {
          const bf16x8 xw = *(const bf16x8*)(XS + fr * XLD + 32 * ks + 8 * fq);
          const bf16x8 xa = *(const bf16x8*)(XS + fr * XLD + 64 + 32 * ks + 8 * fq);
          const bf16x8 ww = *(const bf16x8*)(WL + (size_t)(16 * nt + fr) * 64 + 32 * ks + 8 * fq);
          const bf16x8 wa = *(const bf16x8*)(WL + 256 * 64 + (size_t)(16 * nt + fr) * 64 + 32 * ks + 8 * fq);
          aw = __builtin_amdgcn_mfma_f32_16x16x32_bf16(ww, xw, aw, 0, 0, 0);
          aa = __builtin_amdgcn_mfma_f32_16x16x32_bf16(wa, xa, aa, 0, 0, 0);
        }
#pragma unroll
        for (int ks = 0; ks < 4; ++ks) {
          const bf16x8 xg = *(const bf16x8*)(XS + fr * XLD + 128 + 32 * ks + 8 * fq);
          const bf16x8 wg = *(const bf16x8*)(WL + 2 * 256 * 64 + (size_t)(16 * nt + fr) * 128 + 32 * ks + 8 * fq);
          ag = __builtin_amdgcn_mfma_f32_16x16x32_bf16(wg, xg, ag, 0, 0, 0);
        }
        *(f32x4*)(LR + (0 * 16 + fr) * 256 + 16 * nt + 4 * fq) = aw;
        *(f32x4*)(LR + (1 * 16 + fr) * 256 + 16 * nt + 4 * fq) = aa;
        *(f32x4*)(LR + (2 * 16 + fr) * 256 + 16 * nt + 4 * fq) = ag;
      }
    }
    __syncthreads();
    {
      float lw[8], al[8], gg[8], t8[8], kkv[8], kpv[8], o8[8];
      ld8f(lw, LR + (0 * 16 + tk) * 256 + c0); ld8f(al, LR + (1 * 16 + tk) * 256 + c0); ld8f(gg, LR + (2 * 16 + tk) * 256 + c0);
      ld8f(t8, w0 + c0);
#pragma unroll
      for (int i = 0; i < 8; ++i) lw[i] = __expf(-0.6065306597126334f * sigmoidf_(lw[i] + t8[i]));
      ld8f(t8, a0 + c0);
#pragma unroll
      for (int i = 0; i < 8; ++i) al[i] = sigmoidf_(al[i] + t8[i]);
      ld8f(t8, kkp + c0);
      float ss = 0.f;
#pragma unroll
      for (int i = 0; i < 8; ++i) { kkv[i] = k[i] * t8[i]; ss += kkv[i] * kkv[i]; }
      ss = sum8(ss);
      const float rn = rsqrtf(ss + 1e-6f);
      ld8f(t8, kap + c0);
#pragma unroll
      for (int i = 0; i < 8; ++i) { kkv[i] *= rn; kpv[i] = k[i] * (1.0f + (al[i] - 1.0f) * t8[i]); }
      ld8f(t8, rkp + c0);
      float rks = 0.f;
#pragma unroll
      for (int i = 0; i < 8; ++i) rks += r[i] * kpv[i] * t8[i];
      rks = sum8(rks);
#pragma unroll
      for (int i = 0; i < 8; ++i) o8[i] = -kkv[i];
      *(u32x4*)(rwA + idx) = pk8(o8);
      *(f32x4*)(rwW + idx) = (f32x4){lw[0], lw[1], lw[2], lw[3]}; *(f32x4*)(rwW + idx + 4) = (f32x4){lw[4], lw[5], lw[6], lw[7]};
#pragma unroll
      for (int i = 0; i < 8; ++i) o8[i] = kkv[i] * al[i];
      *(u32x4*)(rwB + idx) = pk8(o8);
      *(u32x4*)(rwK + idx) = pk8(kpv);
      *(u32x4*)(rwR + idx) = pk8(r);
      *(u32x4*)(rwV + idx) = pk8(v);
      *(u32x4*)(auxg + (size_t)tok * 256 + c0) = pk8(gg);
      if ((cg & 7) == 0) rk[tok * 4 + h] = rks;
    }
    asm volatile("" ::: "memory");
    {
      float q[8], kx[8];
      unpk8(q, *(const u32x4*)(ur + OFF_B + c0)); unpk8(kx, *(const u32x4*)(ur + OFF_B + 256 + c0));
      const u32x4 vdw = *(const u32x4*)(ur + OFF_B + 512 + c0);
      if ((cg & 3) == 0) {
#pragma unroll
        for (int i = 0; i < 4; ++i) {
          const float invrev = i == 0 ? 0.15915494309189535f : i == 1 ? 0.005985185712713705f : i == 2 ? 0.00022507907903927653f : 8.464330808241401e-06f;
          const float rvf = (float)t * invrev, fr_ = rvf - floorf(rvf);
          const float sn = __builtin_amdgcn_sinf(fr_), cs = __builtin_amdgcn_cosf(fr_);
          const float q1 = q[i], q2 = q[i + 4], k1 = kx[i], k2 = kx[i + 4];
          q[i] = q1 * cs - q2 * sn; q[i + 4] = q2 * cs + q1 * sn;
          kx[i] = k1 * cs - k2 * sn; kx[i + 4] = k2 * cs + k1 * sn;
        }
      }
#pragma unroll
      for (int i = 0; i < 8; ++i) q[i] *= QS_D;
      *(u32x4*)(Qd + idx) = pk8(q); *(u32x4*)(Kd + idx) = pk8(kx);
      asm volatile("" ::: "memory");
      float fqv[8];
      unpk8(fqv, *(const u32x4*)(ur + OFF_C + c0));
#pragma unroll
      for (int i = 0; i < 8; ++i) fqv[i] *= QS_F;
      *(u32x4*)(Qf + idx) = pk8(fqv);
      *(u32x4*)(Kf + idx) = *(const u32x4*)(ur + OFF_C + 256 + c0);
      const u32x4 vfw = *(const u32x4*)(ur + OFF_C + 512 + c0);
      *(u32x4*)(VT + (0 * 16 + tk) * 256 + c0) = vdw;
      *(u32x4*)(VT + (1 * 16 + tk) * 256 + c0) = vfw;
      if (cg == 0) {
        const u32x2 fl = *(const u32x2*)(ur + OFF_C + 768);
        const float f0 = __uint_as_float(fl[0] << 16), f1 = __uint_as_float(fl[0] & 0xffff0000u), f2 = __uint_as_float(fl[1] << 16), f3 = __uint_as_float(fl[1] & 0xffff0000u);
        logf_[(size_t)(b * 4 + 0) * SEQ + t] = logsigmoidf_(f0 + fbias[0]); logf_[(size_t)(b * 4 + 1) * SEQ + t] = logsigmoidf_(f1 + fbias[1]);
        logf_[(size_t)(b * 4 + 2) * SEQ + t] = logsigmoidf_(f2 + fbias[2]); logf_[(size_t)(b * 4 + 3) * SEQ + t] = logsigmoidf_(f3 + fbias[3]);
      }
    }
    asm volatile("" ::: "memory");
    {
      float y[3][8];
#pragma unroll
      for (int seg = 0; seg < 3; ++seg) {
        asm volatile("" ::: "memory");
#pragma unroll
        for (int i = 0; i < 8; ++i) y[seg][i] = 0.f;
#pragma unroll
        for (int jj = 0; jj < 4; ++jj) {
          if (t - 3 + jj >= 0) {
            const bf16_t* up_ = ur + (jj - 3) * UC + OFF_D + seg * 256 + c0;
            const u32x2 lo = *(const u32x2*)up_, hi = *(const u32x2*)(up_ + 4);
            const u32x4 w4 = {lo[0], lo[1], hi[0], hi[1]};
            float uu[8]; unpk8(uu, w4);
#pragma unroll
            for (int i = 0; i < 8; ++i) y[seg][i] += cw[(seg * 256 + c0 + i) * 4 + jj] * uu[i];
          }
        }
#pragma unroll
        for (int i = 0; i < 8; ++i) y[seg][i] = y[seg][i] * sigmoidf_(y[seg][i]);
      }
      float sq = 0.f, sk = 0.f;
#pragma unroll
      for (int i = 0; i < 8; ++i) { sq += y[0][i] * y[0][i]; sk += y[1][i] * y[1][i]; }
      sq = sum8(sq); sk = sum8(sk);
      const float rq = rsqrtf(sq + 1e-6f) * 0.125f, rkn = rsqrtf(sk + 1e-6f);
#pragma unroll
      for (int i = 0; i < 8; ++i) { y[0][i] *= rq; y[1][i] *= rkn; }
      *(u32x4*)(gq + idx) = pk8(y[0]); *(u32x4*)(gk + idx) = pk8(y[1]); *(u32x4*)(gv + idx) = pk8(y[2]);
      asm volatile("" ::: "memory");
      {
        const bf16_t* gp = ur + OFF_D + 776 + c0;
        const u32x2 lo = *(const u32x2*)gp, hi = *(const u32x2*)(gp + 4);
        const u32x4 w4 = {lo[0], lo[1], hi[0], hi[1]};
        float g8[8]; unpk8(g8, w4);
#pragma unroll
        for (int i = 0; i < 8; ++i) g8[i] = g8[i] * sigmoidf_(g8[i]);
        *(u32x4*)(auxgate + (size_t)tok * 256 + c0) = pk8(g8);
      }
      if ((cg & 7) == 0) {
        const float beta = sigmoidf_(bf2f(ur[OFF_D + 768 + h]));
        const float gl = -__expf(alog[h]) * softplusf_(bf2f(ur[OFF_D + 772 + h]) + dtb[h]);
        gbeta[(size_t)bh * SEQ + t] = beta; ga[(size_t)bh * SEQ + t] = __expf(gl);
      }
    }
    __syncthreads();
    {
      const int ch = tid & 255, hf = tid >> 8;
#pragma unroll
      for (int m = 0; m < 2; ++m) {
        const bf16_t* vs = VT + (m * 16 + hf * 8) * 256 + ch;
        u32x4 w;
        w[0] = (unsigned)vs[0] | ((unsigned)vs[256] << 16); w[1] = (unsigned)vs[512] | ((unsigned)vs[768] << 16);
        w[2] = (unsigned)vs[1024] | ((unsigned)vs[1280] << 16); w[3] = (unsigned)vs[1536] | ((unsigned)vs[1792] << 16);
        bf16_t* dst = (m == 0 ? Vd : Vf) + ((size_t)(b * 4 + (ch >> 6)) * 64 + (ch & 63)) * SEQ + t0 + hf * 8;
        *(u32x4*)dst = w;
      }
    }
  }
}

DI float dpp_sum16(float x) {
  x += __int_as_float(__builtin_amdgcn_update_dpp(0, __float_as_int(x), 0xB1, 0xF, 0xF, true));
  x += __int_as_float(__builtin_amdgcn_update_dpp(0, __float_as_int(x), 0x4E, 0xF, 0xF, true));
  x += __int_as_float(__builtin_amdgcn_update_dpp(0, __float_as_int(x), 0x141, 0xF, 0xF, true));
  x += __int_as_float(__builtin_amdgcn_update_dpp(0, __float_as_int(x), 0x140, 0xF, 0xF, true));
  return x;
}
constexpr int SCH = 16;
constexpr int RS = 448;
DI float sum32(float x) {
  x = dpp_sum16(x);
  auto rr = __builtin_amdgcn_permlane16_swap(__float_as_uint(x), __float_as_uint(x), false, false);
  return __uint_as_float(rr[0]) + __uint_as_float(rr[1]);
}
struct StepIn { f32x4 q0, q1, q2; float V; };
DI void ld_step(StepIn& s, const float* sp, const float* vp) {
  s.q0 = *(const f32x4*)(sp); s.q1 = *(const f32x4*)(sp + 4); s.q2 = *(const f32x4*)(sp + 8); s.V = *vp;
}
template <int WHICH>
DI void scan_block(const Params& p, int L, int bh, int quarter, char* lds) {
  float* buf = (float*)lds;
  float* pbuf = buf + 2 * SCH * RS;
  char* R = p.ws + O_R;
  const int tid = otid();
  const size_t base = (size_t)bh * SEQ * 64;
  float* oout = (float*)(R + R_OSCAN) + (size_t)WHICH * NBH * SEQ * 64 + base;
  constexpr int NCH = SEQ / SCH;
  const int r = tid >> 5, sub = tid & 31, v = quarter * 16 + r;
  const int sst = (tid >> 4) & (SCH - 1), sk = (tid & 15) * 4;
  const bool stager = tid < SCH * 16;
  const u32x2* pA = (const u32x2*)((const bf16_t*)(R + (WHICH == 0 ? R_RWA : R_GK)) + base);
  const u32x2* pB = (const u32x2*)((const bf16_t*)(R + R_RWB) + base);
  const u32x2* pK = (const u32x2*)((const bf16_t*)(R + R_RWK) + base);
  const u32x2* pR = (const u32x2*)((const bf16_t*)(R + (WHICH == 0 ? R_RWR : R_GQ)) + base);
  const u32x2* pV = (const u32x2*)((const bf16_t*)(R + (WHICH == 0 ? R_RWV : R_GV)) + base);
  const f32x4* pW = (const f32x4*)((const float*)(R + R_RWW) + base);
  const float* gbeta = (const float*)(p.ws + O_SMALL + SM_GBETA) + (size_t)bh * SEQ;
  const float* ga = (const float*)(p.ws + O_SMALL + SM_GA) + (size_t)bh * SEQ;
  const u32x2 z2 = {0u, 0u};
  u32x2 ra = z2, ran = z2, rb = z2, rkk = z2, rr = z2, rv = z2; f32x4 rw = {0.f, 0.f, 0.f, 0.f};
  float rbeta = 0.f, raa = 0.f;
#define SCAN_LOAD(c)                                                                           \
  if (stager) {                                                                                \
    const int t_ = (c) * SCH + sst;                                                            \
    const size_t o_ = (size_t)t_ * 16 + (tid & 15);                                            \
    ra = pA[o_]; rr = pR[o_]; rv = pV[o_];                                                     \
    ran = t_ + 1 < SEQ ? pA[o_ + 16] : z2;                                                     \
    if (WHICH == 0) { rb = pB[o_]; rkk = pK[o_]; rw = pW[o_]; }                                \
    else { rbeta = gbeta[t_]; raa = ga[t_]; }                                                  \
  }
#define UNPK4(src) ((f32x4){__uint_as_float(src[0] << 16), __uint_as_float(src[0] & 0xffff0000u), __uint_as_float(src[1] << 16), __uint_as_float(src[1] & 0xffff0000u)})
#define DOT4(a, b) ((a[0] * b[0] + a[1] * b[1]) + (a[2] * b[2] + a[3] * b[3]))
#define SCAN_STAGE(c)                                                                          \
  if (stager) {                                                                                \
    float* rec_ = buf + ((c) & 1) * (SCH * RS) + sst * RS;                                     \
    f32x4 fAn, fW, fB, fK;                                                                     \
    if (WHICH == 0) { fAn = UNPK4(ran); fW = rw; fB = UNPK4(rb); fK = UNPK4(rkk); }            \
    else { const f32x4 k0_ = UNPK4(ra), kn_ = UNPK4(ran); fAn = -kn_; fW = (f32x4){raa, raa, raa, raa}; fB = k0_ * (raa * rbeta); fK = k0_ * rbeta; } \
    const float c1_ = dpp_sum16(DOT4(fB, fAn)), c2_ = dpp_sum16(DOT4(fK, fAn));               \
    const f32x4 fR = UNPK4(rr), fWA = fW * fAn;                                                \
    float* d_ = rec_ + (tid & 15) * 24;                                                        \
    *(f32x4*)(d_) = (f32x4){fWA[0], fWA[1], fW[0], fW[1]}; *(f32x4*)(d_ + 4) = (f32x4){fB[0], fB[1], fK[0], fK[1]}; *(f32x4*)(d_ + 8) = (f32x4){fR[0], fR[1], c1_, c2_};       \
    *(f32x4*)(d_ + 12) = (f32x4){fWA[2], fWA[3], fW[2], fW[3]}; *(f32x4*)(d_ + 16) = (f32x4){fB[2], fB[3], fK[2], fK[3]}; *(f32x4*)(d_ + 20) = (f32x4){fR[2], fR[3], c1_, c2_}; \
    *(f32x4*)(rec_ + 384 + sk) = UNPK4(rv);                                                    \
  }
#define SCAN_FLUSH(c)                                                                          \
  {                                                                                            \
    const float* pb_ = pbuf + ((c) & 1) * (SCH * 512);                                         \
    _Pragma("unroll") for (int ps_ = 0; ps_ < 4; ++ps_) {                                      \
      const int o_ = ps_ * 64 + (tid >> 3);                                                    \
      const f32x4 q_ = *(const f32x4*)(pb_ + o_ * 32 + (tid & 7) * 4);                         \
      float sm_ = (q_[0] + q_[1]) + (q_[2] + q_[3]);                                           \
      sm_ += __int_as_float(__builtin_amdgcn_update_dpp(0, __float_as_int(sm_), 0xB1, 0xF, 0xF, true));   \
      sm_ += __int_as_float(__builtin_amdgcn_update_dpp(0, __float_as_int(sm_), 0x4E, 0xF, 0xF, true));   \
      sm_ += __int_as_float(__builtin_amdgcn_update_dpp(0, __float_as_int(sm_), 0x141, 0xF, 0xF, true));  \
      if ((tid & 7) == 0) oout[((size_t)(c) * SCH + (o_ >> 4)) * 64 + quarter * 16 + (o_ & 15)] = sm_;   \
    }                                                                                          \
  }
  SCAN_LOAD(0);
  __syncthreads();
  SCAN_STAGE(0);
  f32x2 S1 = {0.f, 0.f}; float pre = 0.f, X = 0.f;
#pragma unroll 1
  for (int c = 0; c < NCH; ++c) {
    __syncthreads();
    if (c >= 1) SCAN_FLUSH(c - 1);
    if (c + 1 < NCH) SCAN_LOAD(c + 1);
    const float* cb = buf + (c & 1) * (SCH * RS);
    float* pb = pbuf + (c & 1) * (SCH * 512) + r * 32 + sub;
    StepIn cur, nxt;
    ld_step(cur, cb + sub * 12, cb + 384 + v);
#pragma unroll 4
    for (int st = 0; st < SCH; ++st) {
      const int sn = st + 1 < SCH ? st + 1 : st;
      ld_step(nxt, cb + sn * RS + sub * 12, cb + sn * RS + 384 + v);
      const float sa = X + pre;
      const float Xn = sum32(S1[0] * cur.q0[0] + S1[1] * cur.q0[1]);
      const float s0 = S1[0] * cur.q0[2] + (cur.q1[0] * sa + cur.q1[2] * cur.V);
      const float s1 = S1[1] * cur.q0[3] + (cur.q1[1] * sa + cur.q1[3] * cur.V);
      pre = sa * cur.q2[2] + cur.V * cur.q2[3];
      pb[st * 512] = s0 * cur.q2[0] + s1 * cur.q2[1];
      S1[0] = s0; S1[1] = s1; X = Xn;
      cur = nxt;
    }
    if (c + 1 < NCH) SCAN_STAGE(c + 1);
  }
  __syncthreads();
  SCAN_FLUSH(NCH - 1);
#undef SCAN_LOAD
#undef SCAN_STAGE
#undef SCAN_FLUSH
#undef UNPK4
#undef DOT4
}

constexpr int CLD = 72;
constexpr int CMB = 64 * CLD * 2;
constexpr int NCHK = SEQ / 64;
template <class F> DI void mm64(const bf16_t* X, const bf16_t* Y, int wid, int lane, F f) {
  const int fr = lane & 15, fq = lane >> 4;
#pragma unroll
  for (int q = 0; q < 2; ++q) {
    const int tile = wid * 2 + q, ti = tile >> 2, tj = tile & 3;
    f32x4 acc = {0.f, 0.f, 0.f, 0.f};
#pragma unroll
    for (int ks = 0; ks < 2; ++ks) {
      const bf16x8 yf = *(const bf16x8*)(Y + (16 * tj + fr) * CLD + 32 * ks + 8 * fq);
      const bf16x8 xf = *(const bf16x8*)(X + (16 * ti + fr) * CLD + 32 * ks + 8 * fq);
      acc = __builtin_amdgcn_mfma_f32_16x16x32_bf16(yf, xf, acc, 0, 0, 0);
    }
    f(16 * ti + fr, 16 * tj + 4 * fq, acc);
  }
}
DI void st4bf(bf16_t* d, const f32x4& v) { u32x2 w; w[0] = pk2(v[0], v[1]); w[1] = pk2(v[2], v[3]); *(u32x2*)d = w; }

template <int WHICH>
DI void chunk_pre(const Params& p, int bh, int c, char* lds) {
  bf16_t* M[11];
#pragma unroll
  for (int i = 0; i < 11; ++i) M[i] = (bf16_t*)(lds + i * CMB);
  float* NF = (float*)(lds + 11 * CMB);
  float* SC = NF + 64 * 65;
  char* R = p.ws + O_R;
  const int tid = otid(), lane = tid & 63, wid = tid >> 6;
  const int item = (WHICH * NBH + bh) * NCHK + c;
  const size_t base = ((size_t)bh * SEQ + (size_t)c * 64) * 64;
  const bf16_t* gA = (const bf16_t*)(R + (WHICH == 0 ? R_RWA : R_GK)) + base;
  const bf16_t* gB = (const bf16_t*)(R + R_RWB) + base;
  const bf16_t* gK = (const bf16_t*)(R + R_RWK) + base;
  const bf16_t* gR = (const bf16_t*)(R + (WHICH == 0 ? R_RWR : R_GQ)) + base;
  const bf16_t* gV = (const bf16_t*)(R + (WHICH == 0 ? R_RWV : R_GV)) + base;
  const float* gW = (const float*)(R + R_RWW) + base;
  bf16_t* oRh = (bf16_t*)(R + R_CHK) + (size_t)item * 4096;
  bf16_t* oGh = (bf16_t*)(R + R_CHK + CHK_SZ) + (size_t)item * 4096;
  bf16_t* oSV = (bf16_t*)(R + R_CHK + 2 * CHK_SZ) + (size_t)item * 4096;
  float* oout = (float*)(R + R_OSCAN) + (size_t)WHICH * NBH * SEQ * 64 + base;
  __syncthreads();
  if (WHICH == 0) {
    const int k = tid & 63, seg = tid >> 6;
    float lg[8]; float run = 0.f;
#pragma unroll
    for (int i = 0; i < 8; ++i) { run += __logf(gW[(size_t)(seg * 8 + i) * 64 + k]); lg[i] = run; }
    SC[seg * 64 + k] = run;
    __syncthreads();
    float off = 0.f;
    for (int s2 = 0; s2 < seg; ++s2) off += SC[s2 * 64 + k];
#pragma unroll
    for (int i = 0; i < 8; ++i) NF[(seg * 8 + i) * 65 + k] = lg[i] + off;
    __syncthreads();
    if (tid < 64) SC[512 + tid] = __expf(NF[63 * 65 + tid]);
  } else {
    if (tid < 64) {
      const float a = ((const float*)(p.ws + O_SMALL + SM_GA))[(size_t)bh * SEQ + c * 64 + tid];
      const float be = ((const float*)(p.ws + O_SMALL + SM_GBETA))[(size_t)bh * SEQ + c * 64 + tid];
      float g = __logf(a);
#pragma unroll
      for (int o = 1; o < 64; o <<= 1) { const float t2 = shfl_up_l(g, o, lane); if (lane >= o) g += t2; }
      SC[tid] = g; SC[64 + tid] = a * be; SC[128 + tid] = be;
    }
    __syncthreads();
    if (tid < 64) SC[512 + tid] = __expf(SC[63]);
  }
  __syncthreads();
  {
    const int t = tid >> 3, kg = (tid & 7) * 8;
    float a8[8], r8[8], b8[8], k8[8], e0[8], e1[8], em[8], ee[8];
    unpk8(a8, *(const u32x4*)(gA + t * 64 + kg)); unpk8(r8, *(const u32x4*)(gR + t * 64 + kg));
    const u32x4 vraw = *(const u32x4*)(gV + t * 64 + kg);
    if (WHICH == 0) {
      unpk8(b8, *(const u32x4*)(gB + t * 64 + kg)); unpk8(k8, *(const u32x4*)(gK + t * 64 + kg));
#pragma unroll
      for (int i = 0; i < 8; ++i) {
        const float g1 = NF[t * 65 + kg + i], g0 = t > 0 ? NF[(t - 1) * 65 + kg + i] : 0.f, gl = NF[63 * 65 + kg + i];
        e0[i] = __expf(g0); e1[i] = __expf(g1); em[i] = __expf(-g1); ee[i] = __expf(gl - g1);
      }
    } else {
      const float g1 = SC[t], g0 = t > 0 ? SC[t - 1] : 0.f, gl = SC[63], ab = SC[64 + t], be = SC[128 + t];
      const float x0 = __expf(g0), x1 = __expf(g1), xe = __expf(gl - g1);
#pragma unroll
      for (int i = 0; i < 8; ++i) { const float kv = a8[i]; b8[i] = ab * kv; k8[i] = be * kv; a8[i] = -kv; e0[i] = x0; e1[i] = x1; em[i] = 1.f; ee[i] = xe; }
    }
    float o8[8];
#pragma unroll
    for (int i = 0; i < 8; ++i) o8[i] = a8[i] * e0[i];
    *(u32x4*)(M[0] + t * CLD + kg) = pk8(o8);
#pragma unroll
    for (int i = 0; i < 8; ++i) M[1][(kg + i) * CLD + t] = f2bf(o8[i]);
#pragma unroll
    for (int i = 0; i < 8; ++i) o8[i] = r8[i] * e1[i];
    *(u32x4*)(M[2] + t * CLD + kg) = pk8(o8);
    if (WHICH == 0) {
#pragma unroll
      for (int i = 0; i < 8; ++i) o8[i] = b8[i] * em[i];
      *(u32x4*)(M[3] + t * CLD + kg) = pk8(o8);
#pragma unroll
      for (int i = 0; i < 8; ++i) o8[i] = k8[i] * em[i];
      *(u32x4*)(M[4] + t * CLD + kg) = pk8(o8);
    } else {
#pragma unroll
      for (int i = 0; i < 8; ++i) o8[i] = -a8[i];
      *(u32x4*)(M[3] + t * CLD + kg) = pk8(o8);
      *(u32x4*)(M[4] + t * CLD + kg) = pk8(r8);
    }
#pragma unroll
    for (int i = 0; i < 8; ++i) M[5][(kg + i) * CLD + t] = f2bf(b8[i] * ee[i]);
#pragma unroll
    for (int i = 0; i < 8; ++i) o8[i] = k8[i] * ee[i];
    *(u32x4*)(M[6] + t * CLD + kg) = pk8(o8);
    M[7][(kg + 0) * CLD + t] = (bf16_t)(vraw[0] & 0xffffu); M[7][(kg + 1) * CLD + t] = (bf16_t)(vraw[0] >> 16);
    M[7][(kg + 2) * CLD + t] = (bf16_t)(vraw[1] & 0xffffu); M[7][(kg + 3) * CLD + t] = (bf16_t)(vraw[1] >> 16);
    M[7][(kg + 4) * CLD + t] = (bf16_t)(vraw[2] & 0xffffu); M[7][(kg + 5) * CLD + t] = (bf16_t)(vraw[2] >> 16);
    M[7][(kg + 6) * CLD + t] = (bf16_t)(vraw[3] & 0xffffu); M[7][(kg + 7) * CLD + t] = (bf16_t)(vraw[3] >> 16);
  }
  __syncthreads();
  if (WHICH == 0) {
    mm64(M[3], M[0], wid, lane, [&](int j, int t0, const f32x4& v) {
#pragma unroll
      for (int r = 0; r < 4; ++r) NF[j * 65 + t0 + r] = (j < t0 + r) ? v[r] : 0.f; });
    mm64(M[4], M[0], wid, lane, [&](int i, int t0, const f32x4& v) {
      f32x4 w;
#pragma unroll
      for (int r = 0; r < 4; ++r) w[r] = (i < t0 + r) ? v[r] : 0.f;
      st4bf(M[8] + i * CLD + t0, w); });
    mm64(M[2], M[3], wid, lane, [&](int t, int j0, const f32x4& v) {
      f32x4 w;
#pragma unroll
      for (int r = 0; r < 4; ++r) w[r] = (j0 + r <= t) ? v[r] : 0.f;
      st4bf(M[9] + t * CLD + j0, w); });
    mm64(M[2], M[4], wid, lane, [&](int t, int i0, const f32x4& v) {
      f32x4 w;
#pragma unroll
      for (int r = 0; r < 4; ++r) w[r] = (i0 + r <= t) ? v[r] : 0.f;
      st4bf(M[10] + t * CLD + i0, w); });
  } else {
    mm64(M[3], M[3], wid, lane, [&](int j, int t0, const f32x4& v) {
      const float gj = SC[j], abj = SC[64 + j], bej = SC[128 + j];
      f32x4 w;
#pragma unroll
      for (int r = 0; r < 4; ++r) {
        const int t = t0 + r;
        const float d = (j < t) ? __expf(SC[t - 1 > 0 ? t - 1 : 0] - gj) * v[r] : 0.f;
        NF[j * 65 + t] = -abj * d; w[r] = -bej * d;
      }
      st4bf(M[8] + j * CLD + t0, w); });
    mm64(M[4], M[3], wid, lane, [&](int t, int j0, const f32x4& v) {
      const float gt = SC[t];
      f32x4 w1, w2;
#pragma unroll
      for (int r = 0; r < 4; ++r) {
        const int j = j0 + r;
        const float d = (j <= t) ? __expf(gt - SC[j]) * v[r] : 0.f;
        w1[r] = SC[64 + j] * d; w2[r] = SC[128 + j] * d;
      }
      st4bf(M[9] + t * CLD + j0, w1); st4bf(M[10] + t * CLD + j0, w2); });
  }
  __syncthreads();
  {
    const int i = tid >> 3, sidx = tid & 7;
    float tr[8], nv[8], nn[8];
#pragma unroll
    for (int m = 0; m < 8; ++m) { tr[m] = 0.f; nv[m] = NF[(sidx + 8 * m) * 65]; nn[m] = 0.f; }
#pragma unroll
    for (int t = 0; t < 64; ++t) {
      if (t + 1 < 64) {
#pragma unroll
        for (int m = 0; m < 8; ++m) if (8 * m < t + 1) nn[m] = NF[(sidx + 8 * m) * 65 + t + 1];
      }
      float pa = 0.f, pb = 0.f;
#pragma unroll
      for (int m = 0; m < 8; m += 2) { if (8 * m < t) pa += tr[m] * nv[m]; if (8 * (m + 1) < t) pb += tr[m + 1] * nv[m + 1]; }
      const float val = sum8(pa + pb) + (i == t ? 1.f : 0.f);
      if (sidx == (t & 7)) { tr[t >> 3] = val; M[0][t * CLD + i] = f2bf(val); }
#pragma unroll
      for (int m = 0; m < 8; ++m) nv[m] = nn[m];
    }
  }
  __syncthreads();
  mm64(M[1], M[0], wid, lane, [&](int k, int t0, const f32x4& v) { st4bf(M[3] + k * CLD + t0, v); });
  mm64(M[8], M[0], wid, lane, [&](int i, int t0, const f32x4& v) { st4bf(M[4] + i * CLD + t0, v); });
  __syncthreads();
  mm64(M[9], M[3], wid, lane, [&](int t, int k0, const f32x4& v) {
    float rr[8]; const u32x2 rw = *(const u32x2*)(M[2] + t * CLD + k0);
    const f32x4 o = {v[0] + __uint_as_float(rw[0] << 16), v[1] + __uint_as_float(rw[0] & 0xffff0000u), v[2] + __uint_as_float(rw[1] << 16), v[3] + __uint_as_float(rw[1] & 0xffff0000u)};
    (void)rr; st4bf(oRh + t * 64 + k0, o); });
  mm64(M[9], M[4], wid, lane, [&](int t, int i0, const f32x4& v) {
    const u32x2 rw = *(const u32x2*)(M[10] + t * CLD + i0);
    const f32x4 o = {v[0] + __uint_as_float(rw[0] << 16), v[1] + __uint_as_float(rw[0] & 0xffff0000u), v[2] + __uint_as_float(rw[1] << 16), v[3] + __uint_as_float(rw[1] & 0xffff0000u)};
    st4bf(M[1] + t * CLD + i0, o); });
  mm64(M[5], M[3], wid, lane, [&](int kp, int k0, const f32x4& v) {
    f32x4 o = v;
#pragma unroll
    for (int r = 0; r < 4; ++r) if (k0 + r == kp) o[r] += SC[512 + kp];
    st4bf(oGh + kp * 64 + k0, o); });
  __syncthreads();
  mm64(M[5], M[4], wid, lane, [&](int kp, int i0, const f32x4& v) {
    f32x4 o;
#pragma unroll
    for (int r = 0; r < 4; ++r) o[r] = v[r] + bf2f(M[6][(i0 + r) * CLD + kp]);
    st4bf(M[8] + kp * CLD + i0, o); });
  __syncthreads();
  mm64(M[7], M[1], wid, lane, [&](int v, int t0, const f32x4& val) {
#pragma unroll
    for (int r = 0; r < 4; ++r) oout[(size_t)(t0 + r) * 64 + v] = val[r]; });
  mm64(M[7], M[8], wid, lane, [&](int v, int k0, const f32x4& val) { st4bf(oSV + v * 64 + k0, val); });
}

template <int WHICH>
DI void chunk_seq(const Params& p, int bh, char* lds) {
  bf16_t* SH = (bf16_t*)lds;
  bf16_t* SL = (bf16_t*)(lds + CMB);
  bf16_t* SR = (bf16_t*)(lds + 2 * CMB);
  bf16_t* SG = (bf16_t*)(lds + 4 * CMB);
  char* R = p.ws + O_R;
  const int tid = otid(), lane = tid & 63, wid = tid >> 6, fr = lane & 15, fq = lane >> 4;
  const size_t item0 = (size_t)(WHICH * NBH + bh) * NCHK;
  const bf16_t* gRh = (const bf16_t*)(R + R_CHK) + item0 * 4096;
  const bf16_t* gGh = (const bf16_t*)(R + R_CHK + CHK_SZ) + item0 * 4096;
  const bf16_t* gSV = (const bf16_t*)(R + R_CHK + 2 * CHK_SZ) + item0 * 4096;
  float* oout = (float*)(R + R_OSCAN) + (size_t)WHICH * NBH * SEQ * 64 + (size_t)bh * SEQ * 64;
  f32x4 st[2];
  st[0] = (f32x4){0.f, 0.f, 0.f, 0.f}; st[1] = st[0];
  const int lrow = tid >> 3, lch = (tid & 7) * 8;
  int sv_off[2], ov_off[2];
#pragma unroll
  for (int q = 0; q < 2; ++q) { const int tile = wid * 2 + q, ti = tile >> 2, tj = tile & 3; sv_off[q] = (16 * ti + fr) * 64 + 16 * tj + 4 * fq; ov_off[q] = (16 * tj + fr) * 64 + 16 * ti + 4 * fq; }
  u32x4 rreg = *(const u32x4*)(gRh + lrow * 64 + lch), greg = *(const u32x4*)(gGh + lrow * 64 + lch);
  u32x2 svr[2]; f32x4 ovr[2];
#pragma unroll
  for (int q = 0; q < 2; ++q) { svr[q] = *(const u32x2*)(gSV + sv_off[q]); ovr[q] = *(const f32x4*)(oout + ov_off[q]); }
  __syncthreads();
#pragma unroll 1
  for (int c = 0; c < NCHK; ++c) {
    bf16_t* sr = SR + (c & 1) * (64 * CLD); bf16_t* sg = SG + (c & 1) * (64 * CLD);
#pragma unroll
    for (int q = 0; q < 2; ++q) {
      const int tile = wid * 2 + q, ti = tile >> 2, tj = tile & 3, v = 16 * ti + fr, k0 = 16 * tj + 4 * fq;
      f32x4 hi, lo;
#pragma unroll
      for (int r = 0; r < 4; ++r) { const float h = bf2f(f2bf(st[q][r])); hi[r] = h; lo[r] = st[q][r] - h; }
      st4bf(SH + v * CLD + k0, hi); st4bf(SL + v * CLD + k0, lo);
    }
    *(u32x4*)(sr + lrow * CLD + lch) = rreg; *(u32x4*)(sg + lrow * CLD + lch) = greg;
    const u32x2 sv0 = svr[0], sv1 = svr[1]; const f32x4 ov0 = ovr[0], ov1 = ovr[1];
    __syncthreads();
    if (c + 1 < NCHK) {
      rreg = *(const u32x4*)(gRh + (size_t)(c + 1) * 4096 + lrow * 64 + lch); greg = *(const u32x4*)(gGh + (size_t)(c + 1) * 4096 + lrow * 64 + lch);
#pragma unroll
      for (int q = 0; q < 2; ++q) { svr[q] = *(const u32x2*)(gSV + (size_t)(c + 1) * 4096 + sv_off[q]); ovr[q] = *(const f32x4*)(oout + (size_t)(c + 1) * 4096 + ov_off[q]); }
    }
#pragma unroll
    for (int q = 0; q < 2; ++q) {
      const int tile = wid * 2 + q, ti = tile >> 2, tj = tile & 3;
      f32x4 acc = q == 0 ? ov0 : ov1;
#pragma unroll
      for (int ks = 0; ks < 2; ++ks) {
        const bf16x8 sf = *(const bf16x8*)(SH + (16 * ti + fr) * CLD + 32 * ks + 8 * fq);
        const bf16x8 rf = *(const bf16x8*)(sr + (16 * tj + fr) * CLD + 32 * ks + 8 * fq);
        acc = __builtin_amdgcn_mfma_f32_16x16x32_bf16(sf, rf, acc, 0, 0, 0);
      }
      *(f32x4*)(oout + (size_t)c * 4096 + ov_off[q]) = acc;
    }
#pragma unroll
    for (int q = 0; q < 2; ++q) {
      const int tile = wid * 2 + q, ti = tile >> 2, tj = tile & 3;
      const u32x2 svw = q == 0 ? sv0 : sv1;
      f32x4 acc = {__uint_as_float(svw[0] << 16), __uint_as_float(svw[0] & 0xffff0000u), __uint_as_float(svw[1] << 16), __uint_as_float(svw[1] & 0xffff0000u)};
#pragma unroll
      for (int ks = 0; ks < 2; ++ks) {
        const bf16x8 gf = *(const bf16x8*)(sg + (16 * tj + fr) * CLD + 32 * ks + 8 * fq);
        const bf16x8 hf = *(const bf16x8*)(SH + (16 * ti + fr) * CLD + 32 * ks + 8 * fq);
        const bf16x8 lf = *(const bf16x8*)(SL + (16 * ti + fr) * CLD + 32 * ks + 8 * fq);
        acc = __builtin_amdgcn_mfma_f32_16x16x32_bf16(gf, hf, acc, 0, 0, 0);
        acc = __builtin_amdgcn_mfma_f32_16x16x32_bf16(gf, lf, acc, 0, 0, 0);
      }
      st[q] = acc;
    }
    __syncthreads();
  }
}

DI void phase_scanpost(const Params& p, int L) {
  char* R = p.ws + O_R;
  const float* osc = (const float*)(R + R_OSCAN);
  const float* rk = (const float*)(p.ws + O_SMALL + SM_RK);
  const bf16_t* rwV = (const bf16_t*)(R + R_RWV);
  const bf16_t* auxg = (const bf16_t*)(R + R_AUXG); const bf16_t* auxgate = (const bf16_t*)(R + R_AUXGATE);
  bf16_t* y = (bf16_t*)(R + R_Y);
  const float* lnw = p.in[17] + L * 256; const float* lnb = p.in[18] + L * 256; const float* gnw = p.in[25] + L * 64;
#pragma unroll 1
  for (int it0 = obid() * 64; it0 < 2 * NBH * SEQ; it0 += gridDim.x * 64) {
    const int tid = otid(), item = it0 + (tid >> 3), d0 = (tid & 7) * 8;
    const int which = item >= NBH * SEQ, rem = item - which * NBH * SEQ, bh = rem / SEQ, t = rem % SEQ, b = bh >> 2, h = bh & 3, tok = b * SEQ + t;
    float o[8]; ld8f(o, osc + (size_t)item * 64 + d0);
    float g8[8]; unpk8(g8, *(const u32x4*)((which == 0 ? auxg : auxgate) + (size_t)tok * 256 + h * 64 + d0));
    float out[8];
    if (which == 0) {
      float s1 = 0.f;
#pragma unroll
      for (int i = 0; i < 8; ++i) s1 += o[i];
      const float mean = sum8(s1) * (1.0f / 64.0f);
      float s2 = 0.f;
#pragma unroll
      for (int i = 0; i < 8; ++i) { o[i] -= mean; s2 += o[i] * o[i]; }
      const float rstd = rsqrtf(sum8(s2) * (1.0f / 64.0f) + 64e-5f);
      float w8[8], b8[8], v8[8];
      ld8f(w8, lnw + h * 64 + d0); ld8f(b8, lnb + h * 64 + d0);
      unpk8(v8, *(const u32x4*)(rwV + ((size_t)bh * SEQ + t) * 64 + d0));
      const float rkv = rk[tok * 4 + h];
#pragma unroll
      for (int i = 0; i < 8; ++i) out[i] = (o[i] * rstd * w8[i] + b8[i] + rkv * v8[i]) * g8[i];
      *(u32x4*)(y + ((size_t)0 * NTOK + tok) * 256 + h * 64 + d0) = pk8(out);
    } else {
      float s2 = 0.f;
#pragma unroll
      for (int i = 0; i < 8; ++i) s2 += o[i] * o[i];
      const float rstd = rsqrtf(sum8(s2) * (1.0f / 64.0f) + 1e-6f);
      float w8[8]; ld8f(w8, gnw + d0);
#pragma unroll
      for (int i = 0; i < 8; ++i) out[i] = o[i] * rstd * w8[i] * g8[i];
      *(u32x4*)(y + ((size_t)3 * NTOK + tok) * 256 + h * 64 + d0) = pk8(out);
    }
  }
}

DI bf16x8 packf8(float a0, float a1, float a2, float a3, float a4, float a5, float a6, float a7) {
  u32x4 w; w[0] = pk2(a0, a1); w[1] = pk2(a2, a3); w[2] = pk2(a4, a5); w[3] = pk2(a6, a7);
  return __builtin_bit_cast(bf16x8, w);
}
constexpr int KLD = 72;
constexpr int ATT_KV_OFF = 2 * 64 * KLD * 2 + 8192 * 4 + 256;
constexpr int ATT_XB_OFF = ATT_KV_OFF + 4 * 64 * KLD * 2;
template <int TYPE>
DI void attn_unit(const Params& p, int L, int bh, int qt, char* lds) {
  bf16_t* KV = (bf16_t*)(lds + ATT_KV_OFF);
  float* cs = (float*)(lds + 2 * 64 * KLD * 2);
  float* red = cs + 8192;
  char* R = p.ws + O_R;
  const int tid = otid(), lane = tid & 63, wid = tid >> 6, r32 = lane & 31, hi = lane >> 5;
  const int b = bh >> 2, h = bh & 3;
  const int map = TYPE == 0 ? (wid >> 2) : 0, wq = TYPE == 0 ? (wid & 3) : wid;
  const int QROWS = TYPE == 0 ? 128 : 256;
  const int q0 = qt * QROWS, qw0 = q0 + wq * 32, q = qw0 + r32;
  const bf16_t* Qg = (const bf16_t*)(R + (TYPE == 0 ? R_QD : R_QF)) + (size_t)bh * SEQ * 64;
  const bf16_t* Kg = (const bf16_t*)(R + (TYPE == 0 ? R_KD : R_KF)) + (size_t)bh * SEQ * 64;
  const bf16_t* Vg = (const bf16_t*)(R + (TYPE == 0 ? R_VD : R_VF)) + (size_t)bh * 64 * SEQ;
  const int NT = (q0 + QROWS) / 64;
  __syncthreads();
  const int lrow = tid >> 3, lch = (tid & 7) * 8;
  u32x4 kreg = *(const u32x4*)(Kg + (size_t)lrow * 64 + lch);
  u32x4 vreg = *(const u32x4*)(Vg + (size_t)lrow * SEQ + lch);
  float cq = 0.f;
  if (TYPE == 1) {
    const float* lf = (const float*)(p.ws + O_SMALL + SM_LOGF) + (size_t)bh * SEQ;
    const int n = q0 + 256;
    float loc[16]; float tot = 0.f;
#pragma unroll
    for (int i = 0; i < 16; ++i) { const int e = tid * 16 + i; loc[i] = e < n ? lf[e] : 0.f; tot += loc[i]; }
    float inc = tot;
#pragma unroll
    for (int o = 1; o < 64; o <<= 1) { const float t2 = shfl_up_l(inc, o, lane); if (lane >= o) inc += t2; }
    if (lane == 63) red[wid] = inc;
    __syncthreads();
    float pre = inc - tot;
    for (int w = 0; w < wid; ++w) pre += red[w];
#pragma unroll
    for (int i = 0; i < 16; ++i) { pre += loc[i]; const int e = tid * 16 + i; if (e < n) cs[e] = pre * 1.4426950408889634f; }
    __syncthreads();
    cq = cs[q];
  }
  constexpr int NS = TYPE == 0 ? 2 : 4;
  const int sbase = TYPE == 0 ? 2 * map : 0;
  bf16x8 qf[NS];
#pragma unroll
  for (int s = 0; s < NS; ++s) qf[s] = *(const bf16x8*)(Qg + (size_t)q * 64 + 16 * (sbase + s) + 8 * hi);
  constexpr float ATHR = 8.0f;
  float mref = 0.f, l = 0.f; f32x16 o[2];
#pragma unroll
  for (int r = 0; r < 16; ++r) { o[0][r] = 0.f; o[1][r] = 0.f; }
  bf16_t* Kb = (bf16_t*)(lds + ATT_KV_OFF);
  bf16_t* Vb = Kb + 2 * 64 * KLD;
  const int vpos = (lch & ~15) + ((lch & 8) ? 4 : 0);
  const int tmax = (qw0 + 31) >> 6;
#define ST_K(buf) { *(u32x4*)(Kb + (buf) * (64 * KLD) + lrow * KLD + lch) = kreg; }
#define ST_V(buf) { bf16_t* vb_ = Vb + (buf) * (64 * KLD) + lrow * KLD + vpos; *(u32x2*)(vb_) = (u32x2){vreg[0], vreg[1]}; *(u32x2*)(vb_ + 8) = (u32x2){vreg[2], vreg[3]}; }
#define LD_K(t_) { kreg = *(const u32x4*)(Kg + (size_t)((t_) * 64 + lrow) * 64 + lch); }
#define LD_V(t_) { vreg = *(const u32x4*)(Vg + (size_t)lrow * SEQ + (t_) * 64 + lch); }
#define QK_TILE(P0, P1, t_)                                                                    \
  {                                                                                            \
    const bf16_t* Ks_ = Kb + ((t_) & 1) * (64 * KLD); const int kv_ = (t_) * 64;               \
    if (TYPE == 1) {                                                                           \
      const float cm_ = cq - mref;                                                             \
      _Pragma("unroll") for (int g = 0; g < 4; ++g) {                                          \
        const f32x4 c0_ = *(const f32x4*)(cs + kv_ + 8 * g + 4 * hi), c1_ = *(const f32x4*)(cs + kv_ + 32 + 8 * g + 4 * hi); \
        _Pragma("unroll") for (int i = 0; i < 4; ++i) { P0[4 * g + i] = cm_ - c0_[i]; P1[4 * g + i] = cm_ - c1_[i]; } }      \
    } else { _Pragma("unroll") for (int r = 0; r < 16; ++r) { P0[r] = -mref; P1[r] = -mref; } } \
    bf16x8 kf0_[NS], kf1_[NS];                                                                 \
    _Pragma("unroll") for (int s = 0; s < NS; ++s) {                                           \
      kf0_[s] = *(const bf16x8*)(Ks_ + r32 * KLD + 16 * (sbase + s) + 8 * hi);                 \
      kf1_[s] = *(const bf16x8*)(Ks_ + (32 + r32) * KLD + 16 * (sbase + s) + 8 * hi); }        \
    __builtin_amdgcn_sched_barrier(0);                                                         \
    _Pragma("unroll") for (int s = 0; s < NS; ++s) {                                           \
      P0 = __builtin_amdgcn_mfma_f32_32x32x16_bf16(kf0_[s], qf[s], P0, 0, 0, 0);               \
      P1 = __builtin_amdgcn_mfma_f32_32x32x16_bf16(kf1_[s], qf[s], P1, 0, 0, 0); }             \
  }
  f32x16 p0, p1, n0, n1;
#pragma unroll
  for (int r = 0; r < 16; ++r) { p0[r] = 0.f; p1[r] = 0.f; n0[r] = 0.f; n1[r] = 0.f; }
  __syncthreads();
  ST_K(0); ST_V(0);
  if (NT > 1) { LD_K(1); LD_V(1); }
  __syncthreads();
  if (NT > 1) ST_K(1);
  if (NT > 2) LD_K(2);
  QK_TILE(p0, p1, 0);
  __syncthreads();
#pragma unroll 1
  for (int jt = 0; jt < NT; ++jt) {
    const int kv0 = jt * 64;
    if (jt + 2 < NT) ST_K(jt & 1);
    if (jt + 1 < NT) ST_V((jt + 1) & 1);
    if (jt + 3 < NT) LD_K(jt + 3);
    if (jt + 2 < NT) LD_V(jt + 2);
    const bool has_next = jt + 1 <= tmax && jt + 1 < NT;
    if (has_next) QK_TILE(n0, n1, jt + 1);
    if (jt <= tmax) {
      bf16x8 vfr[8];
      {
        const bf16_t* Vs = Vb + (jt & 1) * (64 * KLD);
#pragma unroll
        for (int db = 0; db < 2; ++db)
#pragma unroll
          for (int s = 0; s < 4; ++s) vfr[db * 4 + s] = *(const bf16x8*)(Vs + (32 * db + r32) * KLD + 16 * s + 8 * hi);
        __builtin_amdgcn_sched_barrier(0);
      }
      if (kv0 + 63 > qw0) {
        asm volatile("" ::: "memory");
#pragma unroll
        for (int r = 0; r < 16; ++r) { if (kv0 + crow(r, hi) > q) p0[r] = -INFINITY; if (kv0 + 32 + crow(r, hi) > q) p1[r] = -INFINITY; }
      }
      float mx = fmaxf(p0[0], p1[0]);
#pragma unroll
      for (int r = 1; r < 16; ++r) mx = fmaxf(mx, fmaxf(p0[r], p1[r]));
      { auto rr = __builtin_amdgcn_permlane32_swap(__float_as_uint(mx), __float_as_uint(mx), false, false); mx = fmaxf(__uint_as_float(rr[0]), __uint_as_float(rr[1])); }
      if (__any(mx > ATHR)) {
        const float dl = fmaxf(mx, 0.f);
        mref += dl;
        const float f = __builtin_amdgcn_exp2f(-dl);
        l *= f;
#pragma unroll
        for (int r = 0; r < 16; ++r) { p0[r] -= dl; p1[r] -= dl; n0[r] -= dl; n1[r] -= dl; o[0][r] *= f; o[1][r] *= f; }
      }
      float rs = 0.f;
#pragma unroll
      for (int r = 0; r < 16; ++r) { p0[r] = __builtin_amdgcn_exp2f(p0[r]); p1[r] = __builtin_amdgcn_exp2f(p1[r]); rs += p0[r] + p1[r]; }
      l += rs;
      bf16x8 pf[4];
      pf[0] = packf8(p0[0], p0[1], p0[2], p0[3], p0[4], p0[5], p0[6], p0[7]);
      pf[1] = packf8(p0[8], p0[9], p0[10], p0[11], p0[12], p0[13], p0[14], p0[15]);
      pf[2] = packf8(p1[0], p1[1], p1[2], p1[3], p1[4], p1[5], p1[6], p1[7]);
      pf[3] = packf8(p1[8], p1[9], p1[10], p1[11], p1[12], p1[13], p1[14], p1[15]);
#pragma unroll
      for (int db = 0; db < 2; ++db)
#pragma unroll
        for (int s = 0; s < 4; ++s) o[db] = __builtin_amdgcn_mfma_f32_32x32x16_bf16(vfr[db * 4 + s], pf[s], o[db], 0, 0, 0);
    }
    p0 = n0; p1 = n1;
    __syncthreads();
  }
#undef ST_K
#undef ST_V
#undef LD_K
#undef LD_V
#undef QK_TILE
  bf16_t* y = (bf16_t*)(R + R_Y);
  const int tid_e = otid(), lane_e = tid_e & 63, wid_e = tid_e >> 6, hi_e = lane_e >> 5;
  const int wq_e = TYPE == 0 ? (wid_e & 3) : wid_e, q_e = q0 + wq_e * 32 + (lane_e & 31);
  const size_t orow = ((size_t)(TYPE == 0 ? 1 : 2) * NTOK + (size_t)b * SEQ + q_e) * 256 + h * 64;
  const float lt = xsum32(l);
  const float li = 1.0f / lt;
  if (TYPE == 1) {
#pragma unroll
    for (int db = 0; db < 2; ++db)
#pragma unroll
      for (int g = 0; g < 4; ++g) {
        u32x2 w; w[0] = pk2(o[db][4 * g] * li, o[db][4 * g + 1] * li); w[1] = pk2(o[db][4 * g + 2] * li, o[db][4 * g + 3] * li);
        *(u32x2*)(y + orow + 32 * db + 8 * g + 4 * hi_e) = w;
      }
  } else {
    float* xb = (float*)(lds + ATT_XB_OFF);
    if (map == 1) {
#pragma unroll
      for (int db = 0; db < 2; ++db)
#pragma unroll
        for (int r = 0; r < 16; ++r) xb[(wq_e * 32 + db * 16 + r) * 64 + lane_e] = o[db][r] * li;
    }
    __syncthreads();
    if (map == 0) {
      const float* lp = p.in[19] + L * 128;
      float s01 = 0.f, s23 = 0.f;
      for (int i = 0; i < 32; ++i) { s01 += lp[i] * lp[32 + i]; s23 += lp[64 + i] * lp[96 + i]; }
      const float lam_init = L == 0 ? 0.2f : 0.35550906759096934f;
      const float lam = __expf(s01) - __expf(s23) + lam_init;
      const float* sub = p.in[20] + L * 64;
      float ss = 0.f;
#pragma unroll
      for (int db = 0; db < 2; ++db)
#pragma unroll
        for (int r = 0; r < 16; ++r) { const float vv = o[db][r] * li - lam * xb[(wq_e * 32 + db * 16 + r) * 64 + lane_e]; o[db][r] = vv; ss += vv * vv; }
      ss = xsum32(ss);
      const float sc = rsqrtf(ss * (1.0f / 64.0f) + 1e-5f) * (1.0f - lam_init);
#pragma unroll
      for (int db = 0; db < 2; ++db)
#pragma unroll
        for (int g = 0; g < 4; ++g) {
          const int d = 32 * db + 8 * g + 4 * hi_e;
          const f32x4 sw = *(const f32x4*)(sub + d);
          u32x2 w; w[0] = pk2(o[db][4 * g] * sc * sw[0], o[db][4 * g + 1] * sc * sw[1]); w[1] = pk2(o[db][4 * g + 2] * sc * sw[2], o[db][4 * g + 3] * sc * sw[3]);
          *(u32x2*)(y + orow + d) = w;
        }
    }
  }
}

template <class BarF>
DI void phase_mix(const Params& p, int L, char* lds, int qslot, BarF gbar) {
  int* ctr = (int*)(p.ws + O_CTL) + CW_QCTR + qslot * 64;
  int* s_unit = (int*)(lds + 2 * 64 * KLD * 2 + 8192 * 4 + 64);
#pragma unroll 1
  for (int item = obid(); item < 2 * NBH * NCHK; item += gridDim.x) {
    const int bh = (item >> 7) & 7, c = item & 127;
    if (item < NBH * NCHK) chunk_pre<0>(p, bh, c, lds); else chunk_pre<1>(p, bh, c, lds);
  }
  gbar();
  {
    const int bid = obid();
    if (bid < 16) { if (bid < 8) chunk_seq<0>(p, bid & 7, lds); else chunk_seq<1>(p, bid & 7, lds); }
  }
#pragma unroll 1
  for (;;) {
    __syncthreads();
    if (otid() == 0) *s_unit = atomicAdd(ctr, 1);
    __syncthreads();
    const int u = *s_unit;
    if (u >= 768) break;
    const int level = 31 - u / 24, w = u % 24;
    if (w < 8) attn_unit<1>(p, L, w, level, lds);
    else if (w < 16) attn_unit<0>(p, L, w - 8, 2 * level + 1, lds);
    else attn_unit<0>(p, L, w - 16, 2 * level, lds);
  }
  if (L == 0 && qslot == 0) {
    int* cctr = (int*)(p.ws + O_CTL) + CW_QCTR + 8 * 64;
    float* tl = (float*)lds; const int tid = otid();
    s_unit = (int*)(lds + 64 * 257 * 4 + 64);
#pragma unroll 1
    for (;;) {
      __syncthreads();
      if (tid == 0) *s_unit = atomicAdd(cctr, 2);
      __syncthreads();
      const int g0 = *s_unit;
      if (g0 >= MOE_CONV_TILES) break;
#pragma unroll 1
      for (int g = g0; g < g0 + 2; ++g) moe_convert_tile(p, g, tl, tid);
    }
  }
}
DI void phase_mix_attn_only(const Params& p, int L, char* lds, int qslot) {
  int* ctr = (int*)(p.ws + O_CTL) + CW_QCTR + qslot * 64;
  int* s_unit = (int*)(lds + 2 * 64 * KLD * 2 + 8192 * 4 + 64);
#pragma unroll 1
  for (;;) {
    __syncthreads();
    if (otid() == 0) *s_unit = atomicAdd(ctr, 1);
    __syncthreads();
    const int u = *s_unit;
    if (u >= 768) break;
    const int level = 31 - u / 24, w = u % 24;
    if (w < 8) attn_unit<1>(p, L, w, level, lds);
    else if (w < 16) attn_unit<0>(p, L, w - 8, 2 * level + 1, lds);
    else attn_unit<0>(p, L, w - 16, 2 * level, lds);
  }
}


template <class F>
DI void run_gemm(PG8_LAS unsigned char* lds, const bf16_t* A, const bf16_t* Bt, int M, int N, int K, const int* texp, size_t bstride, F f) {
  pg8::Gemm g{A, Bt, M, N, K, texp, bstride};
  pg8::StaticOrder S; S.init(M, N, (int)gridDim.x, obid());
  pg8::EpiFn<F> E{f};
  pg8::gemm_phase<pg8::EpiFn<F>, pg8::StaticOrder, true, true>(lds, g, S, E);
}
DI void st_bf16x8(bf16_t* dst, const f32x4& a, const f32x4& b);
struct EpiGU {
  static constexpr bool PERM = true, AFTER_DRAIN = false;
  bf16_t* T; int ldt;
  __device__ __forceinline__ void operator()(const f32x4 (&acc)[2][2][4][2], const pg8::Unit& u, int wr, int wc, int fr, int fq) const {
#pragma unroll
    for (int ai = 0; ai < 2; ++ai)
#pragma unroll
      for (int m = 0; m < 4; ++m) {
        bf16_t* rowp = T + (size_t)(u.pm * 256 + ai * 128 + wr * 64 + m * 16 + fr) * ldt + u.pn * 128 + wc * 32 + 8 * fq;
        f32x4 o[2];
#pragma unroll
        for (int n = 0; n < 2; ++n) {
          const f32x4 g = acc[ai][0][m][n], up = acc[ai][1][m][n];
#pragma unroll
          for (int i = 0; i < 4; ++i) o[n][i] = g[i] * sigmoidf_(g[i]) * up[i];
        }
        st_bf16x8(rowp, o[0], o[1]);
      }
  }
};
DI void run_gemm_gu(PG8_LAS unsigned char* lds, const bf16_t* A, const bf16_t* Bt, int M, int N, int K, const int* texp, size_t bstride, bf16_t* T, int ldt) {
  pg8::Gemm g{A, Bt, M, N, K, texp, bstride};
  pg8::StaticOrder S; S.init(M, N, (int)gridDim.x, obid());
  EpiGU E{T, ldt};
  pg8::gemm_phase<EpiGU, pg8::StaticOrder, true, true>(lds, g, S, E);
}
template <class F>
DI void run_gemm8(PG8_LAS unsigned char* lds, const bf16_t* A, const bf16_t* Bt, int M, int N, int K, const int* texp, size_t bstride, F f) {
  asm volatile("" : "+s"(K));
  pg8::Gemm g{A, Bt, M, N, K, texp, bstride};
  pg8::StaticOrder S; S.init(M, N, (int)gridDim.x, obid());
  pg8::EpiFn8<F> E{f};
  pg8::gemm_phase<pg8::EpiFn8<F>, pg8::StaticOrder, true, true>(lds, g, S, E);
}
DI void st_bf16x8(bf16_t* dst, const f32x4& a, const f32x4& b) { u32x4 w; w[0] = pk2(a[0], a[1]); w[1] = pk2(a[2], a[3]); w[2] = pk2(b[0], b[1]); w[3] = pk2(b[2], b[3]); *(u32x4*)dst = w; }
DI void st_bf16x4(bf16_t* dst, const f32x4& v) { u32x2 w; w[0] = pk2(v[0], v[1]); w[1] = pk2(v[2], v[3]); *(u32x2*)dst = w; }
DI f32x4 ld_bf16x4(const bf16_t* src) { const u32x2 w = *(const u32x2*)src; return (f32x4){__uint_as_float(w[0] << 16), __uint_as_float(w[0] & 0xffff0000u), __uint_as_float(w[1] << 16), __uint_as_float(w[1] & 0xffff0000u)}; }

DI void phase_u(const Params& p, int L, PG8_LAS unsigned char* lds) {
  bf16_t* u = (bf16_t*)(p.ws + O_R + R_U);
  run_gemm8(lds, (const bf16_t*)(p.ws + O_HB), (const bf16_t*)(p.ws + O_WIN + L * SZ_WIN), NTOK, UN, DM, nullptr, 0,
            [=](int row, int col, const f32x4& a, const f32x4& b) { if (col < UC) st_bf16x8(u + (size_t)row * UC + col, a, b); });
}
DI void phase_proj(const Params& p, int L, PG8_LAS unsigned char* lds) {
  bf16_t* PJ = (bf16_t*)(p.ws + O_R + R_PJ);
  run_gemm8(lds, (const bf16_t*)(p.ws + O_R + R_Y), (const bf16_t*)(p.ws + O_WBO) + (size_t)L * 4 * 1024 * 256, 4 * NTOK, 1024, 256,
           (const int*)(p.ws + O_SMALL + SM_TEXP4), (size_t)1024 * 256 * 2,
           [=](int row, int col, const f32x4& a, const f32x4& b) { st_bf16x8(PJ + (size_t)(row & (NTOK - 1)) * 4096 + (row >> 14) * 1024 + col, a, b); });
}
DI void phase_gate(const Params& p, int L, PG8_LAS unsigned char* lds) {
  bf16_t* PJ = (bf16_t*)(p.ws + O_R + R_PJ);
  run_gemm8(lds, (const bf16_t*)(p.ws + O_HB), (const bf16_t*)(p.ws + O_WIN + L * SZ_WIN) + (size_t)OFF_G * DM, NTOK, 4096, DM, nullptr, 0,
            [=](int row, int col, const f32x4& a, const f32x4& b) {
              bf16_t* q = PJ + (size_t)row * 4096 + col;
              float pj[8]; unpk8(pj, *(const u32x4*)q);
              f32x4 o0, o1;
#pragma unroll
              for (int i = 0; i < 4; ++i) { o0[i] = sigmoidf_(a[i]) * pj[i]; o1[i] = sigmoidf_(b[i]) * pj[4 + i]; }
              st_bf16x8(q, o0, o1);
            });
}
DI void phase_bsum(const Params& p) {
  const u32x4* GP = (const u32x4*)(p.ws + O_R + R_PJ); u32x4* M = (u32x4*)(p.ws + O_R + R_M);
  const int gtid = obid() * NTHR + otid(), gsz = gridDim.x * NTHR;
  for (int i = gtid; i < NTOK * 128; i += gsz) {
    const int tok = i >> 7, c8 = i & 127;
    float a[8];
#pragma unroll
    for (int k = 0; k < 8; ++k) a[k] = 0.f;
#pragma unroll
    for (int b = 0; b < 4; ++b) {
      const u32x4 w = GP[(size_t)tok * 512 + b * 128 + c8];
#pragma unroll
      for (int k = 0; k < 4; ++k) { a[2 * k] += __uint_as_float(w[k] << 16); a[2 * k + 1] += __uint_as_float(w[k] & 0xffff0000u); }
    }
    u32x4 o; o[0] = pk2(a[0], a[1]); o[1] = pk2(a[2], a[3]); o[2] = pk2(a[4], a[5]); o[3] = pk2(a[6], a[7]);
    M[i] = o;
  }
}
DI void phase_xadd(const Params& p, const bf16_t* A, const bf16_t* Bt, int K, PG8_LAS unsigned char* lds) {
  float* x = p.x;
  run_gemm(lds, A, Bt, NTOK, DM, K, nullptr, 0, [=](int row, int col, const f32x4& v) { float* xp = x + (size_t)row * DM + col; f32x4 xv = *(f32x4*)xp; xv += v; *(f32x4*)xp = xv; });
}
DI void phase_ffn_up(const Params& p, PG8_LAS unsigned char* lds) {
  run_gemm_gu(lds, (const bf16_t*)(p.ws + O_HB), (const bf16_t*)(p.ws + O_FGU), NTOK, 2 * FFD, DM, nullptr, 0, (bf16_t*)(p.ws + O_R + R_T), FFD);
}
DI void phase_moe_gather(const Params& p) {
  const int* cnt = (const int*)(p.ws + O_CTL) + CW_MOECNT;
  const int* list = (const int*)(p.ws + O_SMALL + SM_LIST);
  const float* gw = (const float*)(p.ws + O_SMALL + SM_GW);
  int* texp = (int*)(p.ws + O_SMALL + SM_TEXP);
  int* rowtok = (int*)(p.ws + O_SMALL + SM_ROWTOK);
  float* rowgw = (float*)(p.ws + O_SMALL + SM_ROWGW);
  int* slotrow = (int*)(p.ws + O_SMALL + SM_SLOTROW);
  const bf16_t* hb = (const bf16_t*)(p.ws + O_HB);
  bf16_t* xbuf = (bf16_t*)(p.ws + O_XBUF);
  const int lane = otid() & 63, wid = otid() >> 6;
  int c[8];
#pragma unroll
  for (int e = 0; e < 8; ++e) c[e] = cnt[e];
  int total = 0;
#pragma unroll
  for (int e = 0; e < 8; ++e) total += (c[e] + 255) & ~255;
  for (int row = obid() * 8 + wid; row < total; row += gridDim.x * 8) {
    int e = 0, s = 0, o = 0;
#pragma unroll
    for (int i = 0; i < 8; ++i) { const int pc = (c[i] + 255) & ~255; if (row >= o && row < o + pc) { e = i; s = row - o; } o += pc; }
    int ce = 0;
#pragma unroll
    for (int i = 0; i < 8; ++i) if (i == e) ce = c[i];
    const bool valid = s < ce;
    const int tok = valid ? list[(size_t)e * NTOK + s] : -1;
    u32x4 v0 = {0u, 0u, 0u, 0u}, v1 = {0u, 0u, 0u, 0u};
    if (valid) { const u32x4* src = (const u32x4*)(hb + (size_t)tok * DM); v0 = src[lane]; v1 = src[64 + lane]; }
    u32x4* dst = (u32x4*)(xbuf + (size_t)row * DM); dst[lane] = v0; dst[64 + lane] = v1;
    if (lane == 0) { rowtok[row] = tok; rowgw[row] = valid ? gw[(size_t)e * NTOK + s] : 0.f; if ((row & 255) == 0) texp[row >> 8] = e; if (valid) slotrow[(size_t)e * NTOK + s] = row; }
  }
}
DI int moe_rows(const Params& p) {
  const int* cnt = (const int*)(p.ws + O_CTL) + CW_MOECNT;
  int total = 0;
#pragma unroll
  for (int e = 0; e < 8; ++e) total += (cnt[e] + 255) & ~255;
  return total;
}
DI void phase_moe_up(const Params& p, PG8_LAS unsigned char* lds) {
  const int Mp = moe_rows(p);
  run_gemm_gu(lds, (const bf16_t*)(p.ws + O_XBUF), (const bf16_t*)(p.ws + O_MGU), Mp, 2 * FFE, DM, (const int*)(p.ws + O_SMALL + SM_TEXP), (size_t)2 * FFE * DM * 2, (bf16_t*)(p.ws + O_T2), FFE);
}
DI void phase_moe_down(const Params& p, PG8_LAS unsigned char* lds) {
  const int Mp = moe_rows(p);
  const float* rowgw = (const float*)(p.ws + O_SMALL + SM_ROWGW);
  bf16_t* Y2 = (bf16_t*)(p.ws + O_XBUF);
  run_gemm8(lds, (const bf16_t*)(p.ws + O_T2), (const bf16_t*)(p.ws + O_MD), Mp, DM, FFE, (const int*)(p.ws + O_SMALL + SM_TEXP), (size_t)DM * FFE * 2,
           [=](int row, int col, const f32x4& a, const f32x4& b) { const float w = rowgw[row]; st_bf16x8(Y2 + (size_t)row * DM + col, a * w, b * w); });
}
DI void phase_ple_proj(const Params& p, int L, PG8_LAS unsigned char* lds) {
  bf16_t* PJ2 = (bf16_t*)(p.ws + O_R + R_PJ2);
  run_gemm8(lds, (const bf16_t*)(p.ws + O_PB), (const bf16_t*)(p.ws + O_PP) + (size_t)L * 1024 * 256, NTOK, DM, 256, nullptr, 0,
           [=](int row, int col, const f32x4& a, const f32x4& b) { st_bf16x8(PJ2 + (size_t)row * DM + col, a, b); });
}
DI void phase_ple_gate(const Params& p, int L, PG8_LAS unsigned char* lds) {
  const bf16_t* PJ2 = (const bf16_t*)(p.ws + O_R + R_PJ2);
  float* x = p.x;
  run_gemm(lds, (const bf16_t*)(p.ws + O_HB), (const bf16_t*)(p.ws + O_PG) + (size_t)L * 1024 * 1024, NTOK, DM, DM, nullptr, 0,
           [=](int row, int col, const f32x4& v) {
             const f32x4 pj = ld_bf16x4(PJ2 + (size_t)row * DM + col);
             float* xp = x + (size_t)row * DM + col; f32x4 xv = *(f32x4*)xp;
             xv[0] += sigmoidf_(v[0]) * pj[0]; xv[1] += sigmoidf_(v[1]) * pj[1]; xv[2] += sigmoidf_(v[2]) * pj[2]; xv[3] += sigmoidf_(v[3]) * pj[3];
             *(f32x4*)xp = xv;
           });
}
DI void phase_final(const Params& p) {
  const int lane = otid() & 63, wid = otid() >> 6;
  const float* g = p.in[35];
  for (int row = obid() * 8 + wid; row < NTOK; row += gridDim.x * 8) {
    float* xr = p.x + (size_t)row * DM;
    f32x4 v[4]; float ss = 0.f;
#pragma unroll
    for (int j = 0; j < 4; ++j) { v[j] = *(const f32x4*)(xr + j * 256 + lane * 4); ss += v[j][0] * v[j][0] + v[j][1] * v[j][1] + v[j][2] * v[j][2] + v[j][3] * v[j][3]; }
    ss = wave_sum(ss);
    const float rstd = rsqrtf(ss * (1.0f / 1024.0f) + 1e-6f);
#pragma unroll
    for (int j = 0; j < 4; ++j) { const f32x4 gg = *(const f32x4*)(g + j * 256 + lane * 4); *(f32x4*)(xr + j * 256 + lane * 4) = v[j] * rstd * gg; }
  }
}


constexpr int RING_BYTES = 131072, LDSCTL_OFF = RING_BYTES, MISC_OFF = LDSCTL_OFF + 320, LDS_BYTES = 147456;
static_assert(2 * SCH * RS * 4 + 2 * SCH * 512 * 4 <= RING_BYTES, "scan LDS");

__global__ void __launch_bounds__(NTHR) __attribute__((target("no-packed-fp32-ops"))) fwd_megakernel(Params p) {
  extern __shared__ __attribute__((aligned(16))) unsigned char lds_raw[];
  LAS unsigned char* ldsp = (LAS unsigned char*)lds_raw;
  char* lds = (char*)lds_raw;
  for (int u = threadIdx.x; u < (LDS_BYTES - LDSCTL_OFF) / 4; u += NTHR) ((LAS unsigned*)(ldsp + LDSCTL_OFF))[u] = 0u;
  __syncthreads();
  XcdBarrier bar = xcd_barrier_post((unsigned*)(p.ws + O_CTL) + CW_BAR, (volatile LAS unsigned*)(ldsp + MISC_OFF) + 8);
#define GBAR() xcd_barrier(bar)
  phase0(olaunder(p), lds);
#if PROBE == 3
  GBAR(); phase0(olaunder(p), lds);
#endif
  if (p.x == nullptr) cg::this_grid().sync();
  GBAR();
  {
    constexpr int L = 0;
    norm_phase<false>(olaunder(p), p.in[2] + L * DM, nullptr);
    GBAR();
#if PROBE == 36
    if (L == 0) {
#pragma unroll 1
      for (int rep = 0; rep < 4; ++rep) { norm_phase<false>(olaunder(p), p.in[2] + L * DM, nullptr); GBAR(); }
    }
#endif
#if PROBE == 40
    if (L == 0) { for (int rep = 0; rep < 20; ++rep) GBAR(); }
#endif
    phase_u(olaunder(p), L, ldsp);
    GBAR();
#if PROBE == 31
    if (L == 0) { phase_u(olaunder(p), L, ldsp); GBAR(); }
#endif
    phase_prep2(olaunder(p), L, lds);
    GBAR();
#if PROBE == 2
    if (L == 0) { phase_prep2(olaunder(p), L, lds); GBAR(); }
#endif
#if PROBE == 21
    if (L == 0) { phase_prep<1>(olaunder(p), L, lds); GBAR(); }
#endif
#if PROBE == 22
    if (L == 0) { phase_prep<2>(olaunder(p), L, lds); GBAR(); }
#endif
#if PROBE == 23
    if (L == 0) { phase_prep<4>(olaunder(p), L, lds); GBAR(); }
#endif
    phase_mix(olaunder(p), L, lds, L, [&]() { xcd_barrier(bar); });
    GBAR();
#if PROBE == 1
    if (L == 0) { phase_mix(olaunder(p), L, lds, 2, [&]() { xcd_barrier(bar); }); GBAR(); }
#endif
#if PROBE == 5
    if (L == 0) { phase_mix_attn_only(olaunder(p), L, lds, 2); GBAR(); }
#endif
    phase_scanpost(olaunder(p), L);
    GBAR();
#if PROBE == 38
    if (L == 0) { phase_scanpost(olaunder(p), L); GBAR(); phase_scanpost(olaunder(p), L); GBAR(); }
#endif
    phase_proj(olaunder(p), L, ldsp);
    GBAR();
#if PROBE == 35
    if (L == 0) { phase_proj(olaunder(p), L, ldsp); GBAR(); }
#endif
    phase_gate(olaunder(p), L, ldsp);
    GBAR();
    phase_bsum(olaunder(p));
    GBAR();
#if PROBE == 37
    if (L == 0) {
#pragma unroll 1
      for (int rep = 0; rep < 4; ++rep) { phase_bsum(olaunder(p)); GBAR(); }
    }
#endif
    phase_xadd(olaunder(p), (const bf16_t*)(p.ws + O_R + R_M), (const bf16_t*)(p.ws + O_WOUT) + (size_t)L * 1024 * 1024, DM, ldsp);
    GBAR();
    if (L == 0) {
      norm_phase<false>(olaunder(p), p.in[3] + L * DM, nullptr);
      GBAR();
      phase_ffn_up(olaunder(p), ldsp);
      GBAR();
#if PROBE == 32
      phase_ffn_up(olaunder(p), ldsp); GBAR();
#endif
      phase_xadd(olaunder(p), (const bf16_t*)(p.ws + O_R + R_T), (const bf16_t*)(p.ws + O_FD), FFD, ldsp);
      GBAR();
    } else {
      norm_phase<true>(olaunder(p), p.in[3] + L * DM, p.in[29]);
      GBAR();
      phase_moe_gather(olaunder(p));
      GBAR();
      phase_moe_up(olaunder(p), ldsp);
      GBAR();
#if PROBE == 33
      phase_moe_up(olaunder(p), ldsp); GBAR();
#endif
#if PROBE == 34
      phase_moe_down(olaunder(p), ldsp); GBAR();
#endif
      phase_moe_down(olaunder(p), ldsp);
      GBAR();
    }
    if (L == 0) norm_phase<false>(olaunder(p), p.in[4] + L * DM, nullptr);
    else norm_phase<false, true>(olaunder(p), p.in[4] + L * DM, nullptr);
    convert_p(olaunder(p), L);
    GBAR();
    phase_ple_proj(olaunder(p), L, ldsp);
    GBAR();
    phase_ple_gate(olaunder(p), L, ldsp);
    GBAR();
    }
  {
    constexpr int L = 1;
    norm_phase<false>(olaunder(p), p.in[2] + L * DM, nullptr);
    GBAR();
#if PROBE == 36
    if (L == 0) {
#pragma unroll 1
      for (int rep = 0; rep < 4; ++rep) { norm_phase<false>(olaunder(p), p.in[2] + L * DM, nullptr); GBAR(); }
    }
#endif
#if PROBE == 40
    if (L == 0) { for (int rep = 0; rep < 20; ++rep) GBAR(); }
#endif
    phase_u(olaunder(p), L, ldsp);
    GBAR();
#if PROBE == 31
    if (L == 0) { phase_u(olaunder(p), L, ldsp); GBAR(); }
#endif
    phase_prep2(olaunder(p), L, lds);
    GBAR();
#if PROBE == 2
    if (L == 0) { phase_prep2(olaunder(p), L, lds); GBAR(); }
#endif
#if PROBE == 21
    if (L == 0) { phase_prep<1>(olaunder(p), L, lds); GBAR(); }
#endif
#if PROBE == 22
    if (L == 0) { phase_prep<2>(olaunder(p), L, lds); GBAR(); }
#endif
#if PROBE == 23
    if (L == 0) { phase_prep<4>(olaunder(p), L, lds); GBAR(); }
#endif
    phase_mix(olaunder(p), L, lds, L, [&]() { xcd_barrier(bar); });
    GBAR();
#if PROBE == 1
    if (L == 0) { phase_mix(olaunder(p), L, lds, 2, [&]() { xcd_barrier(bar); }); GBAR(); }
#endif
#if PROBE == 5
    if (L == 0) { phase_mix_attn_only(olaunder(p), L, lds, 2); GBAR(); }
#endif
    phase_scanpost(olaunder(p), L);
    GBAR();
#if PROBE == 38
    if (L == 0) { phase_scanpost(olaunder(p), L); GBAR(); phase_scanpost(olaunder(p), L); GBAR(); }
#endif
    phase_proj(olaunder(p), L, ldsp);
    GBAR();
#if PROBE == 35
    if (L == 0) { phase_proj(olaunder(p), L, ldsp); GBAR(); }
#endif
    phase_gate(olaunder(p), L, ldsp);
    GBAR();
    phase_bsum(olaunder(p));
    GBAR();
#if PROBE == 37
    if (L == 0) {
#pragma unroll 1
      for (int rep = 0; rep < 4; ++rep) { phase_bsum(olaunder(p)); GBAR(); }
    }
#endif
    phase_xadd(olaunder(p), (const bf16_t*)(p.ws + O_R + R_M), (const bf16_t*)(p.ws + O_WOUT) + (size_t)L * 1024 * 1024, DM, ldsp);
    GBAR();
    if (L == 0) {
      norm_phase<false>(olaunder(p), p.in[3] + L * DM, nullptr);
      GBAR();
      phase_ffn_up(olaunder(p), ldsp);
      GBAR();
#if PROBE == 32
      phase_ffn_up(olaunder(p), ldsp); GBAR();
#endif
      phase_xadd(olaunder(p), (const bf16_t*)(p.ws + O_R + R_T), (const bf16_t*)(p.ws + O_FD), FFD, ldsp);
      GBAR();
    } else {
      norm_phase<true>(olaunder(p), p.in[3] + L * DM, p.in[29]);
      GBAR();
      phase_moe_gather(olaunder(p));
      GBAR();
      phase_moe_up(olaunder(p), ldsp);
      GBAR();
#if PROBE == 33
      phase_moe_up(olaunder(p), ldsp); GBAR();
#endif
#if PROBE == 34
      phase_moe_down(olaunder(p), ldsp); GBAR();
#endif
      phase_moe_down(olaunder(p), ldsp);
      GBAR();
    }
    if (L == 0) norm_phase<false>(olaunder(p), p.in[4] + L * DM, nullptr);
    else norm_phase<false, true>(olaunder(p), p.in[4] + L * DM, nullptr);
    convert_p(olaunder(p), L);
    GBAR();
    phase_ple_proj(olaunder(p), L, ldsp);
    GBAR();
    phase_ple_gate(olaunder(p), L, ldsp);
    GBAR();
    }
  phase_final(olaunder(p));
}

extern "C" void kernel_launch(void* const* d_in, const int* in_sizes, int n_in, void* d_out, int out_size,
                              void* d_ws, size_t ws_size, hipStream_t stream) {
  static int grid_blocks = 0;
  if (grid_blocks == 0) {
    int dev = 0, cus = 0, per_cu = 0;
    (void)hipGetDevice(&dev);
    (void)hipDeviceGetAttribute(&cus, hipDeviceAttributeMultiprocessorCount, dev);
    if (hipFuncSetAttribute((const void*)fwd_megakernel, hipFuncAttributeMaxDynamicSharedMemorySize, LDS_BYTES) != hipSuccess) { fprintf(stderr, "hipFuncSetAttribute failed\n"); grid_blocks = -1; return; }
    (void)hipOccupancyMaxActiveBlocksPerMultiprocessor(&per_cu, (const void*)fwd_megakernel, NTHR, LDS_BYTES);
    if (per_cu < 1) { fprintf(stderr, "occupancy query says %d blocks per CU\n", per_cu); grid_blocks = -1; return; }
    grid_blocks = cus;
  }
  if (grid_blocks < 0) return;
  if (ws_size < WS_NEED) { fprintf(stderr, "workspace too small: %zu < %zu\n", ws_size, (size_t)WS_NEED); return; }
  (void)hipMemsetAsync((char*)d_ws + O_CTL, 0, CTL_BYTES, stream);
  Params p{};
  for (int i = 0; i < 36; ++i) p.in[i] = (const float*)d_in[i];
  p.x = (float*)d_out;
  p.ws = (char*)d_ws;
  void* args[] = {&p};
  hipError_t e = hipLaunchCooperativeKernel((void*)fwd_megakernel, dim3(grid_blocks), dim3(NTHR), args, LDS_BYTES, stream);
  if (e != hipSuccess) fprintf(stderr, "cooperative launch failed: %s (grid %d)\n", hipGetErrorString(e), grid_blocks);
}
```
